# Optimizing an MI355X kernel written in HIP

```python
import math
import jax
import jax.numpy as jnp
from jax import lax

D_MODEL = 1024
BATCH = 8
SEQ = 4096
DEPTH = 2

MEM_LEN = 256
EPS = 1e-6
NEG_INF = -1e30
FORCE_SCORE = 1e4

POOL_WIDTH = D_MODEL // 2
POOL_WINDOWS = (2, 4, 8, 16)
POOL_GROUPS = len(POOL_WINDOWS)
POOL_GROUP_DIM = POOL_WIDTH // POOL_GROUPS
DN_WIDTH = D_MODEL - POOL_WIDTH
DN_HEAD_DIM = 128
DN_HEADS = DN_WIDTH // DN_HEAD_DIM
DN_CONV = 4
DN_CHUNK = 64
A_SIZES = (POOL_WIDTH, DN_WIDTH, DN_WIDTH, DN_WIDTH, DN_WIDTH, DN_HEADS, DN_HEADS)
IN_A_COLS = POOL_WIDTH + 4 * DN_WIDTH + 2 * DN_HEADS

NSA_HEAD_DIM = 64
NSA_HEADS = D_MODEL // NSA_HEAD_DIM
NSA_GROUPS = 4
NSA_REP = NSA_HEADS // NSA_GROUPS
NSA_KV = NSA_GROUPS * NSA_HEAD_DIM
CMP_LEN = 32
CMP_STRIDE = 16
CMP_HIDDEN = 2 * NSA_HEAD_DIM
SLC_LEN = 64
SLC_TOP = 16
WINDOW = 512
NSA_QBLOCK = 32
C_SIZES = (D_MODEL, NSA_KV, NSA_KV, NSA_KV, NSA_KV, NSA_KV, NSA_KV, 3 * NSA_HEADS)
IN_C_COLS = D_MODEL + 6 * NSA_KV + 3 * NSA_HEADS

XA_HEADS = 4
XA_HEAD_DIM = D_MODEL // XA_HEADS
FF_DIM = 4 * D_MODEL

N_EVEN = (DEPTH + 1) // 2
N_ODD = DEPTH // 2

kernel_name = 'hybrid_pool_deltanet_nsa_trunk'


def rmsnorm(x, g):
    xf = x.astype(jnp.float32)
    y = xf * lax.rsqrt(jnp.mean(xf * xf, axis=-1, keepdims=True) + EPS)
    return (y * g.astype(jnp.float32)).astype(x.dtype)


def l2norm(x):
    return x * lax.rsqrt(jnp.sum(x * x, axis=-1, keepdims=True) + EPS)


def alibi_slopes(n_heads):
    h = jnp.arange(1, n_heads + 1, dtype=jnp.float32)
    return jnp.exp2(-8.0 * h / n_heads)


def split_cols(z, sizes):
    outs, start = [], 0
    for n in sizes:
        outs.append(z[..., start:start + n])
        start += n
    return outs


def causal_depthwise_conv(x, w):
    width, ch = w.shape
    return lax.conv_general_dilated(
        x, w[:, None, :].astype(x.dtype), window_strides=(1,), padding=[(width - 1, 0)],
        dimension_numbers=('NWC', 'WIO', 'NWC'), feature_group_count=ch)


def multiscale_pool(u, pool_w, pool_scale):
    b, s, _ = u.shape
    uf = u.astype(jnp.float32)
    pos1 = jnp.arange(1, s + 1, dtype=jnp.float32)[None, :, None]
    outs = []
    for gi, win in enumerate(POOL_WINDOWS):
        ug = uf[..., gi * POOL_GROUP_DIM:(gi + 1) * POOL_GROUP_DIM]
        csum = jnp.pad(jnp.cumsum(ug, axis=1), ((0, 0), (1, 0), (0, 0)))
        lower = jnp.pad(csum, ((0, 0), (win - 1, 0), (0, 0)))[:, :s]
        mean = (csum[:, 1:] - lower) / jnp.minimum(pos1, float(win))
        outs.append(mean - ug)
    y = jnp.stack(outs, axis=2)
    y = jnp.einsum('bsgc,gcd->bsgd', y, pool_w.astype(jnp.float32)).reshape(b, s, POOL_WIDTH)
    return (y * pool_scale.astype(jnp.float32)).astype(u.dtype)


def gated_delta_rule(q, k, v, beta, log_decay):
    b, h, s, dk = q.shape
    dv = v.shape[-1]
    c = DN_CHUNK
    n = s // c
    q = q * (dk ** -0.5)
    q, k, v = (a.reshape(b, h, n, c, a.shape[-1]) for a in (q, k, v))
    beta = beta.reshape(b, h, n, c)
    gc = jnp.cumsum(log_decay.reshape(b, h, n, c), axis=-1)
    causal = jnp.tril(jnp.ones((c, c), dtype=bool))
    strict = jnp.tril(jnp.ones((c, c), dtype=bool), -1)
    diff = gc[..., :, None] - gc[..., None, :]
    decay_mat = jnp.where(causal, jnp.exp(jnp.where(causal, diff, 0.0)), 0.0)
    kb = k * beta[..., None]
    a_low = jnp.where(strict, jnp.einsum('bhnid,bhnjd->bhnij', kb, k) * decay_mat, 0.0)
    eye = jnp.eye(c, dtype=jnp.float32)
    t_mat = lax.linalg.triangular_solve(eye + a_low, jnp.broadcast_to(eye, a_low.shape),
                                        left_side=True, lower=True, unit_diagonal=True)
    w_c = jnp.matmul(t_mat, kb * jnp.exp(gc)[..., None])
    u_c = jnp.matmul(t_mat, v * beta[..., None])
    attn = jnp.where(causal, jnp.einsum('bhnid,bhnjd->bhnij', q, k) * decay_mat, 0.0)

    def step(state, xs):
        q_i, k_i, w_i, u_i, attn_i, gc_i = xs
        v_new = u_i - jnp.matmul(w_i, state)
        o_i = jnp.matmul(q_i * jnp.exp(gc_i)[..., None], state) + jnp.matmul(attn_i, v_new)
        g_last = gc_i[..., -1]
        k_dec = k_i * jnp.exp(g_last[..., None] - gc_i)[..., None]
        state = state * jnp.exp(g_last)[..., None, None] + jnp.einsum('bhcd,bhce->bhde', k_dec, v_new)
        return state, o_i

    xs = tuple(jnp.moveaxis(a, 2, 0) for a in (q, k, w_c, u_c, attn, gc))
    state0 = jnp.zeros((b, h, dk, dv), jnp.float32)
    _, o = lax.scan(step, state0, xs)
    return jnp.moveaxis(o, 0, 2).reshape(b, h, s, dv)


def gated_deltanet(q, k, v, gate, beta_logit, alpha_logit, conv_w, a_log, dt_bias, o_norm):
    b, s, _ = q.shape
    f32 = jnp.float32
    qkv = jax.nn.silu(causal_depthwise_conv(jnp.concatenate([q, k, v], axis=-1), conv_w))
    qkv = jnp.transpose(qkv.astype(f32).reshape(b, s, 3, DN_HEADS, DN_HEAD_DIM), (2, 0, 3, 1, 4))
    qh, kh, vh = l2norm(qkv[0]), l2norm(qkv[1]), qkv[2]
    beta = jnp.transpose(jax.nn.sigmoid(beta_logit.astype(f32)), (0, 2, 1))
    log_decay = -jnp.exp(a_log.astype(f32)) * jax.nn.softplus(alpha_logit.astype(f32) + dt_bias.astype(f32))
    o = gated_delta_rule(qh, kh, vh, beta, jnp.transpose(log_decay, (0, 2, 1)))
    o = jnp.transpose(o, (0, 2, 1, 3))
    o = rmsnorm(o, o_norm) * jax.nn.silu(gate.astype(f32).reshape(b, s, DN_HEADS, DN_HEAD_DIM))
    return o.reshape(b, s, DN_WIDTH).astype(q.dtype)


def pool_delta_mixer(h, w_in, pool_w, pool_scale, conv_w, a_log, dt_bias, o_norm, w_out):
    z = h @ w_in
    u, q, k, v, gate, beta_l, alpha_l = split_cols(z, A_SIZES)
    y_pool = multiscale_pool(u, pool_w, pool_scale)
    y_dn = gated_deltanet(q, k, v, gate, beta_l, alpha_l, conv_w, a_log, dt_bias, o_norm)
    return jnp.concatenate([y_pool, y_dn], axis=-1) @ w_out


def compress_kv(kv, pe, w1, w2):
    b, s, g, d = kv.shape
    n_str = s // CMP_STRIDE
    per = CMP_LEN // CMP_STRIDE
    n_cmp = n_str - per + 1
    c = kv.reshape(b, n_str, CMP_STRIDE, g, d)
    blocks = jnp.concatenate([c[:, j:j + n_cmp] for j in range(per)], axis=2)
    blocks = blocks + pe[None, None, :, None, :].astype(kv.dtype)
    flat = jnp.transpose(blocks, (0, 1, 3, 2, 4)).reshape(b, n_cmp, g, CMP_LEN * d)
    return jax.nn.silu(flat @ w1) @ w2


def nsa_attention(q, kc, vc, ks, vs, kw, vw, gate_logit, pe_k, w1_k, w2_k, pe_v, w1_v, w2_v):
    b, s, _ = q.shape
    dt = q.dtype
    f32 = jnp.float32
    g_, r_, d_ = NSA_GROUPS, NSA_REP, NSA_HEAD_DIM
    qh = q.reshape(b, s, g_, r_, d_)
    ck = compress_kv(kc.reshape(b, s, g_, d_), pe_k, w1_k, w2_k)
    cv = compress_kv(vc.reshape(b, s, g_, d_), pe_v, w1_v, w2_v)
    n_cmp = ck.shape[1]
    n_slc = s // SLC_LEN
    top_n = min(SLC_TOP, n_slc)
    ks_b = jnp.transpose(ks.reshape(b, n_slc, SLC_LEN, g_, d_), (0, 3, 1, 2, 4))
    vs_b = jnp.transpose(vs.reshape(b, n_slc, SLC_LEN, g_, d_), (0, 3, 1, 2, 4))
    kw_p = jnp.pad(kw.reshape(b, s, g_, d_), ((0, 0), (WINDOW, 0), (0, 0), (0, 0)))
    vw_p = jnp.pad(vw.reshape(b, s, g_, d_), ((0, 0), (WINDOW, 0), (0, 0), (0, 0)))
    gates = jax.nn.sigmoid(gate_logit.astype(f32)).reshape(b, s, g_, r_, 3)
    slopes = alibi_slopes(NSA_HEADS).reshape(g_, r_)
    scale = d_ ** -0.5
    c_lo = jnp.arange(n_cmp) * CMP_STRIDE
    cmp_end = c_lo + CMP_LEN - 1
    s_lo = jnp.arange(n_slc) * SLC_LEN
    overlap = jnp.clip(jnp.minimum(c_lo[:, None] + CMP_LEN, s_lo[None, :] + SLC_LEN)
                       - jnp.maximum(c_lo[:, None], s_lo[None, :]), 0, None).astype(f32) / CMP_LEN
    blk = jnp.arange(n_slc)
    in_blk = jnp.arange(SLC_LEN)
    win_off = jnp.arange(WINDOW + NSA_QBLOCK)
    b_idx = jnp.arange(b)[:, None, None, None]
    g_idx = jnp.arange(g_)[None, :, None, None]

    def one_block(i):
        q0 = i * NSA_QBLOCK
        qb = lax.dynamic_slice_in_dim(qh, q0, NSA_QBLOCK, axis=1)
        t = q0 + jnp.arange(NSA_QBLOCK)
        dist_c = (t[:, None] - cmp_end[None, :]).astype(f32)
        ok_c = dist_c >= 0
        sc = jnp.einsum('bqgrd,bcgd->bgrqc', qb, ck).astype(f32) * scale
        sc = jnp.where(ok_c, sc - slopes[:, :, None, None] * dist_c, NEG_INF)
        p_cmp = jnp.where(jnp.any(ok_c, axis=-1)[:, None], jax.nn.softmax(sc, axis=-1), 0.0)
        o_cmp = jnp.einsum('bgrqc,bcgd->bqgrd', p_cmp.astype(dt), cv)
        imp = jnp.einsum('bgrqc,cn->bgqn', p_cmp, overlap)
        cur = t[:, None] // SLC_LEN
        forced = (blk[None, :] == 0) | (blk[None, :] == cur) | (blk[None, :] == cur - 1)
        causal_blk = blk[None, :] * SLC_LEN <= t[:, None]
        imp = jnp.where(forced, FORCE_SCORE, jnp.where(causal_blk, imp, -1.0))
        _, idx = lax.top_k(imp, top_n)
        kg = ks_b[b_idx, g_idx, idx]
        vg = vs_b[b_idx, g_idx, idx]
        dist_s = (t[None, None, :, None, None] - (idx[..., None] * SLC_LEN + in_blk)).astype(f32)
        ss = jnp.einsum('bqgrd,bgqnld->bgrqnl', qb, kg).astype(f32) * scale
        ss = jnp.where(dist_s[:, :, None] >= 0,
                       ss - slopes[None, :, :, None, None, None] * dist_s[:, :, None], NEG_INF)
        p_slc = jax.nn.softmax(ss.reshape(b, g_, r_, NSA_QBLOCK, -1), axis=-1).reshape(ss.shape)
        o_slc = jnp.einsum('bgrqnl,bgqnld->bqgrd', p_slc.astype(dt), vg)
        kwb = lax.dynamic_slice_in_dim(kw_p, q0, WINDOW + NSA_QBLOCK, axis=1)
        vwb = lax.dynamic_slice_in_dim(vw_p, q0, WINDOW + NSA_QBLOCK, axis=1)
        kpos = q0 - WINDOW + win_off
        dist_w = t[:, None] - kpos[None, :]
        ok_w = (dist_w >= 0) & (dist_w < WINDOW) & (kpos[None, :] >= 0)
        sw = jnp.einsum('bqgrd,bkgd->bgrqk', qb, kwb).astype(f32) * scale
        sw = jnp.where(ok_w, sw - slopes[:, :, None, None] * dist_w.astype(f32), NEG_INF)
        p_win = jax.nn.softmax(sw, axis=-1)
        o_win = jnp.einsum('bgrqk,bkgd->bqgrd', p_win.astype(dt), vwb)
        gb = lax.dynamic_slice_in_dim(gates, q0, NSA_QBLOCK, axis=1)
        o = gb[..., 0:1] * o_cmp + gb[..., 1:2] * o_slc + gb[..., 2:3] * o_win
        return o.reshape(b, NSA_QBLOCK, NSA_HEADS * d_).astype(dt)

    out = lax.map(one_block, jnp.arange(s // NSA_QBLOCK))
    return jnp.moveaxis(out, 0, 1).reshape(b, s, NSA_HEADS * d_)


def nsa_mixer(h, w_in, pe_k, w1_k, w2_k, pe_v, w1_v, w2_v, w_out):
    z = h @ w_in
    q, kc, vc, ks, vs, kw, vw, gl = split_cols(z, C_SIZES)
    return nsa_attention(q, kc, vc, ks, vs, kw, vw, gl, pe_k, w1_k, w2_k, pe_v, w1_v, w2_v) @ w_out


def memory_xattn(h, mem_h, wq, wk, wv, wo):
    b, s, _ = h.shape
    m = mem_h.shape[1]
    q = (h @ wq).reshape(b, s, XA_HEADS, XA_HEAD_DIM)
    k = (mem_h @ wk).reshape(b, m, XA_HEADS, XA_HEAD_DIM)
    v = (mem_h @ wv).reshape(b, m, XA_HEADS, XA_HEAD_DIM)
    sc = jnp.einsum('bshd,bmhd->bhsm', q, k).astype(jnp.float32) * (XA_HEAD_DIM ** -0.5)
    p = jax.nn.softmax(sc, axis=-1).astype(h.dtype)
    o = jnp.einsum('bhsm,bmhd->bshd', p, v).reshape(b, s, D_MODEL)
    return o @ wo


def squared_relu_mlp(h, w1, w2):
    return jnp.square(jax.nn.relu(h @ w1)) @ w2


def setup_inputs(seed: int = 0) -> dict:
    key = jax.random.key(seed)
    keys = iter(jax.random.split(key, 40))
    f32 = jnp.float32

    def dense(shape, fan_in):
        return jax.random.normal(next(keys), shape, f32) * (fan_in ** -0.5)

    def gain(shape):
        return 1.0 + 0.05 * jax.random.normal(next(keys), shape, f32)

    ne, no, dep = N_EVEN, N_ODD, DEPTH
    x = jax.random.normal(next(keys), (BATCH, SEQ, D_MODEL), f32)
    mem = jax.random.normal(next(keys), (BATCH, MEM_LEN, D_MODEL), f32)
    a_ln = gain((ne, D_MODEL))
    a_w_in = dense((ne, D_MODEL, IN_A_COLS), D_MODEL)
    a_pool_w = dense((ne, POOL_GROUPS, POOL_GROUP_DIM, POOL_GROUP_DIM), POOL_GROUP_DIM)
    a_pool_scale = gain((ne, POOL_WIDTH))
    a_conv_w = dense((ne, DN_CONV, 3 * DN_WIDTH), DN_CONV)
    a_a_log = jnp.log(jax.random.uniform(next(keys), (ne, DN_HEADS), f32, 1.0, 16.0))
    dt_init = jnp.exp(jax.random.uniform(next(keys), (ne, DN_HEADS), f32, math.log(1e-3), math.log(1e-1)))
    a_dt_bias = dt_init + jnp.log(-jnp.expm1(-dt_init))
    a_o_norm = gain((ne, DN_HEAD_DIM))
    a_w_out = dense((ne, D_MODEL, D_MODEL), D_MODEL)
    c_ln = gain((no, D_MODEL))
    c_w_in = dense((no, D_MODEL, IN_C_COLS), D_MODEL)
    c_pe_k = 0.1 * jax.random.normal(next(keys), (no, CMP_LEN, NSA_HEAD_DIM), f32)
    c_w1_k = dense((no, CMP_LEN * NSA_HEAD_DIM, CMP_HIDDEN), CMP_LEN * NSA_HEAD_DIM)
    c_w2_k = dense((no, CMP_HIDDEN, NSA_HEAD_DIM), CMP_HIDDEN)
    c_pe_v = 0.1 * jax.random.normal(next(keys), (no, CMP_LEN, NSA_HEAD_DIM), f32)
    c_w1_v = dense((no, CMP_LEN * NSA_HEAD_DIM, CMP_HIDDEN), CMP_LEN * NSA_HEAD_DIM)
    c_w2_v = dense((no, CMP_HIDDEN, NSA_HEAD_DIM), CMP_HIDDEN)
    c_w_out = dense((no, D_MODEL, D_MODEL), D_MODEL)
    xa_ln = gain((dep, D_MODEL))
    xa_mem_ln = gain((dep, D_MODEL))
    xa_wq = dense((dep, D_MODEL, D_MODEL), D_MODEL)
    xa_wk = dense((dep, D_MODEL, D_MODEL), D_MODEL)
    xa_wv = dense((dep, D_MODEL, D_MODEL), D_MODEL)
    xa_wo = dense((dep, D_MODEL, D_MODEL), D_MODEL)
    ff_ln = gain((dep, D_MODEL))
    ff_w1 = dense((dep, D_MODEL, FF_DIM), D_MODEL)
    ff_w2 = dense((dep, FF_DIM, D_MODEL), FF_DIM)
    final_ln = gain((D_MODEL,))
    return {'x': x, 'mem': mem,
            'a_ln': a_ln, 'a_w_in': a_w_in, 'a_pool_w': a_pool_w, 'a_pool_scale': a_pool_scale,
            'a_conv_w': a_conv_w, 'a_a_log': a_a_log, 'a_dt_bias': a_dt_bias, 'a_o_norm': a_o_norm,
            'a_w_out': a_w_out,
            'c_ln': c_ln, 'c_w_in': c_w_in, 'c_pe_k': c_pe_k, 'c_w1_k': c_w1_k, 'c_w2_k': c_w2_k,
            'c_pe_v': c_pe_v, 'c_w1_v': c_w1_v, 'c_w2_v': c_w2_v, 'c_w_out': c_w_out,
            'xa_ln': xa_ln, 'xa_mem_ln': xa_mem_ln, 'xa_wq': xa_wq, 'xa_wk': xa_wk, 'xa_wv': xa_wv,
            'xa_wo': xa_wo,
            'ff_ln': ff_ln, 'ff_w1': ff_w1, 'ff_w2': ff_w2, 'final_ln': final_ln}


def reference(x, mem,
              a_ln, a_w_in, a_pool_w, a_pool_scale, a_conv_w, a_a_log, a_dt_bias, a_o_norm, a_w_out,
              c_ln, c_w_in, c_pe_k, c_w1_k, c_w2_k, c_pe_v, c_w1_v, c_w2_v, c_w_out,
              xa_ln, xa_mem_ln, xa_wq, xa_wk, xa_wv, xa_wo,
              ff_ln, ff_w1, ff_w2, final_ln):
    for l in range(DEPTH):
        i = l // 2
        if l % 2 == 0:
            x = x + pool_delta_mixer(rmsnorm(x, a_ln[i]), a_w_in[i], a_pool_w[i], a_pool_scale[i],
                                     a_conv_w[i], a_a_log[i], a_dt_bias[i], a_o_norm[i], a_w_out[i])
        else:
            x = x + nsa_mixer(rmsnorm(x, c_ln[i]), c_w_in[i], c_pe_k[i], c_w1_k[i], c_w2_k[i],
                              c_pe_v[i], c_w1_v[i], c_w2_v[i], c_w_out[i])
        x = x + memory_xattn(rmsnorm(x, xa_ln[l]), rmsnorm(mem, xa_mem_ln[l]),
                             xa_wq[l], xa_wk[l], xa_wv[l], xa_wo[l])
        x = x + squared_relu_mlp(rmsnorm(x, ff_ln[l]), ff_w1[l], ff_w2[l])
    return rmsnorm(x, final_ln)
```

```cpp
#include <hip/hip_runtime.h>
#include <hip/hip_cooperative_groups.h>
#include <cstdio>
#include <cstdint>
namespace cg = cooperative_groups;
namespace pg8 {
#define PG8_LAS __attribute__((address_space(3)))
typedef unsigned short bf16_t;
typedef short bf16x8 __attribute__((ext_vector_type(8)));
typedef float f32x4 __attribute__((ext_vector_type(4)));
typedef unsigned u32x4 __attribute__((ext_vector_type(4)));
constexpr int BM = 256, BK = 64, HALF = 128, HTB = HALF * BK * 2  , STAGE_BYTES = 8 * HTB, NXCD = 8, WGM = 8;

__host__ __device__ __forceinline__ int lds_byte(int r, int c) { const int st = (r >> 4) * 2 + (c >> 5), rr = r & 15, cc = c & 31, ob = rr * 64 + cc * 2; return st * 1024 + (ob ^ (((ob >> 9) & 1) << 5)); }
__host__ __device__ __forceinline__ void stage_rc(int b, int& R, int& C) { const int st = b / 1024, sb = b % 1024, swz = sb ^ (((sb >> 9) & 1) << 5); R = (st >> 1) * 16 + swz / 64; C = (st & 1) * 32 + (swz % 64) / 2; }
__host__ __device__ __forceinline__ int perm32(int rho) { const int n = rho >> 4, i = rho & 15; return 8 * (i >> 2) + 4 * n + (i & 3); }

struct Unit { int pm, pn, ui; };
struct Gemm { const bf16_t* A; const bf16_t* Bt; int M, N, K; };

struct StaticOrder {
    int nM, nN, nwg, G, c;
    __host__ __device__ void init(int M, int N, int G_, int c_) { nM = M / BM; nN = N / BM; nwg = nM * nN; G = G_; c = c_; }
    __host__ __device__ bool next(int i, Unit& u) const {
        const long L = (long)i * G + c; if (L >= nwg) return false;
        int wgid = (int)L; { const int q = nwg / NXCD, r = nwg % NXCD, xcd = wgid % NXCD, off = wgid / NXCD; wgid = (xcd < r ? xcd * (q + 1) : r * (q + 1) + (xcd - r) * q) + off; }
        const int nig = WGM * nN, gid = wgid / nig, fm = gid * WGM, gsz = (nM - fm) < WGM ? (nM - fm) : WGM;
        u.pm = fm + ((wgid % nig) % gsz); u.pn = (wgid % nig) / gsz; u.ui = i; return true;
    }
    __device__ __forceinline__ void a_ready(const Unit&) const {}
    __device__ __forceinline__ void done(const Unit&) const {}
};
__device__ __forceinline__ unsigned cvt_pk_bf16(float lo, float hi) { unsigned r; asm volatile("v_cvt_pk_bf16_f32 %0, %1, %2" : "=v"(r) : "v"(lo), "v"(hi)); return r; }
typedef float f32x2 __attribute__((ext_vector_type(2)));
typedef float f32x2 __attribute__((ext_vector_type(2)));
template <class Epi, class Sched, bool ALIGN_EPI = false, bool SP2 = false>
__device__ __forceinline__ void gemm_phase(PG8_LAS unsigned char* lds, const Gemm g, const Sched& S, const Epi& E) {
    int tid_l = threadIdx.x; asm volatile("" : "+v"(tid_l));
    const int tid = tid_l, wid = __builtin_amdgcn_readfirstlane(tid >> 6), lane = tid & 63, wr = wid >> 2, wc = wid & 3, fr = lane & 15, fq = lane >> 4;
    const int K = g.K, nt = K / BK;
    unsigned voffA[2], voffB[2];
#pragma unroll
    for (int i = 0; i < 2; ++i) { int R, C; stage_rc(tid * 16 + i * 8192, R, C); const int Rb = Epi::PERM ? ((R & ~31) + perm32(R & 31)) : R;
        voffA[i] = (unsigned)(R * K + C) * 2u; voffB[i] = (unsigned)(Rb * K + C) * 2u; }
    const size_t kstep = (size_t)(BK * 2);
    const size_t hstep = (size_t)HALF * K * 2;
    const size_t tstep = 2 * hstep;
    const unsigned ldsw = (unsigned)wid * 1024u;
    const int aoff = lds_byte(wr * 64 + fr, fq * 8), boff = lds_byte(wc * 32 + fr, fq * 8);
#define PG8_SA(b, h) (((b) * 2 + (h)) * HTB)
#define PG8_SB(b, h) ((4 + (b) * 2 + (h)) * HTB)
#define PG8_STAGE(bufoff, gbase, voff) do { _Pragma("unroll") for (int _i = 0; _i < 2; ++_i) \
        __builtin_amdgcn_global_load_lds((const unsigned*)((const char*)(gbase) + (voff)[_i]), (PG8_LAS unsigned*)(lds + (bufoff) + ldsw + _i * 8192), 16, 0, 0); } while (0)
#define PG8_LDA(dst, b, h) do { _Pragma("unroll") for (int m = 0; m < 4; ++m) _Pragma("unroll") for (int k = 0; k < 2; ++k) dst[m][k] = *(const PG8_LAS bf16x8*)(lds + PG8_SA(b, h) + aoff + m * 2048 + k * 1024); } while (0)
#define PG8_LDB(dst, b, h) do { _Pragma("unroll") for (int n = 0; n < 2; ++n) _Pragma("unroll") for (int k = 0; k < 2; ++k) dst[n][k] = *(const PG8_LAS bf16x8*)(lds + PG8_SB(b, h) + boff + n * 2048 + k * 1024); } while (0)
#define PG8_MMA(ai, bj, At, Bt) do { __builtin_amdgcn_s_setprio(1); _Pragma("unroll") for (int m = 0; m < 4; ++m) _Pragma("unroll") for (int n = 0; n < 2; ++n) _Pragma("unroll") for (int k = 0; k < 2; ++k) \
        acc[ai][bj][m][n] = __builtin_amdgcn_mfma_f32_16x16x32_bf16(Bt[n][k], At[m][k], acc[ai][bj][m][n], 0, 0, 0); __builtin_amdgcn_s_setprio(0); } while (0)
#define PG8_WAIT_V(n) asm volatile("s_waitcnt vmcnt(" #n ")" ::: "memory")
#define PG8_WAIT_L(n) asm volatile("s_waitcnt lgkmcnt(" #n ")" ::: "memory")
#define PG8_BAR __builtin_amdgcn_s_barrier()
#define PG8_SCHED __builtin_amdgcn_sched_barrier(0)
    Unit cur, nxt; int ui = 0;
    if (!S.next(0, cur)) return;
    f32x4 acc[2][2][4][2];
#pragma unroll
    for (int a = 0; a < 2; ++a)
#pragma unroll
        for (int b = 0; b < 2; ++b)
#pragma unroll
            for (int m = 0; m < 4; ++m)
#pragma unroll
                for (int n = 0; n < 2; ++n) acc[a][b][m][n] = (f32x4){0.f, 0.f, 0.f, 0.f};
    bf16x8 At[4][2], B0[2][2], B1[2][2];
    const char* cA = (const char*)g.A + (size_t)cur.pm * tstep; const char* cB = (const char*)g.Bt + (size_t)cur.pn * tstep;
    S.a_ready(cur);
    if constexpr (SP2) {
        PG8_STAGE(PG8_SB(0, 0), cB, voffB); PG8_STAGE(PG8_SB(0, 1), cB + hstep, voffB); PG8_STAGE(PG8_SA(0, 0), cA, voffA); PG8_STAGE(PG8_SA(0, 1), cA + hstep, voffA);
        if (wr == 1) PG8_BAR;
        PG8_WAIT_V(2); PG8_BAR;
        PG8_STAGE(PG8_SB(1, 0), cB + kstep, voffB); PG8_STAGE(PG8_SA(1, 0), cA + kstep, voffA); PG8_STAGE(PG8_SB(1, 1), cB + hstep + kstep, voffB);
        PG8_WAIT_V(6); PG8_BAR;
    } else {
        PG8_STAGE(PG8_SB(0, 0), cB, voffB); PG8_STAGE(PG8_SA(0, 0), cA, voffA); PG8_STAGE(PG8_SB(0, 1), cB + hstep, voffB); PG8_STAGE(PG8_SA(0, 1), cA + hstep, voffA);
        if (wr == 1) PG8_BAR;
        PG8_WAIT_V(4); PG8_BAR;
        PG8_STAGE(PG8_SB(1, 0), cB + kstep, voffB); PG8_STAGE(PG8_SA(1, 0), cA + kstep, voffA); PG8_STAGE(PG8_SB(1, 1), cB + hstep + kstep, voffB);
        PG8_WAIT_V(6); PG8_BAR;
    }
    for (;;) {
        const bool has_next = S.next(ui + 1, nxt);
        const char* nA = has_next ? (const char*)g.A + (size_t)nxt.pm * tstep : cA; const char* nB = has_next ? (const char*)g.Bt + (size_t)nxt.pn * tstep : cB;
        for (int t = 0; t < nt; t += 2) {
            const bool last = (t == nt - 2);
            const char* a1 = cA + (size_t)(t + 1) * kstep;
            const char* a2 = last ? nA : cA + (size_t)(t + 2) * kstep; const char* b2 = last ? nB : cB + (size_t)(t + 2) * kstep;
            const char* a3 = a2 + kstep; const char* b3 = b2 + kstep;
            if (last && has_next) S.a_ready(nxt);
            if constexpr (SP2) {
            PG8_LDB(B0, 0, 0); PG8_LDB(B1, 0, 1); PG8_SCHED; PG8_LDA(At, 0, 0); PG8_STAGE(PG8_SA(1, 1), a1 + hstep, voffA);
            PG8_WAIT_V(8); PG8_WAIT_L(0); PG8_BAR; PG8_MMA(0, 0, At, B0); PG8_MMA(0, 1, At, B1); PG8_BAR; PG8_SCHED;
            PG8_LDA(At, 0, 1); PG8_STAGE(PG8_SB(0, 0), b2, voffB); PG8_STAGE(PG8_SB(0, 1), b2 + hstep, voffB); PG8_STAGE(PG8_SA(0, 0), a2, voffA);
            PG8_WAIT_V(8); PG8_WAIT_L(0); PG8_BAR; PG8_MMA(1, 0, At, B0); PG8_MMA(1, 1, At, B1); PG8_BAR; PG8_SCHED;
            PG8_LDB(B0, 1, 0); PG8_LDB(B1, 1, 1); PG8_SCHED; PG8_LDA(At, 1, 0); PG8_STAGE(PG8_SA(0, 1), a2 + hstep, voffA);
            PG8_WAIT_V(8); PG8_WAIT_L(0); PG8_BAR; PG8_MMA(0, 0, At, B0); PG8_MMA(0, 1, At, B1); PG8_BAR; PG8_SCHED;
            PG8_LDA(At, 1, 1); PG8_STAGE(PG8_SB(1, 0), b3, voffB); PG8_STAGE(PG8_SB(1, 1), b3 + hstep, voffB); PG8_STAGE(PG8_SA(1, 0), a3, voffA);
            PG8_WAIT_V(8); PG8_WAIT_L(0); PG8_BAR; PG8_MMA(1, 0, At, B0); PG8_MMA(1, 1, At, B1); PG8_BAR; PG8_SCHED;
            } else {
            PG8_LDB(B0, 0, 0); PG8_SCHED; PG8_LDA(At, 0, 0); PG8_STAGE(PG8_SA(1, 1), a1 + hstep, voffA);
            PG8_WAIT_L(8); PG8_BAR; PG8_WAIT_L(0); PG8_MMA(0, 0, At, B0); PG8_BAR; PG8_SCHED;
            PG8_LDB(B1, 0, 1); PG8_STAGE(PG8_SB(0, 0), b2, voffB);
            PG8_BAR; PG8_WAIT_L(0); PG8_MMA(0, 1, At, B1); PG8_BAR;
            PG8_LDA(At, 0, 1); PG8_STAGE(PG8_SA(0, 0), a2, voffA);
            PG8_BAR; PG8_WAIT_L(0); PG8_MMA(1, 0, At, B0); PG8_BAR; PG8_SCHED;
            PG8_STAGE(PG8_SB(0, 1), b2 + hstep, voffB);
            PG8_WAIT_V(6); PG8_BAR; PG8_MMA(1, 1, At, B1); PG8_BAR;
            PG8_LDB(B0, 1, 0); PG8_SCHED; PG8_LDA(At, 1, 0); PG8_STAGE(PG8_SA(0, 1), a2 + hstep, voffA);
            PG8_WAIT_L(8); PG8_BAR; PG8_WAIT_L(0); PG8_MMA(0, 0, At, B0); PG8_BAR; PG8_SCHED;
            PG8_LDB(B1, 1, 1); PG8_STAGE(PG8_SB(1, 0), b3, voffB);
            PG8_BAR; PG8_WAIT_L(0); PG8_MMA(0, 1, At, B1); PG8_BAR;
            PG8_LDA(At, 1, 1); PG8_STAGE(PG8_SA(1, 0), a3, voffA);
            PG8_BAR; PG8_WAIT_L(0); PG8_MMA(1, 0, At, B0); PG8_BAR; PG8_SCHED;
            PG8_STAGE(PG8_SB(1, 1), b3 + hstep, voffB);
            PG8_WAIT_V(6); PG8_BAR; PG8_MMA(1, 1, At, B1); PG8_BAR;
            }
        }
        if constexpr (ALIGN_EPI) { if (wr == 0) PG8_BAR; }
        if constexpr (!Epi::AFTER_DRAIN) { E(acc, cur, wr, wc, fr, fq); S.done(cur); }
        if (!has_next) break;
#pragma unroll
        for (int a = 0; a < 2; ++a)
#pragma unroll
            for (int b = 0; b < 2; ++b)
#pragma unroll
                for (int m = 0; m < 4; ++m)
#pragma unroll
                    for (int n = 0; n < 2; ++n) acc[a][b][m][n] = (f32x4){0.f, 0.f, 0.f, 0.f};
        cur = nxt; cA = nA; cB = nB; ++ui;
        if constexpr (ALIGN_EPI) { if (wr == 1) PG8_BAR; }
    }
    PG8_WAIT_V(0);
    if constexpr (!ALIGN_EPI) { if (wr == 0) PG8_BAR; }
    PG8_BAR;
    if constexpr (Epi::AFTER_DRAIN) { E.fused(acc, cur, wr, wc, fr, fq, lds, wid, lane); S.done(cur); }
#undef PG8_SA
#undef PG8_SB
#undef PG8_STAGE
#undef PG8_LDA
#undef PG8_LDB
#undef PG8_MMA
#undef PG8_WAIT_V
#undef PG8_WAIT_L
#undef PG8_BAR
#undef PG8_SCHED
}
}
namespace pg8 {
__device__ __forceinline__ float row_rstd(const float* ss, int row) {
    const f32x4* p = (const f32x4*)(ss + (size_t)row * 16);
    const f32x4 a = p[0], b = p[1], c = p[2], d = p[3];
    const float s = (((a[0] + a[1]) + (a[2] + a[3])) + ((b[0] + b[1]) + (b[2] + b[3]))) + (((c[0] + c[1]) + (c[2] + c[3])) + ((d[0] + d[1]) + (d[2] + d[3])));
    return rsqrtf(s * (1.0f / 1024.0f) + 1e-6f);
}
__device__ __forceinline__ u32x4 pack8(f32x4 v0, f32x4 v1) { u32x4 w; w.x = cvt_pk_bf16(v0[0], v0[1]); w.y = cvt_pk_bf16(v0[2], v0[3]); w.z = cvt_pk_bf16(v1[0], v1[1]); w.w = cvt_pk_bf16(v1[2], v1[3]); return w; }

template <int ACT  > struct EpiBf {
    static constexpr bool PERM = true, AFTER_DRAIN = false;
    bf16_t* O; int ldc; const PG8_LAS float* rs; float mul;
    __device__ __forceinline__ void operator()(const f32x4 (&acc)[2][2][4][2], const Unit& u, int wr, int wc, int fr, int fq) const {
        const int row0 = u.pm * BM + wr * 64 + fr, col0 = u.pn * BM + wc * 32 + 8 * fq;
#pragma unroll
        for (int ai = 0; ai < 2; ++ai)
#pragma unroll
            for (int m = 0; m < 4; ++m) { const int row = row0 + ai * HALF + m * 16; const float sc = rs ? mul * rs[256 * u.ui + ai * HALF + wr * 64 + m * 16 + fr] : mul; bf16_t* rowp = O + (size_t)row * ldc + col0;
#pragma unroll
                for (int bj = 0; bj < 2; ++bj) { f32x4 v0 = acc[ai][bj][m][0] * sc, v1 = acc[ai][bj][m][1] * sc;
                    if (ACT == 1) {
#pragma unroll
                        for (int j = 0; j < 4; ++j) { const float a = fmaxf(v0[j], 0.f), b = fmaxf(v1[j], 0.f); v0[j] = a * a; v1[j] = b * b; } }
                    *(u32x4*)(rowp + bj * HALF) = pack8(v0, v1); } }
    }
};
struct EpiF32 {
    static constexpr bool PERM = true, AFTER_DRAIN = false;
    float* C; int ldc;
    __device__ __forceinline__ void operator()(const f32x4 (&acc)[2][2][4][2], const Unit& u, int wr, int wc, int fr, int fq) const {
        const int row0 = u.pm * BM + wr * 64 + fr, col0 = u.pn * BM + wc * 32 + 8 * fq;
#pragma unroll
        for (int ai = 0; ai < 2; ++ai)
#pragma unroll
            for (int m = 0; m < 4; ++m) { float* rowp = C + (size_t)(row0 + ai * HALF + m * 16) * ldc + col0;
#pragma unroll
                for (int bj = 0; bj < 2; ++bj) { *(f32x4*)(rowp + bj * HALF) = acc[ai][bj][m][0]; *(f32x4*)(rowp + bj * HALF + 4) = acc[ai][bj][m][1]; } }
    }
};
template <bool F32RES> struct EpiRes {
    static constexpr bool PERM = true, AFTER_DRAIN = false;
    bf16_t* xh; float* ssout; const float* r32;
    __device__ __forceinline__ void operator()(const f32x4 (&acc)[2][2][4][2], const Unit& u, int wr, int wc, int fr, int fq) const {
        const int row0 = u.pm * BM + wr * 64 + fr, col0 = u.pn * BM + wc * 32 + 8 * fq;
#pragma unroll
        for (int ai = 0; ai < 2; ++ai) {
            u32x4 pre[4][2]; f32x4 pf[4][2][2];
#pragma unroll
            for (int m = 0; m < 4; ++m)
#pragma unroll
                for (int bj = 0; bj < 2; ++bj) { const size_t off = (size_t)(row0 + ai * HALF + m * 16) * 1024 + col0 + bj * HALF;
                    if (F32RES) { pf[m][bj][0] = *(const f32x4*)(r32 + off); pf[m][bj][1] = *(const f32x4*)(r32 + off + 4); } else pre[m][bj] = *(const u32x4*)(xh + off); }
            asm volatile("" ::: "memory"); __builtin_amdgcn_sched_barrier(0);
#pragma unroll
            for (int m = 0; m < 4; ++m) { const int row = row0 + ai * HALF + m * 16; float q = 0.f;
#pragma unroll
                for (int bj = 0; bj < 2; ++bj) { const size_t off = (size_t)row * 1024 + col0 + bj * HALF; f32x4 r0, r1;
                    if (F32RES) { r0 = pf[m][bj][0]; r1 = pf[m][bj][1]; }
                    else { const u32x4 p = pre[m][bj];
                        r0 = (f32x4){__uint_as_float(p.x << 16), __uint_as_float(p.x & 0xffff0000u), __uint_as_float(p.y << 16), __uint_as_float(p.y & 0xffff0000u)};
                        r1 = (f32x4){__uint_as_float(p.z << 16), __uint_as_float(p.z & 0xffff0000u), __uint_as_float(p.w << 16), __uint_as_float(p.w & 0xffff0000u)}; }
                    const f32x4 v0 = acc[ai][bj][m][0] + r0, v1 = acc[ai][bj][m][1] + r1;
                    q += ((v0[0] * v0[0] + v0[1] * v0[1]) + (v0[2] * v0[2] + v0[3] * v0[3])) + ((v1[0] * v1[0] + v1[1] * v1[1]) + (v1[2] * v1[2] + v1[3] * v1[3]));
                    *(u32x4*)(xh + off) = pack8(v0, v1); }
                q += __shfl_xor(q, 16); q += __shfl_xor(q, 32);
                if (fq == 0) ssout[(size_t)row * 16 + u.pn * 4 + wc] = q; }
            asm volatile("" ::: "memory"); __builtin_amdgcn_sched_barrier(0); }
    }
};
struct EpiInA {
    static constexpr bool PERM = true, AFTER_DRAIN = false;
    bf16_t* z; float* ba; const PG8_LAS float* rs;
    __device__ __forceinline__ void operator()(const f32x4 (&acc)[2][2][4][2], const Unit& u, int wr, int wc, int fr, int fq) const {
        const int row0 = u.pm * BM + wr * 64 + fr, col0 = u.pn * BM + wc * 32 + 8 * fq;
#pragma unroll
        for (int ai = 0; ai < 2; ++ai)
#pragma unroll
            for (int m = 0; m < 4; ++m) { const int row = row0 + ai * HALF + m * 16; const float sc = rs[256 * u.ui + ai * HALF + wr * 64 + m * 16 + fr];
                if (u.pn < 10) { bf16_t* rowp = z + (size_t)row * 2560 + col0;
#pragma unroll
                    for (int bj = 0; bj < 2; ++bj) *(u32x4*)(rowp + bj * HALF) = pack8(acc[ai][bj][m][0] * sc, acc[ai][bj][m][1] * sc);
                } else if (wc == 0 && fq == 0) { *(f32x4*)(ba + (size_t)row * 8) = acc[ai][0][m][0] * sc; *(f32x4*)(ba + (size_t)row * 8 + 4) = acc[ai][0][m][1] * sc; } }
    }
};
struct EpiInC {
    static constexpr bool PERM = true, AFTER_DRAIN = false;
    bf16_t* q; bf16_t* kv; float* gates; const PG8_LAS float* rs;
    __device__ __forceinline__ void operator()(const f32x4 (&acc)[2][2][4][2], const Unit& u, int wr, int wc, int fr, int fq) const {
        const int row0 = u.pm * BM + wr * 64 + fr, col0 = u.pn * BM + wc * 32 + 8 * fq;
#pragma unroll
        for (int ai = 0; ai < 2; ++ai)
#pragma unroll
            for (int m = 0; m < 4; ++m) { const int row = row0 + ai * HALF + m * 16; const float sc = rs[256 * u.ui + ai * HALF + wr * 64 + m * 16 + fr];
                if (u.pn < 4) { bf16_t* rowp = q + (size_t)row * 1024 + col0;
#pragma unroll
                    for (int bj = 0; bj < 2; ++bj) *(u32x4*)(rowp + bj * HALF) = pack8(acc[ai][bj][m][0] * sc, acc[ai][bj][m][1] * sc);
                } else if (u.pn < 10) { const int b = row >> 12, s = row & 4095;
#pragma unroll
                    for (int bj = 0; bj < 2; ++bj) { const int cp = col0 + bj * HALF - 1024, kind = cp >> 8, g = (cp >> 6) & 3, d = cp & 63;
                        *(u32x4*)(kv + (size_t)kind * ((size_t)32768 * 256) + ((size_t)((b * 4 + g) * 4096 + s)) * 64 + d) = pack8(acc[ai][bj][m][0] * sc, acc[ai][bj][m][1] * sc); }
                } else { const int cl = wc * 32 + 8 * fq; if (cl < 48) { *(f32x4*)(gates + (size_t)row * 48 + cl) = acc[ai][0][m][0] * sc; *(f32x4*)(gates + (size_t)row * 48 + cl + 4) = acc[ai][0][m][1] * sc; } } }
    }
};
}
#define LAS __attribute__((address_space(3)))
typedef unsigned short bf16;
typedef float f32x4 __attribute__((ext_vector_type(4)));
typedef unsigned v4u __attribute__((ext_vector_type(4)));
typedef unsigned v2u __attribute__((ext_vector_type(2)));
typedef short bf16x8 __attribute__((ext_vector_type(8)));
typedef float f32x16 __attribute__((ext_vector_type(16)));
typedef short v4i16 __attribute__((ext_vector_type(4)));
typedef float f32x2_t __attribute__((ext_vector_type(2))); typedef __bf16 bf16x2_t __attribute__((ext_vector_type(2)));
__device__ __forceinline__ unsigned cvtpk(float lo, float hi) { f32x2_t v = {lo, hi}; bf16x2_t b = __builtin_convertvector(v, bf16x2_t); return __builtin_bit_cast(unsigned, b); }

constexpr int NWAVES = 8, NTHR = 512;
constexpr int T = 32768, SEQ = 4096, DM = 1024, FF = 4096;
constexpr int LDS_BYTES = 147456;
constexpr float EPS = 1e-6f;

enum { I_X = 0, I_MEM, I_A_LN, I_A_WIN, I_A_POOLW, I_A_POOLS, I_A_CONV, I_A_ALOG, I_A_DTB, I_A_ONORM, I_A_WOUT,
       I_C_LN, I_C_WIN, I_C_PEK, I_C_W1K, I_C_W2K, I_C_PEV, I_C_W1V, I_C_W2V, I_C_WOUT,
       I_XA_LN, I_XA_MLN, I_XA_WQ, I_XA_WK, I_XA_WV, I_XA_WO, I_FF_LN, I_FF_W1, I_FF_W2, I_FLN, N_IN };

constexpr size_t MiB = (size_t)1 << 20;
constexpr size_t WS_AIN = 0, WS_AOUT = 6 * MiB, WS_CIN = 8 * MiB, WS_COUT = 14 * MiB, WS_XQ = 16 * MiB, WS_XKV = 20 * MiB, WS_XO = 28 * MiB;
constexpr size_t WS_F1 = 32 * MiB, WS_F2 = 48 * MiB, WS_CMPK = 64 * MiB, WS_CMPV = 64 * MiB + 512 * 1024, WS_CBIAS = 65 * MiB;
constexpr size_t WS_MEMH = 66 * MiB, WS_MEMKV = 74 * MiB, WS_SS = 90 * MiB, WS_BA = 92 * MiB, WS_GATES = 93 * MiB, WS_CK = 99 * MiB, WS_CV = 100 * MiB;
constexpr size_t WS_P01K = 101 * MiB, WS_P01V = 109 * MiB, WS_POOLW = 117 * MiB;
constexpr size_t WS_Z = 120 * MiB, WS_Y = 280 * MiB, WS_QXA = 344 * MiB, WS_XH = 408 * MiB, WS_HMID = 120 * MiB, WS_END = 489 * MiB;
constexpr size_t KV_KIND = (size_t)T * 256;

struct Params { const float* in[N_IN]; float* out; unsigned char* ws; int ph_lo, ph_hi; };

__device__ __forceinline__ float bf2f(unsigned v) { return __uint_as_float(v << 16); }
__device__ __forceinline__ unsigned f2bf(float f) { unsigned u = __float_as_uint(f); return (u + 0x7fffu + ((u >> 16) & 1u)) >> 16; }
__device__ __forceinline__ unsigned pk2(float lo, float hi) { return f2bf(lo) | (f2bf(hi) << 16); }
__device__ __forceinline__ float wave_sum(float v) {
#pragma unroll
    for (int o = 1; o < 64; o <<= 1) v += __shfl_xor(v, o);
    return v;
}
__device__ __forceinline__ float wave_max(float v) {
#pragma unroll
    for (int o = 1; o < 64; o <<= 1) v = fmaxf(v, __shfl_xor(v, o));
    return v;
}
__device__ __forceinline__ float silu_f(float x) { return x / (1.f + __expf(-x)); }
__device__ __forceinline__ float sigmoid_f(float x) { return 1.f / (1.f + __expf(-x)); }
#define LDS_WAIT() asm volatile("s_waitcnt lgkmcnt(0)" ::: "memory")

__device__ __forceinline__ void transpose_item(const float* W, int K, int N, int ld, const float* gain, bf16* WT, int row_off, LAS float* scr, int item, int lane) {
    const int nblk = N / 32, kb = item / nblk, nb = item % nblk, k0 = 64 * kb, n0 = 32 * nb;
#pragma unroll
    for (int i = 0; i < 8; ++i) { const int kk = 8 * i + (lane >> 3), nn = (lane & 7) * 4; f32x4 v = *(const f32x4*)(W + (size_t)(k0 + kk) * ld + n0 + nn); if (gain) v = v * gain[k0 + kk];
        scr[kk * 33 + nn] = v.x; scr[kk * 33 + nn + 1] = v.y; scr[kk * 33 + nn + 2] = v.z; scr[kk * 33 + nn + 3] = v.w; }
    LDS_WAIT();
    const int c = lane & 7;
#pragma unroll
    for (int j = 0; j < 4; ++j) { const int n = (lane >> 3) + 8 * j; const LAS float* s = scr + (8 * c) * 33 + n;
        v4u o; o.x = pk2(s[0 * 33], s[1 * 33]); o.y = pk2(s[2 * 33], s[3 * 33]); o.z = pk2(s[4 * 33], s[5 * 33]); o.w = pk2(s[6 * 33], s[7 * 33]);
        *(v4u*)(WT + (size_t)(row_off + n0 + n) * K + k0 + 8 * c) = o; }
    LDS_WAIT();
}
#define TJOB(W_, K_, N_, LD_, G_, WT_, RO_) { const int ni_ = ((K_) / 64) * ((N_) / 32); if (r < ni_) { transpose_item((W_), (K_), (N_), (LD_), (G_), (WT_), (RO_), scr, r, lane); continue; } r -= ni_; }

__device__ __forceinline__ void phase_prologue(const Params& P, LAS unsigned char* lds) {
    int tid_l = threadIdx.x; asm volatile("" : "+v"(tid_l)); const int tid = tid_l, lane = tid & 63, wave = tid >> 6;
    const int gw = blockIdx.x * NWAVES + wave, NGW = gridDim.x * NWAVES;
    unsigned char* ws = P.ws;
    LAS float* scr = (LAS float*)(lds + wave * 16384);
    constexpr int NITEMS = 1280 + 512 + 1280 + 512 + 2 * 512 + 4 * 512 + 2 * 512 + 2 * 2048 + 2 * 2048 + 4 * 64;
    for (int it = gw; it < NITEMS; it += NGW) {
        int r = it;
        TJOB(P.in[I_A_WIN], 1024, 2560, 2568, P.in[I_A_LN], (bf16*)(ws + WS_AIN), 0)
        TJOB(P.in[I_A_WOUT], 1024, 1024, 1024, nullptr, (bf16*)(ws + WS_AOUT), 0)
        TJOB(P.in[I_C_WIN], 1024, 2560, 2608, P.in[I_C_LN], (bf16*)(ws + WS_CIN), 0)
        TJOB(P.in[I_C_WOUT], 1024, 1024, 1024, nullptr, (bf16*)(ws + WS_COUT), 0)
        TJOB(P.in[I_XA_WQ], 1024, 1024, 1024, P.in[I_XA_LN], (bf16*)(ws + WS_XQ), 0)
        TJOB(P.in[I_XA_WQ] + 1048576, 1024, 1024, 1024, P.in[I_XA_LN] + 1024, (bf16*)(ws + WS_XQ) + 1048576, 0)
        TJOB(P.in[I_XA_WK], 1024, 1024, 1024, P.in[I_XA_MLN], (bf16*)(ws + WS_XKV), 0)
        TJOB(P.in[I_XA_WV], 1024, 1024, 1024, P.in[I_XA_MLN], (bf16*)(ws + WS_XKV), 1024)
        TJOB(P.in[I_XA_WK] + 1048576, 1024, 1024, 1024, P.in[I_XA_MLN] + 1024, (bf16*)(ws + WS_XKV) + 2097152, 0)
        TJOB(P.in[I_XA_WV] + 1048576, 1024, 1024, 1024, P.in[I_XA_MLN] + 1024, (bf16*)(ws + WS_XKV) + 2097152, 1024)
        TJOB(P.in[I_XA_WO], 1024, 1024, 1024, nullptr, (bf16*)(ws + WS_XO), 0)
        TJOB(P.in[I_XA_WO] + 1048576, 1024, 1024, 1024, nullptr, (bf16*)(ws + WS_XO) + 1048576, 0)
        TJOB(P.in[I_FF_W1], 1024, 4096, 4096, P.in[I_FF_LN], (bf16*)(ws + WS_F1), 0)
        TJOB(P.in[I_FF_W1] + 4194304, 1024, 4096, 4096, P.in[I_FF_LN] + 1024, (bf16*)(ws + WS_F1) + 4194304, 0)
        TJOB(P.in[I_FF_W2], 4096, 1024, 1024, nullptr, (bf16*)(ws + WS_F2), 0)
        TJOB(P.in[I_FF_W2] + 4194304, 4096, 1024, 1024, nullptr, (bf16*)(ws + WS_F2) + 4194304, 0)
        TJOB(P.in[I_C_W1K], 1024, 128, 128, nullptr, (bf16*)(ws + WS_CMPK), 0)
        TJOB(P.in[I_C_W1K] + 131072, 1024, 128, 128, nullptr, (bf16*)(ws + WS_CMPK), 128)
        TJOB(P.in[I_C_W1V], 1024, 128, 128, nullptr, (bf16*)(ws + WS_CMPV), 0)
        TJOB(P.in[I_C_W1V] + 131072, 1024, 128, 128, nullptr, (bf16*)(ws + WS_CMPV), 128)
    }
    const int gt = blockIdx.x * NTHR + tid, NGT = gridDim.x * NTHR;
    for (int i = gt; i < 256 * 1024; i += NGT) { const int k = i >> 8, j = i & 255;
        { float v = 0.f; if (j < 8) v = P.in[I_A_LN][k] * P.in[I_A_WIN][(size_t)k * 2568 + 2560 + j]; ((bf16*)(ws + WS_AIN))[(size_t)(2560 + j) * 1024 + k] = (bf16)f2bf(v); }
        { float v = 0.f; if (j < 48) v = P.in[I_C_LN][k] * P.in[I_C_WIN][(size_t)k * 2608 + 2560 + j]; ((bf16*)(ws + WS_CIN))[(size_t)(2560 + j) * 1024 + k] = (bf16)f2bf(v); } }
    for (int i = gt; i < 4 * 128 * 128; i += NGT) { const int g = i >> 14, d = (i >> 7) & 127, c = i & 127; ((bf16*)(ws + WS_POOLW))[i] = (bf16)f2bf(P.in[I_A_POOLW][(size_t)g * 16384 + c * 128 + d] * P.in[I_A_POOLS][g * 128 + d]); }
    if (gw < 256) { const int n = gw & 127; const float* pe = gw < 128 ? P.in[I_C_PEK] : P.in[I_C_PEV]; const float* w1 = gw < 128 ? P.in[I_C_W1K] : P.in[I_C_W1V];
        float s = 0.f;
#pragma unroll 8
        for (int j = 0; j < 32; ++j) { const int i = lane + 64 * j; s += pe[i] * w1[(size_t)i * 128 + n]; }
        s = wave_sum(s); if (lane == 0) ((float*)(ws + WS_CBIAS))[gw] = s; }
    { bf16* xh = (bf16*)(ws + WS_XH); float* ss = (float*)(ws + WS_SS);
      for (int m = gw; m < T; m += NGW) { const f32x4* xr = (const f32x4*)(P.in[I_X] + (size_t)m * DM) + lane; f32x4 v[4]; float s = 0.f;
#pragma unroll
          for (int j = 0; j < 4; ++j) { v[j] = xr[64 * j]; s += (v[j].x * v[j].x + v[j].y * v[j].y) + (v[j].z * v[j].z + v[j].w * v[j].w); }
          s = wave_sum(s);
          v2u* o8 = (v2u*)(xh + (size_t)m * DM) + lane;
#pragma unroll
          for (int j = 0; j < 4; ++j) { v2u w; w.x = pk2(v[j].x, v[j].y); w.y = pk2(v[j].z, v[j].w); o8[64 * j] = w; }
          if (lane < 16) ss[(size_t)m * 16 + lane] = lane == 0 ? s : 0.f; } }
    { bf16* mh = (bf16*)(ws + WS_MEMH);
      for (int m = gw; m < 2048; m += NGW) { const f32x4* xr = (const f32x4*)(P.in[I_MEM] + (size_t)m * DM) + lane; f32x4 v[4]; float s = 0.f;
#pragma unroll
          for (int j = 0; j < 4; ++j) { v[j] = xr[64 * j]; s += (v[j].x * v[j].x + v[j].y * v[j].y) + (v[j].z * v[j].z + v[j].w * v[j].w); }
          const float rs = rsqrtf(wave_sum(s) * (1.f / DM) + EPS);
          v2u* o8 = (v2u*)(mh + (size_t)m * DM) + lane;
#pragma unroll
          for (int j = 0; j < 4; ++j) { v2u w; w.x = pk2(v[j].x * rs, v[j].y * rs); w.y = pk2(v[j].z * rs, v[j].w * rs); o8[64 * j] = w; } } }
}

__device__ __forceinline__ void phase_final(const Params& P) {
    const int tid = threadIdx.x, lane = tid & 63, wave = tid >> 6;
    const int gw = blockIdx.x * NWAVES + wave, NGW = gridDim.x * NWAVES;
    const float* ss = (const float*)(P.ws + WS_SS); const bf16* xh = (const bf16*)(P.ws + WS_XH);
    for (int m = gw; m < T; m += NGW) { f32x4* orow = (f32x4*)(P.out + (size_t)m * DM); const f32x4* gr = (const f32x4*)P.in[I_FLN];
        const float rs = pg8::row_rstd(ss, m);
#pragma unroll
        for (int j = 0; j < 2; ++j) { const v4u p = *(const v4u*)(xh + (size_t)m * DM + (j * 64 + lane) * 8); const f32x4 g0 = gr[(j * 64 + lane) * 2], g1 = gr[(j * 64 + lane) * 2 + 1];
            orow[(j * 64 + lane) * 2] = (f32x4){bf2f(p.x & 0xffff) * rs * g0.x, bf2f(p.x >> 16) * rs * g0.y, bf2f(p.y & 0xffff) * rs * g0.z, bf2f(p.y >> 16) * rs * g0.w};
            orow[(j * 64 + lane) * 2 + 1] = (f32x4){bf2f(p.z & 0xffff) * rs * g1.x, bf2f(p.z >> 16) * rs * g1.y, bf2f(p.w & 0xffff) * rs * g1.z, bf2f(p.w >> 16) * rs * g1.w}; } }
}
__device__ __forceinline__ void phase_pool(const Params& P, LAS unsigned char* lds) {
    int tid_l = threadIdx.x; asm volatile("" : "+v"(tid_l)); const int tid = tid_l, lane = tid & 63, wave = tid >> 6; const int g = blockIdx.x & 3, win = 2 << g;
    const bf16* z = (const bf16*)(P.ws + WS_Z); bf16* y = (bf16*)(P.ws + WS_Y);
    LAS unsigned short* ur = (LAS unsigned short*)lds;
    LAS unsigned char* yp = lds + 20480;
    const int nt = wave & 3, mt = wave >> 2, q = lane & 31, h = lane >> 5;
    bf16x8 bfr[8];
    { const bf16* bt = (const bf16*)(P.ws + WS_POOLW) + (size_t)g * 16384 + (size_t)(nt * 32 + q) * 128 + 8 * h;
#pragma unroll
      for (int ks = 0; ks < 8; ++ks) bfr[ks] = *(const bf16x8*)(bt + 16 * ks); }
    v4u pre[3];
#define POOL_LOAD(it_) { const int t0_ = ((it_) >> 2) * 64, s0_ = t0_ & (SEQ - 1); _Pragma("unroll") for (int j = 0; j < 3; ++j) { const int p = tid + 512 * j, row = p >> 4, pc = p & 15; pre[j] = (v4u){0u, 0u, 0u, 0u}; \
        if (p < 79 * 16 && s0_ + row - 15 >= 0) pre[j] = *(const v4u*)(z + (size_t)(t0_ + row - 15) * 2560 + g * 128 + pc * 8); } }
    int it = blockIdx.x; if (it < 2048) POOL_LOAD(it)
    for (; it < 2048; it += gridDim.x) { const int t0 = (it >> 2) * 64, s0 = t0 & (SEQ - 1);
#pragma unroll
        for (int j = 0; j < 3; ++j) { const int p = tid + 512 * j; if (p < 79 * 16) *(LAS v4u*)(lds + (p >> 4) * 256 + (p & 15) * 16) = pre[j]; }
        __syncthreads();
        if (it + (int)gridDim.x < 2048) POOL_LOAD(it + (int)gridDim.x)
        { const int c = tid & 127, tq = tid >> 7; float sum = 0.f;
          for (int j = 1; j < win; ++j) sum += bf2f(ur[(tq * 16 + 15 - j) * 128 + c]);
#pragma unroll 4
          for (int i = 0; i < 16; ++i) { const int tl = tq * 16 + i, s = s0 + tl; const float u = bf2f(ur[(tl + 15) * 128 + c]); sum += u;
              const float cnt = (float)((s + 1 < win) ? s + 1 : win);
              *(LAS unsigned short*)(yp + tl * 272 + c * 2) = (unsigned short)f2bf(sum / cnt - u);
              sum -= bf2f(ur[(tl + 16 - win) * 128 + c]); } }
        __syncthreads();
        { f32x16 acc;
#pragma unroll
          for (int r = 0; r < 16; ++r) acc[r] = 0.f;
          LAS const unsigned char* ap = yp + (mt * 32 + q) * 272 + h * 16;
#pragma unroll
          for (int ks = 0; ks < 8; ++ks) acc = __builtin_amdgcn_mfma_f32_32x32x16_bf16(bfr[ks], *(const LAS bf16x8*)(ap + ks * 32), acc, 0, 0, 0);
          bf16* yo = y + (size_t)(t0 + mt * 32 + q) * DM + g * 128 + nt * 32 + 4 * h;
#pragma unroll
          for (int a = 0; a < 4; ++a) { v2u w; w.x = cvtpk(acc[4 * a], acc[4 * a + 1]); w.y = cvtpk(acc[4 * a + 2], acc[4 * a + 3]); *(v2u*)(yo + 8 * a) = w; } }
    }
#undef POOL_LOAD
    __syncthreads();
}
__device__ __forceinline__ void dn_naive_item(const Params& P, LAS unsigned char* lds, int item) {
    int tid_l = threadIdx.x; asm volatile("" : "+v"(tid_l)); const int tid = tid_l, lane = tid & 63, wave = tid >> 6; const int b = item >> 2, h = item & 3;
    const bf16* z = (const bf16*)(P.ws + WS_Z); bf16* y = (bf16*)(P.ws + WS_Y); const float* ba = (const float*)(P.ws + WS_BA);
    LAS float* qs = (LAS float*)lds; LAS float* ks = qs + 8192; LAS float* vs = ks + 8192; LAS float* ot = vs + 8192; LAS float* bet = ot + 8192; LAS float* egs = bet + 64;
    const float* cw = P.in[I_A_CONV];
    const float a_exp = __expf(P.in[I_A_ALOG][h]), dtb = P.in[I_A_DTB][h];
    float Sreg[32];
#pragma unroll
    for (int i = 0; i < 32; ++i) Sreg[i] = 0.f;
    const int kq = tid & 3, dv = tid >> 2;
    for (int n = 0; n < 64; ++n) {
        const int sb = n * 64; const size_t rb = (size_t)b * SEQ;
        for (int idx = tid; idx < 64 * 384; idx += NTHR) { const int tl = idx / 384, cc = idx % 384, part = cc >> 7, d = cc & 127; const int ch = part * 512 + h * 128 + d, s = sb + tl; float a = 0.f;
#pragma unroll
            for (int kk = 0; kk < 4; ++kk) { const int sp = s - 3 + kk; if (sp >= 0) a += cw[kk * 1536 + ch] * bf2f(z[(rb + sp) * 2560 + 512 + ch]); }
            qs[part * 8192 + tl * 128 + d] = silu_f(a); }
        if (tid < 64) { const size_t t = rb + sb + tid; const float bl = ba[t * 8 + h], al = ba[t * 8 + 4 + h] + dtb; const float sp = al > 20.f ? al : log1pf(__expf(al));
            bet[tid] = sigmoid_f(bl); egs[tid] = __expf(-a_exp * sp); }
        __syncthreads();
        for (int r = wave * 16; r < wave * 16 + 16; ++r) { LAS float* row = qs + (r >> 6) * 8192 + (r & 63) * 128; const float a = row[lane], c2 = row[lane + 64];
            const float sc = rsqrtf(wave_sum(a * a + c2 * c2) + EPS); row[lane] = a * sc; row[lane + 64] = c2 * sc; }
        __syncthreads();
        for (int tl = 0; tl < 64; ++tl) {
            float kr[32], kS = 0.f;
#pragma unroll
            for (int i = 0; i < 8; ++i) { const f32x4 v = *(const LAS f32x4*)(ks + tl * 128 + kq * 32 + 4 * i); kr[4 * i] = v.x; kr[4 * i + 1] = v.y; kr[4 * i + 2] = v.z; kr[4 * i + 3] = v.w; }
#pragma unroll
            for (int i = 0; i < 32; ++i) kS += kr[i] * Sreg[i];
            kS += __shfl_xor(kS, 1); kS += __shfl_xor(kS, 2);
            const float e = egs[tl], cf = bet[tl] * (vs[tl * 128 + dv] - e * kS);
            float o = 0.f;
#pragma unroll
            for (int i = 0; i < 8; ++i) { const f32x4 qv = *(const LAS f32x4*)(qs + tl * 128 + kq * 32 + 4 * i);
                Sreg[4 * i] = e * Sreg[4 * i] + kr[4 * i] * cf; Sreg[4 * i + 1] = e * Sreg[4 * i + 1] + kr[4 * i + 1] * cf; Sreg[4 * i + 2] = e * Sreg[4 * i + 2] + kr[4 * i + 2] * cf; Sreg[4 * i + 3] = e * Sreg[4 * i + 3] + kr[4 * i + 3] * cf;
                o += (qv.x * Sreg[4 * i] + qv.y * Sreg[4 * i + 1]) + (qv.z * Sreg[4 * i + 2] + qv.w * Sreg[4 * i + 3]); }
            o += __shfl_xor(o, 1); o += __shfl_xor(o, 2);
            if (kq == 0) ot[tl * 128 + dv] = o * 0.08838834764831845f;
        }
        __syncthreads();
        for (int tl = wave * 8; tl < wave * 8 + 8; ++tl) { const float a = ot[tl * 128 + lane], c2 = ot[tl * 128 + lane + 64]; const float rs = rsqrtf(wave_sum(a * a + c2 * c2) * (1.f / 128.f) + EPS);
            const size_t t = rb + sb + tl; const float g0 = bf2f(z[t * 2560 + 2048 + h * 128 + lane]), g1 = bf2f(z[t * 2560 + 2048 + h * 128 + lane + 64]);
            y[t * DM + 512 + h * 128 + lane] = (bf16)f2bf(a * rs * P.in[I_A_ONORM][lane] * silu_f(g0));
            y[t * DM + 512 + h * 128 + lane + 64] = (bf16)f2bf(c2 * rs * P.in[I_A_ONORM][lane + 64] * silu_f(g1)); }
        __syncthreads();
    }
}

__device__ __forceinline__ void phase_xatt_naive(const Params& P, LAS unsigned char* lds, int l) {
    int tid_l = threadIdx.x; asm volatile("" : "+v"(tid_l)); const int tid = tid_l, lane = tid & 63, wave = tid >> 6;
    const int gw = blockIdx.x * NWAVES + wave, NGW = gridDim.x * NWAVES;
    const bf16* qx = (const bf16*)(P.ws + WS_QXA); const bf16* kv = (const bf16*)(P.ws + WS_MEMKV) + (size_t)l * 2048 * 2048; bf16* y = (bf16*)(P.ws + WS_Y);
    LAS float* qf = (LAS float*)(lds + wave * 8192); LAS float* pw = qf + 1024;
    for (int t = gw; t < T; t += NGW) { const int b = t >> 12;
        { const v4u a = *(const v4u*)(qx + (size_t)t * DM + lane * 16), c = *(const v4u*)(qx + (size_t)t * DM + lane * 16 + 8); LAS float* d = qf + lane * 16;
          d[0] = bf2f(a.x & 0xffff); d[1] = bf2f(a.x >> 16); d[2] = bf2f(a.y & 0xffff); d[3] = bf2f(a.y >> 16); d[4] = bf2f(a.z & 0xffff); d[5] = bf2f(a.z >> 16); d[6] = bf2f(a.w & 0xffff); d[7] = bf2f(a.w >> 16);
          d[8] = bf2f(c.x & 0xffff); d[9] = bf2f(c.x >> 16); d[10] = bf2f(c.y & 0xffff); d[11] = bf2f(c.y >> 16); d[12] = bf2f(c.z & 0xffff); d[13] = bf2f(c.z >> 16); d[14] = bf2f(c.w & 0xffff); d[15] = bf2f(c.w >> 16); }
        LDS_WAIT();
        for (int hh = 0; hh < 4; ++hh) { float sc[4];
#pragma unroll
            for (int i = 0; i < 4; ++i) { const bf16* kr = kv + (size_t)(b * 256 + lane + 64 * i) * 2048 + hh * 256; float s = 0.f;
                for (int c8 = 0; c8 < 32; ++c8) { const v4u kk = *(const v4u*)(kr + c8 * 8); const f32x4 q0 = *(const LAS f32x4*)(qf + hh * 256 + c8 * 8), q1 = *(const LAS f32x4*)(qf + hh * 256 + c8 * 8 + 4);
                    s += (q0.x * bf2f(kk.x & 0xffff) + q0.y * bf2f(kk.x >> 16)) + (q0.z * bf2f(kk.y & 0xffff) + q0.w * bf2f(kk.y >> 16)) + (q1.x * bf2f(kk.z & 0xffff) + q1.y * bf2f(kk.z >> 16)) + (q1.z * bf2f(kk.w & 0xffff) + q1.w * bf2f(kk.w >> 16)); }
                sc[i] = s * 0.0625f; }
            const float mx = wave_max(fmaxf(fmaxf(sc[0], sc[1]), fmaxf(sc[2], sc[3])));
            float ps = 0.f;
#pragma unroll
            for (int i = 0; i < 4; ++i) { sc[i] = __expf(sc[i] - mx); ps += sc[i]; }
            const float inv = 1.f / wave_sum(ps);
#pragma unroll
            for (int i = 0; i < 4; ++i) pw[lane + 64 * i] = sc[i] * inv;
            LDS_WAIT();
            float o0 = 0.f, o1 = 0.f, o2 = 0.f, o3 = 0.f; const bf16* vb = kv + (size_t)(b * 256) * 2048 + 1024 + hh * 256 + lane * 4;
            for (int j = 0; j < 256; ++j) { const v2u vv = *(const v2u*)(vb + (size_t)j * 2048); const float p = pw[j];
                o0 += p * bf2f(vv.x & 0xffff); o1 += p * bf2f(vv.x >> 16); o2 += p * bf2f(vv.y & 0xffff); o3 += p * bf2f(vv.y >> 16); }
            v2u w; w.x = pk2(o0, o1); w.y = pk2(o2, o3); *(v2u*)(y + (size_t)t * DM + hh * 256 + lane * 4) = w;
            LDS_WAIT();
        }
    }
}

__device__ __forceinline__ void cmpfin_bg(const Params& P, LAS unsigned char* lds, int kvs, int bg) {
    const int tid = threadIdx.x, lane = tid & 63, wave = tid >> 6;
    const float* p01 = (const float*)(P.ws + (kvs ? WS_P01V : WS_P01K)) + (size_t)bg * 256 * 256; const float* bias = (const float*)(P.ws + WS_CBIAS) + kvs * 128; const float* w2 = P.in[kvs ? I_C_W2V : I_C_W2K];
    bf16* outp = (bf16*)(P.ws + (kvs ? WS_CV : WS_CK)) + (size_t)bg * 256 * 64;
    LAS float* hb = (LAS float*)(lds + wave * 1024);
    unsigned w2p[64];
#pragma unroll
    for (int j = 0; j < 64; ++j) w2p[j] = pk2(w2[(2 * j) * 64 + lane], w2[(2 * j + 1) * 64 + lane]);
    for (int c = wave; c < 255; c += NWAVES) {
#pragma unroll
        for (int i = 0; i < 2; ++i) { const int j = lane + 64 * i; hb[j] = silu_f(p01[(size_t)c * 256 + j] + p01[(size_t)(c + 1) * 256 + 128 + j] + bias[j]); }
        LDS_WAIT();
        float o0 = 0.f, o1 = 0.f;
#pragma unroll
        for (int j = 0; j < 128; j += 4) { if ((j & 31) == 0) __builtin_amdgcn_sched_barrier(0); const f32x4 hv = *(const LAS f32x4*)(hb + j); const unsigned wa = w2p[j >> 1], wb = w2p[(j >> 1) + 1];
            o0 += hv.x * bf2f(wa & 0xffff) + hv.z * bf2f(wb & 0xffff); o1 += hv.y * __uint_as_float(wa & 0xffff0000u) + hv.w * __uint_as_float(wb & 0xffff0000u); }
        outp[(size_t)c * 64 + lane] = (bf16)f2bf(o0 + o1);
        LDS_WAIT();
    }
}
__device__ __forceinline__ void dot4(const bf16* kr, const LAS float* qf, float (&s)[4]) {
    s[0] = s[1] = s[2] = s[3] = 0.f;
#pragma unroll
    for (int c8 = 0; c8 < 8; ++c8) { const v4u kk = *(const v4u*)(kr + c8 * 8);
        const float k0 = bf2f(kk.x & 0xffff), k1 = bf2f(kk.x >> 16), k2 = bf2f(kk.y & 0xffff), k3 = bf2f(kk.y >> 16), k4 = bf2f(kk.z & 0xffff), k5 = bf2f(kk.z >> 16), k6 = bf2f(kk.w & 0xffff), k7 = bf2f(kk.w >> 16);
#pragma unroll
        for (int r = 0; r < 4; ++r) { const f32x4 q0 = *(const LAS f32x4*)(qf + r * 64 + c8 * 8), q1 = *(const LAS f32x4*)(qf + r * 64 + c8 * 8 + 4);
            s[r] += ((q0.x * k0 + q0.y * k1) + (q0.z * k2 + q0.w * k3)) + ((q1.x * k4 + q1.y * k5) + (q1.z * k6 + q1.w * k7)); } }
}
__device__ __forceinline__ void phase_nsa_naive(const Params& P, LAS unsigned char* lds) {
    int tid_l = threadIdx.x; asm volatile("" : "+v"(tid_l)); const int tid = tid_l, lane = tid & 63, wave = tid >> 6;
    const int gw = blockIdx.x * NWAVES + wave, NGW = gridDim.x * NWAVES;
    const bf16* qb = (const bf16*)(P.ws + WS_Z); const bf16* kvb = qb + (size_t)T * 1024;
    const bf16* ck = (const bf16*)(P.ws + WS_CK); const bf16* cv = (const bf16*)(P.ws + WS_CV);
    const float* gates = (const float*)(P.ws + WS_GATES); bf16* y = (bf16*)(P.ws + WS_Y);
    LAS float* qf = (LAS float*)(lds + wave * 8192); LAS float* pc = qf + 256; LAS float* ps = pc + 1024;
    for (int it = gw; it < 4 * T; it += NGW) {
        const int t = it & 4095, g = (it >> 12) & 3, b = it >> 14; const size_t tg = (size_t)b * SEQ + t; const int bg = b * 4 + g;
        float slope[4];
#pragma unroll
        for (int r = 0; r < 4; ++r) slope[r] = exp2f(-0.5f * (float)(g * 4 + r + 1));
#pragma unroll
        for (int r = 0; r < 4; ++r) qf[r * 64 + lane] = bf2f(qb[tg * 1024 + g * 256 + r * 64 + lane]);
        LDS_WAIT();
        const int ncv = t >= 31 ? ((t - 31) >> 4) + 1 : 0;
#pragma unroll 1
        for (int cc = 0; cc < 4; ++cc) { const int c = lane + 64 * cc; float s[4] = {0.f, 0.f, 0.f, 0.f};
            if (cc * 64 < ncv) dot4(ck + ((size_t)bg * 256 + c) * 64, qf, s);
#pragma unroll
            for (int r = 0; r < 4; ++r) pc[r * 256 + c] = c < ncv ? s[r] * 0.125f - slope[r] * (float)(t - (16 * c + 31)) : -INFINITY; }
        LDS_WAIT();
#pragma unroll 1
        for (int r = 0; r < 4; ++r) { float v0 = pc[r * 256 + lane], v1 = pc[r * 256 + lane + 64], v2 = pc[r * 256 + lane + 128], v3 = pc[r * 256 + lane + 192];
            const float mx = wave_max(fmaxf(fmaxf(v0, v1), fmaxf(v2, v3)));
            v0 = lane < ncv ? __expf(v0 - mx) : 0.f; v1 = lane + 64 < ncv ? __expf(v1 - mx) : 0.f; v2 = lane + 128 < ncv ? __expf(v2 - mx) : 0.f; v3 = lane + 192 < ncv ? __expf(v3 - mx) : 0.f;
            const float sm = wave_sum((v0 + v1) + (v2 + v3)); const float inv = ncv > 0 ? 1.f / sm : 0.f;
            pc[r * 256 + lane] = v0 * inv; pc[r * 256 + lane + 64] = v1 * inv; pc[r * 256 + lane + 128] = v2 * inv; pc[r * 256 + lane + 192] = v3 * inv; }
        LDS_WAIT();
        float osum[4];
        { float ocmp[4] = {0.f, 0.f, 0.f, 0.f};
          const bf16* cvp = cv + (size_t)bg * 256 * 64 + lane;
#pragma unroll 2
          for (int c = 0; c < ncv; ++c) { const float v = bf2f(cvp[c * 64]);
#pragma unroll
              for (int r = 0; r < 4; ++r) ocmp[r] += pc[r * 256 + c] * v; }
#pragma unroll
          for (int r = 0; r < 4; ++r) osum[r] = sigmoid_f(gates[tg * 48 + (g * 4 + r) * 3]) * ocmp[r]; }
        unsigned long long mask;
        { const int n = lane, cur = t >> 6; float imp = 0.f;
#pragma unroll
          for (int r = 0; r < 4; ++r) { const f32x4 v = *(const LAS f32x4*)(pc + r * 256 + 4 * n); imp += v.x + v.y + v.z + 0.5f * v.w; if (n > 0) imp += 0.5f * pc[r * 256 + 4 * n - 1]; }
          const bool forced = (n == 0) || (n == cur) || (n == cur - 1);
          const float val = forced ? 1e4f : (n <= cur ? imp : -1.f);
          int rank = 0;
#pragma unroll 4
          for (int m = 0; m < 64; ++m) { const float vm = __shfl(val, m); rank += (vm > val || (vm == val && m < n)) ? 1 : 0; }
          mask = __ballot(rank < 16 && n <= cur); }
#pragma unroll 1
        for (int br = 0; br < 2; ++br) {
            const bf16* kp = kvb + (size_t)(br == 0 ? 2 : 4) * KV_KIND + (size_t)bg * SEQ * 64; const bf16* vp = kvb + (size_t)(br == 0 ? 3 : 5) * KV_KIND + (size_t)bg * SEQ * 64;
            float m_[4] = {-INFINITY, -INFINITY, -INFINITY, -INFINITY}, l_[4] = {0.f, 0.f, 0.f, 0.f}, acc[4] = {0.f, 0.f, 0.f, 0.f};
            const int jlo = br == 0 ? 0 : (t >= 511 ? t - 511 : 0);
            unsigned long long todo = br == 0 ? mask : 0ull; int j0 = jlo & ~63;
#pragma unroll 1
            for (;;) {
                if (br == 0) { if (!todo) break; j0 = (__ffsll((long long)todo) - 1) * 64; todo &= todo - 1; } else { if (j0 > t) break; }
                const int j = j0 + lane; const bool valid = j >= jlo && j <= t;
                float s[4]; dot4(kp + (size_t)j * 64, qf, s);
#pragma unroll
                for (int r = 0; r < 4; ++r) { const float sv = valid ? s[r] * 0.125f - slope[r] * (float)(t - j) : -INFINITY; const float mn = fmaxf(m_[r], wave_max(sv));
                    const float p = valid ? __expf(sv - mn) : 0.f; const float f = __expf(m_[r] - mn); l_[r] = l_[r] * f + wave_sum(p); acc[r] *= f; m_[r] = mn; ps[r * 64 + lane] = p; }
                LDS_WAIT();
                const bf16* vr = vp + (size_t)j0 * 64 + lane;
#pragma unroll 2
                for (int jj = 0; jj < 64; jj += 4) { const float v0 = bf2f(vr[jj * 64]), v1 = bf2f(vr[(jj + 1) * 64]), v2 = bf2f(vr[(jj + 2) * 64]), v3 = bf2f(vr[(jj + 3) * 64]);
#pragma unroll
                    for (int r = 0; r < 4; ++r) { const f32x4 pv = *(const LAS f32x4*)(ps + r * 64 + jj); acc[r] += (pv.x * v0 + pv.y * v1) + (pv.z * v2 + pv.w * v3); } }
                LDS_WAIT();
                if (br == 1) j0 += 64;
            }
#pragma unroll
            for (int r = 0; r < 4; ++r) osum[r] += sigmoid_f(gates[tg * 48 + (g * 4 + r) * 3 + 1 + br]) * (acc[r] / l_[r]);
        }
#pragma unroll
        for (int r = 0; r < 4; ++r) y[tg * DM + g * 256 + r * 64 + lane] = (bf16)f2bf(osum[r]);
        LDS_WAIT();
    }
}
constexpr int NSA_KB = 0, NSA_VB = 18432, NSA_IMPA = 34816, NSA_IMPB = 51200, NSA_MASK = 67584, NSA_UNI = 68096;
constexpr float LOG2E_F = 1.4426950408889634f;

__device__ __forceinline__ float quad_sum(float x) {
    x += __int_as_float(__builtin_amdgcn_update_dpp(0, __float_as_int(x), 0xB1, 0xF, 0xF, true));
    x += __int_as_float(__builtin_amdgcn_update_dpp(0, __float_as_int(x), 0x4E, 0xF, 0xF, true));
    return x;
}
__device__ __forceinline__ void nsa_qk(f32x16& p0, f32x16& p1, LAS const unsigned char* kb, const bf16x8 (&qf)[4], int q, int h) {
#pragma unroll
    for (int r = 0; r < 16; ++r) { p0[r] = 0.f; p1[r] = 0.f; }
#pragma unroll
    for (int ks = 0; ks < 4; ++ks) { const bf16x8 a0 = *(const LAS bf16x8*)(kb + q * 144 + ks * 32 + h * 16), a1 = *(const LAS bf16x8*)(kb + (q + 32) * 144 + ks * 32 + h * 16);
        p0 = __builtin_amdgcn_mfma_f32_32x32x16_bf16(a0, qf[ks], p0, 0, 0, 0); p1 = __builtin_amdgcn_mfma_f32_32x32x16_bf16(a1, qf[ks], p1, 0, 0, 0); }
}
template <bool CHECK> __device__ __forceinline__ void nsa_bias(f32x16& p0, f32x16& p1, float basef, float slopeK, float cst, float klo, float khi, int h) {
    const float C = 0.125f * LOG2E_F; const float i0 = basef + 4.f * (float)h; const float t0v = fmaf(slopeK, i0, cst);
#pragma unroll
    for (int r = 0; r < 16; ++r) { const float off = (float)((r & 3) + 8 * (r >> 2));
        float v0 = fmaf(p0[r], C, fmaf(slopeK, off, t0v)), v1 = fmaf(p1[r], C, fmaf(slopeK, off + 32.f, t0v));
        if (CHECK) { const float x0 = i0 + off, x1 = i0 + off + 32.f; v0 = (x0 >= klo && x0 <= khi) ? v0 : -INFINITY; v1 = (x1 >= klo && x1 <= khi) ? v1 : -INFINITY; }
        p0[r] = v0; p1[r] = v1; }
}
__device__ __forceinline__ float nsa_rowmax(const f32x16& p0, const f32x16& p1) {
    float a = fmaxf(p0[0], p1[0]);
#pragma unroll
    for (int r = 1; r < 16; ++r) a = fmaxf(a, fmaxf(p0[r], p1[r]));
    return fmaxf(a, __shfl_xor(a, 32));
}
__device__ __forceinline__ void nsa_pv(f32x16 (&o)[2], const f32x16& p0, const f32x16& p1, LAS const unsigned char* vb, int lane, int h) {
    bf16x8 pk[4];
#pragma unroll
    for (int s = 0; s < 4; ++s) { v4u w;
        if (s < 2) { w.x = cvtpk(p0[8 * s + 0], p0[8 * s + 1]); w.y = cvtpk(p0[8 * s + 2], p0[8 * s + 3]); w.z = cvtpk(p0[8 * s + 4], p0[8 * s + 5]); w.w = cvtpk(p0[8 * s + 6], p0[8 * s + 7]); }
        else { w.x = cvtpk(p1[8 * (s - 2) + 0], p1[8 * (s - 2) + 1]); w.y = cvtpk(p1[8 * (s - 2) + 2], p1[8 * (s - 2) + 3]); w.z = cvtpk(p1[8 * (s - 2) + 4], p1[8 * (s - 2) + 5]); w.w = cvtpk(p1[8 * (s - 2) + 6], p1[8 * (s - 2) + 7]); }
        pk[s] = __builtin_bit_cast(bf16x8, w); }
    LAS const unsigned char* vp = vb + (4 * h + ((lane & 15) >> 2)) * 64 + ((lane >> 4) & 1) * 32 + (lane & 3) * 8;
#pragma unroll
    for (int dt = 0; dt < 2; ++dt)
#pragma unroll
        for (int s = 0; s < 4; ++s) { const v4i16 lo = __builtin_amdgcn_ds_read_tr16_b64_v4i16((LAS v4i16*)(vp + dt * 4096 + s * 1024)), hi = __builtin_amdgcn_ds_read_tr16_b64_v4i16((LAS v4i16*)(vp + dt * 4096 + s * 1024 + 512));
            const bf16x8 a = (bf16x8){lo[0], lo[1], lo[2], lo[3], hi[0], hi[1], hi[2], hi[3]};
            o[dt] = __builtin_amdgcn_mfma_f32_32x32x16_bf16(a, pk[s], o[dt], 0, 0, 0); }
}
__device__ __forceinline__ void nsa_online(f32x16& p0, f32x16& p1, float& m, float& l, f32x16 (&o)[2]) {
    const float mx = nsa_rowmax(p0, p1), mn = fmaxf(m, mx), mu = (mn == -INFINITY) ? 0.f : mn; const float f = __builtin_amdgcn_exp2f(m - mu);
    float sum = 0.f;
#pragma unroll
    for (int r = 0; r < 16; ++r) { p0[r] = __builtin_amdgcn_exp2f(p0[r] - mu); p1[r] = __builtin_amdgcn_exp2f(p1[r] - mu); sum += p0[r] + p1[r]; }
    l = l * f + sum; m = mn;
    if (__any(f != 1.f)) {
#pragma unroll
        for (int r = 0; r < 16; ++r) { o[0][r] *= f; o[1][r] *= f; } }
}

typedef float f2v __attribute__((ext_vector_type(2)));
__device__ __forceinline__ void nsa_fast(f32x16& p0, f32x16& p1, const f32x16& bo0, const f32x16& bo1, float t0v, float& m, float& l, f32x16 (&o)[2]) {
    const float C = 0.125f * LOG2E_F; const f2v C2 = {C, C};
#pragma unroll
    for (int k = 0; k < 8; ++k) { f2v a = {p0[2 * k], p0[2 * k + 1]}, b = {p1[2 * k], p1[2 * k + 1]}; const f2v ba = {bo0[2 * k], bo0[2 * k + 1]}, bb = {bo1[2 * k], bo1[2 * k + 1]};
        a = a * C2 + ba; b = b * C2 + bb; p0[2 * k] = a.x; p0[2 * k + 1] = a.y; p1[2 * k] = b.x; p1[2 * k + 1] = b.y; }
    float mx = __builtin_fmaxf(p0[0], p1[0]);
#pragma unroll
    for (int r = 1; r < 16; ++r) mx = __builtin_fmaxf(__builtin_fmaxf(mx, p0[r]), p1[r]);
    mx += t0v; mx = __builtin_fmaxf(mx, __shfl_xor(mx, 32));
    const float mn = __builtin_fmaxf(m, mx), mu = (mn == -INFINITY) ? 0.f : mn; const float f = __builtin_amdgcn_exp2f(m - mu), d = mu - t0v; const f2v d2 = {d, d};
    f2v s2 = {0.f, 0.f};
#pragma unroll
    for (int k = 0; k < 8; ++k) { f2v a = {p0[2 * k], p0[2 * k + 1]}, b = {p1[2 * k], p1[2 * k + 1]}; a = a - d2; b = b - d2;
        a.x = __builtin_amdgcn_exp2f(a.x); a.y = __builtin_amdgcn_exp2f(a.y); b.x = __builtin_amdgcn_exp2f(b.x); b.y = __builtin_amdgcn_exp2f(b.y);
        s2 = s2 + a; s2 = s2 + b; p0[2 * k] = a.x; p0[2 * k + 1] = a.y; p1[2 * k] = b.x; p1[2 * k + 1] = b.y; }
    l = l * f + (s2.x + s2.y); m = mn;
    if (__any(f != 1.f)) {
#pragma unroll
        for (int r = 0; r < 16; ++r) { o[0][r] *= f; o[1][r] *= f; } }
}
__device__ __forceinline__ void nsa_item(const Params& P, LAS unsigned char* lds, int bg, int tile) {
    int tid_l = threadIdx.x; asm volatile("" : "+v"(tid_l)); const int tid = tid_l, lane = tid & 63, wave = tid >> 6, q = lane & 31, h = lane >> 5;
    const int b = bg >> 2, g = bg & 3, t0 = tile * 64, cur = tile;
    const int tl = 8 * wave + (q >> 2), t = t0 + tl, r = q & 3; const size_t tg = (size_t)b * SEQ + t;
    const bf16* qb = (const bf16*)(P.ws + WS_Z); const bf16* kvb = qb + (size_t)T * 1024;
    const bf16* ckp = (const bf16*)(P.ws + WS_CK) + (size_t)bg * 256 * 64; const bf16* cvp = (const bf16*)(P.ws + WS_CV) + (size_t)bg * 256 * 64;
    const bf16* ksp = kvb + 2 * KV_KIND + (size_t)bg * SEQ * 64; const bf16* vsp = kvb + 3 * KV_KIND + (size_t)bg * SEQ * 64;
    const bf16* kwp = kvb + 4 * KV_KIND + (size_t)bg * SEQ * 64; const bf16* vwp = kvb + 5 * KV_KIND + (size_t)bg * SEQ * 64;
    const float* gp = (const float*)(P.ws + WS_GATES) + tg * 48 + (g * 4 + r) * 3;
    LAS float* impA = (LAS float*)(lds + NSA_IMPA); LAS float* impB = (LAS float*)(lds + NSA_IMPB);
    LAS unsigned long long* masks = (LAS unsigned long long*)(lds + NSA_MASK); LAS unsigned long long* uni = (LAS unsigned long long*)(lds + NSA_UNI);
    const int srow = tid >> 3, spc = tid & 7; const unsigned koff = srow * 144 + spc * 16, voff = (spc >> 2) * 4096 + srow * 64 + (spc & 3) * 16; const size_t goff = (size_t)srow * 64 + spc * 8;
    const float slope2 = exp2f(-0.5f * (float)(g * 4 + r + 1)) * LOG2E_F; const float tf = (float)t;
    bf16x8 qf[4];
#pragma unroll
    for (int ks = 0; ks < 4; ++ks) qf[ks] = *(const bf16x8*)(qb + tg * 1024 + g * 256 + r * 64 + 16 * ks + 8 * h);
    { const v4u z4 = {0u, 0u, 0u, 0u};
#pragma unroll
      for (int i = 0; i < 4; ++i) *(LAS v4u*)(lds + NSA_IMPA + (tid * 4 + i) * 16) = z4; }
    if (tid < 8) uni[tid] = 0ull;
    v4u kreg, vreg;
#define KBUF(i) (lds + NSA_KB + (i) * 9216)
#define VBUF(i) (lds + NSA_VB + (i) * 8192)
    f32x16 osum[2], o[2], p0, p1, bo0, bo1;
    const int nct = (((t0 + 32) >> 4) >> 6) + 1;
    const float cmaxf = t >= 31 ? (float)((t - 31) >> 4) : -1.f; const float cstc = slope2 * (31.f - tf), slopec = 16.f * slope2;
    float m1 = -INFINITY, l1 = 0.f;
    kreg = *(const v4u*)(ckp + (size_t)(nct - 1) * 4096 + goff); *(LAS v4u*)(KBUF(0) + koff) = kreg; __syncthreads();
#pragma unroll 1
    for (int i = 0; i < nct; ++i) { const int ct = nct - 1 - i;
        if (i + 1 < nct) kreg = *(const v4u*)(ckp + (size_t)(ct - 1) * 4096 + goff);
        nsa_qk(p0, p1, KBUF(i & 1), qf, q, h); nsa_bias<true>(p0, p1, (float)(ct * 64), slopec, cstc, 0.f, cmaxf, h);
        { const float mx = nsa_rowmax(p0, p1), mn = fmaxf(m1, mx), mu = (mn == -INFINITY) ? 0.f : mn; float sum = 0.f;
#pragma unroll
          for (int rr = 0; rr < 16; ++rr) sum += __builtin_amdgcn_exp2f(p0[rr] - mu) + __builtin_amdgcn_exp2f(p1[rr] - mu);
          l1 = l1 * __builtin_amdgcn_exp2f(m1 - mu) + sum; m1 = mn; }
        if (i + 1 < nct) *(LAS v4u*)(KBUF((i + 1) & 1) + koff) = kreg;
        __syncthreads(); }
    l1 += __shfl_xor(l1, 32);
    const float inv1 = l1 > 0.f ? 1.f / l1 : 0.f, mu1 = (m1 == -INFINITY) ? 0.f : m1;
#pragma unroll
    for (int rr = 0; rr < 16; ++rr) { o[0][rr] = 0.f; o[1][rr] = 0.f; }
    kreg = *(const v4u*)(ckp + (size_t)(nct - 1) * 4096 + goff); vreg = *(const v4u*)(cvp + (size_t)(nct - 1) * 4096 + goff);
    *(LAS v4u*)(KBUF(0) + koff) = kreg; *(LAS v4u*)(VBUF(0) + voff) = vreg; __syncthreads();
#pragma unroll 1
    for (int i = 0; i < nct; ++i) { const int ct = nct - 1 - i;
        if (i + 1 < nct) { kreg = *(const v4u*)(ckp + (size_t)(ct - 1) * 4096 + goff); vreg = *(const v4u*)(cvp + (size_t)(ct - 1) * 4096 + goff); }
        nsa_qk(p0, p1, KBUF(i & 1), qf, q, h); nsa_bias<true>(p0, p1, (float)(ct * 64), slopec, cstc, 0.f, cmaxf, h);
#pragma unroll
        for (int rr = 0; rr < 16; ++rr) { p0[rr] = __builtin_amdgcn_exp2f(p0[rr] - mu1) * inv1; p1[rr] = __builtin_amdgcn_exp2f(p1[rr] - mu1) * inv1; }
#pragma unroll
        for (int a = 0; a < 4; ++a) {
            float A0 = quad_sum(p0[4 * a] + p0[4 * a + 1] + p0[4 * a + 2] + 0.5f * p0[4 * a + 3]), B0 = quad_sum(0.5f * p0[4 * a + 3]);
            float A1 = quad_sum(p1[4 * a] + p1[4 * a + 1] + p1[4 * a + 2] + 0.5f * p1[4 * a + 3]), B1 = quad_sum(0.5f * p1[4 * a + 3]);
            if (r == 0) { const int n0 = 16 * ct + 2 * a + h, n1 = n0 + 8; impA[tl * 64 + n0] = A0; impA[tl * 64 + n1] = A1; impB[tl * 64 + n0 + 1] = B0; if (n1 < 63) impB[tl * 64 + n1 + 1] = B1; } }
        nsa_pv(o, p0, p1, VBUF(i & 1), lane, h);
        if (i + 1 < nct) { *(LAS v4u*)(KBUF((i + 1) & 1) + koff) = kreg; *(LAS v4u*)(VBUF((i + 1) & 1) + voff) = vreg; }
        __syncthreads(); }
    { const float g0 = sigmoid_f(gp[0]);
#pragma unroll
      for (int rr = 0; rr < 16; ++rr) { osum[0][rr] = g0 * o[0][rr]; osum[1][rr] = g0 * o[1][rr]; } }
    { const int tkl = lane >> 3, part = lane & 7, tk = 8 * wave + tkl; unsigned key[8];
      { const f32x4 a0 = *(const LAS f32x4*)(impA + tk * 64 + part * 8), a1 = *(const LAS f32x4*)(impA + tk * 64 + part * 8 + 4), b0 = *(const LAS f32x4*)(impB + tk * 64 + part * 8), b1 = *(const LAS f32x4*)(impB + tk * 64 + part * 8 + 4);
        const float im[8] = {a0.x + b0.x, a0.y + b0.y, a0.z + b0.z, a0.w + b0.w, a1.x + b1.x, a1.y + b1.y, a1.z + b1.z, a1.w + b1.w};
#pragma unroll
        for (int e2 = 0; e2 < 8; ++e2) { const int n = part * 8 + e2; const bool forced = (n == 0) || (n == cur) || (n == cur - 1); key[e2] = n <= cur ? (forced ? 0x7F000000u : __float_as_uint(im[e2]) + 1u) : 0u; } }
      unsigned Tk = 0u;
#pragma unroll 1
      for (int bb = 30; bb >= 0; --bb) { const unsigned cand = Tk | (1u << bb); int c = 0;
#pragma unroll
          for (int e2 = 0; e2 < 8; ++e2) c += key[e2] >= cand ? 1 : 0;
          c += __builtin_amdgcn_update_dpp(0, c, 0xB1, 0xF, 0xF, true); c += __builtin_amdgcn_update_dpp(0, c, 0x4E, 0xF, 0xF, true); c += __builtin_amdgcn_update_dpp(0, c, 0x141, 0xF, 0xF, true);
          Tk = c >= 16 ? cand : Tk; }
      int cg = 0, le = 0;
#pragma unroll
      for (int e2 = 0; e2 < 8; ++e2) { cg += key[e2] > Tk ? 1 : 0; le += key[e2] == Tk ? 1 : 0; }
      cg += __builtin_amdgcn_update_dpp(0, cg, 0xB1, 0xF, 0xF, true); cg += __builtin_amdgcn_update_dpp(0, cg, 0x4E, 0xF, 0xF, true); cg += __builtin_amdgcn_update_dpp(0, cg, 0x141, 0xF, 0xF, true);
      int incl = le;
#pragma unroll
      for (int o2 = 1; o2 < 8; o2 <<= 1) { const int v = __shfl_up(incl, o2, 8); if (part >= o2) incl += v; }
      int before = incl - le; const int need = 16 - cg; unsigned byte = 0u;
#pragma unroll
      for (int e2 = 0; e2 < 8; ++e2) { const bool eq = key[e2] == Tk; const bool selb = (key[e2] > Tk || (eq && before < need)) && (part * 8 + e2 <= cur); before += eq ? 1 : 0; byte |= selb ? (1u << e2) : 0u; }
      ((LAS unsigned char*)masks)[tk * 8 + part] = (unsigned char)byte;
      __hip_atomic_fetch_or(uni, (unsigned long long)byte << (8 * part), __ATOMIC_RELAXED, __HIP_MEMORY_SCOPE_WORKGROUP); }
    __syncthreads();
    unsigned long long todo = uni[0]; const unsigned long long mymask = masks[tl];
#define NSA_LOAD(kp_, vp_, n_) { kreg = *(const v4u*)((kp_) + (size_t)(n_) * 4096 + goff); vreg = *(const v4u*)((vp_) + (size_t)(n_) * 4096 + goff); }
#define NSA_STORE(i_) { *(LAS v4u*)(KBUF((i_) & 1) + koff) = kreg; *(LAS v4u*)(VBUF((i_) & 1) + voff) = vreg; }
#define NSA_FAST(i_, t0v_) { nsa_qk(p0, p1, KBUF((i_) & 1), qf, q, h); nsa_fast(p0, p1, bo0, bo1, (t0v_), m, l, o); nsa_pv(o, p0, p1, VBUF((i_) & 1), lane, h); }
#define NSA_STEP(CHECK_, i_, basef_, cst_, klo_, khi_) { nsa_qk(p0, p1, KBUF((i_) & 1), qf, q, h); nsa_bias<CHECK_>(p0, p1, (basef_), slope2, (cst_), (klo_), (khi_), h); nsa_online(p0, p1, m, l, o); nsa_pv(o, p0, p1, VBUF((i_) & 1), lane, h); }
    {
        float m = -INFINITY, l = 0.f; const float cst = -slope2 * tf;
#pragma unroll
        for (int rr = 0; rr < 16; ++rr) { o[0][rr] = 0.f; o[1][rr] = 0.f; bo0[rr] = slope2 * (float)((rr & 3) + 8 * (rr >> 2)); bo1[rr] = slope2 * (float)((rr & 3) + 8 * (rr >> 2) + 32); }
        todo &= ~(1ull << cur);
        NSA_LOAD(ksp, vsp, cur) NSA_STORE(0) __syncthreads();
        int i = 0, nn = todo ? 63 - __clzll((long long)todo) : -1; if (nn >= 0) todo &= ~(1ull << nn);
        if (nn >= 0) NSA_LOAD(ksp, vsp, nn)
        NSA_STEP(true, 0, (float)(cur * 64), cst, 0.f, tf)
        if (nn >= 0) NSA_STORE(1)
        __syncthreads();
#pragma unroll 1
        while (nn >= 0) { const int n = nn; ++i; nn = todo ? 63 - __clzll((long long)todo) : -1; if (nn >= 0) todo &= ~(1ull << nn);
            if (nn >= 0) NSA_LOAD(ksp, vsp, nn)
            const bool sel = (mymask >> n) & 1ull;
            NSA_FAST(i, sel ? fmaf(slope2, (float)(n * 64 + 4 * h), cst) : -INFINITY)
            if (nn >= 0) NSA_STORE(i + 1)
            __syncthreads(); }
        l += __shfl_xor(l, 32); const float gs = sigmoid_f(gp[1]) / l;
#pragma unroll
        for (int rr = 0; rr < 16; ++rr) { osum[0][rr] += gs * o[0][rr]; osum[1][rr] += gs * o[1][rr]; }
    }
    {
        float m = -INFINITY, l = 0.f; const float cst = -slope2 * tf;
#pragma unroll
        for (int rr = 0; rr < 16; ++rr) { o[0][rr] = 0.f; o[1][rr] = 0.f; }
        const int nw = tile < 8 ? tile + 1 : 9, nmid = nw < 8 ? nw : 8;
        NSA_LOAD(kwp, vwp, tile) NSA_STORE(0) __syncthreads();
        if (nw > 1) NSA_LOAD(kwp, vwp, tile - 1)
        NSA_STEP(true, 0, (float)(tile * 64), cst, 0.f, tf)
        if (nw > 1) NSA_STORE(1)
        __syncthreads();
#pragma unroll 1
        for (int i = 1; i < nmid; ++i) { const int jt = tile - i;
            if (i + 1 < nw) NSA_LOAD(kwp, vwp, jt - 1)
            NSA_FAST(i, fmaf(slope2, (float)(jt * 64 + 4 * h), cst))
            if (i + 1 < nw) NSA_STORE(i + 1)
            __syncthreads(); }
        if (nw == 9) { NSA_STEP(true, 8, (float)((tile - 8) * 64), cst, tf - 511.f, 1e9f) __syncthreads(); }
        l += __shfl_xor(l, 32); const float gs = sigmoid_f(gp[2]) / l;
#pragma unroll
        for (int rr = 0; rr < 16; ++rr) { osum[0][rr] += gs * o[0][rr]; osum[1][rr] += gs * o[1][rr]; }
    }
#undef NSA_LOAD
#undef NSA_STORE
#undef NSA_STEP
#undef NSA_FAST
    { bf16* yp = (bf16*)(P.ws + WS_Y) + tg * DM + g * 256 + r * 64 + 4 * h;
#pragma unroll
      for (int dt = 0; dt < 2; ++dt)
#pragma unroll
          for (int a = 0; a < 4; ++a) { v2u w; w.x = cvtpk(osum[dt][4 * a], osum[dt][4 * a + 1]); w.y = cvtpk(osum[dt][4 * a + 2], osum[dt][4 * a + 3]); *(v2u*)(yp + dt * 32 + a * 8) = w; } }
#undef KBUF
#undef VBUF
}
__device__ __forceinline__ void phase_nsa(const Params& P, LAS unsigned char* lds) {
    for (int it = blockIdx.x; it < 2048; it += gridDim.x) { const int rnd = it / 256, c = it % 256; const int bg = c & 31, tile = 63 - 8 * rnd - (c >> 5); nsa_item(P, lds, bg, tile); }
}

__device__ __forceinline__ void xatt_item(const Params& P, LAS unsigned char* lds, int l, int bh, int blk) {
    int tid_l = threadIdx.x; asm volatile("" : "+v"(tid_l)); const int tid = tid_l, lane = tid & 63, wave = tid >> 6, q = lane & 31, h = lane >> 5;
    const int b = bh >> 2, hh = bh & 3; const size_t t = (size_t)b * SEQ + blk * 256 + wave * 32 + q;
    const bf16* kvp = (const bf16*)(P.ws + WS_MEMKV) + (size_t)(b * 256) * 4096 + l * 2048 + hh * 256;
    const bf16* qp = (const bf16*)(P.ws + WS_QXA) + t * DM + hh * 256 + 8 * h;
#pragma unroll
    for (int half = 0; half < 2; ++half) { v4u kr[8];
#pragma unroll
        for (int i = 0; i < 8; ++i) { const int p = tid + 512 * (half * 8 + i); kr[i] = *(const v4u*)(kvp + (size_t)(p >> 5) * 4096 + (p & 31) * 8); }
#pragma unroll
        for (int i = 0; i < 8; ++i) { const int p = tid + 512 * (half * 8 + i); *(LAS v4u*)(lds + (p >> 5) * 528 + (p & 31) * 16) = kr[i]; } }
    bf16x8 qf[16];
#pragma unroll
    for (int ks = 0; ks < 16; ++ks) qf[ks] = *(const bf16x8*)(qp + 16 * ks);
    __syncthreads();
    const float C = 0.0625f * LOG2E_F;
    v4u pk[16]; float m = 0.f, lsum = 0.f, f0 = 1.f;
#pragma unroll
    for (int half = 0; half < 2; ++half) {
        f32x16 s[4];
#pragma unroll
        for (int kt = 0; kt < 4; ++kt) {
#pragma unroll
            for (int r = 0; r < 16; ++r) s[kt][r] = 0.f;
            LAS const unsigned char* kb = lds + (half * 128 + kt * 32 + q) * 528 + h * 16;
#pragma unroll
            for (int ks = 0; ks < 16; ++ks) s[kt] = __builtin_amdgcn_mfma_f32_32x32x16_bf16(*(const LAS bf16x8*)(kb + ks * 32), qf[ks], s[kt], 0, 0, 0); }
        float mx = s[0][0];
#pragma unroll
        for (int kt = 0; kt < 4; ++kt)
#pragma unroll
            for (int r = 0; r < 16; ++r) mx = fmaxf(mx, s[kt][r]);
        mx = fmaxf(mx, __shfl_xor(mx, 32)) * C;
        const float mn = half == 0 ? mx : fmaxf(m, mx);
        if (half == 1) { f0 = __builtin_amdgcn_exp2f(m - mn); lsum *= f0; }
        m = mn;
        float sum = 0.f;
#pragma unroll
        for (int kt = 0; kt < 4; ++kt) {
#pragma unroll
            for (int r = 0; r < 16; ++r) { s[kt][r] = __builtin_amdgcn_exp2f(fmaf(s[kt][r], C, -mn)); sum += s[kt][r]; }
#pragma unroll
            for (int e = 0; e < 2; ++e) { v4u w; w.x = cvtpk(s[kt][8 * e + 0], s[kt][8 * e + 1]); w.y = cvtpk(s[kt][8 * e + 2], s[kt][8 * e + 3]); w.z = cvtpk(s[kt][8 * e + 4], s[kt][8 * e + 5]); w.w = cvtpk(s[kt][8 * e + 6], s[kt][8 * e + 7]); pk[half * 8 + kt * 2 + e] = w; } }
        lsum += sum;
    }
    lsum += __shfl_xor(lsum, 32); const float invl = 1.f / lsum;
    __syncthreads();
#pragma unroll
    for (int c = 0; c < 2; ++c) { v4u vr[8];
#pragma unroll
        for (int i = 0; i < 8; ++i) { const int p = tid + 512 * i; vr[i] = *(const v4u*)(kvp + 1024 + (size_t)(p >> 4) * 4096 + c * 128 + (p & 15) * 8); }
#pragma unroll
        for (int i = 0; i < 8; ++i) { const int p = tid + 512 * i; *(LAS v4u*)(lds + c * 65536 + ((p & 15) >> 2) * 16384 + (p >> 4) * 64 + (p & 3) * 16) = vr[i]; } }
    __syncthreads();
    bf16* yp = (bf16*)(P.ws + WS_Y) + t * DM + hh * 256 + 4 * h;
    LAS const unsigned char* vp = lds + (4 * h + ((lane & 15) >> 2)) * 64 + ((lane >> 4) & 1) * 32 + (lane & 3) * 8;
#pragma unroll 1
    for (int dt = 0; dt < 8; ++dt) { f32x16 o;
#pragma unroll
        for (int r = 0; r < 16; ++r) o[r] = 0.f;
        LAS const unsigned char* vd = vp + dt * 16384;
#pragma unroll
        for (int s = 0; s < 8; ++s) { const v4i16 lo = __builtin_amdgcn_ds_read_tr16_b64_v4i16((LAS v4i16*)(vd + s * 1024)), hi = __builtin_amdgcn_ds_read_tr16_b64_v4i16((LAS v4i16*)(vd + s * 1024 + 512));
            o = __builtin_amdgcn_mfma_f32_32x32x16_bf16((bf16x8){lo[0], lo[1], lo[2], lo[3], hi[0], hi[1], hi[2], hi[3]}, __builtin_bit_cast(bf16x8, pk[s]), o, 0, 0, 0); }
#pragma unroll
        for (int r = 0; r < 16; ++r) o[r] *= f0;
#pragma unroll
        for (int s = 8; s < 16; ++s) { const v4i16 lo = __builtin_amdgcn_ds_read_tr16_b64_v4i16((LAS v4i16*)(vd + s * 1024)), hi = __builtin_amdgcn_ds_read_tr16_b64_v4i16((LAS v4i16*)(vd + s * 1024 + 512));
            o = __builtin_amdgcn_mfma_f32_32x32x16_bf16((bf16x8){lo[0], lo[1], lo[2], lo[3], hi[0], hi[1], hi[2], hi[3]}, __builtin_bit_cast(bf16x8, pk[s]), o, 0, 0, 0); }
#pragma unroll
        for (int a = 0; a < 4; ++a) { v2u w; w.x = cvtpk(o[4 * a] * invl, o[4 * a + 1] * invl); w.y = cvtpk(o[4 * a + 2] * invl, o[4 * a + 3] * invl); *(v2u*)(yp + dt * 32 + a * 8) = w; } }
    __syncthreads();
}
__device__ __forceinline__ void phase_xatt(const Params& P, LAS unsigned char* lds, int l) {
    for (int it = blockIdx.x; it < 512; it += gridDim.x) { const int c = it % 256, k = it / 256; xatt_item(P, lds, l, c & 31, (c >> 5) + 8 * k); }
}

constexpr size_t WS_DN = 344 * MiB, DN_CHUNK_BYTES = 73728, WS_EGL = 488 * MiB;
constexpr int DNA_RHS = 0, DNA_QB = 65536, DNA_KB = 82944, DNA_AM = 100352, DNA_SSQ = 118784, DNA_GC = 126976;
__device__ __forceinline__ void dna_item(const Params& P, LAS unsigned char* lds, int item) {
    int tid_l = threadIdx.x; asm volatile("" : "+v"(tid_l)); const int tid = tid_l, lane = tid & 63, wave = tid >> 6;
    const int bh = item >> 6, n = item & 63, b = bh >> 2, h = bh & 3, sb = n * 64; const size_t rb = (size_t)b * SEQ;
    const bf16* z = (const bf16*)(P.ws + WS_Z); const float* ba = (const float*)(P.ws + WS_BA); const float* cw = P.in[I_A_CONV];
    unsigned char* ob = P.ws + WS_DN + (size_t)item * DN_CHUNK_BYTES;
    LAS float* rhs = (LAS float*)(lds + DNA_RHS); LAS float* Am = (LAS float*)(lds + DNA_AM); LAS float* ssq = (LAS float*)(lds + DNA_SSQ);
    LAS float* gcs = (LAS float*)(lds + DNA_GC); LAS float* bet = gcs + 64; LAS float* egc = gcs + 128; LAS float* ekd = gcs + 192;
    const float SC = 0.08838834764831845f;
    if (wave == 0) { const size_t t = rb + sb + lane; const float bl = ba[t * 8 + h], al = ba[t * 8 + 4 + h] + P.in[I_A_DTB][h]; const float sp = al > 20.f ? al : log1pf(__expf(al));
        float g = -__expf(P.in[I_A_ALOG][h]) * sp;
#pragma unroll
        for (int o = 1; o < 64; o <<= 1) { const float v = __shfl_up(g, o); if (lane >= o) g += v; }
        const float gl = __shfl(g, 63);
        gcs[lane] = g; bet[lane] = sigmoid_f(bl); egc[lane] = __expf(g); ekd[lane] = __expf(gl - g);
        if (lane == 63) ((float*)(P.ws + WS_EGL))[item] = __expf(g); }
    { const int gd = tid & 15, tq = tid >> 4, d0 = gd * 8;
      f32x4 wa[3][4][2]; v4u za[3][2][4];
#pragma unroll
      for (int part = 0; part < 3; ++part) { const int ch0 = part * 512 + h * 128 + d0;
#pragma unroll
          for (int kk = 0; kk < 4; ++kk) { wa[part][kk][0] = *(const f32x4*)(cw + kk * 1536 + ch0); wa[part][kk][1] = *(const f32x4*)(cw + kk * 1536 + ch0 + 4); }
#pragma unroll
          for (int tt = 0; tt < 2; ++tt)
#pragma unroll
              for (int kk = 0; kk < 4; ++kk) { const int sp = sb + tq + 32 * tt - 3 + kk; za[part][tt][kk] = (v4u){0u, 0u, 0u, 0u}; if (sp >= 0) za[part][tt][kk] = *(const v4u*)(z + (rb + sp) * 2560 + 512 + ch0); } }
      __builtin_amdgcn_sched_barrier(0);
      __syncthreads();
#pragma unroll
      for (int part = 0; part < 3; ++part) {
#pragma unroll
          for (int tt = 0; tt < 2; ++tt) { const int tl = tq + 32 * tt;
              float a[8];
#pragma unroll
              for (int e2 = 0; e2 < 8; ++e2) a[e2] = 0.f;
#pragma unroll
              for (int kk = 0; kk < 4; ++kk) { const v4u zv = za[part][tt][kk]; const f32x4 w0 = wa[part][kk][0], w1 = wa[part][kk][1];
                  a[0] += w0.x * bf2f(zv.x & 0xffff); a[1] += w0.y * bf2f(zv.x >> 16); a[2] += w0.z * bf2f(zv.y & 0xffff); a[3] += w0.w * bf2f(zv.y >> 16);
                  a[4] += w1.x * bf2f(zv.z & 0xffff); a[5] += w1.y * bf2f(zv.z >> 16); a[6] += w1.z * bf2f(zv.w & 0xffff); a[7] += w1.w * bf2f(zv.w >> 16); }
              float q2 = 0.f;
#pragma unroll
              for (int e2 = 0; e2 < 8; ++e2) { a[e2] = a[e2] * __builtin_amdgcn_rcpf(1.f + __builtin_amdgcn_exp2f(-LOG2E_F * a[e2])); q2 += a[e2] * a[e2]; }
              if (part < 2) {
                  q2 += __shfl_xor(q2, 1); q2 += __shfl_xor(q2, 2); q2 += __shfl_xor(q2, 4); q2 += __shfl_xor(q2, 8);
                  const float rs = rsqrtf(q2 + EPS);
#pragma unroll
                  for (int e2 = 0; e2 < 8; ++e2) a[e2] *= rs;
                  v4u wv; wv.x = cvtpk(a[0], a[1]); wv.y = cvtpk(a[2], a[3]); wv.z = cvtpk(a[4], a[5]); wv.w = cvtpk(a[6], a[7]);
                  *(LAS v4u*)(lds + (part == 0 ? DNA_QB : DNA_KB) + tl * 272 + d0 * 2) = wv;
                  if (part == 0) { const float f = SC * egc[tl]; v4u g4; g4.x = cvtpk(a[0] * f, a[1] * f); g4.y = cvtpk(a[2] * f, a[3] * f); g4.z = cvtpk(a[4] * f, a[5] * f); g4.w = cvtpk(a[6] * f, a[7] * f);
                      *(v4u*)(ob + 16384 + (((tl >> 4) * 4 + (d0 >> 5)) * 64 + (tl & 15) + 16 * ((d0 >> 3) & 3)) * 16) = g4; }
                  else { const float f = ekd[tl], fb = bet[tl] * egc[tl];
                      *(LAS f32x4*)(rhs + tl * 256 + d0) = (f32x4){a[0] * fb, a[1] * fb, a[2] * fb, a[3] * fb}; *(LAS f32x4*)(rhs + tl * 256 + d0 + 4) = (f32x4){a[4] * fb, a[5] * fb, a[6] * fb, a[7] * fb};
                      bf16* kd = (bf16*)(ob + 32768) + ((((d0 >> 4) * 2 + (tl >> 5)) * 64 + 16 * ((tl >> 3) & 3)) * 8) + (tl & 7);
#pragma unroll
                      for (int e2 = 0; e2 < 8; ++e2) kd[(((d0 & 15) + e2) * 8)] = (bf16)f2bf(a[e2] * f); } }
              else { const float fb = bet[tl];
                  *(LAS f32x4*)(rhs + tl * 256 + 128 + d0) = (f32x4){a[0] * fb, a[1] * fb, a[2] * fb, a[3] * fb}; *(LAS f32x4*)(rhs + tl * 256 + 128 + d0 + 4) = (f32x4){a[4] * fb, a[5] * fb, a[6] * fb, a[7] * fb}; } } } }
    __syncthreads();
    if (wave < 6) { const int isq = wave >= 3, jb = wave - 3 * isq, it = jb >= 1, jt = jb == 2; const int q = lane & 31, hh = lane >> 5;
        f32x16 d;
#pragma unroll
        for (int r = 0; r < 16; ++r) d[r] = 0.f;
        LAS const unsigned char* ap = lds + (isq ? DNA_QB : DNA_KB) + (it * 32 + q) * 272 + hh * 16; LAS const unsigned char* bp = lds + DNA_KB + (jt * 32 + q) * 272 + hh * 16;
#pragma unroll
        for (int ks = 0; ks < 8; ++ks) d = __builtin_amdgcn_mfma_f32_32x32x16_bf16(*(const LAS bf16x8*)(ap + ks * 32), *(const LAS bf16x8*)(bp + ks * 32), d, 0, 0, 0);
        const int j = jt * 32 + q; const float gj = gcs[j];
#pragma unroll
        for (int r = 0; r < 16; ++r) { const int i = it * 32 + (r & 3) + 8 * (r >> 2) + 4 * hh; const float dec = __expf(fminf(gcs[i] - gj, 0.f));
            if (!isq) Am[(j & 1) * 2304 + i * 36 + (j >> 1)] = i > j ? d[r] * bet[i] * dec : 0.f;
            else ((bf16*)(ob + 65536))[((((i >> 4) * 2 + (j >> 5)) * 64 + (i & 15) + 16 * ((j >> 3) & 3)) * 8) + (j & 7)] = (bf16)f2bf(i >= j ? d[r] * SC * dec : 0.f); } }
    else if (wave == 6) { const v4u z4 = {0u, 0u, 0u, 0u}; *(v4u*)(ob + 65536 + ((0 * 2 + 1) * 64 + lane) * 16) = z4; *(v4u*)(ob + 65536 + ((1 * 2 + 1) * 64 + lane) * 16) = z4; }
    __syncthreads();
    if (tid < 256) { const int cp = tid >> 1, par = tid & 1, c = 2 * cp; LAS const float* Ap = Am + par * 2304; f2v x[32];
#pragma unroll
      for (int jj = 0; jj < 32; ++jj) x[jj] = (f2v){0.f, 0.f};
      f32x4 ab[2][8]; f2v rb[2]; f2v xl[4] = {{0.f, 0.f}, {0.f, 0.f}, {0.f, 0.f}, {0.f, 0.f}};
      rb[0] = *(const LAS f2v*)(rhs + c);
      unsigned* wp = (unsigned*)((bf16*)ob + (((c >> 5) * 64 + 16 * ((c >> 3) & 3)) * 8) + (c & 7));
      const int dv = c - 128; unsigned char* up = ob + 49152 + (((dv >> 4) * 4) * 64 + (dv & 15)) * 8;
#pragma unroll
      for (int i = 0; i < 64; ++i) {
          if (i + 1 < 64) {
#pragma unroll
              for (int j4 = 0; j4 < ((i + 2) / 2 + 3) / 4; ++j4) ab[(i + 1) & 1][j4] = *(const LAS f32x4*)(Ap + (i + 1) * 36 + 4 * j4);
              rb[(i + 1) & 1] = *(const LAS f2v*)(rhs + (i + 1) * 256 + c); }
          __builtin_amdgcn_sched_barrier(0);
          f2v acc = {0.f, 0.f};
#pragma unroll
          for (int jj = 0; jj < (i + 1) / 2; ++jj) { const float a = ab[i & 1][jj >> 2][jj & 3]; acc = acc + (f2v){a, a} * x[jj]; }
          acc.x += __int_as_float(__builtin_amdgcn_update_dpp(0, __float_as_int(acc.x), 0xB1, 0xF, 0xF, true)); acc.y += __int_as_float(__builtin_amdgcn_update_dpp(0, __float_as_int(acc.y), 0xB1, 0xF, 0xF, true));
          const f2v xi = rb[i & 1] - acc;
          x[i >> 1] = ((i & 1) == par) ? xi : x[i >> 1];
          xl[i & 3] = xi;
          if (tid < 128) { if ((i & 1) == par) wp[(((i >> 4) * 4) * 64 + (i & 15)) * 4] = cvtpk(xi.x, xi.y); }
          else if ((i & 3) == 3 && ((i >> 2) & 1) == par) { v2u w0, w1; w0.x = cvtpk(xl[0].x, xl[1].x); w0.y = cvtpk(xl[2].x, xl[3].x); w1.x = cvtpk(xl[0].y, xl[1].y); w1.y = cvtpk(xl[2].y, xl[3].y);
              unsigned char* u0 = up + (((i >> 2) >> 2) * 64 + 16 * ((i >> 2) & 3)) * 8; *(v2u*)u0 = w0; *(v2u*)(u0 + 8) = w1; }
          __builtin_amdgcn_sched_barrier(0);
      } }
    __syncthreads();
}
__device__ __forceinline__ void phase_dna(const Params& P, LAS unsigned char* lds) { for (int it = blockIdx.x; it < 2048; it += gridDim.x) dna_item(P, lds, it); }

typedef float f32x4v __attribute__((ext_vector_type(4)));
struct DnFrag { bf16x8 m1[4]; bf16x8 at[2]; bf16x8 kd[2]; v2u u; float eg; };
__device__ __forceinline__ void dnb_load(DnFrag& f, const unsigned char* base, const float* egl, int n, int wave, int lane, int sl) {
    const unsigned char* cb = base + (size_t)n * DN_CHUNK_BYTES; const int ct = wave & 3;
    const unsigned char* m1 = cb + (wave < 4 ? 0 : 16384) + ((ct * 4) * 64 + lane) * 16;
#pragma unroll
    for (int ks = 0; ks < 4; ++ks) f.m1[ks] = *(const bf16x8*)(m1 + ks * 1024);
#pragma unroll
    for (int ks = 0; ks < 2; ++ks) f.kd[ks] = *(const bf16x8*)(cb + 32768 + ((wave * 2 + ks) * 64 + lane) * 16);
    if (wave < 4) f.u = *(const v2u*)(cb + 49152 + ((sl * 4 + ct) * 64 + lane) * 8);
    else {
#pragma unroll
        for (int ks = 0; ks < 2; ++ks) f.at[ks] = *(const bf16x8*)(cb + 65536 + ((ct * 2 + ks) * 64 + lane) * 16); }
    f.eg = egl[n];
}
__device__ __forceinline__ void phase_dnb(const Params& P, LAS unsigned char* lds) {
    int tid_l = threadIdx.x; asm volatile("" : "+v"(tid_l)); const int tid = tid_l, lane = tid & 63, wave = __builtin_amdgcn_readfirstlane(tid >> 6);
    const int x = blockIdx.x; if (x >= 256) return;
    const int xcd = x & 7, idx = x >> 3, bh = xcd * 4 + (idx >> 3), sl = idx & 7, b = bh >> 2, h = bh & 3, ct = wave & 3;
    const unsigned char* base = P.ws + WS_DN + (size_t)bh * 64 * DN_CHUNK_BYTES; const float* egl = (const float*)(P.ws + WS_EGL) + bh * 64;
    bf16* yo = (bf16*)(P.ws + WS_Y) + ((size_t)b * SEQ + 16 * ct + 4 * (lane >> 4)) * DM + 512 + h * 128 + sl * 16 + (lane & 15);
    LAS unsigned char* St = lds; LAS unsigned char* vnT = lds + 4352;
    LAS const unsigned char* stb = St + (lane & 15) * 272 + (lane >> 4) * 16; LAS const unsigned char* vnb = vnT + (lane & 15) * 144 + (lane >> 4) * 16;
    if (tid < 272) *(LAS v4u*)(St + tid * 16) = (v4u){0u, 0u, 0u, 0u};
    f32x4v Sacc = {0.f, 0.f, 0.f, 0.f};
    DnFrag fr[4];
#pragma unroll
    for (int u = 0; u < 4; ++u) dnb_load(fr[u], base, egl, u, wave, lane, sl);
    __syncthreads();
#pragma unroll 1
    for (int n0 = 0; n0 < 64; n0 += 4) {
#pragma unroll
        for (int u = 0; u < 4; ++u) { const int n = n0 + u;
            f32x4v acc = {0.f, 0.f, 0.f, 0.f};
#pragma unroll
            for (int ks = 0; ks < 4; ++ks) acc = __builtin_amdgcn_mfma_f32_16x16x32_bf16(fr[u].m1[ks], *(const LAS bf16x8*)(stb + ks * 64), acc, 0, 0, 0);
            if (wave < 4) { const float u0 = bf2f(fr[u].u.x & 0xffff), u1 = bf2f(fr[u].u.x >> 16), u2 = bf2f(fr[u].u.y & 0xffff), u3 = bf2f(fr[u].u.y >> 16);
                v2u w; w.x = cvtpk(u0 - acc[0], u1 - acc[1]); w.y = cvtpk(u2 - acc[2], u3 - acc[3]); *(LAS v2u*)(vnT + (lane & 15) * 144 + (16 * ct + 4 * (lane >> 4)) * 2) = w; }
            __syncthreads();
            const bf16x8 v0 = *(const LAS bf16x8*)(vnb), v1 = *(const LAS bf16x8*)(vnb + 64);
            if (wave >= 4) { acc = __builtin_amdgcn_mfma_f32_16x16x32_bf16(fr[u].at[0], v0, acc, 0, 0, 0); acc = __builtin_amdgcn_mfma_f32_16x16x32_bf16(fr[u].at[1], v1, acc, 0, 0, 0);
                bf16* yp = yo + (size_t)n * 64 * DM;
#pragma unroll
                for (int r = 0; r < 4; ++r) yp[(size_t)r * DM] = (bf16)f2bf(acc[r]); }
            Sacc = Sacc * fr[u].eg;
            Sacc = __builtin_amdgcn_mfma_f32_16x16x32_bf16(fr[u].kd[0], v0, Sacc, 0, 0, 0); Sacc = __builtin_amdgcn_mfma_f32_16x16x32_bf16(fr[u].kd[1], v1, Sacc, 0, 0, 0);
            { v2u w; w.x = cvtpk(Sacc[0], Sacc[1]); w.y = cvtpk(Sacc[2], Sacc[3]); *(LAS v2u*)(St + (lane & 15) * 272 + (16 * wave + 4 * (lane >> 4)) * 2) = w; }
            dnb_load(fr[u], base, egl, n + 4 < 64 ? n + 4 : 63, wave, lane, sl);
            __syncthreads();
        }
    }
}
__device__ __forceinline__ void phase_dnc(const Params& P, LAS unsigned char* lds) {
    int tid_l = threadIdx.x; asm volatile("" : "+v"(tid_l)); const int tid = tid_l, lane = tid & 63, wave = tid >> 6;
    const int gw = blockIdx.x * NWAVES + wave, NGW = gridDim.x * NWAVES;
    const bf16* z = (const bf16*)(P.ws + WS_Z); bf16* y = (bf16*)(P.ws + WS_Y);
    float on[8];
#pragma unroll
    for (int e = 0; e < 8; ++e) on[e] = P.in[I_A_ONORM][(lane & 15) * 8 + e];
    for (int it0 = gw; it0 < T; it0 += 4 * NGW) {
        const int hh = lane >> 4, d0 = (lane & 15) * 8; v4u ov[4], gv[4];
#pragma unroll
        for (int u = 0; u < 4; ++u) { const int it = it0 + u * NGW; if (it < T) { ov[u] = *(const v4u*)(y + (size_t)it * DM + 512 + hh * 128 + d0); gv[u] = *(const v4u*)(z + (size_t)it * 2560 + 2048 + hh * 128 + d0); } }
#pragma unroll
        for (int u = 0; u < 4; ++u) { const int it = it0 + u * NGW; if (it >= T) break;
            float o[8] = {bf2f(ov[u].x & 0xffff), bf2f(ov[u].x >> 16), bf2f(ov[u].y & 0xffff), bf2f(ov[u].y >> 16), bf2f(ov[u].z & 0xffff), bf2f(ov[u].z >> 16), bf2f(ov[u].w & 0xffff), bf2f(ov[u].w >> 16)};
            const float g[8] = {bf2f(gv[u].x & 0xffff), bf2f(gv[u].x >> 16), bf2f(gv[u].y & 0xffff), bf2f(gv[u].y >> 16), bf2f(gv[u].z & 0xffff), bf2f(gv[u].z >> 16), bf2f(gv[u].w & 0xffff), bf2f(gv[u].w >> 16)};
            float s = 0.f;
#pragma unroll
            for (int e = 0; e < 8; ++e) s += o[e] * o[e];
            s += __shfl_xor(s, 1); s += __shfl_xor(s, 2); s += __shfl_xor(s, 4); s += __shfl_xor(s, 8);
            const float rs = rsqrtf(s * (1.f / 128.f) + EPS);
#pragma unroll
            for (int e = 0; e < 8; ++e) o[e] = o[e] * rs * on[e] * (g[e] * __builtin_amdgcn_rcpf(1.f + __builtin_amdgcn_exp2f(-LOG2E_F * g[e])));
            v4u w; w.x = cvtpk(o[0], o[1]); w.y = cvtpk(o[2], o[3]); w.z = cvtpk(o[4], o[5]); w.w = cvtpk(o[6], o[7]);
            *(v4u*)(y + (size_t)it * DM + 512 + hh * 128 + d0) = w; } }
    phase_pool(P, lds);
}

constexpr size_t WS_CTL = 118 * MiB; constexpr int CTL_BYTES = 16384, LDS_CTL_OFF = 147392;
#define XB_TMO      128
#define XB_XCNT(j)  (256  + 64 * (j))
#define XB_XSUB(j)  (1280 + 64 * (j))
#define XB_XGEN(j)  (2304 + 64 * (j))
#define XB_TOP      3328
#define XB_TOPGEN   3392
#define XCD_BAR_WORDS 3456
#define XB_SPIN_CAP (1u << 18)

__device__ __forceinline__ unsigned xb_ld(unsigned* p)              { return __hip_atomic_load(p, __ATOMIC_RELAXED, __HIP_MEMORY_SCOPE_AGENT); }
__device__ __forceinline__ unsigned xb_add(unsigned* p, unsigned v) { return __hip_atomic_fetch_add(p, v, __ATOMIC_RELAXED, __HIP_MEMORY_SCOPE_AGENT); }
__device__ __forceinline__ unsigned xb_xcc_id() { return (unsigned)__builtin_amdgcn_s_getreg((3 << 11) | 20) & 0xFu; }
#define XB_SPIN(cond, bar) do { unsigned _sp = 0; while (cond) { __builtin_amdgcn_s_sleep(1); \
    if ((++_sp & 255u) == 0u) { if (xb_ld(&(bar)[XB_TMO])) break; if (_sp > XB_SPIN_CAP) { atomicAdd(&(bar)[XB_TMO], 1u); break; } } } } while (0)

struct XcdBarrier {
    unsigned* bar; unsigned x;
    volatile LAS unsigned* st;
};

__device__ __forceinline__ XcdBarrier xcd_barrier_post(unsigned* bar, volatile LAS unsigned* st) {
    XcdBarrier b; b.bar = bar; b.x = xb_xcc_id(); b.st = st;
    if (threadIdx.x == 0) (void)xb_add(&bar[XB_XCNT(b.x)], 1u);
    return b;
}
__device__ __forceinline__ void xcd_barrier_complete(unsigned* bar, unsigned x, unsigned& nloc, unsigned& nx) {
    const unsigned G = gridDim.x * gridDim.y * gridDim.z;
    unsigned sum, cnt, mine, sp = 0u;
    for (;;) {
        sum = 0u; cnt = 0u; mine = 0u;
#pragma unroll
        for (unsigned j = 0; j < 16; ++j) { const unsigned c = xb_ld(&bar[XB_XCNT(j)]); sum += c; cnt += (c > 0u) ? 1u : 0u; mine = (j == x) ? c : mine; }
        if (sum == G) break;
        __builtin_amdgcn_s_sleep(1);
        if ((++sp & 255u) == 0u) { if (xb_ld(&bar[XB_TMO])) break; if (sp > XB_SPIN_CAP) { atomicAdd(&bar[XB_TMO], 1u); break; } }
    }
    nloc = mine > 0u ? mine : 1u; nx = cnt > 0u ? cnt : 1u;
}

__device__ __forceinline__ void xcd_barrier(const XcdBarrier& b) {
    asm volatile("s_waitcnt vmcnt(0)" ::: "memory");
    __syncthreads();
    if (threadIdx.x == 0) {
        unsigned* bar = b.bar;
        __builtin_amdgcn_s_waitcnt(0);
        unsigned nloc = b.st[0], nx = b.st[1];
        if (nloc == 0u) { xcd_barrier_complete(bar, b.x, nloc, nx); b.st[0] = nloc; b.st[1] = nx; }
        const unsigned old = xb_add(&bar[XB_XSUB(b.x)], 1u);
        const unsigned gen = old / nloc;
        if (old + 1u == (gen + 1u) * nloc) {
            __builtin_amdgcn_fence(__ATOMIC_RELEASE, "agent");
            asm volatile("s_waitcnt vmcnt(0)" ::: "memory");
            const unsigned og = xb_add(&bar[XB_TOP], 1u);
            const unsigned tg = og / nx;
            if (og + 1u == (tg + 1u) * nx) xb_add(&bar[XB_TOPGEN], 1u);
            else XB_SPIN(xb_ld(&bar[XB_TOPGEN]) == tg, bar);
            __builtin_amdgcn_fence(__ATOMIC_ACQUIRE, "agent");
            xb_add(&bar[XB_XGEN(b.x)], 1u);
            asm volatile("s_waitcnt vmcnt(0)" ::: "memory");
        } else {
            XB_SPIN(xb_ld(&bar[XB_XGEN(b.x)]) == gen, bar);
            __builtin_amdgcn_fence(__ATOMIC_ACQUIRE, "agent");
            asm volatile("s_waitcnt vmcnt(0)" ::: "memory");
        }
    }
    __syncthreads();
}

constexpr int LDS_RS_OFF = 131072;
template <class E> __device__ __forceinline__ void run_gemm(LAS unsigned char* lds, const bf16* A, const bf16* Bt, int M, int N, int K, const E& e, const float* ss = nullptr) {
    pg8::Gemm g{A, Bt, M, N, K}; pg8::StaticOrder So; So.init(M, N, (int)gridDim.x, (int)blockIdx.x);
    if (ss) { pg8::Unit u; LAS float* rs = (LAS float*)(lds + LDS_RS_OFF);
        for (int i = 0; So.next(i, u); ++i) { const int r = threadIdx.x; if (r < 256) rs[256 * i + r] = pg8::row_rstd(ss, u.pm * 256 + r); }
        __syncthreads(); }
    pg8::gemm_phase<E, pg8::StaticOrder, true, true>(lds, g, So, e);
}
constexpr int N_PHASES = 22;
#ifndef MK_PER_PHASE
#define MK_PER_PHASE 0
#endif

template <int ph> __device__ __forceinline__ void do_phase(const Params& P, LAS unsigned char* lds) {
    unsigned char* ws = P.ws;
    bf16* xh = (bf16*)(ws + WS_XH); float* ss = (float*)(ws + WS_SS); bf16* yb = (bf16*)(ws + WS_Y); bf16* zb = (bf16*)(ws + WS_Z);
    if constexpr (ph == 0) phase_prologue(P, lds);
    else if constexpr (ph == 1) { pg8::EpiInA e{zb, (float*)(ws + WS_BA), (LAS float*)(lds + LDS_RS_OFF)}; run_gemm(lds, xh, (const bf16*)(ws + WS_AIN), T, 2816, 1024, e, ss);
        { pg8::EpiBf<0> e2{(bf16*)(ws + WS_MEMKV), 4096, nullptr, 1.f}; run_gemm(lds, (const bf16*)(ws + WS_MEMH), (const bf16*)(ws + WS_XKV), 2048, 4096, 1024, e2); } }
    else if constexpr (ph == 2) phase_dna(P, lds);
    else if constexpr (ph == 3) phase_dnb(P, lds);
    else if constexpr (ph == 4) phase_dnc(P, lds);
    else if constexpr (ph == 11) { pg8::EpiInC e{zb, zb + (size_t)T * 1024, (float*)(ws + WS_GATES), (LAS float*)(lds + LDS_RS_OFF)}; run_gemm(lds, xh, (const bf16*)(ws + WS_CIN), T, 2816, 1024, e, ss); }
    else if constexpr (ph == 12) { const int kvs = (int)blockIdx.x >> 5;
        if (kvs < 2) { pg8::EpiF32 e{(float*)(ws + (kvs ? WS_P01V : WS_P01K)), 256};
            pg8::Gemm g{zb + (size_t)T * 1024 + (size_t)kvs * KV_KIND, (const bf16*)(ws + (kvs ? WS_CMPV : WS_CMPK)), 8192, 256, 1024}; pg8::StaticOrder So; So.init(8192, 256, (int)gridDim.x, (int)blockIdx.x & 31);
            pg8::gemm_phase<pg8::EpiF32, pg8::StaticOrder, true, true>(lds, g, So, e);
            pg8::Unit u; So.next(0, u);
            __builtin_amdgcn_fence(__ATOMIC_RELEASE, "agent"); asm volatile("s_waitcnt vmcnt(0)" ::: "memory"); __syncthreads(); __builtin_amdgcn_fence(__ATOMIC_ACQUIRE, "agent"); asm volatile("s_waitcnt vmcnt(0)" ::: "memory");
            cmpfin_bg(P, lds, kvs, u.pm); } }
    else if constexpr (ph == 13) { }
    else if constexpr (ph == 14) phase_nsa(P, lds);
    else if constexpr (ph == 21) phase_final(P);
    else { constexpr int l = ph >= 15 ? 1 : 0, k = ph - (l ? 15 : 5);
        if constexpr (k == 1) {
            { pg8::EpiBf<0> e{(bf16*)(ws + WS_QXA), 1024, (LAS float*)(lds + LDS_RS_OFF), 1.f}; run_gemm(lds, xh, (const bf16*)(ws + WS_XQ) + (size_t)l * 1048576, T, 1024, 1024, e, ss); } }
        else if constexpr (k == 2) phase_xatt(P, lds, l);
        else if constexpr (k == 4) { pg8::EpiBf<1> e{(bf16*)(ws + WS_HMID), 4096, (LAS float*)(lds + LDS_RS_OFF), 1.f}; run_gemm(lds, xh, (const bf16*)(ws + WS_F1) + (size_t)l * 4194304, T, 4096, 1024, e, ss); }
        else { const bf16* A = k == 5 ? (const bf16*)(ws + WS_HMID) : yb; constexpr int K = k == 5 ? 4096 : 1024;
            const bf16* Bt = k == 0 ? (const bf16*)(ws + (l ? WS_COUT : WS_AOUT)) : k == 3 ? (const bf16*)(ws + WS_XO) + (size_t)l * 1048576 : (const bf16*)(ws + WS_F2) + (size_t)l * 4194304;
            if constexpr (ph == 5) { pg8::EpiRes<true> e{xh, ss, P.in[I_X]}; run_gemm(lds, A, Bt, T, 1024, K, e); }
            else { pg8::EpiRes<false> e{xh, ss, nullptr}; run_gemm(lds, A, Bt, T, 1024, K, e); } } }
}
__global__ void __launch_bounds__(NTHR, 2) trunk_fwd(Params P) {
    extern __shared__ __attribute__((aligned(16))) unsigned char lds_raw[];
    LAS unsigned char* lds = (LAS unsigned char*)lds_raw;
    cg::grid_group grid = cg::this_grid();
    const int lo = P.ph_lo, hi = P.ph_hi;
#ifndef PROBE_PH
#define PROBE_PH -1
#endif
    if (threadIdx.x < 2) ((LAS unsigned*)(lds + LDS_CTL_OFF))[threadIdx.x] = 0u;
    __syncthreads();
    const XcdBarrier bar = xcd_barrier_post((unsigned*)(P.ws + WS_CTL), (volatile LAS unsigned*)(lds + LDS_CTL_OFF));
    if (P.ph_lo < 0) grid.sync();
#define SEAM(k) { xcd_barrier(bar); }
#define RUN(k) if (lo <= (k) && (k) < hi) { if ((k) == PROBE_PH) { do_phase<(k)>(P, lds); SEAM(k) } do_phase<(k)>(P, lds); if ((k) + 1 < hi) SEAM(k) }
    RUN(0) RUN(1) RUN(2) RUN(3) RUN(4) RUN(5) RUN(6) RUN(7) RUN(8) RUN(9) RUN(10) RUN(11) RUN(12) RUN(14) RUN(15) RUN(16) RUN(17) RUN(18) RUN(19) RUN(20) RUN(21)
#undef RUN
}

extern "C" void kernel_launch(void* const* d_in, const int* in_sizes, int n_in, void* d_out, int out_size, void* d_ws, size_t ws_size, hipStream_t stream) {
    static int grid = 0;
    if (grid == 0) {
        if (n_in != N_IN || in_sizes[0] != T * DM || out_size != T * DM || ws_size < WS_END) { fprintf(stderr, "kernel_launch: unexpected shapes (n_in %d, in0 %d, out %d, ws %zu)\n", n_in, n_in > 0 ? in_sizes[0] : -1, out_size, ws_size); grid = -1; return; }
        int dev = 0, cus = 0, per_cu = 0;
        if (hipGetDevice(&dev) != hipSuccess || hipDeviceGetAttribute(&cus, hipDeviceAttributeMultiprocessorCount, dev) != hipSuccess) { grid = -1; return; }
        if (hipFuncSetAttribute((const void*)trunk_fwd, hipFuncAttributeMaxDynamicSharedMemorySize, LDS_BYTES) != hipSuccess) { fprintf(stderr, "kernel_launch: hipFuncSetAttribute failed\n"); grid = -1; return; }
        if (hipOccupancyMaxActiveBlocksPerMultiprocessor(&per_cu, (const void*)trunk_fwd, NTHR, LDS_BYTES) != hipSuccess || per_cu < 1) { fprintf(stderr, "kernel_launch: occupancy query says %d blocks/CU\n", per_cu); (void)hipGetLastError(); grid = -1; return; }
        grid = cus;
        fprintf(stderr, "kernel_launch: %d CUs, %d blocks/CU by the occupancy query, grid %d\n", cus, per_cu, grid);
    }
    if (grid < 0) return;
    Params p{};
    for (int i = 0; i < N_IN; ++i) p.in[i] = (const float*)d_in[i];
    p.out = (float*)d_out; p.ws = (unsigned char*)d_ws;
#if MK_PER_PHASE
    for (int ph = 0; ph < N_PHASES; ++ph) { p.ph_lo = ph; p.ph_hi = ph + 1; hipLaunchKernelGGL(trunk_fwd, dim3(grid), dim3(NTHR), LDS_BYTES, stream, p); }
#else
    p.ph_lo = 0; p.ph_hi = N_PHASES;
    if (hipMemsetAsync((char*)d_ws + WS_CTL, 0, CTL_BYTES, stream) != hipSuccess) { fprintf(stderr, "kernel_launch: memset of the barrier words failed\n"); return; }
    void* args[] = {&p};
    hipError_t e = hipLaunchCooperativeKernel((const void*)trunk_fwd, dim3(grid), dim3(NTHR), args, LDS_BYTES, stream);
    if (e != hipSuccess) fprintf(stderr, "kernel_launch: cooperative launch failed: %s (grid %d)\n", hipGetErrorString(e), grid);
#endif
}
```

```cpp
#include <hip/hip_runtime.h>
#include <hip/hip_cooperative_groups.h>
#include <cstdio>
#include <cstdint>
namespace cg = cooperative_groups;
namespace pg8 {
#define PG8_LAS __attribute__((address_space(3)))
typedef unsigned short bf16_t;
typedef short bf16x8 __attribute__((ext_vector_type(8)));
typedef float f32x4 __attribute__((ext_vector_type(4)));
typedef unsigned u32x4 __attribute__((ext_vector_type(4)));
constexpr int BM = 256, BK = 64, HALF = 128, HTB = HALF * BK * 2  , STAGE_BYTES = 8 * HTB, NXCD = 8, WGM = 8;

__host__ __device__ __forceinline__ int lds_byte(int r, int c) { const int st = (r >> 4) * 2 + (c >> 5), rr = r & 15, cc = c & 31, ob = rr * 64 + cc * 2; return st * 1024 + (ob ^ (((ob >> 9) & 1) << 5)); }
__host__ __device__ __forceinline__ void stage_rc(int b, int& R, int& C) { const int st = b / 1024, sb = b % 1024, swz = sb ^ (((sb >> 9) & 1) << 5); R = (st >> 1) * 16 + swz / 64; C = (st & 1) * 32 + (swz % 64) / 2; }
__host__ __device__ __forceinline__ int perm32(int rho) { const int n = rho >> 4, i = rho & 15; return 8 * (i >> 2) + 4 * n + (i & 3); }

struct Unit { int pm, pn, ui, kind; };
struct Gemm { const bf16_t* A; const bf16_t* Bt; int M, N, K; const bf16_t* A2 = nullptr; const bf16_t* Bt2 = nullptr; };

struct StaticOrder {
    int nM, nN, nwg, G, c;
    __host__ __device__ void init(int M, int N, int G_, int c_) { nM = M / BM; nN = N / BM; nwg = nM * nN; G = G_; c = c_; }
    __host__ __device__ bool next(int i, Unit& u) const {
        const long L = (long)i * G + c; if (L >= nwg) return false;
        int wgid = (int)L; { const int q = nwg / NXCD, r = nwg % NXCD, xcd = wgid % NXCD, off = wgid / NXCD; wgid = (xcd < r ? xcd * (q + 1) : r * (q + 1) + (xcd - r) * q) + off; }
        const int nig = WGM * nN, gid = wgid / nig, fm = gid * WGM, gsz = (nM - fm) < WGM ? (nM - fm) : WGM;
        u.pm = fm + ((wgid % nig) % gsz); u.pn = (wgid % nig) / gsz; u.ui = i; u.kind = 0; return true;
    }
    __device__ __forceinline__ void a_ready(const Unit&) const {}
    __device__ __forceinline__ void done(const Unit&) const {}
};
__device__ __forceinline__ unsigned cvt_pk_bf16(float lo, float hi) { unsigned r; asm volatile("v_cvt_pk_bf16_f32 %0, %1, %2" : "=v"(r) : "v"(lo), "v"(hi)); return r; }
typedef float f32x2 __attribute__((ext_vector_type(2)));
typedef float f32x2 __attribute__((ext_vector_type(2)));
template <class Epi, class Sched, bool ALIGN_EPI = false, bool SP2 = false>
__device__ __forceinline__ void gemm_phase(PG8_LAS unsigned char* lds, const Gemm g, const Sched& S, const Epi& E) {
    int tid_l = threadIdx.x; asm volatile("" : "+v"(tid_l));
    const int tid = tid_l, wid = __builtin_amdgcn_readfirstlane(tid >> 6), lane = tid & 63, wr = wid >> 2, wc = wid & 3, fr = lane & 15, fq = lane >> 4;
    const int K = g.K, nt = K / BK;
    unsigned voffA[2], voffB[2];
#pragma unroll
    for (int i = 0; i < 2; ++i) { int R, C; stage_rc(tid * 16 + i * 8192, R, C); const int Rb = Epi::PERM ? ((R & ~31) + perm32(R & 31)) : R;
        voffA[i] = (unsigned)(R * K + C) * 2u; voffB[i] = (unsigned)(Rb * K + C) * 2u; }
    const size_t kstep = (size_t)(BK * 2);
    const size_t hstep = (size_t)HALF * K * 2;
    const size_t tstep = 2 * hstep;
    const unsigned ldsw = (unsigned)wid * 1024u;
    const int aoff = lds_byte(wr * 64 + fr, fq * 8), boff = lds_byte(wc * 32 + fr, fq * 8);
#define PG8_SA(b, h) (((b) * 2 + (h)) * HTB)
#define PG8_SB(b, h) ((4 + (b) * 2 + (h)) * HTB)
#define PG8_STAGE(bufoff, gbase, voff) do { _Pragma("unroll") for (int _i = 0; _i < 2; ++_i) \
        __builtin_amdgcn_global_load_lds((const unsigned*)((const char*)(gbase) + (voff)[_i]), (PG8_LAS unsigned*)(lds + (bufoff) + ldsw + _i * 8192), 16, 0, 0); } while (0)
#define PG8_LDA(dst, b, h) do { _Pragma("unroll") for (int m = 0; m < 4; ++m) _Pragma("unroll") for (int k = 0; k < 2; ++k) dst[m][k] = *(const PG8_LAS bf16x8*)(lds + PG8_SA(b, h) + aoff + m * 2048 + k * 1024); } while (0)
#define PG8_LDB(dst, b, h) do { _Pragma("unroll") for (int n = 0; n < 2; ++n) _Pragma("unroll") for (int k = 0; k < 2; ++k) dst[n][k] = *(const PG8_LAS bf16x8*)(lds + PG8_SB(b, h) + boff + n * 2048 + k * 1024); } while (0)
#define PG8_MMA(ai, bj, At, Bt) do { __builtin_amdgcn_s_setprio(1); _Pragma("unroll") for (int m = 0; m < 4; ++m) _Pragma("unroll") for (int n = 0; n < 2; ++n) _Pragma("unroll") for (int k = 0; k < 2; ++k) \
        acc[ai][bj][m][n] = __builtin_amdgcn_mfma_f32_16x16x32_bf16(Bt[n][k], At[m][k], acc[ai][bj][m][n], 0, 0, 0); __builtin_amdgcn_s_setprio(0); } while (0)
#define PG8_WAIT_V(n) asm volatile("s_waitcnt vmcnt(" #n ")" ::: "memory")
#define PG8_WAIT_L(n) asm volatile("s_waitcnt lgkmcnt(" #n ")" ::: "memory")
#define PG8_BAR __builtin_amdgcn_s_barrier()
#define PG8_SCHED __builtin_amdgcn_sched_barrier(0)
    Unit cur, nxt; int ui = 0;
    if (!S.next(0, cur)) return;
    f32x4 acc[2][2][4][2];
#pragma unroll
    for (int a = 0; a < 2; ++a)
#pragma unroll
        for (int b = 0; b < 2; ++b)
#pragma unroll
            for (int m = 0; m < 4; ++m)
#pragma unroll
                for (int n = 0; n < 2; ++n) acc[a][b][m][n] = (f32x4){0.f, 0.f, 0.f, 0.f};
    bf16x8 At[4][2], B0[2][2], B1[2][2];
    const char* cA = (const char*)(cur.kind ? g.A2 : g.A) + (size_t)cur.pm * tstep; const char* cB = (const char*)(cur.kind ? g.Bt2 : g.Bt) + (size_t)cur.pn * tstep;
    S.a_ready(cur);
    if constexpr (SP2) {
        PG8_STAGE(PG8_SB(0, 0), cB, voffB); PG8_STAGE(PG8_SB(0, 1), cB + hstep, voffB); PG8_STAGE(PG8_SA(0, 0), cA, voffA); PG8_STAGE(PG8_SA(0, 1), cA + hstep, voffA);
        if (wr == 1) PG8_BAR;
        PG8_WAIT_V(2); PG8_BAR;
        PG8_STAGE(PG8_SB(1, 0), cB + kstep, voffB); PG8_STAGE(PG8_SA(1, 0), cA + kstep, voffA); PG8_STAGE(PG8_SB(1, 1), cB + hstep + kstep, voffB);
        PG8_WAIT_V(6); PG8_BAR;
    } else {
        PG8_STAGE(PG8_SB(0, 0), cB, voffB); PG8_STAGE(PG8_SA(0, 0), cA, voffA); PG8_STAGE(PG8_SB(0, 1), cB + hstep, voffB); PG8_STAGE(PG8_SA(0, 1), cA + hstep, voffA);
        if (wr == 1) PG8_BAR;
        PG8_WAIT_V(4); PG8_BAR;
        PG8_STAGE(PG8_SB(1, 0), cB + kstep, voffB); PG8_STAGE(PG8_SA(1, 0), cA + kstep, voffA); PG8_STAGE(PG8_SB(1, 1), cB + hstep + kstep, voffB);
        PG8_WAIT_V(6); PG8_BAR;
    }
    for (;;) {
        const bool has_next = S.next(ui + 1, nxt);
        const char* nA = has_next ? (const char*)(nxt.kind ? g.A2 : g.A) + (size_t)nxt.pm * tstep : cA; const char* nB = has_next ? (const char*)(nxt.kind ? g.Bt2 : g.Bt) + (size_t)nxt.pn * tstep : cB;
        for (int t = 0; t < nt; t += 2) {
            const bool last = (t == nt - 2);
            const char* a1 = cA + (size_t)(t + 1) * kstep;
            const char* a2 = last ? nA : cA + (size_t)(t + 2) * kstep; const char* b2 = last ? nB : cB + (size_t)(t + 2) * kstep;
            const char* a3 = a2 + kstep; const char* b3 = b2 + kstep;
            if (last && has_next) S.a_ready(nxt);
            if constexpr (SP2) {
            PG8_LDB(B0, 0, 0); PG8_LDB(B1, 0, 1); PG8_SCHED; PG8_LDA(At, 0, 0); PG8_STAGE(PG8_SA(1, 1), a1 + hstep, voffA);
            PG8_WAIT_V(8); PG8_WAIT_L(0); PG8_BAR; PG8_MMA(0, 0, At, B0); PG8_MMA(0, 1, At, B1); PG8_BAR; PG8_SCHED;
            PG8_LDA(At, 0, 1); PG8_STAGE(PG8_SB(0, 0), b2, voffB); PG8_STAGE(PG8_SB(0, 1), b2 + hstep, voffB); PG8_STAGE(PG8_SA(0, 0), a2, voffA);
            PG8_WAIT_V(8); PG8_WAIT_L(0); PG8_BAR; PG8_MMA(1, 0, At, B0); PG8_MMA(1, 1, At, B1); PG8_BAR; PG8_SCHED;
            PG8_LDB(B0, 1, 0); PG8_LDB(B1, 1, 1); PG8_SCHED; PG8_LDA(At, 1, 0); PG8_STAGE(PG8_SA(0, 1), a2 + hstep, voffA);
            PG8_WAIT_V(8); PG8_WAIT_L(0); PG8_BAR; PG8_MMA(0, 0, At, B0); PG8_MMA(0, 1, At, B1); PG8_BAR; PG8_SCHED;
            PG8_LDA(At, 1, 1); PG8_STAGE(PG8_SB(1, 0), b3, voffB); PG8_STAGE(PG8_SB(1, 1), b3 + hstep, voffB); PG8_STAGE(PG8_SA(1, 0), a3, voffA);
            PG8_WAIT_V(8); PG8_WAIT_L(0); PG8_BAR; PG8_MMA(1, 0, At, B0); PG8_MMA(1, 1, At, B1); PG8_BAR; PG8_SCHED;
            } else {
            PG8_LDB(B0, 0, 0); PG8_SCHED; PG8_LDA(At, 0, 0); PG8_STAGE(PG8_SA(1, 1), a1 + hstep, voffA);
            PG8_WAIT_L(8); PG8_BAR; PG8_WAIT_L(0); PG8_MMA(0, 0, At, B0); PG8_BAR; PG8_SCHED;
            PG8_LDB(B1, 0, 1); PG8_STAGE(PG8_SB(0, 0), b2, voffB);
            PG8_BAR; PG8_WAIT_L(0); PG8_MMA(0, 1, At, B1); PG8_BAR;
            PG8_LDA(At, 0, 1); PG8_STAGE(PG8_SA(0, 0), a2, voffA);
            PG8_BAR; PG8_WAIT_L(0); PG8_MMA(1, 0, At, B0); PG8_BAR; PG8_SCHED;
            PG8_STAGE(PG8_SB(0, 1), b2 + hstep, voffB);
            PG8_WAIT_V(6); PG8_BAR; PG8_MMA(1, 1, At, B1); PG8_BAR;
            PG8_LDB(B0, 1, 0); PG8_SCHED; PG8_LDA(At, 1, 0); PG8_STAGE(PG8_SA(0, 1), a2 + hstep, voffA);
            PG8_WAIT_L(8); PG8_BAR; PG8_WAIT_L(0); PG8_MMA(0, 0, At, B0); PG8_BAR; PG8_SCHED;
            PG8_LDB(B1, 1, 1); PG8_STAGE(PG8_SB(1, 0), b3, voffB);
            PG8_BAR; PG8_WAIT_L(0); PG8_MMA(0, 1, At, B1); PG8_BAR;
            PG8_LDA(At, 1, 1); PG8_STAGE(PG8_SA(1, 0), a3, voffA);
            PG8_BAR; PG8_WAIT_L(0); PG8_MMA(1, 0, At, B0); PG8_BAR; PG8_SCHED;
            PG8_STAGE(PG8_SB(1, 1), b3 + hstep, voffB);
            PG8_WAIT_V(6); PG8_BAR; PG8_MMA(1, 1, At, B1); PG8_BAR;
            }
        }
        if constexpr (ALIGN_EPI) { if (wr == 0) PG8_BAR; }
        if constexpr (!Epi::AFTER_DRAIN) { E(acc, cur, wr, wc, fr, fq); S.done(cur); }
        if (!has_next) break;
#pragma unroll
        for (int a = 0; a < 2; ++a)
#pragma unroll
            for (int b = 0; b < 2; ++b)
#pragma unroll
                for (int m = 0; m < 4; ++m)
#pragma unroll
                    for (int n = 0; n < 2; ++n) acc[a][b][m][n] = (f32x4){0.f, 0.f, 0.f, 0.f};
        cur = nxt; cA = nA; cB = nB; ++ui;
        if constexpr (ALIGN_EPI) { if (wr == 1) PG8_BAR; }
    }
    PG8_WAIT_V(0);
    if constexpr (!ALIGN_EPI) { if (wr == 0) PG8_BAR; }
    PG8_BAR;
    if constexpr (Epi::AFTER_DRAIN) { E.fused(acc, cur, wr, wc, fr, fq, lds, wid, lane); S.done(cur); }
#undef PG8_SA
#undef PG8_SB
#undef PG8_STAGE
#undef PG8_LDA
#undef PG8_LDB
#undef PG8_MMA
#undef PG8_WAIT_V
#undef PG8_WAIT_L
#undef PG8_BAR
#undef PG8_SCHED
}
}
namespace pg8 {
struct DualOrder {
    StaticOrder s1, s2; int G, c;
    __host__ __device__ void init(int M1, int N1, int M2, int N2, int G_, int c_) { s1.init(M1, N1, 1, 0); s2.init(M2, N2, 1, 0); G = G_; c = c_; }
    __host__ __device__ bool next(int i, Unit& u) const {
        const long L = (long)i * G + c; if (L >= s1.nwg + s2.nwg) return false;
        if (L < s1.nwg) { s1.next((int)L, u); u.kind = 0; } else { s2.next((int)(L - s1.nwg), u); u.kind = 1; }
        u.ui = i; return true;
    }
    __device__ __forceinline__ void a_ready(const Unit&) const {}
    __device__ __forceinline__ void done(const Unit&) const {}
};
__device__ __forceinline__ float row_rstd(const float* ss, int row) {
    const f32x4* p = (const f32x4*)(ss + (size_t)row * 16);
    const f32x4 a = p[0], b = p[1], c = p[2], d = p[3];
    const float s = (((a[0] + a[1]) + (a[2] + a[3])) + ((b[0] + b[1]) + (b[2] + b[3]))) + (((c[0] + c[1]) + (c[2] + c[3])) + ((d[0] + d[1]) + (d[2] + d[3])));
    return rsqrtf(s * (1.0f / 1024.0f) + 1e-6f);
}
__device__ __forceinline__ u32x4 pack8(f32x4 v0, f32x4 v1) { u32x4 w; w.x = cvt_pk_bf16(v0[0], v0[1]); w.y = cvt_pk_bf16(v0[2], v0[3]); w.z = cvt_pk_bf16(v1[0], v1[1]); w.w = cvt_pk_bf16(v1[2], v1[3]); return w; }

template <int ACT  > struct EpiBf {
    static constexpr bool PERM = true, AFTER_DRAIN = false;
    bf16_t* O; int ldc; const PG8_LAS float* rs; float mul;
    __device__ __forceinline__ void operator()(const f32x4 (&acc)[2][2][4][2], const Unit& u, int wr, int wc, int fr, int fq) const {
        const int row0 = u.pm * BM + wr * 64 + fr, col0 = u.pn * BM + wc * 32 + 8 * fq;
#pragma unroll
        for (int ai = 0; ai < 2; ++ai)
#pragma unroll
            for (int m = 0; m < 4; ++m) { const int row = row0 + ai * HALF + m * 16; const float sc = rs ? mul * rs[256 * u.ui + ai * HALF + wr * 64 + m * 16 + fr] : mul; bf16_t* rowp = O + (size_t)row * ldc + col0;
#pragma unroll
                for (int bj = 0; bj < 2; ++bj) { f32x4 v0 = acc[ai][bj][m][0] * sc, v1 = acc[ai][bj][m][1] * sc;
                    if (ACT == 1) {
#pragma unroll
                        for (int j = 0; j < 4; ++j) { const float a = fmaxf(v0[j], 0.f), b = fmaxf(v1[j], 0.f); v0[j] = a * a; v1[j] = b * b; } }
                    *(u32x4*)(rowp + bj * HALF) = pack8(v0, v1); } }
    }
};
struct EpiF32 {
    static constexpr bool PERM = true, AFTER_DRAIN = false;
    float* C; int ldc;
    __device__ __forceinline__ void operator()(const f32x4 (&acc)[2][2][4][2], const Unit& u, int wr, int wc, int fr, int fq) const {
        const int row0 = u.pm * BM + wr * 64 + fr, col0 = u.pn * BM + wc * 32 + 8 * fq;
#pragma unroll
        for (int ai = 0; ai < 2; ++ai)
#pragma unroll
            for (int m = 0; m < 4; ++m) { float* rowp = C + (size_t)(row0 + ai * HALF + m * 16) * ldc + col0;
#pragma unroll
                for (int bj = 0; bj < 2; ++bj) { *(f32x4*)(rowp + bj * HALF) = acc[ai][bj][m][0]; *(f32x4*)(rowp + bj * HALF + 4) = acc[ai][bj][m][1]; } }
    }
};
template <bool F32RES> struct EpiRes {
    static constexpr bool PERM = true, AFTER_DRAIN = false;
    bf16_t* xh; float* ssout; const float* r32;
    __device__ __forceinline__ void operator()(const f32x4 (&acc)[2][2][4][2], const Unit& u, int wr, int wc, int fr, int fq) const {
        const int row0 = u.pm * BM + wr * 64 + fr, col0 = u.pn * BM + wc * 32 + 8 * fq;
#pragma unroll
        for (int ai = 0; ai < 2; ++ai) {
            u32x4 pre[4][2]; f32x4 pf[4][2][2];
#pragma unroll
            for (int m = 0; m < 4; ++m)
#pragma unroll
                for (int bj = 0; bj < 2; ++bj) { const size_t off = (size_t)(row0 + ai * HALF + m * 16) * 1024 + col0 + bj * HALF;
                    if (F32RES) { pf[m][bj][0] = *(const f32x4*)(r32 + off); pf[m][bj][1] = *(const f32x4*)(r32 + off + 4); } else pre[m][bj] = *(const u32x4*)(xh + off); }
            asm volatile("" ::: "memory"); __builtin_amdgcn_sched_barrier(0);
#pragma unroll
            for (int m = 0; m < 4; ++m) { const int row = row0 + ai * HALF + m * 16; float q = 0.f;
#pragma unroll
                for (int bj = 0; bj < 2; ++bj) { const size_t off = (size_t)row * 1024 + col0 + bj * HALF; f32x4 r0, r1;
                    if (F32RES) { r0 = pf[m][bj][0]; r1 = pf[m][bj][1]; }
                    else { const u32x4 p = pre[m][bj];
                        r0 = (f32x4){__uint_as_float(p.x << 16), __uint_as_float(p.x & 0xffff0000u), __uint_as_float(p.y << 16), __uint_as_float(p.y & 0xffff0000u)};
                        r1 = (f32x4){__uint_as_float(p.z << 16), __uint_as_float(p.z & 0xffff0000u), __uint_as_float(p.w << 16), __uint_as_float(p.w & 0xffff0000u)}; }
                    const f32x4 v0 = acc[ai][bj][m][0] + r0, v1 = acc[ai][bj][m][1] + r1;
                    q += ((v0[0] * v0[0] + v0[1] * v0[1]) + (v0[2] * v0[2] + v0[3] * v0[3])) + ((v1[0] * v1[0] + v1[1] * v1[1]) + (v1[2] * v1[2] + v1[3] * v1[3]));
                    *(u32x4*)(xh + off) = pack8(v0, v1); }
                q += __shfl_xor(q, 16); q += __shfl_xor(q, 32);
                if (fq == 0) ssout[(size_t)row * 16 + u.pn * 4 + wc] = q; }
            asm volatile("" ::: "memory"); __builtin_amdgcn_sched_barrier(0); }
    }
};
struct EpiInA {
    static constexpr bool PERM = true, AFTER_DRAIN = false;
    bf16_t* z; float* ba; const PG8_LAS float* rs;
    __device__ __forceinline__ void operator()(const f32x4 (&acc)[2][2][4][2], const Unit& u, int wr, int wc, int fr, int fq) const {
        const int row0 = u.pm * BM + wr * 64 + fr, col0 = u.pn * BM + wc * 32 + 8 * fq;
#pragma unroll
        for (int ai = 0; ai < 2; ++ai)
#pragma unroll
            for (int m = 0; m < 4; ++m) { const int row = row0 + ai * HALF + m * 16; const float sc = rs[256 * u.ui + ai * HALF + wr * 64 + m * 16 + fr];
                if (u.pn < 10) { bf16_t* rowp = z + (size_t)row * 2560 + col0;
#pragma unroll
                    for (int bj = 0; bj < 2; ++bj) *(u32x4*)(rowp + bj * HALF) = pack8(acc[ai][bj][m][0] * sc, acc[ai][bj][m][1] * sc);
                } else if (wc == 0 && fq == 0) { *(f32x4*)(ba + (size_t)row * 8) = acc[ai][0][m][0] * sc; *(f32x4*)(ba + (size_t)row * 8 + 4) = acc[ai][0][m][1] * sc; } }
    }
};
struct EpiInC {
    static constexpr bool PERM = true, AFTER_DRAIN = false;
    bf16_t* q; bf16_t* kv; float* gates; const PG8_LAS float* rs;
    __device__ __forceinline__ void operator()(const f32x4 (&acc)[2][2][4][2], const Unit& u, int wr, int wc, int fr, int fq) const {
        const int row0 = u.pm * BM + wr * 64 + fr, col0 = u.pn * BM + wc * 32 + 8 * fq;
#pragma unroll
        for (int ai = 0; ai < 2; ++ai)
#pragma unroll
            for (int m = 0; m < 4; ++m) { const int row = row0 + ai * HALF + m * 16; const float sc = rs[256 * u.ui + ai * HALF + wr * 64 + m * 16 + fr];
                if (u.pn < 4) { bf16_t* rowp = q + (size_t)row * 1024 + col0;
#pragma unroll
                    for (int bj = 0; bj < 2; ++bj) *(u32x4*)(rowp + bj * HALF) = pack8(acc[ai][bj][m][0] * sc, acc[ai][bj][m][1] * sc);
                } else if (u.pn < 10) { const int b = row >> 12, s = row & 4095;
#pragma unroll
                    for (int bj = 0; bj < 2; ++bj) { const int cp = col0 + bj * HALF - 1024, kind = cp >> 8, g = (cp >> 6) & 3, d = cp & 63;
                        *(u32x4*)(kv + (size_t)kind * ((size_t)32768 * 256) + ((size_t)((b * 4 + g) * 4096 + s)) * 64 + d) = pack8(acc[ai][bj][m][0] * sc, acc[ai][bj][m][1] * sc); }
                } else { const int cl = wc * 32 + 8 * fq; if (cl < 48) { *(f32x4*)(gates + (size_t)row * 48 + cl) = acc[ai][0][m][0] * sc; *(f32x4*)(gates + (size_t)row * 48 + cl + 4) = acc[ai][0][m][1] * sc; } } }
    }
};
template <class E0, class E1> struct EpiDual {
    static constexpr bool PERM = true, AFTER_DRAIN = false;
    E0 e0; E1 e1;
    __device__ __forceinline__ void operator()(const f32x4 (&acc)[2][2][4][2], const Unit& u, int wr, int wc, int fr, int fq) const { if (u.kind) e1(acc, u, wr, wc, fr, fq); else e0(acc, u, wr, wc, fr, fq); }
};
}
#define LAS __attribute__((address_space(3)))
typedef unsigned short bf16;
typedef float f32x4 __attribute__((ext_vector_type(4)));
typedef unsigned v4u __attribute__((ext_vector_type(4)));
typedef unsigned v2u __attribute__((ext_vector_type(2)));
typedef short bf16x8 __attribute__((ext_vector_type(8)));
typedef float f32x16 __attribute__((ext_vector_type(16)));
typedef short v4i16 __attribute__((ext_vector_type(4)));
typedef float f32x2_t __attribute__((ext_vector_type(2))); typedef __bf16 bf16x2_t __attribute__((ext_vector_type(2)));
__device__ __forceinline__ unsigned cvtpk(float lo, float hi) { f32x2_t v = {lo, hi}; bf16x2_t b = __builtin_convertvector(v, bf16x2_t); return __builtin_bit_cast(unsigned, b); }

constexpr int NWAVES = 8, NTHR = 512;
constexpr int T = 32768, SEQ = 4096, DM = 1024, FF = 4096;
constexpr int LDS_BYTES = 147456;
constexpr float EPS = 1e-6f;

enum { I_X = 0, I_MEM, I_A_LN, I_A_WIN, I_A_POOLW, I_A_POOLS, I_A_CONV, I_A_ALOG, I_A_DTB, I_A_ONORM, I_A_WOUT,
       I_C_LN, I_C_WIN, I_C_PEK, I_C_W1K, I_C_W2K, I_C_PEV, I_C_W1V, I_C_W2V, I_C_WOUT,
       I_XA_LN, I_XA_MLN, I_XA_WQ, I_XA_WK, I_XA_WV, I_XA_WO, I_FF_LN, I_FF_W1, I_FF_W2, I_FLN, N_IN };

constexpr size_t MiB = (size_t)1 << 20;
constexpr size_t WS_AIN = 0, WS_AOUT = 6 * MiB, WS_CIN = 8 * MiB, WS_COUT = 14 * MiB, WS_XQ = 16 * MiB, WS_XKV = 20 * MiB, WS_XO = 28 * MiB;
constexpr size_t WS_F1 = 32 * MiB, WS_F2 = 48 * MiB, WS_CMPK = 64 * MiB, WS_CMPV = 64 * MiB + 512 * 1024, WS_CBIAS = 65 * MiB;
constexpr size_t WS_MEMH = 66 * MiB, WS_MEMKV = 74 * MiB, WS_SS = 90 * MiB, WS_BA = 92 * MiB, WS_GATES = 93 * MiB, WS_CK = 99 * MiB, WS_CV = 100 * MiB;
constexpr size_t WS_P01K = 101 * MiB, WS_P01V = 109 * MiB, WS_POOLW = 117 * MiB;
constexpr size_t WS_Z = 120 * MiB, WS_Y = 280 * MiB, WS_QXA = 344 * MiB, WS_XH = 408 * MiB, WS_HMID = 120 * MiB, WS_END = 489 * MiB;
constexpr size_t KV_KIND = (size_t)T * 256;

struct Params { const float* in[N_IN]; float* out; unsigned char* ws; int ph_lo, ph_hi; };

__device__ __forceinline__ float bf2f(unsigned v) { return __uint_as_float(v << 16); }
__device__ __forceinline__ unsigned f2bf(float f) { unsigned u = __float_as_uint(f); return (u + 0x7fffu + ((u >> 16) & 1u)) >> 16; }
__device__ __forceinline__ unsigned pk2(float lo, float hi) { return f2bf(lo) | (f2bf(hi) << 16); }
__device__ __forceinline__ float wave_sum(float v) {
#pragma unroll
    for (int o = 1; o < 64; o <<= 1) v += __shfl_xor(v, o);
    return v;
}
__device__ __forceinline__ float wave_max(float v) {
#pragma unroll
    for (int o = 1; o < 64; o <<= 1) v = fmaxf(v, __shfl_xor(v, o));
    return v;
}
__device__ __forceinline__ float silu_f(float x) { return x / (1.f + __expf(-x)); }
__device__ __forceinline__ float sigmoid_f(float x) { return 1.f / (1.f + __expf(-x)); }
#define LDS_WAIT() asm volatile("s_waitcnt lgkmcnt(0)" ::: "memory")

__device__ __forceinline__ void transpose_item(const float* W, int K, int N, int ld, const float* gain, bf16* WT, int row_off, LAS float* scr, int item, int lane) {
    const int nblk = N / 32, kb = item / nblk, nb = item % nblk, k0 = 64 * kb, n0 = 32 * nb;
#pragma unroll
    for (int i = 0; i < 8; ++i) { const int kk = 8 * i + (lane >> 3), nn = (lane & 7) * 4; f32x4 v = *(const f32x4*)(W + (size_t)(k0 + kk) * ld + n0 + nn); if (gain) v = v * gain[k0 + kk];
        scr[kk * 33 + nn] = v.x; scr[kk * 33 + nn + 1] = v.y; scr[kk * 33 + nn + 2] = v.z; scr[kk * 33 + nn + 3] = v.w; }
    LDS_WAIT();
    const int c = lane & 7;
#pragma unroll
    for (int j = 0; j < 4; ++j) { const int n = (lane >> 3) + 8 * j; const LAS float* s = scr + (8 * c) * 33 + n;
        v4u o; o.x = pk2(s[0 * 33], s[1 * 33]); o.y = pk2(s[2 * 33], s[3 * 33]); o.z = pk2(s[4 * 33], s[5 * 33]); o.w = pk2(s[6 * 33], s[7 * 33]);
        *(v4u*)(WT + (size_t)(row_off + n0 + n) * K + k0 + 8 * c) = o; }
    LDS_WAIT();
}
#define TJOB(W_, K_, N_, LD_, G_, WT_, RO_) { const int ni_ = ((K_) / 64) * ((N_) / 32); if (r < ni_) { transpose_item((W_), (K_), (N_), (LD_), (G_), (WT_), (RO_), scr, r, lane); continue; } r -= ni_; }

__device__ __forceinline__ void phase_prologue(const Params& P, LAS unsigned char* lds) {
    int tid_l = threadIdx.x; asm volatile("" : "+v"(tid_l)); const int tid = tid_l, lane = tid & 63, wave = tid >> 6;
    const int gw = blockIdx.x * NWAVES + wave, NGW = gridDim.x * NWAVES;
    unsigned char* ws = P.ws;
    LAS float* scr = (LAS float*)(lds + wave * 16384);
    constexpr int NITEMS = 1280 + 512 + 1280 + 512 + 4 * 512 + 512 + 2048 + 2048 + 4 * 64;
    for (int it = gw; it < NITEMS; it += NGW) {
        int r = it;
        TJOB(P.in[I_A_WIN], 1024, 2560, 2568, P.in[I_A_LN], (bf16*)(ws + WS_AIN), 0)
        TJOB(P.in[I_A_WOUT], 1024, 1024, 1024, nullptr, (bf16*)(ws + WS_AOUT), 0)
        TJOB(P.in[I_C_WIN], 1024, 2560, 2608, P.in[I_C_LN], (bf16*)(ws + WS_CIN), 0)
        TJOB(P.in[I_XA_WQ], 1024, 1024, 1024, P.in[I_XA_LN], (bf16*)(ws + WS_XQ), 0)
        TJOB(P.in[I_XA_WK], 1024, 1024, 1024, P.in[I_XA_MLN], (bf16*)(ws + WS_XKV), 0)
        TJOB(P.in[I_XA_WV], 1024, 1024, 1024, P.in[I_XA_MLN], (bf16*)(ws + WS_XKV), 1024)
        TJOB(P.in[I_XA_WK] + 1048576, 1024, 1024, 1024, P.in[I_XA_MLN] + 1024, (bf16*)(ws + WS_XKV) + 2097152, 0)
        TJOB(P.in[I_XA_WV] + 1048576, 1024, 1024, 1024, P.in[I_XA_MLN] + 1024, (bf16*)(ws + WS_XKV) + 2097152, 1024)
        TJOB(P.in[I_XA_WO], 1024, 1024, 1024, nullptr, (bf16*)(ws + WS_XO), 0)
        TJOB(P.in[I_FF_W1], 1024, 4096, 4096, P.in[I_FF_LN], (bf16*)(ws + WS_F1), 0)
        TJOB(P.in[I_FF_W2], 4096, 1024, 1024, nullptr, (bf16*)(ws + WS_F2), 0)
        TJOB(P.in[I_C_W1K], 1024, 128, 128, nullptr, (bf16*)(ws + WS_CMPK), 0)
        TJOB(P.in[I_C_W1K] + 131072, 1024, 128, 128, nullptr, (bf16*)(ws + WS_CMPK), 128)
        TJOB(P.in[I_C_W1V], 1024, 128, 128, nullptr, (bf16*)(ws + WS_CMPV), 0)
        TJOB(P.in[I_C_W1V] + 131072, 1024, 128, 128, nullptr, (bf16*)(ws + WS_CMPV), 128)
    }
    const int gt = blockIdx.x * NTHR + tid, NGT = gridDim.x * NTHR;
    for (int i = gt; i < 256 * 1024; i += NGT) { const int k = i >> 8, j = i & 255;
        { float v = 0.f; if (j < 8) v = P.in[I_A_LN][k] * P.in[I_A_WIN][(size_t)k * 2568 + 2560 + j]; ((bf16*)(ws + WS_AIN))[(size_t)(2560 + j) * 1024 + k] = (bf16)f2bf(v); }
        { float v = 0.f; if (j < 48) v = P.in[I_C_LN][k] * P.in[I_C_WIN][(size_t)k * 2608 + 2560 + j]; ((bf16*)(ws + WS_CIN))[(size_t)(2560 + j) * 1024 + k] = (bf16)f2bf(v); } }
    for (int i = gt; i < 4 * 128 * 128; i += NGT) { const int g = i >> 14, d = (i >> 7) & 127, c = i & 127; ((bf16*)(ws + WS_POOLW))[i] = (bf16)f2bf(P.in[I_A_POOLW][(size_t)g * 16384 + c * 128 + d] * P.in[I_A_POOLS][g * 128 + d]); }
    if (gw < 256) { const int n = gw & 127; const float* pe = gw < 128 ? P.in[I_C_PEK] : P.in[I_C_PEV]; const float* w1 = gw < 128 ? P.in[I_C_W1K] : P.in[I_C_W1V];
        float s = 0.f;
#pragma unroll 8
        for (int j = 0; j < 32; ++j) { const int i = lane + 64 * j; s += pe[i] * w1[(size_t)i * 128 + n]; }
        s = wave_sum(s); if (lane == 0) ((float*)(ws + WS_CBIAS))[gw] = s; }
    { bf16* xh = (bf16*)(ws + WS_XH); float* ss = (float*)(ws + WS_SS);
      for (int m = gw; m < T; m += NGW) { const f32x4* xr = (const f32x4*)(P.in[I_X] + (size_t)m * DM) + lane; f32x4 v[4]; float s = 0.f;
#pragma unroll
          for (int j = 0; j < 4; ++j) { v[j] = xr[64 * j]; s += (v[j].x * v[j].x + v[j].y * v[j].y) + (v[j].z * v[j].z + v[j].w * v[j].w); }
          s = wave_sum(s);
          v2u* o8 = (v2u*)(xh + (size_t)m * DM) + lane;
#pragma unroll
          for (int j = 0; j < 4; ++j) { v2u w; w.x = pk2(v[j].x, v[j].y); w.y = pk2(v[j].z, v[j].w); o8[64 * j] = w; }
          if (lane < 16) ss[(size_t)m * 16 + lane] = lane == 0 ? s : 0.f; } }
    { bf16* mh = (bf16*)(ws + WS_MEMH);
      for (int m = gw; m < 2048; m += NGW) { const f32x4* xr = (const f32x4*)(P.in[I_MEM] + (size_t)m * DM) + lane; f32x4 v[4]; float s = 0.f;
#pragma unroll
          for (int j = 0; j < 4; ++j) { v[j] = xr[64 * j]; s += (v[j].x * v[j].x + v[j].y * v[j].y) + (v[j].z * v[j].z + v[j].w * v[j].w); }
          const float rs = rsqrtf(wave_sum(s) * (1.f / DM) + EPS);
          v2u* o8 = (v2u*)(mh + (size_t)m * DM) + lane;
#pragma unroll
          for (int j = 0; j < 4; ++j) { v2u w; w.x = pk2(v[j].x * rs, v[j].y * rs); w.y = pk2(v[j].z * rs, v[j].w * rs); o8[64 * j] = w; } } }
}

__device__ __forceinline__ void phase_conv_late(const Params& P, LAS unsigned char* lds, int gw, int NGW) {
    const int tid = threadIdx.x, lane = tid & 63, wave = tid >> 6; unsigned char* ws = P.ws;
    LAS float* scr = (LAS float*)(lds + wave * 16384);
    constexpr int NITEMS = 512 + 512 + 512 + 2048 + 2048;
    for (int it = gw; it < NITEMS; it += NGW) {
        int r = it;
        TJOB(P.in[I_C_WOUT], 1024, 1024, 1024, nullptr, (bf16*)(ws + WS_COUT), 0)
        TJOB(P.in[I_XA_WQ] + 1048576, 1024, 1024, 1024, P.in[I_XA_LN] + 1024, (bf16*)(ws + WS_XQ) + 1048576, 0)
        TJOB(P.in[I_XA_WO] + 1048576, 1024, 1024, 1024, nullptr, (bf16*)(ws + WS_XO) + 1048576, 0)
        TJOB(P.in[I_FF_W1] + 4194304, 1024, 4096, 4096, P.in[I_FF_LN] + 1024, (bf16*)(ws + WS_F1) + 4194304, 0)
        TJOB(P.in[I_FF_W2] + 4194304, 4096, 1024, 1024, nullptr, (bf16*)(ws + WS_F2) + 4194304, 0)
    }
}
__device__ __forceinline__ void phase_final(const Params& P) {
    const int tid = threadIdx.x, lane = tid & 63, wave = tid >> 6;
    const int gw = blockIdx.x * NWAVES + wave, NGW = gridDim.x * NWAVES;
    const float* ss = (const float*)(P.ws + WS_SS); const bf16* xh = (const bf16*)(P.ws + WS_XH);
    for (int m = gw; m < T; m += NGW) { f32x4* orow = (f32x4*)(P.out + (size_t)m * DM); const f32x4* gr = (const f32x4*)P.in[I_FLN];
        const float rs = pg8::row_rstd(ss, m);
#pragma unroll
        for (int j = 0; j < 2; ++j) { const v4u p = *(const v4u*)(xh + (size_t)m * DM + (j * 64 + lane) * 8); const f32x4 g0 = gr[(j * 64 + lane) * 2], g1 = gr[(j * 64 + lane) * 2 + 1];
            orow[(j * 64 + lane) * 2] = (f32x4){bf2f(p.x & 0xffff) * rs * g0.x, bf2f(p.x >> 16) * rs * g0.y, bf2f(p.y & 0xffff) * rs * g0.z, bf2f(p.y >> 16) * rs * g0.w};
            orow[(j * 64 + lane) * 2 + 1] = (f32x4){bf2f(p.z & 0xffff) * rs * g1.x, bf2f(p.z >> 16) * rs * g1.y, bf2f(p.w & 0xffff) * rs * g1.z, bf2f(p.w >> 16) * rs * g1.w}; } }
}
__device__ __forceinline__ void phase_pool(const Params& P, LAS unsigned char* lds) {
    int tid_l = threadIdx.x; asm volatile("" : "+v"(tid_l)); const int tid = tid_l, lane = tid & 63, wave = tid >> 6; const int g = blockIdx.x & 3, win = 2 << g;
    const bf16* z = (const bf16*)(P.ws + WS_Z); bf16* y = (bf16*)(P.ws + WS_Y);
    LAS unsigned short* ur = (LAS unsigned short*)lds;
    LAS unsigned char* yp = lds + 20480;
    const int nt = wave & 3, mt = wave >> 2, q = lane & 31, h = lane >> 5;
    bf16x8 bfr[8];
    { const bf16* bt = (const bf16*)(P.ws + WS_POOLW) + (size_t)g * 16384 + (size_t)(nt * 32 + q) * 128 + 8 * h;
#pragma unroll
      for (int ks = 0; ks < 8; ++ks) bfr[ks] = *(const bf16x8*)(bt + 16 * ks); }
    v4u pre[3];
#define POOL_LOAD(it_) { const int t0_ = ((it_) >> 2) * 64, s0_ = t0_ & (SEQ - 1); _Pragma("unroll") for (int j = 0; j < 3; ++j) { const int p = tid + 512 * j, row = p >> 4, pc = p & 15; pre[j] = (v4u){0u, 0u, 0u, 0u}; \
        if (p < 79 * 16 && s0_ + row - 15 >= 0) pre[j] = *(const v4u*)(z + (size_t)(t0_ + row - 15) * 2560 + g * 128 + pc * 8); } }
    int it = blockIdx.x; if (it < 2048) POOL_LOAD(it)
    for (; it < 2048; it += gridDim.x) { const int t0 = (it >> 2) * 64, s0 = t0 & (SEQ - 1);
#pragma unroll
        for (int j = 0; j < 3; ++j) { const int p = tid + 512 * j; if (p < 79 * 16) *(LAS v4u*)(lds + (p >> 4) * 256 + (p & 15) * 16) = pre[j]; }
        __syncthreads();
        if (it + (int)gridDim.x < 2048) POOL_LOAD(it + (int)gridDim.x)
        { const int c = tid & 127, tq = tid >> 7; float sum = 0.f;
          for (int j = 1; j < win; ++j) sum += bf2f(ur[(tq * 16 + 15 - j) * 128 + c]);
#pragma unroll 4
          for (int i = 0; i < 16; ++i) { const int tl = tq * 16 + i, s = s0 + tl; const float u = bf2f(ur[(tl + 15) * 128 + c]); sum += u;
              const float cnt = (float)((s + 1 < win) ? s + 1 : win);
              *(LAS unsigned short*)(yp + tl * 272 + c * 2) = (unsigned short)f2bf(sum / cnt - u);
              sum -= bf2f(ur[(tl + 16 - win) * 128 + c]); } }
        __syncthreads();
        { f32x16 acc;
#pragma unroll
          for (int r = 0; r < 16; ++r) acc[r] = 0.f;
          LAS const unsigned char* ap = yp + (mt * 32 + q) * 272 + h * 16;
#pragma unroll
          for (int ks = 0; ks < 8; ++ks) acc = __builtin_amdgcn_mfma_f32_32x32x16_bf16(bfr[ks], *(const LAS bf16x8*)(ap + ks * 32), acc, 0, 0, 0);
          bf16* yo = y + (size_t)(t0 + mt * 32 + q) * DM + g * 128 + nt * 32 + 4 * h;
#pragma unroll
          for (int a = 0; a < 4; ++a) { v2u w; w.x = cvtpk(acc[4 * a], acc[4 * a + 1]); w.y = cvtpk(acc[4 * a + 2], acc[4 * a + 3]); *(v2u*)(yo + 8 * a) = w; } }
    }
#undef POOL_LOAD
    __syncthreads();
}
__device__ __forceinline__ void dn_naive_item(const Params& P, LAS unsigned char* lds, int item) {
    int tid_l = threadIdx.x; asm volatile("" : "+v"(tid_l)); const int tid = tid_l, lane = tid & 63, wave = tid >> 6; const int b = item >> 2, h = item & 3;
    const bf16* z = (const bf16*)(P.ws + WS_Z); bf16* y = (bf16*)(P.ws + WS_Y); const float* ba = (const float*)(P.ws + WS_BA);
    LAS float* qs = (LAS float*)lds; LAS float* ks = qs + 8192; LAS float* vs = ks + 8192; LAS float* ot = vs + 8192; LAS float* bet = ot + 8192; LAS float* egs = bet + 64;
    const float* cw = P.in[I_A_CONV];
    const float a_exp = __expf(P.in[I_A_ALOG][h]), dtb = P.in[I_A_DTB][h];
    float Sreg[32];
#pragma unroll
    for (int i = 0; i < 32; ++i) Sreg[i] = 0.f;
    const int kq = tid & 3, dv = tid >> 2;
    for (int n = 0; n < 64; ++n) {
        const int sb = n * 64; const size_t rb = (size_t)b * SEQ;
        for (int idx = tid; idx < 64 * 384; idx += NTHR) { const int tl = idx / 384, cc = idx % 384, part = cc >> 7, d = cc & 127; const int ch = part * 512 + h * 128 + d, s = sb + tl; float a = 0.f;
#pragma unroll
            for (int kk = 0; kk < 4; ++kk) { const int sp = s - 3 + kk; if (sp >= 0) a += cw[kk * 1536 + ch] * bf2f(z[(rb + sp) * 2560 + 512 + ch]); }
            qs[part * 8192 + tl * 128 + d] = silu_f(a); }
        if (tid < 64) { const size_t t = rb + sb + tid; const float bl = ba[t * 8 + h], al = ba[t * 8 + 4 + h] + dtb; const float sp = al > 20.f ? al : log1pf(__expf(al));
            bet[tid] = sigmoid_f(bl); egs[tid] = __expf(-a_exp * sp); }
        __syncthreads();
        for (int r = wave * 16; r < wave * 16 + 16; ++r) { LAS float* row = qs + (r >> 6) * 8192 + (r & 63) * 128; const float a = row[lane], c2 = row[lane + 64];
            const float sc = rsqrtf(wave_sum(a * a + c2 * c2) + EPS); row[lane] = a * sc; row[lane + 64] = c2 * sc; }
        __syncthreads();
        for (int tl = 0; tl < 64; ++tl) {
            float kr[32], kS = 0.f;
#pragma unroll
            for (int i = 0; i < 8; ++i) { const f32x4 v = *(const LAS f32x4*)(ks + tl * 128 + kq * 32 + 4 * i); kr[4 * i] = v.x; kr[4 * i + 1] = v.y; kr[4 * i + 2] = v.z; kr[4 * i + 3] = v.w; }
#pragma unroll
            for (int i = 0; i < 32; ++i) kS += kr[i] * Sreg[i];
            kS += __shfl_xor(kS, 1); kS += __shfl_xor(kS, 2);
            const float e = egs[tl], cf = bet[tl] * (vs[tl * 128 + dv] - e * kS);
            float o = 0.f;
#pragma unroll
            for (int i = 0; i < 8; ++i) { const f32x4 qv = *(const LAS f32x4*)(qs + tl * 128 + kq * 32 + 4 * i);
                Sreg[4 * i] = e * Sreg[4 * i] + kr[4 * i] * cf; Sreg[4 * i + 1] = e * Sreg[4 * i + 1] + kr[4 * i + 1] * cf; Sreg[4 * i + 2] = e * Sreg[4 * i + 2] + kr[4 * i + 2] * cf; Sreg[4 * i + 3] = e * Sreg[4 * i + 3] + kr[4 * i + 3] * cf;
                o += (qv.x * Sreg[4 * i] + qv.y * Sreg[4 * i + 1]) + (qv.z * Sreg[4 * i + 2] + qv.w * Sreg[4 * i + 3]); }
            o += __shfl_xor(o, 1); o += __shfl_xor(o, 2);
            if (kq == 0) ot[tl * 128 + dv] = o * 0.08838834764831845f;
        }
        __syncthreads();
        for (int tl = wave * 8; tl < wave * 8 + 8; ++tl) { const float a = ot[tl * 128 + lane], c2 = ot[tl * 128 + lane + 64]; const float rs = rsqrtf(wave_sum(a * a + c2 * c2) * (1.f / 128.f) + EPS);
            const size_t t = rb + sb + tl; const float g0 = bf2f(z[t * 2560 + 2048 + h * 128 + lane]), g1 = bf2f(z[t * 2560 + 2048 + h * 128 + lane + 64]);
            y[t * DM + 512 + h * 128 + lane] = (bf16)f2bf(a * rs * P.in[I_A_ONORM][lane] * silu_f(g0));
            y[t * DM + 512 + h * 128 + lane + 64] = (bf16)f2bf(c2 * rs * P.in[I_A_ONORM][lane + 64] * silu_f(g1)); }
        __syncthreads();
    }
}

__device__ __forceinline__ void phase_xatt_naive(const Params& P, LAS unsigned char* lds, int l) {
    int tid_l = threadIdx.x; asm volatile("" : "+v"(tid_l)); const int tid = tid_l, lane = tid & 63, wave = tid >> 6;
    const int gw = blockIdx.x * NWAVES + wave, NGW = gridDim.x * NWAVES;
    const bf16* qx = (const bf16*)(P.ws + WS_QXA); const bf16* kv = (const bf16*)(P.ws + WS_MEMKV) + (size_t)l * 2048 * 2048; bf16* y = (bf16*)(P.ws + WS_Y);
    LAS float* qf = (LAS float*)(lds + wave * 8192); LAS float* pw = qf + 1024;
    for (int t = gw; t < T; t += NGW) { const int b = t >> 12;
        { const v4u a = *(const v4u*)(qx + (size_t)t * DM + lane * 16), c = *(const v4u*)(qx + (size_t)t * DM + lane * 16 + 8); LAS float* d = qf + lane * 16;
          d[0] = bf2f(a.x & 0xffff); d[1] = bf2f(a.x >> 16); d[2] = bf2f(a.y & 0xffff); d[3] = bf2f(a.y >> 16); d[4] = bf2f(a.z & 0xffff); d[5] = bf2f(a.z >> 16); d[6] = bf2f(a.w & 0xffff); d[7] = bf2f(a.w >> 16);
          d[8] = bf2f(c.x & 0xffff); d[9] = bf2f(c.x >> 16); d[10] = bf2f(c.y & 0xffff); d[11] = bf2f(c.y >> 16); d[12] = bf2f(c.z & 0xffff); d[13] = bf2f(c.z >> 16); d[14] = bf2f(c.w & 0xffff); d[15] = bf2f(c.w >> 16); }
        LDS_WAIT();
        for (int hh = 0; hh < 4; ++hh) { float sc[4];
#pragma unroll
            for (int i = 0; i < 4; ++i) { const bf16* kr = kv + (size_t)(b * 256 + lane + 64 * i) * 2048 + hh * 256; float s = 0.f;
                for (int c8 = 0; c8 < 32; ++c8) { const v4u kk = *(const v4u*)(kr + c8 * 8); const f32x4 q0 = *(const LAS f32x4*)(qf + hh * 256 + c8 * 8), q1 = *(const LAS f32x4*)(qf + hh * 256 + c8 * 8 + 4);
                    s += (q0.x * bf2f(kk.x & 0xffff) + q0.y * bf2f(kk.x >> 16)) + (q0.z * bf2f(kk.y & 0xffff) + q0.w * bf2f(kk.y >> 16)) + (q1.x * bf2f(kk.z & 0xffff) + q1.y * bf2f(kk.z >> 16)) + (q1.z * bf2f(kk.w & 0xffff) + q1.w * bf2f(kk.w >> 16)); }
                sc[i] = s * 0.0625f; }
            const float mx = wave_max(fmaxf(fmaxf(sc[0], sc[1]), fmaxf(sc[2], sc[3])));
            float ps = 0.f;
#pragma unroll
            for (int i = 0; i < 4; ++i) { sc[i] = __expf(sc[i] - mx); ps += sc[i]; }
            const float inv = 1.f / wave_sum(ps);
#pragma unroll
            for (int i = 0; i < 4; ++i) pw[lane + 64 * i] = sc[i] * inv;
            LDS_WAIT();
            float o0 = 0.f, o1 = 0.f, o2 = 0.f, o3 = 0.f; const bf16* vb = kv + (size_t)(b * 256) * 2048 + 1024 + hh * 256 + lane * 4;
            for (int j = 0; j < 256; ++j) { const v2u vv = *(const v2u*)(vb + (size_t)j * 2048); const float p = pw[j];
                o0 += p * bf2f(vv.x & 0xffff); o1 += p * bf2f(vv.x >> 16); o2 += p * bf2f(vv.y & 0xffff); o3 += p * bf2f(vv.y >> 16); }
            v2u w; w.x = pk2(o0, o1); w.y = pk2(o2, o3); *(v2u*)(y + (size_t)t * DM + hh * 256 + lane * 4) = w;
            LDS_WAIT();
        }
    }
}

__device__ __forceinline__ void cmpfin_bg(const Params& P, LAS unsigned char* lds, int kvs, int bg) {
    const int tid = threadIdx.x, lane = tid & 63, wave = tid >> 6;
    const float* p01 = (const float*)(P.ws + (kvs ? WS_P01V : WS_P01K)) + (size_t)bg * 256 * 256; const float* bias = (const float*)(P.ws + WS_CBIAS) + kvs * 128; const float* w2 = P.in[kvs ? I_C_W2V : I_C_W2K];
    bf16* outp = (bf16*)(P.ws + (kvs ? WS_CV : WS_CK)) + (size_t)bg * 256 * 64;
    LAS float* hb = (LAS float*)(lds + wave * 1024);
    unsigned w2p[64];
#pragma unroll
    for (int j = 0; j < 64; ++j) w2p[j] = pk2(w2[(2 * j) * 64 + lane], w2[(2 * j + 1) * 64 + lane]);
    for (int c = wave; c < 255; c += NWAVES) {
#pragma unroll
        for (int i = 0; i < 2; ++i) { const int j = lane + 64 * i; hb[j] = silu_f(p01[(size_t)c * 256 + j] + p01[(size_t)(c + 1) * 256 + 128 + j] + bias[j]); }
        LDS_WAIT();
        float o0 = 0.f, o1 = 0.f;
#pragma unroll
        for (int j = 0; j < 128; j += 4) { if ((j & 31) == 0) __builtin_amdgcn_sched_barrier(0); const f32x4 hv = *(const LAS f32x4*)(hb + j); const unsigned wa = w2p[j >> 1], wb = w2p[(j >> 1) + 1];
            o0 += hv.x * bf2f(wa & 0xffff) + hv.z * bf2f(wb & 0xffff); o1 += hv.y * __uint_as_float(wa & 0xffff0000u) + hv.w * __uint_as_float(wb & 0xffff0000u); }
        outp[(size_t)c * 64 + lane] = (bf16)f2bf(o0 + o1);
        LDS_WAIT();
    }
}
__device__ __forceinline__ void dot4(const bf16* kr, const LAS float* qf, float (&s)[4]) {
    s[0] = s[1] = s[2] = s[3] = 0.f;
#pragma unroll
    for (int c8 = 0; c8 < 8; ++c8) { const v4u kk = *(const v4u*)(kr + c8 * 8);
        const float k0 = bf2f(kk.x & 0xffff), k1 = bf2f(kk.x >> 16), k2 = bf2f(kk.y & 0xffff), k3 = bf2f(kk.y >> 16), k4 = bf2f(kk.z & 0xffff), k5 = bf2f(kk.z >> 16), k6 = bf2f(kk.w & 0xffff), k7 = bf2f(kk.w >> 16);
#pragma unroll
        for (int r = 0; r < 4; ++r) { const f32x4 q0 = *(const LAS f32x4*)(qf + r * 64 + c8 * 8), q1 = *(const LAS f32x4*)(qf + r * 64 + c8 * 8 + 4);
            s[r] += ((q0.x * k0 + q0.y * k1) + (q0.z * k2 + q0.w * k3)) + ((q1.x * k4 + q1.y * k5) + (q1.z * k6 + q1.w * k7)); } }
}
__device__ __forceinline__ void phase_nsa_naive(const Params& P, LAS unsigned char* lds) {
    int tid_l = threadIdx.x; asm volatile("" : "+v"(tid_l)); const int tid = tid_l, lane = tid & 63, wave = tid >> 6;
    const int gw = blockIdx.x * NWAVES + wave, NGW = gridDim.x * NWAVES;
    const bf16* qb = (const bf16*)(P.ws + WS_Z); const bf16* kvb = qb + (size_t)T * 1024;
    const bf16* ck = (const bf16*)(P.ws + WS_CK); const bf16* cv = (const bf16*)(P.ws + WS_CV);
    const float* gates = (const float*)(P.ws + WS_GATES); bf16* y = (bf16*)(P.ws + WS_Y);
    LAS float* qf = (LAS float*)(lds + wave * 8192); LAS float* pc = qf + 256; LAS float* ps = pc + 1024;
    for (int it = gw; it < 4 * T; it += NGW) {
        const int t = it & 4095, g = (it >> 12) & 3, b = it >> 14; const size_t tg = (size_t)b * SEQ + t; const int bg = b * 4 + g;
        float slope[4];
#pragma unroll
        for (int r = 0; r < 4; ++r) slope[r] = exp2f(-0.5f * (float)(g * 4 + r + 1));
#pragma unroll
        for (int r = 0; r < 4; ++r) qf[r * 64 + lane] = bf2f(qb[tg * 1024 + g * 256 + r * 64 + lane]);
        LDS_WAIT();
        const int ncv = t >= 31 ? ((t - 31) >> 4) + 1 : 0;
#pragma unroll 1
        for (int cc = 0; cc < 4; ++cc) { const int c = lane + 64 * cc; float s[4] = {0.f, 0.f, 0.f, 0.f};
            if (cc * 64 < ncv) dot4(ck + ((size_t)bg * 256 + c) * 64, qf, s);
#pragma unroll
            for (int r = 0; r < 4; ++r) pc[r * 256 + c] = c < ncv ? s[r] * 0.125f - slope[r] * (float)(t - (16 * c + 31)) : -INFINITY; }
        LDS_WAIT();
#pragma unroll 1
        for (int r = 0; r < 4; ++r) { float v0 = pc[r * 256 + lane], v1 = pc[r * 256 + lane + 64], v2 = pc[r * 256 + lane + 128], v3 = pc[r * 256 + lane + 192];
            const float mx = wave_max(fmaxf(fmaxf(v0, v1), fmaxf(v2, v3)));
            v0 = lane < ncv ? __expf(v0 - mx) : 0.f; v1 = lane + 64 < ncv ? __expf(v1 - mx) : 0.f; v2 = lane + 128 < ncv ? __expf(v2 - mx) : 0.f; v3 = lane + 192 < ncv ? __expf(v3 - mx) : 0.f;
            const float sm = wave_sum((v0 + v1) + (v2 + v3)); const float inv = ncv > 0 ? 1.f / sm : 0.f;
            pc[r * 256 + lane] = v0 * inv; pc[r * 256 + lane + 64] = v1 * inv; pc[r * 256 + lane + 128] = v2 * inv; pc[r * 256 + lane + 192] = v3 * inv; }
        LDS_WAIT();
        float osum[4];
        { float ocmp[4] = {0.f, 0.f, 0.f, 0.f};
          const bf16* cvp = cv + (size_t)bg * 256 * 64 + lane;
#pragma unroll 2
          for (int c = 0; c < ncv; ++c) { const float v = bf2f(cvp[c * 64]);
#pragma unroll
              for (int r = 0; r < 4; ++r) ocmp[r] += pc[r * 256 + c] * v; }
#pragma unroll
          for (int r = 0; r < 4; ++r) osum[r] = sigmoid_f(gates[tg * 48 + (g * 4 + r) * 3]) * ocmp[r]; }
        unsigned long long mask;
        { const int n = lane, cur = t >> 6; float imp = 0.f;
#pragma unroll
          for (int r = 0; r < 4; ++r) { const f32x4 v = *(const LAS f32x4*)(pc + r * 256 + 4 * n); imp += v.x + v.y + v.z + 0.5f * v.w; if (n > 0) imp += 0.5f * pc[r * 256 + 4 * n - 1]; }
          const bool forced = (n == 0) || (n == cur) || (n == cur - 1);
          const float val = forced ? 1e4f : (n <= cur ? imp : -1.f);
          int rank = 0;
#pragma unroll 4
          for (int m = 0; m < 64; ++m) { const float vm = __shfl(val, m); rank += (vm > val || (vm == val && m < n)) ? 1 : 0; }
          mask = __ballot(rank < 16 && n <= cur); }
#pragma unroll 1
        for (int br = 0; br < 2; ++br) {
            const bf16* kp = kvb + (size_t)(br == 0 ? 2 : 4) * KV_KIND + (size_t)bg * SEQ * 64; const bf16* vp = kvb + (size_t)(br == 0 ? 3 : 5) * KV_KIND + (size_t)bg * SEQ * 64;
            float m_[4] = {-INFINITY, -INFINITY, -INFINITY, -INFINITY}, l_[4] = {0.f, 0.f, 0.f, 0.f}, acc[4] = {0.f, 0.f, 0.f, 0.f};
            const int jlo = br == 0 ? 0 : (t >= 511 ? t - 511 : 0);
            unsigned long long todo = br == 0 ? mask : 0ull; int j0 = jlo & ~63;
#pragma unroll 1
            for (;;) {
                if (br == 0) { if (!todo) break; j0 = (__ffsll((long long)todo) - 1) * 64; todo &= todo - 1; } else { if (j0 > t) break; }
                const int j = j0 + lane; const bool valid = j >= jlo && j <= t;
                float s[4]; dot4(kp + (size_t)j * 64, qf, s);
#pragma unroll
                for (int r = 0; r < 4; ++r) { const float sv = valid ? s[r] * 0.125f - slope[r] * (float)(t - j) : -INFINITY; const float mn = fmaxf(m_[r], wave_max(sv));
                    const float p = valid ? __expf(sv - mn) : 0.f; const float f = __expf(m_[r] - mn); l_[r] = l_[r] * f + wave_sum(p); acc[r] *= f; m_[r] = mn; ps[r * 64 + lane] = p; }
                LDS_WAIT();
                const bf16* vr = vp + (size_t)j0 * 64 + lane;
#pragma unroll 2
                for (int jj = 0; jj < 64; jj += 4) { const float v0 = bf2f(vr[jj * 64]), v1 = bf2f(vr[(jj + 1) * 64]), v2 = bf2f(vr[(jj + 2) * 64]), v3 = bf2f(vr[(jj + 3) * 64]);
#pragma unroll
                    for (int r = 0; r < 4; ++r) { const f32x4 pv = *(const LAS f32x4*)(ps + r * 64 + jj); acc[r] += (pv.x * v0 + pv.y * v1) + (pv.z * v2 + pv.w * v3); } }
                LDS_WAIT();
                if (br == 1) j0 += 64;
            }
#pragma unroll
            for (int r = 0; r < 4; ++r) osum[r] += sigmoid_f(gates[tg * 48 + (g * 4 + r) * 3 + 1 + br]) * (acc[r] / l_[r]);
        }
#pragma unroll
        for (int r = 0; r < 4; ++r) y[tg * DM + g * 256 + r * 64 + lane] = (bf16)f2bf(osum[r]);
        LDS_WAIT();
    }
}
constexpr int NSA_KB = 0, NSA_VB = 18432, NSA_IMPA = 34816, NSA_IMPB = 51200, NSA_MASK = 67584, NSA_UNI = 68096;
constexpr float LOG2E_F = 1.4426950408889634f;

__device__ __forceinline__ float quad_sum(float x) {
    x += __int_as_float(__builtin_amdgcn_update_dpp(0, __float_as_int(x), 0xB1, 0xF, 0xF, true));
    x += __int_as_float(__builtin_amdgcn_update_dpp(0, __float_as_int(x), 0x4E, 0xF, 0xF, true));
    return x;
}
__device__ __forceinline__ void nsa_qk(f32x16& p0, f32x16& p1, LAS const unsigned char* kb, const bf16x8 (&qf)[4], int q, int h) {
#pragma unroll
    for (int r = 0; r < 16; ++r) { p0[r] = 0.f; p1[r] = 0.f; }
#pragma unroll
    for (int ks = 0; ks < 4; ++ks) { const bf16x8 a0 = *(const LAS bf16x8*)(kb + q * 144 + ks * 32 + h * 16), a1 = *(const LAS bf16x8*)(kb + (q + 32) * 144 + ks * 32 + h * 16);
        p0 = __builtin_amdgcn_mfma_f32_32x32x16_bf16(a0, qf[ks], p0, 0, 0, 0); p1 = __builtin_amdgcn_mfma_f32_32x32x16_bf16(a1, qf[ks], p1, 0, 0, 0); }
}
template <bool CHECK> __device__ __forceinline__ void nsa_bias(f32x16& p0, f32x16& p1, float basef, float slopeK, float cst, float klo, float khi, int h) {
    const float C = 0.125f * LOG2E_F; const float i0 = basef + 4.f * (float)h; const float t0v = fmaf(slopeK, i0, cst);
#pragma unroll
    for (int r = 0; r < 16; ++r) { const float off = (float)((r & 3) + 8 * (r >> 2));
        float v0 = fmaf(p0[r], C, fmaf(slopeK, off, t0v)), v1 = fmaf(p1[r], C, fmaf(slopeK, off + 32.f, t0v));
        if (CHECK) { const float x0 = i0 + off, x1 = i0 + off + 32.f; v0 = (x0 >= klo && x0 <= khi) ? v0 : -INFINITY; v1 = (x1 >= klo && x1 <= khi) ? v1 : -INFINITY; }
        p0[r] = v0; p1[r] = v1; }
}
__device__ __forceinline__ float nsa_rowmax(const f32x16& p0, const f32x16& p1) {
    float a = fmaxf(p0[0], p1[0]);
#pragma unroll
    for (int r = 1; r < 16; ++r) a = fmaxf(a, fmaxf(p0[r], p1[r]));
    return fmaxf(a, __shfl_xor(a, 32));
}
__device__ __forceinline__ void nsa_pv(f32x16 (&o)[2], const f32x16& p0, const f32x16& p1, LAS const unsigned char* vb, int lane, int h) {
    bf16x8 pk[4];
#pragma unroll
    for (int s = 0; s < 4; ++s) { v4u w;
        if (s < 2) { w.x = cvtpk(p0[8 * s + 0], p0[8 * s + 1]); w.y = cvtpk(p0[8 * s + 2], p0[8 * s + 3]); w.z = cvtpk(p0[8 * s + 4], p0[8 * s + 5]); w.w = cvtpk(p0[8 * s + 6], p0[8 * s + 7]); }
        else { w.x = cvtpk(p1[8 * (s - 2) + 0], p1[8 * (s - 2) + 1]); w.y = cvtpk(p1[8 * (s - 2) + 2], p1[8 * (s - 2) + 3]); w.z = cvtpk(p1[8 * (s - 2) + 4], p1[8 * (s - 2) + 5]); w.w = cvtpk(p1[8 * (s - 2) + 6], p1[8 * (s - 2) + 7]); }
        pk[s] = __builtin_bit_cast(bf16x8, w); }
    LAS const unsigned char* vp = vb + (4 * h + ((lane & 15) >> 2)) * 64 + ((lane >> 4) & 1) * 32 + (lane & 3) * 8;
#pragma unroll
    for (int dt = 0; dt < 2; ++dt)
#pragma unroll
        for (int s = 0; s < 4; ++s) { const v4i16 lo = __builtin_amdgcn_ds_read_tr16_b64_v4i16((LAS v4i16*)(vp + dt * 4096 + s * 1024)), hi = __builtin_amdgcn_ds_read_tr16_b64_v4i16((LAS v4i16*)(vp + dt * 4096 + s * 1024 + 512));
            const bf16x8 a = (bf16x8){lo[0], lo[1], lo[2], lo[3], hi[0], hi[1], hi[2], hi[3]};
            o[dt] = __builtin_amdgcn_mfma_f32_32x32x16_bf16(a, pk[s], o[dt], 0, 0, 0); }
}
__device__ __forceinline__ void nsa_online(f32x16& p0, f32x16& p1, float& m, float& l, f32x16 (&o)[2]) {
    const float mx = nsa_rowmax(p0, p1), mn = fmaxf(m, mx), mu = (mn == -INFINITY) ? 0.f : mn; const float f = __builtin_amdgcn_exp2f(m - mu);
    float sum = 0.f;
#pragma unroll
    for (int r = 0; r < 16; ++r) { p0[r] = __builtin_amdgcn_exp2f(p0[r] - mu); p1[r] = __builtin_amdgcn_exp2f(p1[r] - mu); sum += p0[r] + p1[r]; }
    l = l * f + sum; m = mn;
    if (__any(f != 1.f)) {
#pragma unroll
        for (int r = 0; r < 16; ++r) { o[0][r] *= f; o[1][r] *= f; } }
}

typedef float f2v __attribute__((ext_vector_type(2)));
__device__ __forceinline__ void nsa_fast(f32x16& p0, f32x16& p1, const f32x16& bo0, const f32x16& bo1, float t0v, float& m, float& l, f32x16 (&o)[2]) {
    const float C = 0.125f * LOG2E_F; const f2v C2 = {C, C};
#pragma unroll
    for (int k = 0; k < 8; ++k) { f2v a = {p0[2 * k], p0[2 * k + 1]}, b = {p1[2 * k], p1[2 * k + 1]}; const f2v ba = {bo0[2 * k], bo0[2 * k + 1]}, bb = {bo1[2 * k], bo1[2 * k + 1]};
        a = a * C2 + ba; b = b * C2 + bb; p0[2 * k] = a.x; p0[2 * k + 1] = a.y; p1[2 * k] = b.x; p1[2 * k + 1] = b.y; }
    float mx = __builtin_fmaxf(p0[0], p1[0]);
#pragma unroll
    for (int r = 1; r < 16; ++r) mx = __builtin_fmaxf(__builtin_fmaxf(mx, p0[r]), p1[r]);
    mx += t0v; mx = __builtin_fmaxf(mx, __shfl_xor(mx, 32));
    const float mn = __builtin_fmaxf(m, mx), mu = (mn == -INFINITY) ? 0.f : mn; const float f = __builtin_amdgcn_exp2f(m - mu), d = mu - t0v; const f2v d2 = {d, d};
    f2v s2 = {0.f, 0.f};
#pragma unroll
    for (int k = 0; k < 8; ++k) { f2v a = {p0[2 * k], p0[2 * k + 1]}, b = {p1[2 * k], p1[2 * k + 1]}; a = a - d2; b = b - d2;
        a.x = __builtin_amdgcn_exp2f(a.x); a.y = __builtin_amdgcn_exp2f(a.y); b.x = __builtin_amdgcn_exp2f(b.x); b.y = __builtin_amdgcn_exp2f(b.y);
        s2 = s2 + a; s2 = s2 + b; p0[2 * k] = a.x; p0[2 * k + 1] = a.y; p1[2 * k] = b.x; p1[2 * k + 1] = b.y; }
    l = l * f + (s2.x + s2.y); m = mn;
    if (__any(f != 1.f)) {
#pragma unroll
        for (int r = 0; r < 16; ++r) { o[0][r] *= f; o[1][r] *= f; } }
}
__device__ __forceinline__ void nsa_item(const Params& P, LAS unsigned char* lds, int bg, int tile) {
    int tid_l = threadIdx.x; asm volatile("" : "+v"(tid_l)); const int tid = tid_l, lane = tid & 63, wave = tid >> 6, q = lane & 31, h = lane >> 5;
    const int b = bg >> 2, g = bg & 3, t0 = tile * 64, cur = tile;
    const int tl = 8 * wave + (q >> 2), t = t0 + tl, r = q & 3; const size_t tg = (size_t)b * SEQ + t;
    const bf16* qb = (const bf16*)(P.ws + WS_Z); const bf16* kvb = qb + (size_t)T * 1024;
    const bf16* ckp = (const bf16*)(P.ws + WS_CK) + (size_t)bg * 256 * 64; const bf16* cvp = (const bf16*)(P.ws + WS_CV) + (size_t)bg * 256 * 64;
    const bf16* ksp = kvb + 2 * KV_KIND + (size_t)bg * SEQ * 64; const bf16* vsp = kvb + 3 * KV_KIND + (size_t)bg * SEQ * 64;
    const bf16* kwp = kvb + 4 * KV_KIND + (size_t)bg * SEQ * 64; const bf16* vwp = kvb + 5 * KV_KIND + (size_t)bg * SEQ * 64;
    const float* gp = (const float*)(P.ws + WS_GATES) + tg * 48 + (g * 4 + r) * 3;
    LAS float* impA = (LAS float*)(lds + NSA_IMPA); LAS float* impB = (LAS float*)(lds + NSA_IMPB);
    LAS unsigned long long* masks = (LAS unsigned long long*)(lds + NSA_MASK); LAS unsigned long long* uni = (LAS unsigned long long*)(lds + NSA_UNI);
    const int srow = tid >> 3, spc = tid & 7; const unsigned koff = srow * 144 + spc * 16, voff = (spc >> 2) * 4096 + srow * 64 + (spc & 3) * 16; const size_t goff = (size_t)srow * 64 + spc * 8;
    const float slope2 = exp2f(-0.5f * (float)(g * 4 + r + 1)) * LOG2E_F; const float tf = (float)t;
    bf16x8 qf[4];
#pragma unroll
    for (int ks = 0; ks < 4; ++ks) qf[ks] = *(const bf16x8*)(qb + tg * 1024 + g * 256 + r * 64 + 16 * ks + 8 * h);
    { const v4u z4 = {0u, 0u, 0u, 0u};
#pragma unroll
      for (int i = 0; i < 4; ++i) *(LAS v4u*)(lds + NSA_IMPA + (tid * 4 + i) * 16) = z4; }
    if (tid < 8) uni[tid] = 0ull;
    v4u kreg, vreg;
#define KBUF(i) (lds + NSA_KB + (i) * 9216)
#define VBUF(i) (lds + NSA_VB + (i) * 8192)
    f32x16 osum[2], o[2], p0, p1, bo0, bo1;
    const int nct = (((t0 + 32) >> 4) >> 6) + 1;
    const float cmaxf = t >= 31 ? (float)((t - 31) >> 4) : -1.f; const float cstc = slope2 * (31.f - tf), slopec = 16.f * slope2;
    float m1 = -INFINITY, l1 = 0.f;
    kreg = *(const v4u*)(ckp + (size_t)(nct - 1) * 4096 + goff); *(LAS v4u*)(KBUF(0) + koff) = kreg; __syncthreads();
#pragma unroll 1
    for (int i = 0; i < nct; ++i) { const int ct = nct - 1 - i;
        if (i + 1 < nct) kreg = *(const v4u*)(ckp + (size_t)(ct - 1) * 4096 + goff);
        nsa_qk(p0, p1, KBUF(i & 1), qf, q, h); nsa_bias<true>(p0, p1, (float)(ct * 64), slopec, cstc, 0.f, cmaxf, h);
        { const float mx = nsa_rowmax(p0, p1), mn = fmaxf(m1, mx), mu = (mn == -INFINITY) ? 0.f : mn; float sum = 0.f;
#pragma unroll
          for (int rr = 0; rr < 16; ++rr) sum += __builtin_amdgcn_exp2f(p0[rr] - mu) + __builtin_amdgcn_exp2f(p1[rr] - mu);
          l1 = l1 * __builtin_amdgcn_exp2f(m1 - mu) + sum; m1 = mn; }
        if (i + 1 < nct) *(LAS v4u*)(KBUF((i + 1) & 1) + koff) = kreg;
        __syncthreads(); }
    l1 += __shfl_xor(l1, 32);
    const float inv1 = l1 > 0.f ? 1.f / l1 : 0.f, mu1 = (m1 == -INFINITY) ? 0.f : m1;
#pragma unroll
    for (int rr = 0; rr < 16; ++rr) { o[0][rr] = 0.f; o[1][rr] = 0.f; }
    kreg = *(const v4u*)(ckp + (size_t)(nct - 1) * 4096 + goff); vreg = *(const v4u*)(cvp + (size_t)(nct - 1) * 4096 + goff);
    *(LAS v4u*)(KBUF(0) + koff) = kreg; *(LAS v4u*)(VBUF(0) + voff) = vreg; __syncthreads();
#pragma unroll 1
    for (int i = 0; i < nct; ++i) { const int ct = nct - 1 - i;
        if (i + 1 < nct) { kreg = *(const v4u*)(ckp + (size_t)(ct - 1) * 4096 + goff); vreg = *(const v4u*)(cvp + (size_t)(ct - 1) * 4096 + goff); }
        nsa_qk(p0, p1, KBUF(i & 1), qf, q, h); nsa_bias<true>(p0, p1, (float)(ct * 64), slopec, cstc, 0.f, cmaxf, h);
#pragma unroll
        for (int rr = 0; rr < 16; ++rr) { p0[rr] = __builtin_amdgcn_exp2f(p0[rr] - mu1) * inv1; p1[rr] = __builtin_amdgcn_exp2f(p1[rr] - mu1) * inv1; }
#pragma unroll
        for (int a = 0; a < 4; ++a) {
            float A0 = quad_sum(p0[4 * a] + p0[4 * a + 1] + p0[4 * a + 2] + 0.5f * p0[4 * a + 3]), B0 = quad_sum(0.5f * p0[4 * a + 3]);
            float A1 = quad_sum(p1[4 * a] + p1[4 * a + 1] + p1[4 * a + 2] + 0.5f * p1[4 * a + 3]), B1 = quad_sum(0.5f * p1[4 * a + 3]);
            if (r == 0) { const int n0 = 16 * ct + 2 * a + h, n1 = n0 + 8; impA[tl * 64 + n0] = A0; impA[tl * 64 + n1] = A1; impB[tl * 64 + n0 + 1] = B0; if (n1 < 63) impB[tl * 64 + n1 + 1] = B1; } }
        nsa_pv(o, p0, p1, VBUF(i & 1), lane, h);
        if (i + 1 < nct) { *(LAS v4u*)(KBUF((i + 1) & 1) + koff) = kreg; *(LAS v4u*)(VBUF((i + 1) & 1) + voff) = vreg; }
        __syncthreads(); }
    { const float g0 = sigmoid_f(gp[0]);
#pragma unroll
      for (int rr = 0; rr < 16; ++rr) { osum[0][rr] = g0 * o[0][rr]; osum[1][rr] = g0 * o[1][rr]; } }
    { const int tkl = lane >> 3, part = lane & 7, tk = 8 * wave + tkl; unsigned key[8];
      { const f32x4 a0 = *(const LAS f32x4*)(impA + tk * 64 + part * 8), a1 = *(const LAS f32x4*)(impA + tk * 64 + part * 8 + 4), b0 = *(const LAS f32x4*)(impB + tk * 64 + part * 8), b1 = *(const LAS f32x4*)(impB + tk * 64 + part * 8 + 4);
        const float im[8] = {a0.x + b0.x, a0.y + b0.y, a0.z + b0.z, a0.w + b0.w, a1.x + b1.x, a1.y + b1.y, a1.z + b1.z, a1.w + b1.w};
#pragma unroll
        for (int e2 = 0; e2 < 8; ++e2) { const int n = part * 8 + e2; const bool forced = (n == 0) || (n == cur) || (n == cur - 1); key[e2] = n <= cur ? (forced ? 0x7F000000u : __float_as_uint(im[e2]) + 1u) : 0u; } }
      unsigned Tk = 0u;
#pragma unroll 1
      for (int bb = 30; bb >= 0; --bb) { const unsigned cand = Tk | (1u << bb); int c = 0;
#pragma unroll
          for (int e2 = 0; e2 < 8; ++e2) c += key[e2] >= cand ? 1 : 0;
          c += __builtin_amdgcn_update_dpp(0, c, 0xB1, 0xF, 0xF, true); c += __builtin_amdgcn_update_dpp(0, c, 0x4E, 0xF, 0xF, true); c += __builtin_amdgcn_update_dpp(0, c, 0x141, 0xF, 0xF, true);
          Tk = c >= 16 ? cand : Tk; }
      int cg = 0, le = 0;
#pragma unroll
      for (int e2 = 0; e2 < 8; ++e2) { cg += key[e2] > Tk ? 1 : 0; le += key[e2] == Tk ? 1 : 0; }
      cg += __builtin_amdgcn_update_dpp(0, cg, 0xB1, 0xF, 0xF, true); cg += __builtin_amdgcn_update_dpp(0, cg, 0x4E, 0xF, 0xF, true); cg += __builtin_amdgcn_update_dpp(0, cg, 0x141, 0xF, 0xF, true);
      int incl = le;
#pragma unroll
      for (int o2 = 1; o2 < 8; o2 <<= 1) { const int v = __shfl_up(incl, o2, 8); if (part >= o2) incl += v; }
      int before = incl - le; const int need = 16 - cg; unsigned byte = 0u;
#pragma unroll
      for (int e2 = 0; e2 < 8; ++e2) { const bool eq = key[e2] == Tk; const bool selb = (key[e2] > Tk || (eq && before < need)) && (part * 8 + e2 <= cur); before += eq ? 1 : 0; byte |= selb ? (1u << e2) : 0u; }
      ((LAS unsigned char*)masks)[tk * 8 + part] = (unsigned char)byte;
      __hip_atomic_fetch_or(uni, (unsigned long long)byte << (8 * part), __ATOMIC_RELAXED, __HIP_MEMORY_SCOPE_WORKGROUP); }
    __syncthreads();
    unsigned long long todo = uni[0]; const unsigned long long mymask = masks[tl];
#define NSA_LOAD(kp_, vp_, n_) { kreg = *(const v4u*)((kp_) + (size_t)(n_) * 4096 + goff); vreg = *(const v4u*)((vp_) + (size_t)(n_) * 4096 + goff); }
#define NSA_STORE(i_) { *(LAS v4u*)(KBUF((i_) & 1) + koff) = kreg; *(LAS v4u*)(VBUF((i_) & 1) + voff) = vreg; }
#define NSA_FAST(i_, t0v_) { nsa_qk(p0, p1, KBUF((i_) & 1), qf, q, h); nsa_fast(p0, p1, bo0, bo1, (t0v_), m, l, o); nsa_pv(o, p0, p1, VBUF((i_) & 1), lane, h); }
#define NSA_STEP(CHECK_, i_, basef_, cst_, klo_, khi_) { nsa_qk(p0, p1, KBUF((i_) & 1), qf, q, h); nsa_bias<CHECK_>(p0, p1, (basef_), slope2, (cst_), (klo_), (khi_), h); nsa_online(p0, p1, m, l, o); nsa_pv(o, p0, p1, VBUF((i_) & 1), lane, h); }
    {
        float m = -INFINITY, l = 0.f; const float cst = -slope2 * tf;
#pragma unroll
        for (int rr = 0; rr < 16; ++rr) { o[0][rr] = 0.f; o[1][rr] = 0.f; bo0[rr] = slope2 * (float)((rr & 3) + 8 * (rr >> 2)); bo1[rr] = slope2 * (float)((rr & 3) + 8 * (rr >> 2) + 32); }
        todo &= ~(1ull << cur);
        NSA_LOAD(ksp, vsp, cur) NSA_STORE(0) __syncthreads();
        int i = 0, nn = todo ? 63 - __clzll((long long)todo) : -1; if (nn >= 0) todo &= ~(1ull << nn);
        if (nn >= 0) NSA_LOAD(ksp, vsp, nn)
        NSA_STEP(true, 0, (float)(cur * 64), cst, 0.f, tf)
        if (nn >= 0) NSA_STORE(1)
        __syncthreads();
#pragma unroll 1
        while (nn >= 0) { const int n = nn; ++i; nn = todo ? 63 - __clzll((long long)todo) : -1; if (nn >= 0) todo &= ~(1ull << nn);
            if (nn >= 0) NSA_LOAD(ksp, vsp, nn)
            const bool sel = (mymask >> n) & 1ull;
            NSA_FAST(i, sel ? fmaf(slope2, (float)(n * 64 + 4 * h), cst) : -INFINITY)
            if (nn >= 0) NSA_STORE(i + 1)
            __syncthreads(); }
        l += __shfl_xor(l, 32); const float gs = sigmoid_f(gp[1]) / l;
#pragma unroll
        for (int rr = 0; rr < 16; ++rr) { osum[0][rr] += gs * o[0][rr]; osum[1][rr] += gs * o[1][rr]; }
    }
    {
        float m = -INFINITY, l = 0.f; const float cst = -slope2 * tf;
#pragma unroll
        for (int rr = 0; rr < 16; ++rr) { o[0][rr] = 0.f; o[1][rr] = 0.f; }
        const int nw = tile < 8 ? tile + 1 : 9, nmid = nw < 8 ? nw : 8;
        NSA_LOAD(kwp, vwp, tile) NSA_STORE(0) __syncthreads();
        if (nw > 1) NSA_LOAD(kwp, vwp, tile - 1)
        NSA_STEP(true, 0, (float)(tile * 64), cst, 0.f, tf)
        if (nw > 1) NSA_STORE(1)
        __syncthreads();
#pragma unroll 1
        for (int i = 1; i < nmid; ++i) { const int jt = tile - i;
            if (i + 1 < nw) NSA_LOAD(kwp, vwp, jt - 1)
            NSA_FAST(i, fmaf(slope2, (float)(jt * 64 + 4 * h), cst))
            if (i + 1 < nw) NSA_STORE(i + 1)
            __syncthreads(); }
        if (nw == 9) { NSA_STEP(true, 8, (float)((tile - 8) * 64), cst, tf - 511.f, 1e9f) __syncthreads(); }
        l += __shfl_xor(l, 32); const float gs = sigmoid_f(gp[2]) / l;
#pragma unroll
        for (int rr = 0; rr < 16; ++rr) { osum[0][rr] += gs * o[0][rr]; osum[1][rr] += gs * o[1][rr]; }
    }
#undef NSA_LOAD
#undef NSA_STORE
#undef NSA_STEP
#undef NSA_FAST
    { bf16* yp = (bf16*)(P.ws + WS_Y) + tg * DM + g * 256 + r * 64 + 4 * h;
#pragma unroll
      for (int dt = 0; dt < 2; ++dt)
#pragma unroll
          for (int a = 0; a < 4; ++a) { v2u w; w.x = cvtpk(osum[dt][4 * a], osum[dt][4 * a + 1]); w.y = cvtpk(osum[dt][4 * a + 2], osum[dt][4 * a + 3]); *(v2u*)(yp + dt * 32 + a * 8) = w; } }
#undef KBUF
#undef VBUF
}
__device__ __forceinline__ void phase_nsa(const Params& P, LAS unsigned char* lds) {
    for (int it = blockIdx.x; it < 2048; it += gridDim.x) { const int rnd = it / 256, c = it % 256; const int bg = c & 31, tile = 63 - 8 * rnd - (c >> 5); nsa_item(P, lds, bg, tile); }
}

__device__ __forceinline__ void xatt_item(const Params& P, LAS unsigned char* lds, int l, int bh, int blk) {
    int tid_l = threadIdx.x; asm volatile("" : "+v"(tid_l)); const int tid = tid_l, lane = tid & 63, wave = tid >> 6, q = lane & 31, h = lane >> 5;
    const int b = bh >> 2, hh = bh & 3; const size_t t = (size_t)b * SEQ + blk * 256 + wave * 32 + q;
    const bf16* kvp = (const bf16*)(P.ws + WS_MEMKV) + (size_t)(b * 256) * 4096 + l * 2048 + hh * 256;
    const bf16* qp = (const bf16*)(P.ws + WS_QXA) + t * DM + hh * 256 + 8 * h;
#pragma unroll
    for (int half = 0; half < 2; ++half) { v4u kr[8];
#pragma unroll
        for (int i = 0; i < 8; ++i) { const int p = tid + 512 * (half * 8 + i); kr[i] = *(const v4u*)(kvp + (size_t)(p >> 5) * 4096 + (p & 31) * 8); }
#pragma unroll
        for (int i = 0; i < 8; ++i) { const int p = tid + 512 * (half * 8 + i); *(LAS v4u*)(lds + (p >> 5) * 528 + (p & 31) * 16) = kr[i]; } }
    bf16x8 qf[16];
#pragma unroll
    for (int ks = 0; ks < 16; ++ks) qf[ks] = *(const bf16x8*)(qp + 16 * ks);
    __syncthreads();
    const float C = 0.0625f * LOG2E_F;
    v4u pk[16]; float m = 0.f, lsum = 0.f, f0 = 1.f;
#pragma unroll
    for (int half = 0; half < 2; ++half) {
        f32x16 s[4];
#pragma unroll
        for (int kt = 0; kt < 4; ++kt) {
#pragma unroll
            for (int r = 0; r < 16; ++r) s[kt][r] = 0.f;
            LAS const unsigned char* kb = lds + (half * 128 + kt * 32 + q) * 528 + h * 16;
#pragma unroll
            for (int ks = 0; ks < 16; ++ks) s[kt] = __builtin_amdgcn_mfma_f32_32x32x16_bf16(*(const LAS bf16x8*)(kb + ks * 32), qf[ks], s[kt], 0, 0, 0); }
        float mx = s[0][0];
#pragma unroll
        for (int kt = 0; kt < 4; ++kt)
#pragma unroll
            for (int r = 0; r < 16; ++r) mx = fmaxf(mx, s[kt][r]);
        mx = fmaxf(mx, __shfl_xor(mx, 32)) * C;
        const float mn = half == 0 ? mx : fmaxf(m, mx);
        if (half == 1) { f0 = __builtin_amdgcn_exp2f(m - mn); lsum *= f0; }
        m = mn;
        float sum = 0.f;
#pragma unroll
        for (int kt = 0; kt < 4; ++kt) {
#pragma unroll
            for (int r = 0; r < 16; ++r) { s[kt][r] = __builtin_amdgcn_exp2f(fmaf(s[kt][r], C, -mn)); sum += s[kt][r]; }
#pragma unroll
            for (int e = 0; e < 2; ++e) { v4u w; w.x = cvtpk(s[kt][8 * e + 0], s[kt][8 * e + 1]); w.y = cvtpk(s[kt][8 * e + 2], s[kt][8 * e + 3]); w.z = cvtpk(s[kt][8 * e + 4], s[kt][8 * e + 5]); w.w = cvtpk(s[kt][8 * e + 6], s[kt][8 * e + 7]); pk[half * 8 + kt * 2 + e] = w; } }
        lsum += sum;
    }
    lsum += __shfl_xor(lsum, 32); const float invl = 1.f / lsum;
    __syncthreads();
#pragma unroll
    for (int c = 0; c < 2; ++c) { v4u vr[8];
#pragma unroll
        for (int i = 0; i < 8; ++i) { const int p = tid + 512 * i; vr[i] = *(const v4u*)(kvp + 1024 + (size_t)(p >> 4) * 4096 + c * 128 + (p & 15) * 8); }
#pragma unroll
        for (int i = 0; i < 8; ++i) { const int p = tid + 512 * i; *(LAS v4u*)(lds + c * 65536 + ((p & 15) >> 2) * 16384 + (p >> 4) * 64 + (p & 3) * 16) = vr[i]; } }
    __syncthreads();
    bf16* yp = (bf16*)(P.ws + WS_Y) + t * DM + hh * 256 + 4 * h;
    LAS const unsigned char* vp = lds + (4 * h + ((lane & 15) >> 2)) * 64 + ((lane >> 4) & 1) * 32 + (lane & 3) * 8;
#pragma unroll 1
    for (int dt = 0; dt < 8; ++dt) { f32x16 o;
#pragma unroll
        for (int r = 0; r < 16; ++r) o[r] = 0.f;
        LAS const unsigned char* vd = vp + dt * 16384;
#pragma unroll
        for (int s = 0; s < 8; ++s) { const v4i16 lo = __builtin_amdgcn_ds_read_tr16_b64_v4i16((LAS v4i16*)(vd + s * 1024)), hi = __builtin_amdgcn_ds_read_tr16_b64_v4i16((LAS v4i16*)(vd + s * 1024 + 512));
            o = __builtin_amdgcn_mfma_f32_32x32x16_bf16((bf16x8){lo[0], lo[1], lo[2], lo[3], hi[0], hi[1], hi[2], hi[3]}, __builtin_bit_cast(bf16x8, pk[s]), o, 0, 0, 0); }
#pragma unroll
        for (int r = 0; r < 16; ++r) o[r] *= f0;
#pragma unroll
        for (int s = 8; s < 16; ++s) { const v4i16 lo = __builtin_amdgcn_ds_read_tr16_b64_v4i16((LAS v4i16*)(vd + s * 1024)), hi = __builtin_amdgcn_ds_read_tr16_b64_v4i16((LAS v4i16*)(vd + s * 1024 + 512));
            o = __builtin_amdgcn_mfma_f32_32x32x16_bf16((bf16x8){lo[0], lo[1], lo[2], lo[3], hi[0], hi[1], hi[2], hi[3]}, __builtin_bit_cast(bf16x8, pk[s]), o, 0, 0, 0); }
#pragma unroll
        for (int a = 0; a < 4; ++a) { v2u w; w.x = cvtpk(o[4 * a] * invl, o[4 * a + 1] * invl); w.y = cvtpk(o[4 * a + 2] * invl, o[4 * a + 3] * invl); *(v2u*)(yp + dt * 32 + a * 8) = w; } }
    __syncthreads();
}
__device__ __forceinline__ void phase_xatt(const Params& P, LAS unsigned char* lds, int l) {
    for (int it = blockIdx.x; it < 512; it += gridDim.x) { const int c = it % 256, k = it / 256; xatt_item(P, lds, l, c & 31, (c >> 5) + 8 * k); }
}

constexpr size_t WS_DN = 344 * MiB, DN_CHUNK_BYTES = 73728, WS_EGL = 488 * MiB;
constexpr int DNA_RHS = 0, DNA_QB = 65536, DNA_KB = 82944, DNA_AM = 100352, DNA_SSQ = 118784, DNA_GC = 126976;
__device__ __forceinline__ void dna_item(const Params& P, LAS unsigned char* lds, int item) {
    int tid_l = threadIdx.x; asm volatile("" : "+v"(tid_l)); const int tid = tid_l, lane = tid & 63, wave = tid >> 6;
    const int bh = item >> 6, n = item & 63, b = bh >> 2, h = bh & 3, sb = n * 64; const size_t rb = (size_t)b * SEQ;
    const bf16* z = (const bf16*)(P.ws + WS_Z); const float* ba = (const float*)(P.ws + WS_BA); const float* cw = P.in[I_A_CONV];
    unsigned char* ob = P.ws + WS_DN + (size_t)item * DN_CHUNK_BYTES;
    LAS float* rhs = (LAS float*)(lds + DNA_RHS); LAS float* Am = (LAS float*)(lds + DNA_AM); LAS float* ssq = (LAS float*)(lds + DNA_SSQ);
    LAS float* gcs = (LAS float*)(lds + DNA_GC); LAS float* bet = gcs + 64; LAS float* egc = gcs + 128; LAS float* ekd = gcs + 192;
    const float SC = 0.08838834764831845f;
    if (wave == 0) { const size_t t = rb + sb + lane; const float bl = ba[t * 8 + h], al = ba[t * 8 + 4 + h] + P.in[I_A_DTB][h]; const float sp = al > 20.f ? al : log1pf(__expf(al));
        float g = -__expf(P.in[I_A_ALOG][h]) * sp;
#pragma unroll
        for (int o = 1; o < 64; o <<= 1) { const float v = __shfl_up(g, o); if (lane >= o) g += v; }
        const float gl = __shfl(g, 63);
        gcs[lane] = g; bet[lane] = sigmoid_f(bl); egc[lane] = __expf(g); ekd[lane] = __expf(gl - g);
        if (lane == 63) ((float*)(P.ws + WS_EGL))[item] = __expf(g); }
    { const int gd = tid & 15, tq = tid >> 4, d0 = gd * 8;
      f32x4 wa[3][4][2]; v4u za[3][2][4];
#pragma unroll
      for (int part = 0; part < 3; ++part) { const int ch0 = part * 512 + h * 128 + d0;
#pragma unroll
          for (int kk = 0; kk < 4; ++kk) { wa[part][kk][0] = *(const f32x4*)(cw + kk * 1536 + ch0); wa[part][kk][1] = *(const f32x4*)(cw + kk * 1536 + ch0 + 4); }
#pragma unroll
          for (int tt = 0; tt < 2; ++tt)
#pragma unroll
              for (int kk = 0; kk < 4; ++kk) { const int sp = sb + tq + 32 * tt - 3 + kk; za[part][tt][kk] = (v4u){0u, 0u, 0u, 0u}; if (sp >= 0) za[part][tt][kk] = *(const v4u*)(z + (rb + sp) * 2560 + 512 + ch0); } }
      __builtin_amdgcn_sched_barrier(0);
      __syncthreads();
#pragma unroll
      for (int part = 0; part < 3; ++part) {
#pragma unroll
          for (int tt = 0; tt < 2; ++tt) { const int tl = tq + 32 * tt;
              float a[8];
#pragma unroll
              for (int e2 = 0; e2 < 8; ++e2) a[e2] = 0.f;
#pragma unroll
              for (int kk = 0; kk < 4; ++kk) { const v4u zv = za[part][tt][kk]; const f32x4 w0 = wa[part][kk][0], w1 = wa[part][kk][1];
                  a[0] += w0.x * bf2f(zv.x & 0xffff); a[1] += w0.y * bf2f(zv.x >> 16); a[2] += w0.z * bf2f(zv.y & 0xffff); a[3] += w0.w * bf2f(zv.y >> 16);
                  a[4] += w1.x * bf2f(zv.z & 0xffff); a[5] += w1.y * bf2f(zv.z >> 16); a[6] += w1.z * bf2f(zv.w & 0xffff); a[7] += w1.w * bf2f(zv.w >> 16); }
              float q2 = 0.f;
#pragma unroll
              for (int e2 = 0; e2 < 8; ++e2) { a[e2] = a[e2] * __builtin_amdgcn_rcpf(1.f + __builtin_amdgcn_exp2f(-LOG2E_F * a[e2])); q2 += a[e2] * a[e2]; }
              if (part < 2) {
                  q2 += __shfl_xor(q2, 1); q2 += __shfl_xor(q2, 2); q2 += __shfl_xor(q2, 4); q2 += __shfl_xor(q2, 8);
                  const float rs = rsqrtf(q2 + EPS);
#pragma unroll
                  for (int e2 = 0; e2 < 8; ++e2) a[e2] *= rs;
                  v4u wv; wv.x = cvtpk(a[0], a[1]); wv.y = cvtpk(a[2], a[3]); wv.z = cvtpk(a[4], a[5]); wv.w = cvtpk(a[6], a[7]);
                  *(LAS v4u*)(lds + (part == 0 ? DNA_QB : DNA_KB) + tl * 272 + d0 * 2) = wv;
                  if (part == 0) { const float f = SC * egc[tl]; v4u g4; g4.x = cvtpk(a[0] * f, a[1] * f); g4.y = cvtpk(a[2] * f, a[3] * f); g4.z = cvtpk(a[4] * f, a[5] * f); g4.w = cvtpk(a[6] * f, a[7] * f);
                      *(v4u*)(ob + 16384 + (((tl >> 4) * 4 + (d0 >> 5)) * 64 + (tl & 15) + 16 * ((d0 >> 3) & 3)) * 16) = g4; }
                  else { const float f = ekd[tl], fb = bet[tl] * egc[tl];
                      *(LAS f32x4*)(rhs + tl * 256 + d0) = (f32x4){a[0] * fb, a[1] * fb, a[2] * fb, a[3] * fb}; *(LAS f32x4*)(rhs + tl * 256 + d0 + 4) = (f32x4){a[4] * fb, a[5] * fb, a[6] * fb, a[7] * fb};
                      bf16* kd = (bf16*)(ob + 32768) + ((((d0 >> 4) * 2 + (tl >> 5)) * 64 + 16 * ((tl >> 3) & 3)) * 8) + (tl & 7);
#pragma unroll
                      for (int e2 = 0; e2 < 8; ++e2) kd[(((d0 & 15) + e2) * 8)] = (bf16)f2bf(a[e2] * f); } }
              else { const float fb = bet[tl];
                  *(LAS f32x4*)(rhs + tl * 256 + 128 + d0) = (f32x4){a[0] * fb, a[1] * fb, a[2] * fb, a[3] * fb}; *(LAS f32x4*)(rhs + tl * 256 + 128 + d0 + 4) = (f32x4){a[4] * fb, a[5] * fb, a[6] * fb, a[7] * fb}; } } } }
    __syncthreads();
    if (wave < 6) { const int isq = wave >= 3, jb = wave - 3 * isq, it = jb >= 1, jt = jb == 2; const int q = lane & 31, hh = lane >> 5;
        f32x16 d;
#pragma unroll
        for (int r = 0; r < 16; ++r) d[r] = 0.f;
        LAS const unsigned char* ap = lds + (isq ? DNA_QB : DNA_KB) + (it * 32 + q) * 272 + hh * 16; LAS const unsigned char* bp = lds + DNA_KB + (jt * 32 + q) * 272 + hh * 16;
#pragma unroll
        for (int ks = 0; ks < 8; ++ks) d = __builtin_amdgcn_mfma_f32_32x32x16_bf16(*(const LAS bf16x8*)(ap + ks * 32), *(const LAS bf16x8*)(bp + ks * 32), d, 0, 0, 0);
        const int j = jt * 32 + q; const float gj = gcs[j];
#pragma unroll
        for (int r = 0; r < 16; ++r) { const int i = it * 32 + (r & 3) + 8 * (r >> 2) + 4 * hh; const float dec = __expf(fminf(gcs[i] - gj, 0.f));
            if (!isq) Am[(j & 1) * 2304 + i * 36 + (j >> 1)] = i > j ? d[r] * bet[i] * dec : 0.f;
            else ((bf16*)(ob + 65536))[((((i >> 4) * 2 + (j >> 5)) * 64 + (i & 15) + 16 * ((j >> 3) & 3)) * 8) + (j & 7)] = (bf16)f2bf(i >= j ? d[r] * SC * dec : 0.f); } }
    else if (wave == 6) { const v4u z4 = {0u, 0u, 0u, 0u}; *(v4u*)(ob + 65536 + ((0 * 2 + 1) * 64 + lane) * 16) = z4; *(v4u*)(ob + 65536 + ((1 * 2 + 1) * 64 + lane) * 16) = z4; }
    __syncthreads();
    if (tid < 256) { const int cp = tid >> 1, par = tid & 1, c = 2 * cp; LAS const float* Ap = Am + par * 2304; f2v x[32];
#pragma unroll
      for (int jj = 0; jj < 32; ++jj) x[jj] = (f2v){0.f, 0.f};
      f32x4 ab[2][8]; f2v rb[2]; f2v xl[4] = {{0.f, 0.f}, {0.f, 0.f}, {0.f, 0.f}, {0.f, 0.f}};
      rb[0] = *(const LAS f2v*)(rhs + c);
      unsigned* wp = (unsigned*)((bf16*)ob + (((c >> 5) * 64 + 16 * ((c >> 3) & 3)) * 8) + (c & 7));
      const int dv = c - 128; unsigned char* up = ob + 49152 + (((dv >> 4) * 4) * 64 + (dv & 15)) * 8;
#pragma unroll
      for (int i = 0; i < 64; ++i) {
          if (i + 1 < 64) {
#pragma unroll
              for (int j4 = 0; j4 < ((i + 2) / 2 + 3) / 4; ++j4) ab[(i + 1) & 1][j4] = *(const LAS f32x4*)(Ap + (i + 1) * 36 + 4 * j4);
              rb[(i + 1) & 1] = *(const LAS f2v*)(rhs + (i + 1) * 256 + c); }
          __builtin_amdgcn_sched_barrier(0);
          f2v acc = {0.f, 0.f};
#pragma unroll
          for (int jj = 0; jj < (i + 1) / 2; ++jj) { const float a = ab[i & 1][jj >> 2][jj & 3]; acc = acc + (f2v){a, a} * x[jj]; }
          acc.x += __int_as_float(__builtin_amdgcn_update_dpp(0, __float_as_int(acc.x), 0xB1, 0xF, 0xF, true)); acc.y += __int_as_float(__builtin_amdgcn_update_dpp(0, __float_as_int(acc.y), 0xB1, 0xF, 0xF, true));
          const f2v xi = rb[i & 1] - acc;
          x[i >> 1] = ((i & 1) == par) ? xi : x[i >> 1];
          xl[i & 3] = xi;
          if (tid < 128) { if ((i & 1) == par) wp[(((i >> 4) * 4) * 64 + (i & 15)) * 4] = cvtpk(xi.x, xi.y); }
          else if ((i & 3) == 3 && ((i >> 2) & 1) == par) { v2u w0, w1; w0.x = cvtpk(xl[0].x, xl[1].x); w0.y = cvtpk(xl[2].x, xl[3].x); w1.x = cvtpk(xl[0].y, xl[1].y); w1.y = cvtpk(xl[2].y, xl[3].y);
              unsigned char* u0 = up + (((i >> 2) >> 2) * 64 + 16 * ((i >> 2) & 3)) * 8; *(v2u*)u0 = w0; *(v2u*)(u0 + 8) = w1; }
          __builtin_amdgcn_sched_barrier(0);
      } }
    __syncthreads();
}
__device__ __forceinline__ void phase_dna(const Params& P, LAS unsigned char* lds) { for (int it = blockIdx.x; it < 2048; it += gridDim.x) dna_item(P, lds, it); }

typedef float f32x4v __attribute__((ext_vector_type(4)));
struct DnFrag { bf16x8 m1[4]; bf16x8 at[2]; bf16x8 kd[2]; v2u u; float eg; };
__device__ __forceinline__ void dnb_load(DnFrag& f, const unsigned char* base, const float* egl, int n, int wave, int lane, int sl) {
    const unsigned char* cb = base + (size_t)n * DN_CHUNK_BYTES; const int ct = wave & 3;
    const unsigned char* m1 = cb + (wave < 4 ? 0 : 16384) + ((ct * 4) * 64 + lane) * 16;
#pragma unroll
    for (int ks = 0; ks < 4; ++ks) f.m1[ks] = *(const bf16x8*)(m1 + ks * 1024);
#pragma unroll
    for (int ks = 0; ks < 2; ++ks) f.kd[ks] = *(const bf16x8*)(cb + 32768 + ((wave * 2 + ks) * 64 + lane) * 16);
    if (wave < 4) f.u = *(const v2u*)(cb + 49152 + ((sl * 4 + ct) * 64 + lane) * 8);
    else {
#pragma unroll
        for (int ks = 0; ks < 2; ++ks) f.at[ks] = *(const bf16x8*)(cb + 65536 + ((ct * 2 + ks) * 64 + lane) * 16); }
    f.eg = egl[n];
}
__device__ __forceinline__ void phase_dnb(const Params& P, LAS unsigned char* lds) {
    int tid_l = threadIdx.x; asm volatile("" : "+v"(tid_l)); const int tid = tid_l, lane = tid & 63, wave = __builtin_amdgcn_readfirstlane(tid >> 6);
    const int x = blockIdx.x; if (x >= 256) return;
    const int xcd = x & 7, idx = x >> 3, bh = xcd * 4 + (idx >> 3), sl = idx & 7, b = bh >> 2, h = bh & 3, ct = wave & 3;
    const unsigned char* base = P.ws + WS_DN + (size_t)bh * 64 * DN_CHUNK_BYTES; const float* egl = (const float*)(P.ws + WS_EGL) + bh * 64;
    bf16* yo = (bf16*)(P.ws + WS_Y) + ((size_t)b * SEQ + 16 * ct + 4 * (lane >> 4)) * DM + 512 + h * 128 + sl * 16 + (lane & 15);
    LAS unsigned char* St = lds; LAS unsigned char* vnT = lds + 4352;
    LAS const unsigned char* stb = St + (lane & 15) * 272 + (lane >> 4) * 16; LAS const unsigned char* vnb = vnT + (lane & 15) * 144 + (lane >> 4) * 16;
    if (tid < 272) *(LAS v4u*)(St + tid * 16) = (v4u){0u, 0u, 0u, 0u};
    f32x4v Sacc = {0.f, 0.f, 0.f, 0.f};
    DnFrag fr[4];
#pragma unroll
    for (int u = 0; u < 4; ++u) dnb_load(fr[u], base, egl, u, wave, lane, sl);
    __syncthreads();
#pragma unroll 1
    for (int n0 = 0; n0 < 64; n0 += 4) {
#pragma unroll
        for (int u = 0; u < 4; ++u) { const int n = n0 + u;
            f32x4v acc = {0.f, 0.f, 0.f, 0.f};
#pragma unroll
            for (int ks = 0; ks < 4; ++ks) acc = __builtin_amdgcn_mfma_f32_16x16x32_bf16(fr[u].m1[ks], *(const LAS bf16x8*)(stb + ks * 64), acc, 0, 0, 0);
            if (wave < 4) { const float u0 = bf2f(fr[u].u.x & 0xffff), u1 = bf2f(fr[u].u.x >> 16), u2 = bf2f(fr[u].u.y & 0xffff), u3 = bf2f(fr[u].u.y >> 16);
                v2u w; w.x = cvtpk(u0 - acc[0], u1 - acc[1]); w.y = cvtpk(u2 - acc[2], u3 - acc[3]); *(LAS v2u*)(vnT + (lane & 15) * 144 + (16 * ct + 4 * (lane >> 4)) * 2) = w; }
            __syncthreads();
            const bf16x8 v0 = *(const LAS bf16x8*)(vnb), v1 = *(const LAS bf16x8*)(vnb + 64);
            if (wave >= 4) { acc = __builtin_amdgcn_mfma_f32_16x16x32_bf16(fr[u].at[0], v0, acc, 0, 0, 0); acc = __builtin_amdgcn_mfma_f32_16x16x32_bf16(fr[u].at[1], v1, acc, 0, 0, 0);
                bf16* yp = yo + (size_t)n * 64 * DM;
#pragma unroll
                for (int r = 0; r < 4; ++r) yp[(size_t)r * DM] = (bf16)f2bf(acc[r]); }
            Sacc = Sacc * fr[u].eg;
            Sacc = __builtin_amdgcn_mfma_f32_16x16x32_bf16(fr[u].kd[0], v0, Sacc, 0, 0, 0); Sacc = __builtin_amdgcn_mfma_f32_16x16x32_bf16(fr[u].kd[1], v1, Sacc, 0, 0, 0);
            { v2u w; w.x = cvtpk(Sacc[0], Sacc[1]); w.y = cvtpk(Sacc[2], Sacc[3]); *(LAS v2u*)(St + (lane & 15) * 272 + (16 * wave + 4 * (lane >> 4)) * 2) = w; }
            dnb_load(fr[u], base, egl, n + 4 < 64 ? n + 4 : 63, wave, lane, sl);
            __syncthreads();
        }
    }
}
__device__ __forceinline__ void phase_dnc(const Params& P, LAS unsigned char* lds) {
    int tid_l = threadIdx.x; asm volatile("" : "+v"(tid_l)); const int tid = tid_l, lane = tid & 63, wave = tid >> 6;
    const int gw = blockIdx.x * NWAVES + wave, NGW = gridDim.x * NWAVES;
    const bf16* z = (const bf16*)(P.ws + WS_Z); bf16* y = (bf16*)(P.ws + WS_Y);
    float on[8];
#pragma unroll
    for (int e = 0; e < 8; ++e) on[e] = P.in[I_A_ONORM][(lane & 15) * 8 + e];
    for (int it0 = gw; it0 < T; it0 += 4 * NGW) {
        const int hh = lane >> 4, d0 = (lane & 15) * 8; v4u ov[4], gv[4];
#pragma unroll
        for (int u = 0; u < 4; ++u) { const int it = it0 + u * NGW; if (it < T) { ov[u] = *(const v4u*)(y + (size_t)it * DM + 512 + hh * 128 + d0); gv[u] = *(const v4u*)(z + (size_t)it * 2560 + 2048 + hh * 128 + d0); } }
#pragma unroll
        for (int u = 0; u < 4; ++u) { const int it = it0 + u * NGW; if (it >= T) break;
            float o[8] = {bf2f(ov[u].x & 0xffff), bf2f(ov[u].x >> 16), bf2f(ov[u].y & 0xffff), bf2f(ov[u].y >> 16), bf2f(ov[u].z & 0xffff), bf2f(ov[u].z >> 16), bf2f(ov[u].w & 0xffff), bf2f(ov[u].w >> 16)};
            const float g[8] = {bf2f(gv[u].x & 0xffff), bf2f(gv[u].x >> 16), bf2f(gv[u].y & 0xffff), bf2f(gv[u].y >> 16), bf2f(gv[u].z & 0xffff), bf2f(gv[u].z >> 16), bf2f(gv[u].w & 0xffff), bf2f(gv[u].w >> 16)};
            float s = 0.f;
#pragma unroll
            for (int e = 0; e < 8; ++e) s += o[e] * o[e];
            s += __shfl_xor(s, 1); s += __shfl_xor(s, 2); s += __shfl_xor(s, 4); s += __shfl_xor(s, 8);
            const float rs = rsqrtf(s * (1.f / 128.f) + EPS);
#pragma unroll
            for (int e = 0; e < 8; ++e) o[e] = o[e] * rs * on[e] * (g[e] * __builtin_amdgcn_rcpf(1.f + __builtin_amdgcn_exp2f(-LOG2E_F * g[e])));
            v4u w; w.x = cvtpk(o[0], o[1]); w.y = cvtpk(o[2], o[3]); w.z = cvtpk(o[4], o[5]); w.w = cvtpk(o[6], o[7]);
            *(v4u*)(y + (size_t)it * DM + 512 + hh * 128 + d0) = w; } }
    phase_pool(P, lds);
}

constexpr size_t WS_CTL = 118 * MiB; constexpr int CTL_BYTES = 16384, LDS_CTL_OFF = 147392;
#define XB_TMO      128
#define XB_XCNT(j)  (256  + 64 * (j))
#define XB_XSUB(j)  (1280 + 64 * (j))
#define XB_XGEN(j)  (2304 + 64 * (j))
#define XB_TOP      3328
#define XB_TOPGEN   3392
#define XCD_BAR_WORDS 3456
#define XB_SPIN_CAP (1u << 18)

__device__ __forceinline__ unsigned xb_ld(unsigned* p)              { return __hip_atomic_load(p, __ATOMIC_RELAXED, __HIP_MEMORY_SCOPE_AGENT); }
__device__ __forceinline__ unsigned xb_add(unsigned* p, unsigned v) { return __hip_atomic_fetch_add(p, v, __ATOMIC_RELAXED, __HIP_MEMORY_SCOPE_AGENT); }
__device__ __forceinline__ unsigned xb_xcc_id() { return (unsigned)__builtin_amdgcn_s_getreg((3 << 11) | 20) & 0xFu; }
#define XB_SPIN(cond, bar) do { unsigned _sp = 0; while (cond) { __builtin_amdgcn_s_sleep(1); \
    if ((++_sp & 255u) == 0u) { if (xb_ld(&(bar)[XB_TMO])) break; if (_sp > XB_SPIN_CAP) { atomicAdd(&(bar)[XB_TMO], 1u); break; } } } } while (0)

struct XcdBarrier {
    unsigned* bar; unsigned x;
    volatile LAS unsigned* st;
};

__device__ __forceinline__ XcdBarrier xcd_barrier_post(unsigned* bar, volatile LAS unsigned* st) {
    XcdBarrier b; b.bar = bar; b.x = xb_xcc_id(); b.st = st;
    if (threadIdx.x == 0) (void)xb_add(&bar[XB_XCNT(b.x)], 1u);
    return b;
}
__device__ __forceinline__ void xcd_barrier_complete(unsigned* bar, unsigned x, unsigned& nloc, unsigned& nx) {
    const unsigned G = gridDim.x * gridDim.y * gridDim.z;
    unsigned sum, cnt, mine, sp = 0u;
    for (;;) {
        sum = 0u; cnt = 0u; mine = 0u;
#pragma unroll
        for (unsigned j = 0; j < 16; ++j) { const unsigned c = xb_ld(&bar[XB_XCNT(j)]); sum += c; cnt += (c > 0u) ? 1u : 0u; mine = (j == x) ? c : mine; }
        if (sum == G) break;
        __builtin_amdgcn_s_sleep(1);
        if ((++sp & 255u) == 0u) { if (xb_ld(&bar[XB_TMO])) break; if (sp > XB_SPIN_CAP) { atomicAdd(&bar[XB_TMO], 1u); break; } }
    }
    nloc = mine > 0u ? mine : 1u; nx = cnt > 0u ? cnt : 1u;
}

__device__ __forceinline__ void xcd_barrier(const XcdBarrier& b) {
    asm volatile("s_waitcnt vmcnt(0)" ::: "memory");
    __syncthreads();
    if (threadIdx.x == 0) {
        unsigned* bar = b.bar;
        __builtin_amdgcn_s_waitcnt(0);
        unsigned nloc = b.st[0], nx = b.st[1];
        if (nloc == 0u) { xcd_barrier_complete(bar, b.x, nloc, nx); b.st[0] = nloc; b.st[1] = nx; }
        const unsigned old = xb_add(&bar[XB_XSUB(b.x)], 1u);
        const unsigned gen = old / nloc;
        if (old + 1u == (gen + 1u) * nloc) {
            __builtin_amdgcn_fence(__ATOMIC_RELEASE, "agent");
            asm volatile("s_waitcnt vmcnt(0)" ::: "memory");
            const unsigned og = xb_add(&bar[XB_TOP], 1u);
            const unsigned tg = og / nx;
            if (og + 1u == (tg + 1u) * nx) xb_add(&bar[XB_TOPGEN], 1u);
            else XB_SPIN(xb_ld(&bar[XB_TOPGEN]) == tg, bar);
            __builtin_amdgcn_fence(__ATOMIC_ACQUIRE, "agent");
            xb_add(&bar[XB_XGEN(b.x)], 1u);
            asm volatile("s_waitcnt vmcnt(0)" ::: "memory");
        } else {
            XB_SPIN(xb_ld(&bar[XB_XGEN(b.x)]) == gen, bar);
            __builtin_amdgcn_fence(__ATOMIC_ACQUIRE, "agent");
            asm volatile("s_waitcnt vmcnt(0)" ::: "memory");
        }
    }
    __syncthreads();
}

constexpr int LDS_RS_OFF = 131072;
template <class E> __device__ __forceinline__ void run_gemm(LAS unsigned char* lds, const bf16* A, const bf16* Bt, int M, int N, int K, const E& e, const float* ss = nullptr) {
    pg8::Gemm g{A, Bt, M, N, K}; pg8::StaticOrder So; So.init(M, N, (int)gridDim.x, (int)blockIdx.x);
    if (ss) { pg8::Unit u; LAS float* rs = (LAS float*)(lds + LDS_RS_OFF);
        for (int i = 0; So.next(i, u); ++i) { const int r = threadIdx.x; if (r < 256) rs[256 * i + r] = pg8::row_rstd(ss, u.pm * 256 + r); }
        __syncthreads(); }
    pg8::gemm_phase<E, pg8::StaticOrder, true, true>(lds, g, So, e);
}
constexpr int N_PHASES = 22;
#ifndef MK_PER_PHASE
#define MK_PER_PHASE 0
#endif

template <int ph> __device__ __forceinline__ void do_phase(const Params& P, LAS unsigned char* lds) {
    unsigned char* ws = P.ws;
    bf16* xh = (bf16*)(ws + WS_XH); float* ss = (float*)(ws + WS_SS); bf16* yb = (bf16*)(ws + WS_Y); bf16* zb = (bf16*)(ws + WS_Z);
    if constexpr (ph == 0) phase_prologue(P, lds);
    else if constexpr (ph == 1) {
        pg8::Gemm g{xh, (const bf16*)(ws + WS_AIN), T, 2816, 1024, (const bf16*)(ws + WS_MEMH), (const bf16*)(ws + WS_XKV)};
        pg8::DualOrder So; So.init(T, 2816, 2048, 4096, (int)gridDim.x, (int)blockIdx.x);
        { pg8::Unit u; LAS float* rs = (LAS float*)(lds + LDS_RS_OFF);
          for (int i = 0; So.next(i, u); ++i) { const int r = threadIdx.x; if (r < 256 && u.kind == 0) rs[256 * i + r] = pg8::row_rstd(ss, u.pm * 256 + r); }
          __syncthreads(); }
        pg8::EpiDual<pg8::EpiInA, pg8::EpiBf<0>> e{{zb, (float*)(ws + WS_BA), (LAS float*)(lds + LDS_RS_OFF)}, {(bf16*)(ws + WS_MEMKV), 4096, nullptr, 1.f}};
        pg8::gemm_phase<pg8::EpiDual<pg8::EpiInA, pg8::EpiBf<0>>, pg8::DualOrder, true, true>(lds, g, So, e); }
    else if constexpr (ph == 2) phase_dna(P, lds);
    else if constexpr (ph == 3) phase_dnb(P, lds);
    else if constexpr (ph == 4) phase_dnc(P, lds);
    else if constexpr (ph == 11) { pg8::EpiInC e{zb, zb + (size_t)T * 1024, (float*)(ws + WS_GATES), (LAS float*)(lds + LDS_RS_OFF)}; run_gemm(lds, xh, (const bf16*)(ws + WS_CIN), T, 2816, 1024, e, ss); }
    else if constexpr (ph == 12) { const int kvs = (int)blockIdx.x >> 5;
        if (kvs < 2) { pg8::EpiF32 e{(float*)(ws + (kvs ? WS_P01V : WS_P01K)), 256};
            pg8::Gemm g{zb + (size_t)T * 1024 + (size_t)kvs * KV_KIND, (const bf16*)(ws + (kvs ? WS_CMPV : WS_CMPK)), 8192, 256, 1024}; pg8::StaticOrder So; So.init(8192, 256, (int)gridDim.x, (int)blockIdx.x & 31);
            pg8::gemm_phase<pg8::EpiF32, pg8::StaticOrder, true, true>(lds, g, So, e);
            pg8::Unit u; So.next(0, u);
            __builtin_amdgcn_fence(__ATOMIC_RELEASE, "agent"); asm volatile("s_waitcnt vmcnt(0)" ::: "memory"); __syncthreads(); __builtin_amdgcn_fence(__ATOMIC_ACQUIRE, "agent"); asm volatile("s_waitcnt vmcnt(0)" ::: "memory");
            cmpfin_bg(P, lds, kvs, u.pm); }
        else phase_conv_late(P, lds, ((int)blockIdx.x - 64) * NWAVES + (int)(threadIdx.x >> 6), ((int)gridDim.x - 64) * NWAVES); }
    else if constexpr (ph == 13) { }
    else if constexpr (ph == 14) phase_nsa(P, lds);
    else if constexpr (ph == 21) phase_final(P);
    else { constexpr int l = ph >= 15 ? 1 : 0, k = ph - (l ? 15 : 5);
        if constexpr (k == 1) {
            { pg8::EpiBf<0> e{(bf16*)(ws + WS_QXA), 1024, (LAS float*)(lds + LDS_RS_OFF), 1.f}; run_gemm(lds, xh, (const bf16*)(ws + WS_XQ) + (size_t)l * 1048576, T, 1024, 1024, e, ss); } }
        else if constexpr (k == 2) phase_xatt(P, lds, l);
        else if constexpr (k == 4) { pg8::EpiBf<1> e{(bf16*)(ws + WS_HMID), 4096, (LAS float*)(lds + LDS_RS_OFF), 1.f}; run_gemm(lds, xh, (const bf16*)(ws + WS_F1) + (size_t)l * 4194304, T, 4096, 1024, e, ss); }
        else { const bf16* A = k == 5 ? (const bf16*)(ws + WS_HMID) : yb; constexpr int K = k == 5 ? 4096 : 1024;
            const bf16* Bt = k == 0 ? (const bf16*)(ws + (l ? WS_COUT : WS_AOUT)) : k == 3 ? (const bf16*)(ws + WS_XO) + (size_t)l * 1048576 : (const bf16*)(ws + WS_F2) + (size_t)l * 4194304;
            if constexpr (ph == 5) { pg8::EpiRes<true> e{xh, ss, P.in[I_X]}; run_gemm(lds, A, Bt, T, 1024, K, e); }
            else { pg8::EpiRes<false> e{xh, ss, nullptr}; run_gemm(lds, A, Bt, T, 1024, K, e); } } }
}
__global__ void __launch_bounds__(NTHR, 2) trunk_fwd(Params P) {
    extern __shared__ __attribute__((aligned(16))) unsigned char lds_raw[];
    LAS unsigned char* lds = (LAS unsigned char*)lds_raw;
    cg::grid_group grid = cg::this_grid();
    const int lo = P.ph_lo, hi = P.ph_hi;
#ifndef PROBE_PH
#define PROBE_PH -1
#endif
    if (threadIdx.x < 2) ((LAS unsigned*)(lds + LDS_CTL_OFF))[threadIdx.x] = 0u;
    __syncthreads();
    const XcdBarrier bar = xcd_barrier_post((unsigned*)(P.ws + WS_CTL), (volatile LAS unsigned*)(lds + LDS_CTL_OFF));
    if (P.ph_lo < 0) grid.sync();
#define SEAM(k) { xcd_barrier(bar); }
#define RUN(k) if (lo <= (k) && (k) < hi) { if ((k) == PROBE_PH) { do_phase<(k)>(P, lds); SEAM(k) } do_phase<(k)>(P, lds); if ((k) + 1 < hi) SEAM(k) }
    RUN(0) RUN(1) RUN(2) RUN(3) RUN(4) RUN(5) RUN(6) RUN(7) RUN(8) RUN(9) RUN(10) RUN(11) RUN(12) RUN(14) RUN(15) RUN(16) RUN(17) RUN(18) RUN(19) RUN(20) RUN(21)
#undef RUN
}

extern "C" void kernel_launch(void* const* d_in, const int* in_sizes, int n_in, void* d_out, int out_size, void* d_ws, size_t ws_size, hipStream_t stream) {
    static int grid = 0;
    if (grid == 0) {
        if (n_in != N_IN || in_sizes[0] != T * DM || out_size != T * DM || ws_size < WS_END) { fprintf(stderr, "kernel_launch: unexpected shapes (n_in %d, in0 %d, out %d, ws %zu)\n", n_in, n_in > 0 ? in_sizes[0] : -1, out_size, ws_size); grid = -1; return; }
        int dev = 0, cus = 0, per_cu = 0;
        if (hipGetDevice(&dev) != hipSuccess || hipDeviceGetAttribute(&cus, hipDeviceAttributeMultiprocessorCount, dev) != hipSuccess) { grid = -1; return; }
        if (hipFuncSetAttribute((const void*)trunk_fwd, hipFuncAttributeMaxDynamicSharedMemorySize, LDS_BYTES) != hipSuccess) { fprintf(stderr, "kernel_launch: hipFuncSetAttribute failed\n"); grid = -1; return; }
        if (hipOccupancyMaxActiveBlocksPerMultiprocessor(&per_cu, (const void*)trunk_fwd, NTHR, LDS_BYTES) != hipSuccess || per_cu < 1) { fprintf(stderr, "kernel_launch: occupancy query says %d blocks/CU\n", per_cu); (void)hipGetLastError(); grid = -1; return; }
        grid = cus;
        fprintf(stderr, "kernel_launch: %d CUs, %d blocks/CU by the occupancy query, grid %d\n", cus, per_cu, grid);
    }
    if (grid < 0) return;
    Params p{};
    for (int i = 0; i < N_IN; ++i) p.in[i] = (const float*)d_in[i];
    p.out = (float*)d_out; p.ws = (unsigned char*)d_ws;
#if MK_PER_PHASE
    for (int ph = 0; ph < N_PHASES; ++ph) { p.ph_lo = ph; p.ph_hi = ph + 1; hipLaunchKernelGGL(trunk_fwd, dim3(grid), dim3(NTHR), LDS_BYTES, stream, p); }
#else
    p.ph_lo = 0; p.ph_hi = N_PHASES;
    if (hipMemsetAsync((char*)d_ws + WS_CTL, 0, CTL_BYTES, stream) != hipSuccess) { fprintf(stderr, "kernel_launch: memset of the barrier words failed\n"); return; }
    void* args[] = {&p};
    hipError_t e = hipLaunchCooperativeKernel((const void*)trunk_fwd, dim3(grid), dim3(NTHR), args, LDS_BYTES, stream);
    if (e != hipSuccess) fprintf(stderr, "kernel_launch: cooperative launch failed: %s (grid %d)\n", hipGetErrorString(e), grid);
#endif
}
```

```cpp
#include <hip/hip_runtime.h>
#include <hip/hip_cooperative_groups.h>
#include <cstdio>
#include <cstdint>
namespace cg = cooperative_groups;
namespace pg8 {
#define PG8_LAS __attribute__((address_space(3)))
typedef unsigned short bf16_t;
typedef short bf16x8 __attribute__((ext_vector_type(8)));
typedef float f32x4 __attribute__((ext_vector_type(4)));
typedef unsigned u32x4 __attribute__((ext_vector_type(4)));
constexpr int BM = 256, BK = 64, HALF = 128, HTB = HALF * BK * 2  , STAGE_BYTES = 8 * HTB, NXCD = 8, WGM = 8;

__host__ __device__ __forceinline__ int lds_byte(int r, int c) { const int st = (r >> 4) * 2 + (c >> 5), rr = r & 15, cc = c & 31, ob = rr * 64 + cc * 2; return st * 1024 + (ob ^ (((ob >> 9) & 1) << 5)); }
__host__ __device__ __forceinline__ void stage_rc(int b, int& R, int& C) { const int st = b / 1024, sb = b % 1024, swz = sb ^ (((sb >> 9) & 1) << 5); R = (st >> 1) * 16 + swz / 64; C = (st & 1) * 32 + (swz % 64) / 2; }
__host__ __device__ __forceinline__ int perm32(int rho) { const int n = rho >> 4, i = rho & 15; return 8 * (i >> 2) + 4 * n + (i & 3); }

struct Unit { int pm, pn, ui, kind; };
struct Gemm { const bf16_t* A; const bf16_t* Bt; int M, N, K; const bf16_t* A2 = nullptr; const bf16_t* Bt2 = nullptr; };

struct StaticOrder {
    int nM, nN, nwg, G, c;
    __host__ __device__ void init(int M, int N, int G_, int c_) { nM = M / BM; nN = N / BM; nwg = nM * nN; G = G_; c = c_; }
    __host__ __device__ bool next(int i, Unit& u) const {
        const long L = (long)i * G + c; if (L >= nwg) return false;
        int wgid = (int)L; { const int q = nwg / NXCD, r = nwg % NXCD, xcd = wgid % NXCD, off = wgid / NXCD; wgid = (xcd < r ? xcd * (q + 1) : r * (q + 1) + (xcd - r) * q) + off; }
        const int nig = WGM * nN, gid = wgid / nig, fm = gid * WGM, gsz = (nM - fm) < WGM ? (nM - fm) : WGM;
        u.pm = fm + ((wgid % nig) % gsz); u.pn = (wgid % nig) / gsz; u.ui = i; u.kind = 0; return true;
    }
    __device__ __forceinline__ void a_ready(const Unit&) const {}
    __device__ __forceinline__ void done(const Unit&) const {}
};
__device__ __forceinline__ unsigned cvt_pk_bf16(float lo, float hi) { unsigned r; asm volatile("v_cvt_pk_bf16_f32 %0, %1, %2" : "=v"(r) : "v"(lo), "v"(hi)); return r; }
typedef float f32x2 __attribute__((ext_vector_type(2)));
typedef float f32x2 __attribute__((ext_vector_type(2)));
template <class Epi, class Sched, bool ALIGN_EPI = false, bool SP2 = false>
__device__ __forceinline__ void gemm_phase(PG8_LAS unsigned char* lds, const Gemm g, const Sched& S, const Epi& E) {
    int tid_l = threadIdx.x; asm volatile("" : "+v"(tid_l));
    const int tid = tid_l, wid = __builtin_amdgcn_readfirstlane(tid >> 6), lane = tid & 63, wr = wid >> 2, wc = wid & 3, fr = lane & 15, fq = lane >> 4;
    const int K = g.K, nt = K / BK;
    unsigned voffA[2], voffB[2];
#pragma unroll
    for (int i = 0; i < 2; ++i) { int R, C; stage_rc(tid * 16 + i * 8192, R, C); const int Rb = Epi::PERM ? ((R & ~31) + perm32(R & 31)) : R;
        voffA[i] = (unsigned)(R * K + C) * 2u; voffB[i] = (unsigned)(Rb * K + C) * 2u; }
    const size_t kstep = (size_t)(BK * 2);
    const size_t hstep = (size_t)HALF * K * 2;
    const size_t tstep = 2 * hstep;
    const unsigned ldsw = (unsigned)wid * 1024u;
    const int aoff = lds_byte(wr * 64 + fr, fq * 8), boff = lds_byte(wc * 32 + fr, fq * 8);
#define PG8_SA(b, h) (((b) * 2 + (h)) * HTB)
#define PG8_SB(b, h) ((4 + (b) * 2 + (h)) * HTB)
#define PG8_STAGE(bufoff, gbase, voff) do { _Pragma("unroll") for (int _i = 0; _i < 2; ++_i) \
        __builtin_amdgcn_global_load_lds((const unsigned*)((const char*)(gbase) + (voff)[_i]), (PG8_LAS unsigned*)(lds + (bufoff) + ldsw + _i * 8192), 16, 0, 0); } while (0)
#define PG8_LDA(dst, b, h) do { _Pragma("unroll") for (int m = 0; m < 4; ++m) _Pragma("unroll") for (int k = 0; k < 2; ++k) dst[m][k] = *(const PG8_LAS bf16x8*)(lds + PG8_SA(b, h) + aoff + m * 2048 + k * 1024); } while (0)
#define PG8_LDB(dst, b, h) do { _Pragma("unroll") for (int n = 0; n < 2; ++n) _Pragma("unroll") for (int k = 0; k < 2; ++k) dst[n][k] = *(const PG8_LAS bf16x8*)(lds + PG8_SB(b, h) + boff + n * 2048 + k * 1024); } while (0)
#define PG8_MMA(ai, bj, At, Bt) do { __builtin_amdgcn_s_setprio(1); _Pragma("unroll") for (int m = 0; m < 4; ++m) _Pragma("unroll") for (int n = 0; n < 2; ++n) _Pragma("unroll") for (int k = 0; k < 2; ++k) \
        acc[ai][bj][m][n] = __builtin_amdgcn_mfma_f32_16x16x32_bf16(Bt[n][k], At[m][k], acc[ai][bj][m][n], 0, 0, 0); __builtin_amdgcn_s_setprio(0); } while (0)
#define PG8_WAIT_V(n) asm volatile("s_waitcnt vmcnt(" #n ")" ::: "memory")
#define PG8_WAIT_L(n) asm volatile("s_waitcnt lgkmcnt(" #n ")" ::: "memory")
#define PG8_BAR __builtin_amdgcn_s_barrier()
#define PG8_SCHED __builtin_amdgcn_sched_barrier(0)
    Unit cur, nxt; int ui = 0;
    if (!S.next(0, cur)) return;
    f32x4 acc[2][2][4][2];
#pragma unroll
    for (int a = 0; a < 2; ++a)
#pragma unroll
        for (int b = 0; b < 2; ++b)
#pragma unroll
            for (int m = 0; m < 4; ++m)
#pragma unroll
                for (int n = 0; n < 2; ++n) acc[a][b][m][n] = (f32x4){0.f, 0.f, 0.f, 0.f};
    bf16x8 At[4][2], B0[2][2], B1[2][2];
    const char* cA = (const char*)(cur.kind ? g.A2 : g.A) + (size_t)cur.pm * tstep; const char* cB = (const char*)(cur.kind ? g.Bt2 : g.Bt) + (size_t)cur.pn * tstep;
    S.a_ready(cur);
    if constexpr (SP2) {
        PG8_STAGE(PG8_SB(0, 0), cB, voffB); PG8_STAGE(PG8_SB(0, 1), cB + hstep, voffB); PG8_STAGE(PG8_SA(0, 0), cA, voffA); PG8_STAGE(PG8_SA(0, 1), cA + hstep, voffA);
        if (wr == 1) PG8_BAR;
        PG8_WAIT_V(2); PG8_BAR;
        PG8_STAGE(PG8_SB(1, 0), cB + kstep, voffB); PG8_STAGE(PG8_SA(1, 0), cA + kstep, voffA); PG8_STAGE(PG8_SB(1, 1), cB + hstep + kstep, voffB);
        PG8_WAIT_V(6); PG8_BAR;
    } else {
        PG8_STAGE(PG8_SB(0, 0), cB, voffB); PG8_STAGE(PG8_SA(0, 0), cA, voffA); PG8_STAGE(PG8_SB(0, 1), cB + hstep, voffB); PG8_STAGE(PG8_SA(0, 1), cA + hstep, voffA);
        if (wr == 1) PG8_BAR;
        PG8_WAIT_V(4); PG8_BAR;
        PG8_STAGE(PG8_SB(1, 0), cB + kstep, voffB); PG8_STAGE(PG8_SA(1, 0), cA + kstep, voffA); PG8_STAGE(PG8_SB(1, 1), cB + hstep + kstep, voffB);
        PG8_WAIT_V(6); PG8_BAR;
    }
    for (;;) {
        const bool has_next = S.next(ui + 1, nxt);
        const char* nA = has_next ? (const char*)(nxt.kind ? g.A2 : g.A) + (size_t)nxt.pm * tstep : cA; const char* nB = has_next ? (const char*)(nxt.kind ? g.Bt2 : g.Bt) + (size_t)nxt.pn * tstep : cB;
        for (int t = 0; t < nt; t += 2) {
            const bool last = (t == nt - 2);
            const char* a1 = cA + (size_t)(t + 1) * kstep;
            const char* a2 = last ? nA : cA + (size_t)(t + 2) * kstep; const char* b2 = last ? nB : cB + (size_t)(t + 2) * kstep;
            const char* a3 = a2 + kstep; const char* b3 = b2 + kstep;
            if (last && has_next) S.a_ready(nxt);
            if constexpr (SP2) {
            PG8_LDB(B0, 0, 0); PG8_LDB(B1, 0, 1); PG8_SCHED; PG8_LDA(At, 0, 0); PG8_STAGE(PG8_SA(1, 1), a1 + hstep, voffA);
            PG8_WAIT_V(8); PG8_WAIT_L(0); PG8_BAR; PG8_MMA(0, 0, At, B0); PG8_MMA(0, 1, At, B1); PG8_BAR; PG8_SCHED;
            PG8_LDA(At, 0, 1); PG8_STAGE(PG8_SB(0, 0), b2, voffB); PG8_STAGE(PG8_SB(0, 1), b2 + hstep, voffB); PG8_STAGE(PG8_SA(0, 0), a2, voffA);
            PG8_WAIT_V(8); PG8_WAIT_L(0); PG8_BAR; PG8_MMA(1, 0, At, B0); PG8_MMA(1, 1, At, B1); PG8_BAR; PG8_SCHED;
            PG8_LDB(B0, 1, 0); PG8_LDB(B1, 1, 1); PG8_SCHED; PG8_LDA(At, 1, 0); PG8_STAGE(PG8_SA(0, 1), a2 + hstep, voffA);
            PG8_WAIT_V(8); PG8_WAIT_L(0); PG8_BAR; PG8_MMA(0, 0, At, B0); PG8_MMA(0, 1, At, B1); PG8_BAR; PG8_SCHED;
            PG8_LDA(At, 1, 1); PG8_STAGE(PG8_SB(1, 0), b3, voffB); PG8_STAGE(PG8_SB(1, 1), b3 + hstep, voffB); PG8_STAGE(PG8_SA(1, 0), a3, voffA);
            PG8_WAIT_V(8); PG8_WAIT_L(0); PG8_BAR; PG8_MMA(1, 0, At, B0); PG8_MMA(1, 1, At, B1); PG8_BAR; PG8_SCHED;
            } else {
            PG8_LDB(B0, 0, 0); PG8_SCHED; PG8_LDA(At, 0, 0); PG8_STAGE(PG8_SA(1, 1), a1 + hstep, voffA);
            PG8_WAIT_L(8); PG8_BAR; PG8_WAIT_L(0); PG8_MMA(0, 0, At, B0); PG8_BAR; PG8_SCHED;
            PG8_LDB(B1, 0, 1); PG8_STAGE(PG8_SB(0, 0), b2, voffB);
            PG8_BAR; PG8_WAIT_L(0); PG8_MMA(0, 1, At, B1); PG8_BAR;
            PG8_LDA(At, 0, 1); PG8_STAGE(PG8_SA(0, 0), a2, voffA);
            PG8_BAR; PG8_WAIT_L(0); PG8_MMA(1, 0, At, B0); PG8_BAR; PG8_SCHED;
            PG8_STAGE(PG8_SB(0, 1), b2 + hstep, voffB);
            PG8_WAIT_V(6); PG8_BAR; PG8_MMA(1, 1, At, B1); PG8_BAR;
            PG8_LDB(B0, 1, 0); PG8_SCHED; PG8_LDA(At, 1, 0); PG8_STAGE(PG8_SA(0, 1), a2 + hstep, voffA);
            PG8_WAIT_L(8); PG8_BAR; PG8_WAIT_L(0); PG8_MMA(0, 0, At, B0); PG8_BAR; PG8_SCHED;
            PG8_LDB(B1, 1, 1); PG8_STAGE(PG8_SB(1, 0), b3, voffB);
            PG8_BAR; PG8_WAIT_L(0); PG8_MMA(0, 1, At, B1); PG8_BAR;
            PG8_LDA(At, 1, 1); PG8_STAGE(PG8_SA(1, 0), a3, voffA);
            PG8_BAR; PG8_WAIT_L(0); PG8_MMA(1, 0, At, B0); PG8_BAR; PG8_SCHED;
            PG8_STAGE(PG8_SB(1, 1), b3 + hstep, voffB);
            PG8_WAIT_V(6); PG8_BAR; PG8_MMA(1, 1, At, B1); PG8_BAR;
            }
        }
        if constexpr (ALIGN_EPI) { if (wr == 0) PG8_BAR; }
        if constexpr (!Epi::AFTER_DRAIN) { E(acc, cur, wr, wc, fr, fq); S.done(cur); }
        if (!has_next) break;
#pragma unroll
        for (int a = 0; a < 2; ++a)
#pragma unroll
            for (int b = 0; b < 2; ++b)
#pragma unroll
                for (int m = 0; m < 4; ++m)
#pragma unroll
                    for (int n = 0; n < 2; ++n) acc[a][b][m][n] = (f32x4){0.f, 0.f, 0.f, 0.f};
        cur = nxt; cA = nA; cB = nB; ++ui;
        if constexpr (ALIGN_EPI) { if (wr == 1) PG8_BAR; }
    }
    PG8_WAIT_V(0);
    if constexpr (!ALIGN_EPI) { if (wr == 0) PG8_BAR; }
    PG8_BAR;
    if constexpr (Epi::AFTER_DRAIN) { E.fused(acc, cur, wr, wc, fr, fq, lds, wid, lane); S.done(cur); }
#undef PG8_SA
#undef PG8_SB
#undef PG8_STAGE
#undef PG8_LDA
#undef PG8_LDB
#undef PG8_MMA
#undef PG8_WAIT_V
#undef PG8_WAIT_L
#undef PG8_BAR
#undef PG8_SCHED
}
}
namespace pg8 {
struct DualOrder {
    StaticOrder s1, s2; int G, c;
    __host__ __device__ void init(int M1, int N1, int M2, int N2, int G_, int c_) { s1.init(M1, N1, 1, 0); s2.init(M2, N2, 1, 0); G = G_; c = c_; }
    __host__ __device__ bool next(int i, Unit& u) const {
        const long L = (long)i * G + c; if (L >= s1.nwg + s2.nwg) return false;
        if (L < s1.nwg) { s1.next((int)L, u); u.kind = 0; } else { s2.next((int)(L - s1.nwg), u); u.kind = 1; }
        u.ui = i; return true;
    }
    __device__ __forceinline__ void a_ready(const Unit&) const {}
    __device__ __forceinline__ void done(const Unit&) const {}
};
__device__ __forceinline__ float row_rstd(const float* ss, int row) {
    const f32x4* p = (const f32x4*)(ss + (size_t)row * 16);
    const f32x4 a = p[0], b = p[1], c = p[2], d = p[3];
    const float s = (((a[0] + a[1]) + (a[2] + a[3])) + ((b[0] + b[1]) + (b[2] + b[3]))) + (((c[0] + c[1]) + (c[2] + c[3])) + ((d[0] + d[1]) + (d[2] + d[3])));
    return rsqrtf(s * (1.0f / 1024.0f) + 1e-6f);
}
__device__ __forceinline__ u32x4 pack8(f32x4 v0, f32x4 v1) { u32x4 w; w.x = cvt_pk_bf16(v0[0], v0[1]); w.y = cvt_pk_bf16(v0[2], v0[3]); w.z = cvt_pk_bf16(v1[0], v1[1]); w.w = cvt_pk_bf16(v1[2], v1[3]); return w; }

template <int ACT  > struct EpiBf {
    static constexpr bool PERM = true, AFTER_DRAIN = false;
    bf16_t* O; int ldc; const PG8_LAS float* rs; float mul;
    __device__ __forceinline__ void operator()(const f32x4 (&acc)[2][2][4][2], const Unit& u, int wr, int wc, int fr, int fq) const {
        const int row0 = u.pm * BM + wr * 64 + fr, col0 = u.pn * BM + wc * 32 + 8 * fq;
#pragma unroll
        for (int ai = 0; ai < 2; ++ai)
#pragma unroll
            for (int m = 0; m < 4; ++m) { const int row = row0 + ai * HALF + m * 16; const float sc = rs ? mul * rs[256 * u.ui + ai * HALF + wr * 64 + m * 16 + fr] : mul; bf16_t* rowp = O + (size_t)row * ldc + col0;
#pragma unroll
                for (int bj = 0; bj < 2; ++bj) { f32x4 v0 = acc[ai][bj][m][0] * sc, v1 = acc[ai][bj][m][1] * sc;
                    if (ACT == 1) {
#pragma unroll
                        for (int j = 0; j < 4; ++j) { const float a = fmaxf(v0[j], 0.f), b = fmaxf(v1[j], 0.f); v0[j] = a * a; v1[j] = b * b; } }
                    *(u32x4*)(rowp + bj * HALF) = pack8(v0, v1); } }
    }
};
struct EpiF32 {
    static constexpr bool PERM = true, AFTER_DRAIN = false;
    float* C; int ldc;
    __device__ __forceinline__ void operator()(const f32x4 (&acc)[2][2][4][2], const Unit& u, int wr, int wc, int fr, int fq) const {
        const int row0 = u.pm * BM + wr * 64 + fr, col0 = u.pn * BM + wc * 32 + 8 * fq;
#pragma unroll
        for (int ai = 0; ai < 2; ++ai)
#pragma unroll
            for (int m = 0; m < 4; ++m) { float* rowp = C + (size_t)(row0 + ai * HALF + m * 16) * ldc + col0;
#pragma unroll
                for (int bj = 0; bj < 2; ++bj) { *(f32x4*)(rowp + bj * HALF) = acc[ai][bj][m][0]; *(f32x4*)(rowp + bj * HALF + 4) = acc[ai][bj][m][1]; } }
    }
};
template <bool F32RES> struct EpiRes {
    static constexpr bool PERM = true, AFTER_DRAIN = false;
    bf16_t* xh; float* ssout; const float* r32;
    __device__ __forceinline__ void operator()(const f32x4 (&acc)[2][2][4][2], const Unit& u, int wr, int wc, int fr, int fq) const {
        const int row0 = u.pm * BM + wr * 64 + fr, col0 = u.pn * BM + wc * 32 + 8 * fq;
#pragma unroll
        for (int ai = 0; ai < 2; ++ai) {
            u32x4 pre[4][2]; f32x4 pf[4][2][2];
#pragma unroll
            for (int m = 0; m < 4; ++m)
#pragma unroll
                for (int bj = 0; bj < 2; ++bj) { const size_t off = (size_t)(row0 + ai * HALF + m * 16) * 1024 + col0 + bj * HALF;
                    if (F32RES) { pf[m][bj][0] = *(const f32x4*)(r32 + off); pf[m][bj][1] = *(const f32x4*)(r32 + off + 4); } else pre[m][bj] = *(const u32x4*)(xh + off); }
            asm volatile("" ::: "memory"); __builtin_amdgcn_sched_barrier(0);
#pragma unroll
            for (int m = 0; m < 4; ++m) { const int row = row0 + ai * HALF + m * 16; float q = 0.f;
#pragma unroll
                for (int bj = 0; bj < 2; ++bj) { const size_t off = (size_t)row * 1024 + col0 + bj * HALF; f32x4 r0, r1;
                    if (F32RES) { r0 = pf[m][bj][0]; r1 = pf[m][bj][1]; }
                    else { const u32x4 p = pre[m][bj];
                        r0 = (f32x4){__uint_as_float(p.x << 16), __uint_as_float(p.x & 0xffff0000u), __uint_as_float(p.y << 16), __uint_as_float(p.y & 0xffff0000u)};
                        r1 = (f32x4){__uint_as_float(p.z << 16), __uint_as_float(p.z & 0xffff0000u), __uint_as_float(p.w << 16), __uint_as_float(p.w & 0xffff0000u)}; }
                    const f32x4 v0 = acc[ai][bj][m][0] + r0, v1 = acc[ai][bj][m][1] + r1;
                    q += ((v0[0] * v0[0] + v0[1] * v0[1]) + (v0[2] * v0[2] + v0[3] * v0[3])) + ((v1[0] * v1[0] + v1[1] * v1[1]) + (v1[2] * v1[2] + v1[3] * v1[3]));
                    *(u32x4*)(xh + off) = pack8(v0, v1); }
                q += __shfl_xor(q, 16); q += __shfl_xor(q, 32);
                if (fq == 0) ssout[(size_t)row * 16 + u.pn * 4 + wc] = q; }
            asm volatile("" ::: "memory"); __builtin_amdgcn_sched_barrier(0); }
    }
};
struct EpiInA {
    static constexpr bool PERM = true, AFTER_DRAIN = false;
    bf16_t* z; float* ba; const PG8_LAS float* rs;
    __device__ __forceinline__ void operator()(const f32x4 (&acc)[2][2][4][2], const Unit& u, int wr, int wc, int fr, int fq) const {
        const int row0 = u.pm * BM + wr * 64 + fr, col0 = u.pn * BM + wc * 32 + 8 * fq;
#pragma unroll
        for (int ai = 0; ai < 2; ++ai)
#pragma unroll
            for (int m = 0; m < 4; ++m) { const int row = row0 + ai * HALF + m * 16; const float sc = rs[256 * u.ui + ai * HALF + wr * 64 + m * 16 + fr];
                if (u.pn < 10) { bf16_t* rowp = z + (size_t)row * 2560 + col0;
#pragma unroll
                    for (int bj = 0; bj < 2; ++bj) *(u32x4*)(rowp + bj * HALF) = pack8(acc[ai][bj][m][0] * sc, acc[ai][bj][m][1] * sc);
                } else if (wc == 0 && fq == 0) { *(f32x4*)(ba + (size_t)row * 8) = acc[ai][0][m][0] * sc; *(f32x4*)(ba + (size_t)row * 8 + 4) = acc[ai][0][m][1] * sc; } }
    }
};
struct EpiInC {
    static constexpr bool PERM = true, AFTER_DRAIN = false;
    bf16_t* q; bf16_t* kv; float* gates; const PG8_LAS float* rs;
    __device__ __forceinline__ void operator()(const f32x4 (&acc)[2][2][4][2], const Unit& u, int wr, int wc, int fr, int fq) const {
        const int row0 = u.pm * BM + wr * 64 + fr, col0 = u.pn * BM + wc * 32 + 8 * fq;
#pragma unroll
        for (int ai = 0; ai < 2; ++ai)
#pragma unroll
            for (int m = 0; m < 4; ++m) { const int row = row0 + ai * HALF + m * 16; const float sc = rs[256 * u.ui + ai * HALF + wr * 64 + m * 16 + fr];
                if (u.pn < 4) { bf16_t* rowp = q + (size_t)row * 1024 + col0; const float sq = sc * 0.18033688011112042f;
#pragma unroll
                    for (int bj = 0; bj < 2; ++bj) *(u32x4*)(rowp + bj * HALF) = pack8(acc[ai][bj][m][0] * sq, acc[ai][bj][m][1] * sq);
                } else if (u.pn < 10) { const int b = row >> 12, s = row & 4095;
#pragma unroll
                    for (int bj = 0; bj < 2; ++bj) { const int cp = col0 + bj * HALF - 1024, kind = cp >> 8, g = (cp >> 6) & 3, d = cp & 63;
                        *(u32x4*)(kv + (size_t)kind * ((size_t)32768 * 256) + ((size_t)((b * 4 + g) * 4096 + s)) * 64 + d) = pack8(acc[ai][bj][m][0] * sc, acc[ai][bj][m][1] * sc); }
                } else { const int cl = wc * 32 + 8 * fq; if (cl < 48) { *(f32x4*)(gates + (size_t)row * 48 + cl) = acc[ai][0][m][0] * sc; *(f32x4*)(gates + (size_t)row * 48 + cl + 4) = acc[ai][0][m][1] * sc; } } }
    }
};
template <class E0, class E1> struct EpiDual {
    static constexpr bool PERM = true, AFTER_DRAIN = false;
    E0 e0; E1 e1;
    __device__ __forceinline__ void operator()(const f32x4 (&acc)[2][2][4][2], const Unit& u, int wr, int wc, int fr, int fq) const { if (u.kind) e1(acc, u, wr, wc, fr, fq); else e0(acc, u, wr, wc, fr, fq); }
};
}
#define LAS __attribute__((address_space(3)))
typedef unsigned short bf16;
typedef float f32x4 __attribute__((ext_vector_type(4)));
typedef unsigned v4u __attribute__((ext_vector_type(4)));
typedef unsigned v2u __attribute__((ext_vector_type(2)));
typedef short bf16x8 __attribute__((ext_vector_type(8)));
typedef float f32x16 __attribute__((ext_vector_type(16)));
typedef short v4i16 __attribute__((ext_vector_type(4)));
typedef float f32x2_t __attribute__((ext_vector_type(2))); typedef __bf16 bf16x2_t __attribute__((ext_vector_type(2)));
__device__ __forceinline__ unsigned cvtpk(float lo, float hi) { f32x2_t v = {lo, hi}; bf16x2_t b = __builtin_convertvector(v, bf16x2_t); return __builtin_bit_cast(unsigned, b); }

constexpr int NWAVES = 8, NTHR = 512;
constexpr int T = 32768, SEQ = 4096, DM = 1024, FF = 4096;
constexpr int LDS_BYTES = 147456;
constexpr float EPS = 1e-6f;

enum { I_X = 0, I_MEM, I_A_LN, I_A_WIN, I_A_POOLW, I_A_POOLS, I_A_CONV, I_A_ALOG, I_A_DTB, I_A_ONORM, I_A_WOUT,
       I_C_LN, I_C_WIN, I_C_PEK, I_C_W1K, I_C_W2K, I_C_PEV, I_C_W1V, I_C_W2V, I_C_WOUT,
       I_XA_LN, I_XA_MLN, I_XA_WQ, I_XA_WK, I_XA_WV, I_XA_WO, I_FF_LN, I_FF_W1, I_FF_W2, I_FLN, N_IN };

constexpr size_t MiB = (size_t)1 << 20;
constexpr size_t WS_AIN = 0, WS_AOUT = 6 * MiB, WS_CIN = 8 * MiB, WS_COUT = 14 * MiB, WS_XQ = 16 * MiB, WS_XKV = 20 * MiB, WS_XO = 28 * MiB;
constexpr size_t WS_F1 = 32 * MiB, WS_F2 = 48 * MiB, WS_CMPK = 64 * MiB, WS_CMPV = 64 * MiB + 512 * 1024, WS_CBIAS = 65 * MiB;
constexpr size_t WS_MEMH = 66 * MiB, WS_MEMKV = 74 * MiB, WS_SS = 90 * MiB, WS_BA = 92 * MiB, WS_GATES = 93 * MiB, WS_CK = 99 * MiB, WS_CV = 100 * MiB;
constexpr size_t WS_P01K = 101 * MiB, WS_P01V = 109 * MiB, WS_POOLW = 117 * MiB;
constexpr size_t WS_Z = 120 * MiB, WS_Y = 280 * MiB, WS_QXA = 344 * MiB, WS_XH = 408 * MiB, WS_HMID = 120 * MiB, WS_END = 489 * MiB;
constexpr size_t KV_KIND = (size_t)T * 256;

struct Params { const float* in[N_IN]; float* out; unsigned char* ws; int ph_lo, ph_hi; };

__device__ __forceinline__ float bf2f(unsigned v) { return __uint_as_float(v << 16); }
__device__ __forceinline__ unsigned f2bf(float f) { unsigned u = __float_as_uint(f); return (u + 0x7fffu + ((u >> 16) & 1u)) >> 16; }
__device__ __forceinline__ unsigned pk2(float lo, float hi) { return f2bf(lo) | (f2bf(hi) << 16); }
__device__ __forceinline__ float wave_sum(float v) {
#pragma unroll
    for (int o = 1; o < 64; o <<= 1) v += __shfl_xor(v, o);
    return v;
}
__device__ __forceinline__ float wave_max(float v) {
#pragma unroll
    for (int o = 1; o < 64; o <<= 1) v = fmaxf(v, __shfl_xor(v, o));
    return v;
}
__device__ __forceinline__ float silu_f(float x) { return x / (1.f + __expf(-x)); }
__device__ __forceinline__ float sigmoid_f(float x) { return 1.f / (1.f + __expf(-x)); }
#define LDS_WAIT() asm volatile("s_waitcnt lgkmcnt(0)" ::: "memory")

__device__ __forceinline__ void transpose_item(const float* W, int K, int N, int ld, const float* gain, bf16* WT, int row_off, LAS float* scr, int item, int lane) {
    const int nblk = N / 32, kb = item / nblk, nb = item % nblk, k0 = 64 * kb, n0 = 32 * nb;
#pragma unroll
    for (int i = 0; i < 8; ++i) { const int kk = 8 * i + (lane >> 3), nn = (lane & 7) * 4; f32x4 v = *(const f32x4*)(W + (size_t)(k0 + kk) * ld + n0 + nn); if (gain) v = v * gain[k0 + kk];
        scr[kk * 33 + nn] = v.x; scr[kk * 33 + nn + 1] = v.y; scr[kk * 33 + nn + 2] = v.z; scr[kk * 33 + nn + 3] = v.w; }
    LDS_WAIT();
    const int c = lane & 7;
#pragma unroll
    for (int j = 0; j < 4; ++j) { const int n = (lane >> 3) + 8 * j; const LAS float* s = scr + (8 * c) * 33 + n;
        v4u o; o.x = pk2(s[0 * 33], s[1 * 33]); o.y = pk2(s[2 * 33], s[3 * 33]); o.z = pk2(s[4 * 33], s[5 * 33]); o.w = pk2(s[6 * 33], s[7 * 33]);
        *(v4u*)(WT + (size_t)(row_off + n0 + n) * K + k0 + 8 * c) = o; }
    LDS_WAIT();
}
#define TJOB(W_, K_, N_, LD_, G_, WT_, RO_) { const int ni_ = ((K_) / 64) * ((N_) / 32); if (r < ni_) { transpose_item((W_), (K_), (N_), (LD_), (G_), (WT_), (RO_), scr, r, lane); continue; } r -= ni_; }

__device__ __forceinline__ void phase_prologue(const Params& P, LAS unsigned char* lds) {
    int tid_l = threadIdx.x; asm volatile("" : "+v"(tid_l)); const int tid = tid_l, lane = tid & 63, wave = tid >> 6;
    const int gw = blockIdx.x * NWAVES + wave, NGW = gridDim.x * NWAVES;
    unsigned char* ws = P.ws;
    LAS float* scr = (LAS float*)(lds + wave * 16384);
    constexpr int NITEMS = 1280 + 512 + 1280 + 512 + 4 * 512 + 512 + 2048 + 2048 + 4 * 64;
    for (int it = gw; it < NITEMS; it += NGW) {
        int r = it;
        TJOB(P.in[I_A_WIN], 1024, 2560, 2568, P.in[I_A_LN], (bf16*)(ws + WS_AIN), 0)
        TJOB(P.in[I_A_WOUT], 1024, 1024, 1024, nullptr, (bf16*)(ws + WS_AOUT), 0)
        TJOB(P.in[I_C_WIN], 1024, 2560, 2608, P.in[I_C_LN], (bf16*)(ws + WS_CIN), 0)
        TJOB(P.in[I_XA_WQ], 1024, 1024, 1024, P.in[I_XA_LN], (bf16*)(ws + WS_XQ), 0)
        TJOB(P.in[I_XA_WK], 1024, 1024, 1024, P.in[I_XA_MLN], (bf16*)(ws + WS_XKV), 0)
        TJOB(P.in[I_XA_WV], 1024, 1024, 1024, P.in[I_XA_MLN], (bf16*)(ws + WS_XKV), 1024)
        TJOB(P.in[I_XA_WK] + 1048576, 1024, 1024, 1024, P.in[I_XA_MLN] + 1024, (bf16*)(ws + WS_XKV) + 2097152, 0)
        TJOB(P.in[I_XA_WV] + 1048576, 1024, 1024, 1024, P.in[I_XA_MLN] + 1024, (bf16*)(ws + WS_XKV) + 2097152, 1024)
        TJOB(P.in[I_XA_WO], 1024, 1024, 1024, nullptr, (bf16*)(ws + WS_XO), 0)
        TJOB(P.in[I_FF_W1], 1024, 4096, 4096, P.in[I_FF_LN], (bf16*)(ws + WS_F1), 0)
        TJOB(P.in[I_FF_W2], 4096, 1024, 1024, nullptr, (bf16*)(ws + WS_F2), 0)
        TJOB(P.in[I_C_W1K], 1024, 128, 128, nullptr, (bf16*)(ws + WS_CMPK), 0)
        TJOB(P.in[I_C_W1K] + 131072, 1024, 128, 128, nullptr, (bf16*)(ws + WS_CMPK), 128)
        TJOB(P.in[I_C_W1V], 1024, 128, 128, nullptr, (bf16*)(ws + WS_CMPV), 0)
        TJOB(P.in[I_C_W1V] + 131072, 1024, 128, 128, nullptr, (bf16*)(ws + WS_CMPV), 128)
    }
    const int gt = blockIdx.x * NTHR + tid, NGT = gridDim.x * NTHR;
    for (int i = gt; i < 56 * 1024; i += NGT) { const int j = i >> 10, kk = i & 1023;
        if (j < 8) ((bf16*)(ws + WS_AIN))[(size_t)(2560 + j) * 1024 + kk] = (bf16)f2bf(P.in[I_A_LN][kk] * P.in[I_A_WIN][(size_t)kk * 2568 + 2560 + j]);
        else ((bf16*)(ws + WS_CIN))[(size_t)(2560 + j - 8) * 1024 + kk] = (bf16)f2bf(P.in[I_C_LN][kk] * P.in[I_C_WIN][(size_t)kk * 2608 + 2560 + j - 8]); }
    for (int i = gt; i < (248 + 208) * 128; i += NGT) { const int row = i >> 7, pc = i & 127; const v4u z4 = {0u, 0u, 0u, 0u};
        if (row < 248) *(v4u*)((bf16*)(ws + WS_AIN) + (size_t)(2568 + row) * 1024 + pc * 8) = z4; else *(v4u*)((bf16*)(ws + WS_CIN) + (size_t)(2608 + row - 248) * 1024 + pc * 8) = z4; }
    for (int i = gt; i < 4 * 128 * 128; i += NGT) { const int g = i >> 14, d = (i >> 7) & 127, c = i & 127; ((bf16*)(ws + WS_POOLW))[i] = (bf16)f2bf(P.in[I_A_POOLW][(size_t)g * 16384 + c * 128 + d] * P.in[I_A_POOLS][g * 128 + d]); }
    if (gw < 256) { const int n = gw & 127; const float* pe = gw < 128 ? P.in[I_C_PEK] : P.in[I_C_PEV]; const float* w1 = gw < 128 ? P.in[I_C_W1K] : P.in[I_C_W1V];
        float s = 0.f;
#pragma unroll 8
        for (int j = 0; j < 32; ++j) { const int i = lane + 64 * j; s += pe[i] * w1[(size_t)i * 128 + n]; }
        s = wave_sum(s); if (lane == 0) ((float*)(ws + WS_CBIAS))[gw] = s; }
    { bf16* xh = (bf16*)(ws + WS_XH); float* ss = (float*)(ws + WS_SS);
      for (int m0 = gw; m0 < T; m0 += 4 * NGW) { f32x4 v[4][4];
#pragma unroll
          for (int u = 0; u < 4; ++u) { const int m = m0 + u * NGW; if (m < T) { const f32x4* xr = (const f32x4*)(P.in[I_X] + (size_t)m * DM) + lane;
#pragma unroll
                  for (int j = 0; j < 4; ++j) v[u][j] = xr[64 * j]; } }
#pragma unroll
          for (int u = 0; u < 4; ++u) { const int m = m0 + u * NGW; if (m >= T) break; float s = 0.f;
#pragma unroll
              for (int j = 0; j < 4; ++j) s += (v[u][j].x * v[u][j].x + v[u][j].y * v[u][j].y) + (v[u][j].z * v[u][j].z + v[u][j].w * v[u][j].w);
              s = wave_sum(s);
              v2u* o8 = (v2u*)(xh + (size_t)m * DM) + lane;
#pragma unroll
              for (int j = 0; j < 4; ++j) { v2u w; w.x = pk2(v[u][j].x, v[u][j].y); w.y = pk2(v[u][j].z, v[u][j].w); o8[64 * j] = w; }
              if (lane < 16) ss[(size_t)m * 16 + lane] = lane == 0 ? s : 0.f; } } }
    { bf16* mh = (bf16*)(ws + WS_MEMH);
      for (int m = gw; m < 2048; m += NGW) { const f32x4* xr = (const f32x4*)(P.in[I_MEM] + (size_t)m * DM) + lane; f32x4 v[4]; float s = 0.f;
#pragma unroll
          for (int j = 0; j < 4; ++j) { v[j] = xr[64 * j]; s += (v[j].x * v[j].x + v[j].y * v[j].y) + (v[j].z * v[j].z + v[j].w * v[j].w); }
          const float rs = rsqrtf(wave_sum(s) * (1.f / DM) + EPS);
          v2u* o8 = (v2u*)(mh + (size_t)m * DM) + lane;
#pragma unroll
          for (int j = 0; j < 4; ++j) { v2u w; w.x = pk2(v[j].x * rs, v[j].y * rs); w.y = pk2(v[j].z * rs, v[j].w * rs); o8[64 * j] = w; } } }
}

__device__ __forceinline__ void phase_conv_late(const Params& P, LAS unsigned char* lds, int gw, int NGW) {
    const int tid = threadIdx.x, lane = tid & 63, wave = tid >> 6; unsigned char* ws = P.ws;
    LAS float* scr = (LAS float*)(lds + wave * 16384);
    constexpr int NITEMS = 512 + 512 + 512 + 2048 + 2048;
    for (int it = gw; it < NITEMS; it += NGW) {
        int r = it;
        TJOB(P.in[I_C_WOUT], 1024, 1024, 1024, nullptr, (bf16*)(ws + WS_COUT), 0)
        TJOB(P.in[I_XA_WQ] + 1048576, 1024, 1024, 1024, P.in[I_XA_LN] + 1024, (bf16*)(ws + WS_XQ) + 1048576, 0)
        TJOB(P.in[I_XA_WO] + 1048576, 1024, 1024, 1024, nullptr, (bf16*)(ws + WS_XO) + 1048576, 0)
        TJOB(P.in[I_FF_W1] + 4194304, 1024, 4096, 4096, P.in[I_FF_LN] + 1024, (bf16*)(ws + WS_F1) + 4194304, 0)
        TJOB(P.in[I_FF_W2] + 4194304, 4096, 1024, 1024, nullptr, (bf16*)(ws + WS_F2) + 4194304, 0)
    }
}
__device__ __forceinline__ void phase_final(const Params& P) {
    const int tid = threadIdx.x, lane = tid & 63, wave = tid >> 6;
    const int gw = blockIdx.x * NWAVES + wave, NGW = gridDim.x * NWAVES;
    const float* ss = (const float*)(P.ws + WS_SS); const bf16* xh = (const bf16*)(P.ws + WS_XH);
    for (int m = gw; m < T; m += NGW) { f32x4* orow = (f32x4*)(P.out + (size_t)m * DM); const f32x4* gr = (const f32x4*)P.in[I_FLN];
        const float rs = pg8::row_rstd(ss, m);
#pragma unroll
        for (int j = 0; j < 2; ++j) { const v4u p = *(const v4u*)(xh + (size_t)m * DM + (j * 64 + lane) * 8); const f32x4 g0 = gr[(j * 64 + lane) * 2], g1 = gr[(j * 64 + lane) * 2 + 1];
            orow[(j * 64 + lane) * 2] = (f32x4){bf2f(p.x & 0xffff) * rs * g0.x, bf2f(p.x >> 16) * rs * g0.y, bf2f(p.y & 0xffff) * rs * g0.z, bf2f(p.y >> 16) * rs * g0.w};
            orow[(j * 64 + lane) * 2 + 1] = (f32x4){bf2f(p.z & 0xffff) * rs * g1.x, bf2f(p.z >> 16) * rs * g1.y, bf2f(p.w & 0xffff) * rs * g1.z, bf2f(p.w >> 16) * rs * g1.w}; } }
}
__device__ __forceinline__ void phase_pool(const Params& P, LAS unsigned char* lds) {
    int tid_l = threadIdx.x; asm volatile("" : "+v"(tid_l)); const int tid = tid_l, lane = tid & 63, wave = tid >> 6; const int g = blockIdx.x & 3, win = 2 << g;
    const bf16* z = (const bf16*)(P.ws + WS_Z); bf16* y = (bf16*)(P.ws + WS_Y);
    LAS unsigned short* ur = (LAS unsigned short*)lds;
    LAS unsigned char* yp = lds + 20480;
    const int nt = wave & 3, mt = wave >> 2, q = lane & 31, h = lane >> 5;
    bf16x8 bfr[8];
    { const bf16* bt = (const bf16*)(P.ws + WS_POOLW) + (size_t)g * 16384 + (size_t)(nt * 32 + q) * 128 + 8 * h;
#pragma unroll
      for (int ks = 0; ks < 8; ++ks) bfr[ks] = *(const bf16x8*)(bt + 16 * ks); }
    v4u pre[3];
#define POOL_LOAD(it_) { const int t0_ = ((it_) >> 2) * 64, s0_ = t0_ & (SEQ - 1); _Pragma("unroll") for (int j = 0; j < 3; ++j) { const int p = tid + 512 * j, row = p >> 4, pc = p & 15; pre[j] = (v4u){0u, 0u, 0u, 0u}; \
        if (p < 79 * 16 && s0_ + row - 15 >= 0) pre[j] = *(const v4u*)(z + (size_t)(t0_ + row - 15) * 2560 + g * 128 + pc * 8); } }
    int it = blockIdx.x; if (it < 2048) POOL_LOAD(it)
    for (; it < 2048; it += gridDim.x) { const int t0 = (it >> 2) * 64, s0 = t0 & (SEQ - 1);
#pragma unroll
        for (int j = 0; j < 3; ++j) { const int p = tid + 512 * j; if (p < 79 * 16) *(LAS v4u*)(lds + (p >> 4) * 256 + (p & 15) * 16) = pre[j]; }
        __syncthreads();
        if (it + (int)gridDim.x < 2048) POOL_LOAD(it + (int)gridDim.x)
        { const int c = tid & 127, tq = tid >> 7; float sum = 0.f;
          for (int j = 1; j < win; ++j) sum += bf2f(ur[(tq * 16 + 15 - j) * 128 + c]);
#pragma unroll 4
          for (int i = 0; i < 16; ++i) { const int tl = tq * 16 + i, s = s0 + tl; const float u = bf2f(ur[(tl + 15) * 128 + c]); sum += u;
              const float cnt = (float)((s + 1 < win) ? s + 1 : win);
              *(LAS unsigned short*)(yp + tl * 272 + c * 2) = (unsigned short)f2bf(sum / cnt - u);
              sum -= bf2f(ur[(tl + 16 - win) * 128 + c]); } }
        __syncthreads();
        { f32x16 acc;
#pragma unroll
          for (int r = 0; r < 16; ++r) acc[r] = 0.f;
          LAS const unsigned char* ap = yp + (mt * 32 + q) * 272 + h * 16;
#pragma unroll
          for (int ks = 0; ks < 8; ++ks) acc = __builtin_amdgcn_mfma_f32_32x32x16_bf16(bfr[ks], *(const LAS bf16x8*)(ap + ks * 32), acc, 0, 0, 0);
          bf16* yo = y + (size_t)(t0 + mt * 32 + q) * DM + g * 128 + nt * 32 + 4 * h;
#pragma unroll
          for (int a = 0; a < 4; ++a) { v2u w; w.x = cvtpk(acc[4 * a], acc[4 * a + 1]); w.y = cvtpk(acc[4 * a + 2], acc[4 * a + 3]); *(v2u*)(yo + 8 * a) = w; } }
    }
#undef POOL_LOAD
    __syncthreads();
}
__device__ __forceinline__ void dn_naive_item(const Params& P, LAS unsigned char* lds, int item) {
    int tid_l = threadIdx.x; asm volatile("" : "+v"(tid_l)); const int tid = tid_l, lane = tid & 63, wave = tid >> 6; const int b = item >> 2, h = item & 3;
    const bf16* z = (const bf16*)(P.ws + WS_Z); bf16* y = (bf16*)(P.ws + WS_Y); const float* ba = (const float*)(P.ws + WS_BA);
    LAS float* qs = (LAS float*)lds; LAS float* ks = qs + 8192; LAS float* vs = ks + 8192; LAS float* ot = vs + 8192; LAS float* bet = ot + 8192; LAS float* egs = bet + 64;
    const float* cw = P.in[I_A_CONV];
    const float a_exp = __expf(P.in[I_A_ALOG][h]), dtb = P.in[I_A_DTB][h];
    float Sreg[32];
#pragma unroll
    for (int i = 0; i < 32; ++i) Sreg[i] = 0.f;
    const int kq = tid & 3, dv = tid >> 2;
    for (int n = 0; n < 64; ++n) {
        const int sb = n * 64; const size_t rb = (size_t)b * SEQ;
        for (int idx = tid; idx < 64 * 384; idx += NTHR) { const int tl = idx / 384, cc = idx % 384, part = cc >> 7, d = cc & 127; const int ch = part * 512 + h * 128 + d, s = sb + tl; float a = 0.f;
#pragma unroll
            for (int kk = 0; kk < 4; ++kk) { const int sp = s - 3 + kk; if (sp >= 0) a += cw[kk * 1536 + ch] * bf2f(z[(rb + sp) * 2560 + 512 + ch]); }
            qs[part * 8192 + tl * 128 + d] = silu_f(a); }
        if (tid < 64) { const size_t t = rb + sb + tid; const float bl = ba[t * 8 + h], al = ba[t * 8 + 4 + h] + dtb; const float sp = al > 20.f ? al : log1pf(__expf(al));
            bet[tid] = sigmoid_f(bl); egs[tid] = __expf(-a_exp * sp); }
        __syncthreads();
        for (int r = wave * 16; r < wave * 16 + 16; ++r) { LAS float* row = qs + (r >> 6) * 8192 + (r & 63) * 128; const float a = row[lane], c2 = row[lane + 64];
            const float sc = rsqrtf(wave_sum(a * a + c2 * c2) + EPS); row[lane] = a * sc; row[lane + 64] = c2 * sc; }
        __syncthreads();
        for (int tl = 0; tl < 64; ++tl) {
            float kr[32], kS = 0.f;
#pragma unroll
            for (int i = 0; i < 8; ++i) { const f32x4 v = *(const LAS f32x4*)(ks + tl * 128 + kq * 32 + 4 * i); kr[4 * i] = v.x; kr[4 * i + 1] = v.y; kr[4 * i + 2] = v.z; kr[4 * i + 3] = v.w; }
#pragma unroll
            for (int i = 0; i < 32; ++i) kS += kr[i] * Sreg[i];
            kS += __shfl_xor(kS, 1); kS += __shfl_xor(kS, 2);
            const float e = egs[tl], cf = bet[tl] * (vs[tl * 128 + dv] - e * kS);
            float o = 0.f;
#pragma unroll
            for (int i = 0; i < 8; ++i) { const f32x4 qv = *(const LAS f32x4*)(qs + tl * 128 + kq * 32 + 4 * i);
                Sreg[4 * i] = e * Sreg[4 * i] + kr[4 * i] * cf; Sreg[4 * i + 1] = e * Sreg[4 * i + 1] + kr[4 * i + 1] * cf; Sreg[4 * i + 2] = e * Sreg[4 * i + 2] + kr[4 * i + 2] * cf; Sreg[4 * i + 3] = e * Sreg[4 * i + 3] + kr[4 * i + 3] * cf;
                o += (qv.x * Sreg[4 * i] + qv.y * Sreg[4 * i + 1]) + (qv.z * Sreg[4 * i + 2] + qv.w * Sreg[4 * i + 3]); }
            o += __shfl_xor(o, 1); o += __shfl_xor(o, 2);
            if (kq == 0) ot[tl * 128 + dv] = o * 0.08838834764831845f;
        }
        __syncthreads();
        for (int tl = wave * 8; tl < wave * 8 + 8; ++tl) { const float a = ot[tl * 128 + lane], c2 = ot[tl * 128 + lane + 64]; const float rs = rsqrtf(wave_sum(a * a + c2 * c2) * (1.f / 128.f) + EPS);
            const size_t t = rb + sb + tl; const float g0 = bf2f(z[t * 2560 + 2048 + h * 128 + lane]), g1 = bf2f(z[t * 2560 + 2048 + h * 128 + lane + 64]);
            y[t * DM + 512 + h * 128 + lane] = (bf16)f2bf(a * rs * P.in[I_A_ONORM][lane] * silu_f(g0));
            y[t * DM + 512 + h * 128 + lane + 64] = (bf16)f2bf(c2 * rs * P.in[I_A_ONORM][lane + 64] * silu_f(g1)); }
        __syncthreads();
    }
}

__device__ __forceinline__ void phase_xatt_naive(const Params& P, LAS unsigned char* lds, int l) {
    int tid_l = threadIdx.x; asm volatile("" : "+v"(tid_l)); const int tid = tid_l, lane = tid & 63, wave = tid >> 6;
    const int gw = blockIdx.x * NWAVES + wave, NGW = gridDim.x * NWAVES;
    const bf16* qx = (const bf16*)(P.ws + WS_QXA); const bf16* kv = (const bf16*)(P.ws + WS_MEMKV) + (size_t)l * 2048 * 2048; bf16* y = (bf16*)(P.ws + WS_Y);
    LAS float* qf = (LAS float*)(lds + wave * 8192); LAS float* pw = qf + 1024;
    for (int t = gw; t < T; t += NGW) { const int b = t >> 12;
        { const v4u a = *(const v4u*)(qx + (size_t)t * DM + lane * 16), c = *(const v4u*)(qx + (size_t)t * DM + lane * 16 + 8); LAS float* d = qf + lane * 16;
          d[0] = bf2f(a.x & 0xffff); d[1] = bf2f(a.x >> 16); d[2] = bf2f(a.y & 0xffff); d[3] = bf2f(a.y >> 16); d[4] = bf2f(a.z & 0xffff); d[5] = bf2f(a.z >> 16); d[6] = bf2f(a.w & 0xffff); d[7] = bf2f(a.w >> 16);
          d[8] = bf2f(c.x & 0xffff); d[9] = bf2f(c.x >> 16); d[10] = bf2f(c.y & 0xffff); d[11] = bf2f(c.y >> 16); d[12] = bf2f(c.z & 0xffff); d[13] = bf2f(c.z >> 16); d[14] = bf2f(c.w & 0xffff); d[15] = bf2f(c.w >> 16); }
        LDS_WAIT();
        for (int hh = 0; hh < 4; ++hh) { float sc[4];
#pragma unroll
            for (int i = 0; i < 4; ++i) { const bf16* kr = kv + (size_t)(b * 256 + lane + 64 * i) * 2048 + hh * 256; float s = 0.f;
                for (int c8 = 0; c8 < 32; ++c8) { const v4u kk = *(const v4u*)(kr + c8 * 8); const f32x4 q0 = *(const LAS f32x4*)(qf + hh * 256 + c8 * 8), q1 = *(const LAS f32x4*)(qf + hh * 256 + c8 * 8 + 4);
                    s += (q0.x * bf2f(kk.x & 0xffff) + q0.y * bf2f(kk.x >> 16)) + (q0.z * bf2f(kk.y & 0xffff) + q0.w * bf2f(kk.y >> 16)) + (q1.x * bf2f(kk.z & 0xffff) + q1.y * bf2f(kk.z >> 16)) + (q1.z * bf2f(kk.w & 0xffff) + q1.w * bf2f(kk.w >> 16)); }
                sc[i] = s * 0.0625f; }
            const float mx = wave_max(fmaxf(fmaxf(sc[0], sc[1]), fmaxf(sc[2], sc[3])));
            float ps = 0.f;
#pragma unroll
            for (int i = 0; i < 4; ++i) { sc[i] = __expf(sc[i] - mx); ps += sc[i]; }
            const float inv = 1.f / wave_sum(ps);
#pragma unroll
            for (int i = 0; i < 4; ++i) pw[lane + 64 * i] = sc[i] * inv;
            LDS_WAIT();
            float o0 = 0.f, o1 = 0.f, o2 = 0.f, o3 = 0.f; const bf16* vb = kv + (size_t)(b * 256) * 2048 + 1024 + hh * 256 + lane * 4;
            for (int j = 0; j < 256; ++j) { const v2u vv = *(const v2u*)(vb + (size_t)j * 2048); const float p = pw[j];
                o0 += p * bf2f(vv.x & 0xffff); o1 += p * bf2f(vv.x >> 16); o2 += p * bf2f(vv.y & 0xffff); o3 += p * bf2f(vv.y >> 16); }
            v2u w; w.x = pk2(o0, o1); w.y = pk2(o2, o3); *(v2u*)(y + (size_t)t * DM + hh * 256 + lane * 4) = w;
            LDS_WAIT();
        }
    }
}

__device__ __forceinline__ void cmpfin_bg(const Params& P, LAS unsigned char* lds, int kvs, int bg) {
    const int tid = threadIdx.x, lane = tid & 63, wave = tid >> 6;
    const float* p01 = (const float*)(P.ws + (kvs ? WS_P01V : WS_P01K)) + (size_t)bg * 256 * 256; const float* bias = (const float*)(P.ws + WS_CBIAS) + kvs * 128; const float* w2 = P.in[kvs ? I_C_W2V : I_C_W2K];
    bf16* outp = (bf16*)(P.ws + (kvs ? WS_CV : WS_CK)) + (size_t)bg * 256 * 64;
    LAS float* hb = (LAS float*)(lds + wave * 1024);
    unsigned w2p[64];
#pragma unroll
    for (int j = 0; j < 64; ++j) w2p[j] = pk2(w2[(2 * j) * 64 + lane], w2[(2 * j + 1) * 64 + lane]);
    for (int c = wave; c < 255; c += NWAVES) {
#pragma unroll
        for (int i = 0; i < 2; ++i) { const int j = lane + 64 * i; hb[j] = silu_f(p01[(size_t)c * 256 + j] + p01[(size_t)(c + 1) * 256 + 128 + j] + bias[j]); }
        LDS_WAIT();
        float o0 = 0.f, o1 = 0.f;
#pragma unroll
        for (int j = 0; j < 128; j += 4) { if ((j & 31) == 0) __builtin_amdgcn_sched_barrier(0); const f32x4 hv = *(const LAS f32x4*)(hb + j); const unsigned wa = w2p[j >> 1], wb = w2p[(j >> 1) + 1];
            o0 += hv.x * bf2f(wa & 0xffff) + hv.z * bf2f(wb & 0xffff); o1 += hv.y * __uint_as_float(wa & 0xffff0000u) + hv.w * __uint_as_float(wb & 0xffff0000u); }
        outp[(size_t)c * 64 + lane] = (bf16)f2bf(o0 + o1);
        LDS_WAIT();
    }
}
__device__ __forceinline__ void dot4(const bf16* kr, const LAS float* qf, float (&s)[4]) {
    s[0] = s[1] = s[2] = s[3] = 0.f;
#pragma unroll
    for (int c8 = 0; c8 < 8; ++c8) { const v4u kk = *(const v4u*)(kr + c8 * 8);
        const float k0 = bf2f(kk.x & 0xffff), k1 = bf2f(kk.x >> 16), k2 = bf2f(kk.y & 0xffff), k3 = bf2f(kk.y >> 16), k4 = bf2f(kk.z & 0xffff), k5 = bf2f(kk.z >> 16), k6 = bf2f(kk.w & 0xffff), k7 = bf2f(kk.w >> 16);
#pragma unroll
        for (int r = 0; r < 4; ++r) { const f32x4 q0 = *(const LAS f32x4*)(qf + r * 64 + c8 * 8), q1 = *(const LAS f32x4*)(qf + r * 64 + c8 * 8 + 4);
            s[r] += ((q0.x * k0 + q0.y * k1) + (q0.z * k2 + q0.w * k3)) + ((q1.x * k4 + q1.y * k5) + (q1.z * k6 + q1.w * k7)); } }
}
__device__ __forceinline__ void phase_nsa_naive(const Params& P, LAS unsigned char* lds) {
    int tid_l = threadIdx.x; asm volatile("" : "+v"(tid_l)); const int tid = tid_l, lane = tid & 63, wave = tid >> 6;
    const int gw = blockIdx.x * NWAVES + wave, NGW = gridDim.x * NWAVES;
    const bf16* qb = (const bf16*)(P.ws + WS_Z); const bf16* kvb = qb + (size_t)T * 1024;
    const bf16* ck = (const bf16*)(P.ws + WS_CK); const bf16* cv = (const bf16*)(P.ws + WS_CV);
    const float* gates = (const float*)(P.ws + WS_GATES); bf16* y = (bf16*)(P.ws + WS_Y);
    LAS float* qf = (LAS float*)(lds + wave * 8192); LAS float* pc = qf + 256; LAS float* ps = pc + 1024;
    for (int it = gw; it < 4 * T; it += NGW) {
        const int t = it & 4095, g = (it >> 12) & 3, b = it >> 14; const size_t tg = (size_t)b * SEQ + t; const int bg = b * 4 + g;
        float slope[4];
#pragma unroll
        for (int r = 0; r < 4; ++r) slope[r] = exp2f(-0.5f * (float)(g * 4 + r + 1));
#pragma unroll
        for (int r = 0; r < 4; ++r) qf[r * 64 + lane] = bf2f(qb[tg * 1024 + g * 256 + r * 64 + lane]);
        LDS_WAIT();
        const int ncv = t >= 31 ? ((t - 31) >> 4) + 1 : 0;
#pragma unroll 1
        for (int cc = 0; cc < 4; ++cc) { const int c = lane + 64 * cc; float s[4] = {0.f, 0.f, 0.f, 0.f};
            if (cc * 64 < ncv) dot4(ck + ((size_t)bg * 256 + c) * 64, qf, s);
#pragma unroll
            for (int r = 0; r < 4; ++r) pc[r * 256 + c] = c < ncv ? s[r] * 0.125f - slope[r] * (float)(t - (16 * c + 31)) : -INFINITY; }
        LDS_WAIT();
#pragma unroll 1
        for (int r = 0; r < 4; ++r) { float v0 = pc[r * 256 + lane], v1 = pc[r * 256 + lane + 64], v2 = pc[r * 256 + lane + 128], v3 = pc[r * 256 + lane + 192];
            const float mx = wave_max(fmaxf(fmaxf(v0, v1), fmaxf(v2, v3)));
            v0 = lane < ncv ? __expf(v0 - mx) : 0.f; v1 = lane + 64 < ncv ? __expf(v1 - mx) : 0.f; v2 = lane + 128 < ncv ? __expf(v2 - mx) : 0.f; v3 = lane + 192 < ncv ? __expf(v3 - mx) : 0.f;
            const float sm = wave_sum((v0 + v1) + (v2 + v3)); const float inv = ncv > 0 ? 1.f / sm : 0.f;
            pc[r * 256 + lane] = v0 * inv; pc[r * 256 + lane + 64] = v1 * inv; pc[r * 256 + lane + 128] = v2 * inv; pc[r * 256 + lane + 192] = v3 * inv; }
        LDS_WAIT();
        float osum[4];
        { float ocmp[4] = {0.f, 0.f, 0.f, 0.f};
          const bf16* cvp = cv + (size_t)bg * 256 * 64 + lane;
#pragma unroll 2
          for (int c = 0; c < ncv; ++c) { const float v = bf2f(cvp[c * 64]);
#pragma unroll
              for (int r = 0; r < 4; ++r) ocmp[r] += pc[r * 256 + c] * v; }
#pragma unroll
          for (int r = 0; r < 4; ++r) osum[r] = sigmoid_f(gates[tg * 48 + (g * 4 + r) * 3]) * ocmp[r]; }
        unsigned long long mask;
        { const int n = lane, cur = t >> 6; float imp = 0.f;
#pragma unroll
          for (int r = 0; r < 4; ++r) { const f32x4 v = *(const LAS f32x4*)(pc + r * 256 + 4 * n); imp += v.x + v.y + v.z + 0.5f * v.w; if (n > 0) imp += 0.5f * pc[r * 256 + 4 * n - 1]; }
          const bool forced = (n == 0) || (n == cur) || (n == cur - 1);
          const float val = forced ? 1e4f : (n <= cur ? imp : -1.f);
          int rank = 0;
#pragma unroll 4
          for (int m = 0; m < 64; ++m) { const float vm = __shfl(val, m); rank += (vm > val || (vm == val && m < n)) ? 1 : 0; }
          mask = __ballot(rank < 16 && n <= cur); }
#pragma unroll 1
        for (int br = 0; br < 2; ++br) {
            const bf16* kp = kvb + (size_t)(br == 0 ? 2 : 4) * KV_KIND + (size_t)bg * SEQ * 64; const bf16* vp = kvb + (size_t)(br == 0 ? 3 : 5) * KV_KIND + (size_t)bg * SEQ * 64;
            float m_[4] = {-INFINITY, -INFINITY, -INFINITY, -INFINITY}, l_[4] = {0.f, 0.f, 0.f, 0.f}, acc[4] = {0.f, 0.f, 0.f, 0.f};
            const int jlo = br == 0 ? 0 : (t >= 511 ? t - 511 : 0);
            unsigned long long todo = br == 0 ? mask : 0ull; int j0 = jlo & ~63;
#pragma unroll 1
            for (;;) {
                if (br == 0) { if (!todo) break; j0 = (__ffsll((long long)todo) - 1) * 64; todo &= todo - 1; } else { if (j0 > t) break; }
                const int j = j0 + lane; const bool valid = j >= jlo && j <= t;
                float s[4]; dot4(kp + (size_t)j * 64, qf, s);
#pragma unroll
                for (int r = 0; r < 4; ++r) { const float sv = valid ? s[r] * 0.125f - slope[r] * (float)(t - j) : -INFINITY; const float mn = fmaxf(m_[r], wave_max(sv));
                    const float p = valid ? __expf(sv - mn) : 0.f; const float f = __expf(m_[r] - mn); l_[r] = l_[r] * f + wave_sum(p); acc[r] *= f; m_[r] = mn; ps[r * 64 + lane] = p; }
                LDS_WAIT();
                const bf16* vr = vp + (size_t)j0 * 64 + lane;
#pragma unroll 2
                for (int jj = 0; jj < 64; jj += 4) { const float v0 = bf2f(vr[jj * 64]), v1 = bf2f(vr[(jj + 1) * 64]), v2 = bf2f(vr[(jj + 2) * 64]), v3 = bf2f(vr[(jj + 3) * 64]);
#pragma unroll
                    for (int r = 0; r < 4; ++r) { const f32x4 pv = *(const LAS f32x4*)(ps + r * 64 + jj); acc[r] += (pv.x * v0 + pv.y * v1) + (pv.z * v2 + pv.w * v3); } }
                LDS_WAIT();
                if (br == 1) j0 += 64;
            }
#pragma unroll
            for (int r = 0; r < 4; ++r) osum[r] += sigmoid_f(gates[tg * 48 + (g * 4 + r) * 3 + 1 + br]) * (acc[r] / l_[r]);
        }
#pragma unroll
        for (int r = 0; r < 4; ++r) y[tg * DM + g * 256 + r * 64 + lane] = (bf16)f2bf(osum[r]);
        LDS_WAIT();
    }
}
constexpr int NSA_KB = 0, NSA_VB = 18432, NSA_IMPA = 34816, NSA_IMPB = 51200, NSA_MASK = 67584, NSA_UNI = 68096;
constexpr float LOG2E_F = 1.4426950408889634f;

__device__ __forceinline__ float quad_sum(float x) {
    x += __int_as_float(__builtin_amdgcn_update_dpp(0, __float_as_int(x), 0xB1, 0xF, 0xF, true));
    x += __int_as_float(__builtin_amdgcn_update_dpp(0, __float_as_int(x), 0x4E, 0xF, 0xF, true));
    return x;
}
__device__ __forceinline__ void nsa_qk(f32x16& p0, f32x16& p1, LAS const unsigned char* kb, const bf16x8 (&qf)[4], int q, int h, const f32x16& init) {
    p0 = init; p1 = init;
#pragma unroll
    for (int ks = 0; ks < 4; ++ks) { const bf16x8 a0 = *(const LAS bf16x8*)(kb + q * 144 + ks * 32 + h * 16), a1 = *(const LAS bf16x8*)(kb + (q + 32) * 144 + ks * 32 + h * 16);
        p0 = __builtin_amdgcn_mfma_f32_32x32x16_bf16(a0, qf[ks], p0, 0, 0, 0); p1 = __builtin_amdgcn_mfma_f32_32x32x16_bf16(a1, qf[ks], p1, 0, 0, 0); }
}
template <bool CHECK> __device__ __forceinline__ void nsa_bias(f32x16& p0, f32x16& p1, float basef, float slopeK, float cst, float klo, float khi, int h) {
    const float C = 1.f; const float i0 = basef + 4.f * (float)h; const float t0v = fmaf(slopeK, i0, cst);
#pragma unroll
    for (int r = 0; r < 16; ++r) { const float off = (float)((r & 3) + 8 * (r >> 2));
        float v0 = fmaf(p0[r], C, fmaf(slopeK, off, t0v)), v1 = fmaf(p1[r], C, fmaf(slopeK, off + 32.f, t0v));
        if (CHECK) { const float x0 = i0 + off, x1 = i0 + off + 32.f; v0 = (x0 >= klo && x0 <= khi) ? v0 : -INFINITY; v1 = (x1 >= klo && x1 <= khi) ? v1 : -INFINITY; }
        p0[r] = v0; p1[r] = v1; }
}
__device__ __forceinline__ float nsa_rowmax(const f32x16& p0, const f32x16& p1) {
    float a = fmaxf(p0[0], p1[0]);
#pragma unroll
    for (int r = 1; r < 16; ++r) a = fmaxf(a, fmaxf(p0[r], p1[r]));
    return fmaxf(a, __shfl_xor(a, 32));
}
__device__ __forceinline__ void nsa_pv(f32x16 (&o)[2], const f32x16& p0, const f32x16& p1, LAS const unsigned char* vb, int lane, int h) {
    bf16x8 pk[4];
#pragma unroll
    for (int s = 0; s < 4; ++s) { v4u w;
        if (s < 2) { w.x = cvtpk(p0[8 * s + 0], p0[8 * s + 1]); w.y = cvtpk(p0[8 * s + 2], p0[8 * s + 3]); w.z = cvtpk(p0[8 * s + 4], p0[8 * s + 5]); w.w = cvtpk(p0[8 * s + 6], p0[8 * s + 7]); }
        else { w.x = cvtpk(p1[8 * (s - 2) + 0], p1[8 * (s - 2) + 1]); w.y = cvtpk(p1[8 * (s - 2) + 2], p1[8 * (s - 2) + 3]); w.z = cvtpk(p1[8 * (s - 2) + 4], p1[8 * (s - 2) + 5]); w.w = cvtpk(p1[8 * (s - 2) + 6], p1[8 * (s - 2) + 7]); }
        pk[s] = __builtin_bit_cast(bf16x8, w); }
    LAS const unsigned char* vp = vb + (4 * h + ((lane & 15) >> 2)) * 64 + ((lane >> 4) & 1) * 32 + (lane & 3) * 8;
#pragma unroll
    for (int dt = 0; dt < 2; ++dt)
#pragma unroll
        for (int s = 0; s < 4; ++s) { const v4i16 lo = __builtin_amdgcn_ds_read_tr16_b64_v4i16((LAS v4i16*)(vp + dt * 4096 + s * 1024)), hi = __builtin_amdgcn_ds_read_tr16_b64_v4i16((LAS v4i16*)(vp + dt * 4096 + s * 1024 + 512));
            const bf16x8 a = (bf16x8){lo[0], lo[1], lo[2], lo[3], hi[0], hi[1], hi[2], hi[3]};
            o[dt] = __builtin_amdgcn_mfma_f32_32x32x16_bf16(a, pk[s], o[dt], 0, 0, 0); }
}
__device__ __forceinline__ void nsa_online(f32x16& p0, f32x16& p1, float& m, float& l, f32x16 (&o)[2]) {
    const float mx = nsa_rowmax(p0, p1), mn = fmaxf(m, mx), mu = (mn == -INFINITY) ? 0.f : mn; const float f = __builtin_amdgcn_exp2f(m - mu);
    float sum = 0.f;
#pragma unroll
    for (int r = 0; r < 16; ++r) { p0[r] = __builtin_amdgcn_exp2f(p0[r] - mu); p1[r] = __builtin_amdgcn_exp2f(p1[r] - mu); sum += p0[r] + p1[r]; }
    l = l * f + sum; m = mn;
    if (__any(f != 1.f)) {
#pragma unroll
        for (int r = 0; r < 16; ++r) { o[0][r] *= f; o[1][r] *= f; } }
}

typedef float f2v __attribute__((ext_vector_type(2)));
__device__ __forceinline__ void nsa_fast(f32x16& p0, f32x16& p1, float c32, float t0v, float& m, float& l, f32x16 (&o)[2]) {
    float mx0 = p0[0], mx1 = p1[0];
#pragma unroll
    for (int r = 1; r < 16; r += 2) { mx0 = __builtin_fmaxf(__builtin_fmaxf(mx0, p0[r]), p0[r < 15 ? r + 1 : r]); mx1 = __builtin_fmaxf(__builtin_fmaxf(mx1, p1[r]), p1[r < 15 ? r + 1 : r]); }
    float mx = __builtin_fmaxf(mx0, mx1 + c32) + t0v; mx = __builtin_fmaxf(mx, __shfl_xor(mx, 32));
    const float mn = __builtin_fmaxf(m, mx), mu = (mn == -INFINITY) ? 0.f : mn; const float f = __builtin_amdgcn_exp2f(m - mu), d = mu - t0v, d1 = d - c32; const f2v d2 = {d, d}, d12 = {d1, d1};
    f2v s2 = {0.f, 0.f};
#pragma unroll
    for (int k = 0; k < 8; ++k) { f2v a = {p0[2 * k], p0[2 * k + 1]}, b = {p1[2 * k], p1[2 * k + 1]}; a = a - d2; b = b - d12;
        a.x = __builtin_amdgcn_exp2f(a.x); a.y = __builtin_amdgcn_exp2f(a.y); b.x = __builtin_amdgcn_exp2f(b.x); b.y = __builtin_amdgcn_exp2f(b.y);
        s2 = s2 + a; s2 = s2 + b; p0[2 * k] = a.x; p0[2 * k + 1] = a.y; p1[2 * k] = b.x; p1[2 * k + 1] = b.y; }
    l = l * f + (s2.x + s2.y); m = mn;
    if (__any(f != 1.f)) {
#pragma unroll
        for (int r = 0; r < 16; ++r) { o[0][r] *= f; o[1][r] *= f; } }
}
__device__ __forceinline__ void nsa_item(const Params& P, LAS unsigned char* lds, int bg, int tile) {
    int tid_l = threadIdx.x; asm volatile("" : "+v"(tid_l)); const int tid = tid_l, lane = tid & 63, wave = tid >> 6, q = lane & 31, h = lane >> 5;
    const int b = bg >> 2, g = bg & 3, t0 = tile * 64, cur = tile;
    const int tl = 8 * wave + (q >> 2), t = t0 + tl, r = q & 3; const size_t tg = (size_t)b * SEQ + t;
    const bf16* qb = (const bf16*)(P.ws + WS_Z); const bf16* kvb = qb + (size_t)T * 1024;
    const bf16* ckp = (const bf16*)(P.ws + WS_CK) + (size_t)bg * 256 * 64; const bf16* cvp = (const bf16*)(P.ws + WS_CV) + (size_t)bg * 256 * 64;
    const bf16* ksp = kvb + 2 * KV_KIND + (size_t)bg * SEQ * 64; const bf16* vsp = kvb + 3 * KV_KIND + (size_t)bg * SEQ * 64;
    const bf16* kwp = kvb + 4 * KV_KIND + (size_t)bg * SEQ * 64; const bf16* vwp = kvb + 5 * KV_KIND + (size_t)bg * SEQ * 64;
    const float* gp = (const float*)(P.ws + WS_GATES) + tg * 48 + (g * 4 + r) * 3;
    LAS float* impA = (LAS float*)(lds + NSA_IMPA); LAS float* impB = (LAS float*)(lds + NSA_IMPB);
    LAS unsigned long long* masks = (LAS unsigned long long*)(lds + NSA_MASK); LAS unsigned long long* uni = (LAS unsigned long long*)(lds + NSA_UNI);
    const int srow = tid >> 3, spc = tid & 7; const unsigned koff = srow * 144 + spc * 16, voff = (spc >> 2) * 4096 + srow * 64 + (spc & 3) * 16; const size_t goff = (size_t)srow * 64 + spc * 8;
    const float slope2 = exp2f(-0.5f * (float)(g * 4 + r + 1)) * LOG2E_F; const float tf = (float)t;
    bf16x8 qf[4];
#pragma unroll
    for (int ks = 0; ks < 4; ++ks) qf[ks] = *(const bf16x8*)(qb + tg * 1024 + g * 256 + r * 64 + 16 * ks + 8 * h);
    { const v4u z4 = {0u, 0u, 0u, 0u};
#pragma unroll
      for (int i = 0; i < 4; ++i) *(LAS v4u*)(lds + NSA_IMPA + (tid * 4 + i) * 16) = z4; }
    if (tid < 8) uni[tid] = 0ull;
    v4u kreg, vreg;
#define KBUF(i) (lds + NSA_KB + (i) * 9216)
#define VBUF(i) (lds + NSA_VB + (i) * 8192)
    f32x16 osum[2], o[2], p0, p1, bo0, zero16;
#pragma unroll
    for (int rr = 0; rr < 16; ++rr) zero16[rr] = 0.f;
    const int nct = (((t0 + 32) >> 4) >> 6) + 1;
    const float cmaxf = t >= 31 ? (float)((t - 31) >> 4) : -1.f; const float cstc = slope2 * (31.f - tf), slopec = 16.f * slope2;
    float m1 = -INFINITY, l1 = 0.f;
    kreg = *(const v4u*)(ckp + (size_t)(nct - 1) * 4096 + goff); *(LAS v4u*)(KBUF(0) + koff) = kreg; __syncthreads();
#pragma unroll 1
    for (int i = 0; i < nct; ++i) { const int ct = nct - 1 - i;
        if (i + 1 < nct) kreg = *(const v4u*)(ckp + (size_t)(ct - 1) * 4096 + goff);
        else { kreg = *(const v4u*)(ckp + (size_t)(nct - 1) * 4096 + goff); vreg = *(const v4u*)(cvp + (size_t)(nct - 1) * 4096 + goff); }
        nsa_qk(p0, p1, KBUF(i & 1), qf, q, h, zero16); nsa_bias<true>(p0, p1, (float)(ct * 64), slopec, cstc, 0.f, cmaxf, h);
        { const float mx = nsa_rowmax(p0, p1), mn = fmaxf(m1, mx), mu = (mn == -INFINITY) ? 0.f : mn; float sum = 0.f;
#pragma unroll
          for (int rr = 0; rr < 16; ++rr) sum += __builtin_amdgcn_exp2f(p0[rr] - mu) + __builtin_amdgcn_exp2f(p1[rr] - mu);
          l1 = l1 * __builtin_amdgcn_exp2f(m1 - mu) + sum; m1 = mn; }
        if (i + 1 < nct) *(LAS v4u*)(KBUF((i + 1) & 1) + koff) = kreg;
        __syncthreads(); }
    l1 += __shfl_xor(l1, 32);
    const float inv1 = l1 > 0.f ? 1.f / l1 : 0.f, mu1 = (m1 == -INFINITY) ? 0.f : m1;
#pragma unroll
    for (int rr = 0; rr < 16; ++rr) { o[0][rr] = 0.f; o[1][rr] = 0.f; }
    *(LAS v4u*)(KBUF(0) + koff) = kreg; *(LAS v4u*)(VBUF(0) + voff) = vreg; __syncthreads();
#pragma unroll 1
    for (int i = 0; i < nct; ++i) { const int ct = nct - 1 - i;
        if (i + 1 < nct) { kreg = *(const v4u*)(ckp + (size_t)(ct - 1) * 4096 + goff); vreg = *(const v4u*)(cvp + (size_t)(ct - 1) * 4096 + goff); }
        else { kreg = *(const v4u*)(ksp + (size_t)cur * 4096 + goff); vreg = *(const v4u*)(vsp + (size_t)cur * 4096 + goff); }
        nsa_qk(p0, p1, KBUF(i & 1), qf, q, h, zero16); nsa_bias<true>(p0, p1, (float)(ct * 64), slopec, cstc, 0.f, cmaxf, h);
#pragma unroll
        for (int rr = 0; rr < 16; ++rr) { p0[rr] = __builtin_amdgcn_exp2f(p0[rr] - mu1) * inv1; p1[rr] = __builtin_amdgcn_exp2f(p1[rr] - mu1) * inv1; }
#pragma unroll
        for (int a = 0; a < 4; ++a) {
            float A0 = quad_sum(p0[4 * a] + p0[4 * a + 1] + p0[4 * a + 2] + 0.5f * p0[4 * a + 3]), B0 = quad_sum(0.5f * p0[4 * a + 3]);
            float A1 = quad_sum(p1[4 * a] + p1[4 * a + 1] + p1[4 * a + 2] + 0.5f * p1[4 * a + 3]), B1 = quad_sum(0.5f * p1[4 * a + 3]);
            if (r == 0) { const int n0 = 16 * ct + 2 * a + h, n1 = n0 + 8; impA[tl * 64 + n0] = A0; impA[tl * 64 + n1] = A1; impB[tl * 64 + n0 + 1] = B0; if (n1 < 63) impB[tl * 64 + n1 + 1] = B1; } }
        nsa_pv(o, p0, p1, VBUF(i & 1), lane, h);
        if (i + 1 < nct) { *(LAS v4u*)(KBUF((i + 1) & 1) + koff) = kreg; *(LAS v4u*)(VBUF((i + 1) & 1) + voff) = vreg; }
        __syncthreads(); }
    { const float g0 = sigmoid_f(gp[0]);
#pragma unroll
      for (int rr = 0; rr < 16; ++rr) { osum[0][rr] = g0 * o[0][rr]; osum[1][rr] = g0 * o[1][rr]; } }
    { const int tkl = lane >> 3, part = lane & 7, tk = 8 * wave + tkl; unsigned key[8];
      { const f32x4 a0 = *(const LAS f32x4*)(impA + tk * 64 + part * 8), a1 = *(const LAS f32x4*)(impA + tk * 64 + part * 8 + 4), b0 = *(const LAS f32x4*)(impB + tk * 64 + part * 8), b1 = *(const LAS f32x4*)(impB + tk * 64 + part * 8 + 4);
        const float im[8] = {a0.x + b0.x, a0.y + b0.y, a0.z + b0.z, a0.w + b0.w, a1.x + b1.x, a1.y + b1.y, a1.z + b1.z, a1.w + b1.w};
#pragma unroll
        for (int e2 = 0; e2 < 8; ++e2) { const int n = part * 8 + e2; const bool forced = (n == 0) || (n == cur) || (n == cur - 1); key[e2] = n <= cur ? (forced ? 0x7F000000u : __float_as_uint(im[e2]) + 1u) : 0u; } }
      unsigned Tk = 0u;
#pragma unroll 1
      for (int bb = 30; bb >= 0; --bb) { const unsigned cand = Tk | (1u << bb); int c = 0;
#pragma unroll
          for (int e2 = 0; e2 < 8; ++e2) c += key[e2] >= cand ? 1 : 0;
          c += __builtin_amdgcn_update_dpp(0, c, 0xB1, 0xF, 0xF, true); c += __builtin_amdgcn_update_dpp(0, c, 0x4E, 0xF, 0xF, true); c += __builtin_amdgcn_update_dpp(0, c, 0x141, 0xF, 0xF, true);
          Tk = c >= 16 ? cand : Tk; }
      int cg = 0, le = 0;
#pragma unroll
      for (int e2 = 0; e2 < 8; ++e2) { cg += key[e2] > Tk ? 1 : 0; le += key[e2] == Tk ? 1 : 0; }
      cg += __builtin_amdgcn_update_dpp(0, cg, 0xB1, 0xF, 0xF, true); cg += __builtin_amdgcn_update_dpp(0, cg, 0x4E, 0xF, 0xF, true); cg += __builtin_amdgcn_update_dpp(0, cg, 0x141, 0xF, 0xF, true);
      int incl = le;
#pragma unroll
      for (int o2 = 1; o2 < 8; o2 <<= 1) { const int v = __shfl_up(incl, o2, 8); if (part >= o2) incl += v; }
      int before = incl - le; const int need = 16 - cg; unsigned byte = 0u;
#pragma unroll
      for (int e2 = 0; e2 < 8; ++e2) { const bool eq = key[e2] == Tk; const bool selb = (key[e2] > Tk || (eq && before < need)) && (part * 8 + e2 <= cur); before += eq ? 1 : 0; byte |= selb ? (1u << e2) : 0u; }
      ((LAS unsigned char*)masks)[tk * 8 + part] = (unsigned char)byte;
      __hip_atomic_fetch_or(uni, (unsigned long long)byte << (8 * part), __ATOMIC_RELAXED, __HIP_MEMORY_SCOPE_WORKGROUP); }
    __syncthreads();
    unsigned long long todo = uni[0]; const unsigned long long mymask = masks[tl];
#define NSA_LOAD(kp_, vp_, n_) { kreg = *(const v4u*)((kp_) + (size_t)(n_) * 4096 + goff); vreg = *(const v4u*)((vp_) + (size_t)(n_) * 4096 + goff); }
#define NSA_STORE(i_) { *(LAS v4u*)(KBUF((i_) & 1) + koff) = kreg; *(LAS v4u*)(VBUF((i_) & 1) + voff) = vreg; }
#define NSA_FAST(i_, t0v_) { nsa_qk(p0, p1, KBUF((i_) & 1), qf, q, h, bo0); nsa_fast(p0, p1, 32.f * slope2, (t0v_), m, l, o); nsa_pv(o, p0, p1, VBUF((i_) & 1), lane, h); }
#define NSA_STEP(CHECK_, i_, basef_, cst_, klo_, khi_) { nsa_qk(p0, p1, KBUF((i_) & 1), qf, q, h, zero16); nsa_bias<CHECK_>(p0, p1, (basef_), slope2, (cst_), (klo_), (khi_), h); nsa_online(p0, p1, m, l, o); nsa_pv(o, p0, p1, VBUF((i_) & 1), lane, h); }
    {
        float m = -INFINITY, l = 0.f; const float cst = -slope2 * tf;
#pragma unroll
        for (int rr = 0; rr < 16; ++rr) { o[0][rr] = 0.f; o[1][rr] = 0.f; bo0[rr] = slope2 * (float)((rr & 3) + 8 * (rr >> 2)); }
        todo &= ~(1ull << cur);
        NSA_STORE(0) __syncthreads();
        int i = 0, nn = todo ? 63 - __clzll((long long)todo) : -1; if (nn >= 0) todo &= ~(1ull << nn);
        if (nn >= 0) NSA_LOAD(ksp, vsp, nn) else NSA_LOAD(kwp, vwp, tile)
        NSA_STEP(true, 0, (float)(cur * 64), cst, 0.f, tf)
        if (nn >= 0) NSA_STORE(1)
        __syncthreads();
#pragma unroll 1
        while (nn >= 0) { const int n = nn; ++i; nn = todo ? 63 - __clzll((long long)todo) : -1; if (nn >= 0) todo &= ~(1ull << nn);
            if (nn >= 0) NSA_LOAD(ksp, vsp, nn) else NSA_LOAD(kwp, vwp, tile)
            const bool sel = (mymask >> n) & 1ull;
            NSA_FAST(i, sel ? fmaf(slope2, (float)(n * 64 + 4 * h), cst) : -INFINITY)
            if (nn >= 0) NSA_STORE(i + 1)
            __syncthreads(); }
        l += __shfl_xor(l, 32); const float gs = sigmoid_f(gp[1]) / l;
#pragma unroll
        for (int rr = 0; rr < 16; ++rr) { osum[0][rr] += gs * o[0][rr]; osum[1][rr] += gs * o[1][rr]; }
    }
    {
        float m = -INFINITY, l = 0.f; const float cst = -slope2 * tf;
#pragma unroll
        for (int rr = 0; rr < 16; ++rr) { o[0][rr] = 0.f; o[1][rr] = 0.f; }
        const int nw = tile < 8 ? tile + 1 : 9, nmid = nw < 8 ? nw : 8;
        NSA_STORE(0) __syncthreads();
        if (nw > 1) NSA_LOAD(kwp, vwp, tile - 1)
        NSA_STEP(true, 0, (float)(tile * 64), cst, 0.f, tf)
        if (nw > 1) NSA_STORE(1)
        __syncthreads();
#pragma unroll 1
        for (int i = 1; i < nmid; ++i) { const int jt = tile - i;
            if (i + 1 < nw) NSA_LOAD(kwp, vwp, jt - 1)
            NSA_FAST(i, fmaf(slope2, (float)(jt * 64 + 4 * h), cst))
            if (i + 1 < nw) NSA_STORE(i + 1)
            __syncthreads(); }
        if (nw == 9) { NSA_STEP(true, 8, (float)((tile - 8) * 64), cst, tf - 511.f, 1e9f) __syncthreads(); }
        l += __shfl_xor(l, 32); const float gs = sigmoid_f(gp[2]) / l;
#pragma unroll
        for (int rr = 0; rr < 16; ++rr) { osum[0][rr] += gs * o[0][rr]; osum[1][rr] += gs * o[1][rr]; }
    }
#undef NSA_LOAD
#undef NSA_STORE
#undef NSA_STEP
#undef NSA_FAST
    { bf16* yp = (bf16*)(P.ws + WS_Y) + tg * DM + g * 256 + r * 64 + 4 * h;
#pragma unroll
      for (int dt = 0; dt < 2; ++dt)
#pragma unroll
          for (int a = 0; a < 4; ++a) { v2u w; w.x = cvtpk(osum[dt][4 * a], osum[dt][4 * a + 1]); w.y = cvtpk(osum[dt][4 * a + 2], osum[dt][4 * a + 3]); *(v2u*)(yp + dt * 32 + a * 8) = w; } }
#undef KBUF
#undef VBUF
}
__device__ __forceinline__ void phase_nsa(const Params& P, LAS unsigned char* lds) {
    for (int it = blockIdx.x; it < 2048; it += gridDim.x) { const int rnd = it / 256, c = it % 256; const int bg = c & 31, tile = 63 - 8 * rnd - (c >> 5); nsa_item(P, lds, bg, tile); }
}

__device__ __forceinline__ void xatt_item(const Params& P, LAS unsigned char* lds, int l, int bh, int blk) {
    int tid_l = threadIdx.x; asm volatile("" : "+v"(tid_l)); const int tid = tid_l, lane = tid & 63, wave = tid >> 6, q = lane & 31, h = lane >> 5;
    const int b = bh >> 2, hh = bh & 3; const size_t t = (size_t)b * SEQ + blk * 256 + wave * 32 + q;
    const bf16* kvp = (const bf16*)(P.ws + WS_MEMKV) + (size_t)(b * 256) * 4096 + l * 2048 + hh * 256;
    const bf16* qp = (const bf16*)(P.ws + WS_QXA) + t * DM + hh * 256 + 8 * h;
#pragma unroll
    for (int half = 0; half < 2; ++half) { v4u kr[8];
#pragma unroll
        for (int i = 0; i < 8; ++i) { const int p = tid + 512 * (half * 8 + i); kr[i] = *(const v4u*)(kvp + (size_t)(p >> 5) * 4096 + (p & 31) * 8); }
#pragma unroll
        for (int i = 0; i < 8; ++i) { const int p = tid + 512 * (half * 8 + i); *(LAS v4u*)(lds + (p >> 5) * 528 + (p & 31) * 16) = kr[i]; } }
    bf16x8 qf[16];
#pragma unroll
    for (int ks = 0; ks < 16; ++ks) qf[ks] = *(const bf16x8*)(qp + 16 * ks);
    __syncthreads();
    const float C = 0.0625f * LOG2E_F;
    v4u pk[16]; float m = 0.f, lsum = 0.f, f0 = 1.f;
#pragma unroll
    for (int half = 0; half < 2; ++half) {
        f32x16 s[4];
#pragma unroll
        for (int kt = 0; kt < 4; ++kt) {
#pragma unroll
            for (int r = 0; r < 16; ++r) s[kt][r] = 0.f;
            LAS const unsigned char* kb = lds + (half * 128 + kt * 32 + q) * 528 + h * 16;
#pragma unroll
            for (int ks = 0; ks < 16; ++ks) s[kt] = __builtin_amdgcn_mfma_f32_32x32x16_bf16(*(const LAS bf16x8*)(kb + ks * 32), qf[ks], s[kt], 0, 0, 0); }
        float mx = s[0][0];
#pragma unroll
        for (int kt = 0; kt < 4; ++kt)
#pragma unroll
            for (int r = 0; r < 16; ++r) mx = fmaxf(mx, s[kt][r]);
        mx = fmaxf(mx, __shfl_xor(mx, 32)) * C;
        const float mn = half == 0 ? mx : fmaxf(m, mx);
        if (half == 1) { f0 = __builtin_amdgcn_exp2f(m - mn); lsum *= f0; }
        m = mn;
        float sum = 0.f;
#pragma unroll
        for (int kt = 0; kt < 4; ++kt) {
#pragma unroll
            for (int r = 0; r < 16; ++r) { s[kt][r] = __builtin_amdgcn_exp2f(fmaf(s[kt][r], C, -mn)); sum += s[kt][r]; }
#pragma unroll
            for (int e = 0; e < 2; ++e) { v4u w; w.x = cvtpk(s[kt][8 * e + 0], s[kt][8 * e + 1]); w.y = cvtpk(s[kt][8 * e + 2], s[kt][8 * e + 3]); w.z = cvtpk(s[kt][8 * e + 4], s[kt][8 * e + 5]); w.w = cvtpk(s[kt][8 * e + 6], s[kt][8 * e + 7]); pk[half * 8 + kt * 2 + e] = w; } }
        lsum += sum;
    }
    lsum += __shfl_xor(lsum, 32); const float invl = 1.f / lsum;
    __syncthreads();
#pragma unroll
    for (int c = 0; c < 2; ++c) { v4u vr[8];
#pragma unroll
        for (int i = 0; i < 8; ++i) { const int p = tid + 512 * i; vr[i] = *(const v4u*)(kvp + 1024 + (size_t)(p >> 4) * 4096 + c * 128 + (p & 15) * 8); }
#pragma unroll
        for (int i = 0; i < 8; ++i) { const int p = tid + 512 * i; *(LAS v4u*)(lds + c * 65536 + ((p & 15) >> 2) * 16384 + (p >> 4) * 64 + (p & 3) * 16) = vr[i]; } }
    __syncthreads();
    bf16* yp = (bf16*)(P.ws + WS_Y) + t * DM + hh * 256 + 4 * h;
    LAS const unsigned char* vp = lds + (4 * h + ((lane & 15) >> 2)) * 64 + ((lane >> 4) & 1) * 32 + (lane & 3) * 8;
#pragma unroll 1
    for (int dt = 0; dt < 8; ++dt) { f32x16 o;
#pragma unroll
        for (int r = 0; r < 16; ++r) o[r] = 0.f;
        LAS const unsigned char* vd = vp + dt * 16384;
#pragma unroll
        for (int s = 0; s < 8; ++s) { const v4i16 lo = __builtin_amdgcn_ds_read_tr16_b64_v4i16((LAS v4i16*)(vd + s * 1024)), hi = __builtin_amdgcn_ds_read_tr16_b64_v4i16((LAS v4i16*)(vd + s * 1024 + 512));
            o = __builtin_amdgcn_mfma_f32_32x32x16_bf16((bf16x8){lo[0], lo[1], lo[2], lo[3], hi[0], hi[1], hi[2], hi[3]}, __builtin_bit_cast(bf16x8, pk[s]), o, 0, 0, 0); }
#pragma unroll
        for (int r = 0; r < 16; ++r) o[r] *= f0;
#pragma unroll
        for (int s = 8; s < 16; ++s) { const v4i16 lo = __builtin_amdgcn_ds_read_tr16_b64_v4i16((LAS v4i16*)(vd + s * 1024)), hi = __builtin_amdgcn_ds_read_tr16_b64_v4i16((LAS v4i16*)(vd + s * 1024 + 512));
            o = __builtin_amdgcn_mfma_f32_32x32x16_bf16((bf16x8){lo[0], lo[1], lo[2], lo[3], hi[0], hi[1], hi[2], hi[3]}, __builtin_bit_cast(bf16x8, pk[s]), o, 0, 0, 0); }
#pragma unroll
        for (int a = 0; a < 4; ++a) { v2u w; w.x = cvtpk(o[4 * a] * invl, o[4 * a + 1] * invl); w.y = cvtpk(o[4 * a + 2] * invl, o[4 * a + 3] * invl); *(v2u*)(yp + dt * 32 + a * 8) = w; } }
    __syncthreads();
}
__device__ __forceinline__ void phase_xatt(const Params& P, LAS unsigned char* lds, int l) {
    for (int it = blockIdx.x; it < 512; it += gridDim.x) { const int c = it % 256, k = it / 256; xatt_item(P, lds, l, c & 31, (c >> 5) + 8 * k); }
}

constexpr size_t WS_DN = 344 * MiB, DN_CHUNK_BYTES = 73728, WS_EGL = 488 * MiB;
constexpr int DNA_RHS = 0, DNA_QB = 65536, DNA_KB = 82944, DNA_AM = 100352, DNA_SSQ = 118784, DNA_GC = 126976;
__device__ __forceinline__ void dna_item(const Params& P, LAS unsigned char* lds, int item) {
    int tid_l = threadIdx.x; asm volatile("" : "+v"(tid_l)); const int tid = tid_l, lane = tid & 63, wave = tid >> 6;
    const int bh = item >> 6, n = item & 63, b = bh >> 2, h = bh & 3, sb = n * 64; const size_t rb = (size_t)b * SEQ;
    const bf16* z = (const bf16*)(P.ws + WS_Z); const float* ba = (const float*)(P.ws + WS_BA); const float* cw = P.in[I_A_CONV];
    unsigned char* ob = P.ws + WS_DN + (size_t)item * DN_CHUNK_BYTES;
    LAS float* rhs = (LAS float*)(lds + DNA_RHS); LAS float* Am = (LAS float*)(lds + DNA_AM); LAS float* ssq = (LAS float*)(lds + DNA_SSQ);
    LAS float* gcs = (LAS float*)(lds + DNA_GC); LAS float* bet = gcs + 64; LAS float* egc = gcs + 128; LAS float* ekd = gcs + 192;
    const float SC = 0.08838834764831845f;
    { const int gd = tid & 15, tq = tid >> 4, d0 = gd * 8;
      f32x4 wa[3][4][2]; v4u za[3][2][4];
#pragma unroll
      for (int part = 0; part < 3; ++part) { const int ch0 = part * 512 + h * 128 + d0;
#pragma unroll
          for (int kk = 0; kk < 4; ++kk) { wa[part][kk][0] = *(const f32x4*)(cw + kk * 1536 + ch0); wa[part][kk][1] = *(const f32x4*)(cw + kk * 1536 + ch0 + 4); }
#pragma unroll
          for (int tt = 0; tt < 2; ++tt)
#pragma unroll
              for (int kk = 0; kk < 4; ++kk) { const int sp = sb + tq + 32 * tt - 3 + kk; za[part][tt][kk] = (v4u){0u, 0u, 0u, 0u}; if (sp >= 0) za[part][tt][kk] = *(const v4u*)(z + (rb + sp) * 2560 + 512 + ch0); } }
      __builtin_amdgcn_sched_barrier(0);
    if (wave == 0) { const size_t t = rb + sb + lane; const float bl = ba[t * 8 + h], al = ba[t * 8 + 4 + h] + P.in[I_A_DTB][h]; const float sp = al > 20.f ? al : log1pf(__expf(al));
        float g = -__expf(P.in[I_A_ALOG][h]) * sp;
#pragma unroll
        for (int o = 1; o < 64; o <<= 1) { const float v = __shfl_up(g, o); if (lane >= o) g += v; }
        const float gl = __shfl(g, 63);
        gcs[lane] = g; bet[lane] = sigmoid_f(bl); egc[lane] = __expf(g); ekd[lane] = __expf(gl - g);
        if (lane == 63) ((float*)(P.ws + WS_EGL))[item] = __expf(g); }
      __syncthreads();
#pragma unroll
      for (int part = 0; part < 3; ++part) {
#pragma unroll
          for (int tt = 0; tt < 2; ++tt) { const int tl = tq + 32 * tt;
              float a[8];
#pragma unroll
              for (int e2 = 0; e2 < 8; ++e2) a[e2] = 0.f;
#pragma unroll
              for (int kk = 0; kk < 4; ++kk) { const v4u zv = za[part][tt][kk]; const f32x4 w0 = wa[part][kk][0], w1 = wa[part][kk][1];
                  a[0] += w0.x * bf2f(zv.x & 0xffff); a[1] += w0.y * bf2f(zv.x >> 16); a[2] += w0.z * bf2f(zv.y & 0xffff); a[3] += w0.w * bf2f(zv.y >> 16);
                  a[4] += w1.x * bf2f(zv.z & 0xffff); a[5] += w1.y * bf2f(zv.z >> 16); a[6] += w1.z * bf2f(zv.w & 0xffff); a[7] += w1.w * bf2f(zv.w >> 16); }
              float q2 = 0.f;
#pragma unroll
              for (int e2 = 0; e2 < 8; ++e2) { a[e2] = a[e2] * __builtin_amdgcn_rcpf(1.f + __builtin_amdgcn_exp2f(-LOG2E_F * a[e2])); q2 += a[e2] * a[e2]; }
              if (part < 2) {
                  q2 += __shfl_xor(q2, 1); q2 += __shfl_xor(q2, 2); q2 += __shfl_xor(q2, 4); q2 += __shfl_xor(q2, 8);
                  const float rs = rsqrtf(q2 + EPS);
#pragma unroll
                  for (int e2 = 0; e2 < 8; ++e2) a[e2] *= rs;
                  v4u wv; wv.x = cvtpk(a[0], a[1]); wv.y = cvtpk(a[2], a[3]); wv.z = cvtpk(a[4], a[5]); wv.w = cvtpk(a[6], a[7]);
                  *(LAS v4u*)(lds + (part == 0 ? DNA_QB : DNA_KB) + tl * 272 + d0 * 2) = wv;
                  if (part == 0) { const float f = SC * egc[tl]; v4u g4; g4.x = cvtpk(a[0] * f, a[1] * f); g4.y = cvtpk(a[2] * f, a[3] * f); g4.z = cvtpk(a[4] * f, a[5] * f); g4.w = cvtpk(a[6] * f, a[7] * f);
                      *(v4u*)(ob + 16384 + (((tl >> 4) * 4 + (d0 >> 5)) * 64 + (tl & 15) + 16 * ((d0 >> 3) & 3)) * 16) = g4; }
                  else { const float f = ekd[tl], fb = bet[tl] * egc[tl];
                      *(LAS f32x4*)(rhs + tl * 256 + d0) = (f32x4){a[0] * fb, a[1] * fb, a[2] * fb, a[3] * fb}; *(LAS f32x4*)(rhs + tl * 256 + d0 + 4) = (f32x4){a[4] * fb, a[5] * fb, a[6] * fb, a[7] * fb};
                      bf16* kd = (bf16*)(ob + 32768) + ((((d0 >> 4) * 2 + (tl >> 5)) * 64 + 16 * ((tl >> 3) & 3)) * 8) + (tl & 7);
#pragma unroll
                      for (int e2 = 0; e2 < 8; ++e2) kd[(((d0 & 15) + e2) * 8)] = (bf16)f2bf(a[e2] * f); } }
              else { const float fb = bet[tl];
                  *(LAS f32x4*)(rhs + tl * 256 + 128 + d0) = (f32x4){a[0] * fb, a[1] * fb, a[2] * fb, a[3] * fb}; *(LAS f32x4*)(rhs + tl * 256 + 128 + d0 + 4) = (f32x4){a[4] * fb, a[5] * fb, a[6] * fb, a[7] * fb}; } } } }
    __syncthreads();
    if (wave < 6) { const int isq = wave >= 3, jb = wave - 3 * isq, it = jb >= 1, jt = jb == 2; const int q = lane & 31, hh = lane >> 5;
        f32x16 d;
#pragma unroll
        for (int r = 0; r < 16; ++r) d[r] = 0.f;
        LAS const unsigned char* ap = lds + (isq ? DNA_QB : DNA_KB) + (it * 32 + q) * 272 + hh * 16; LAS const unsigned char* bp = lds + DNA_KB + (jt * 32 + q) * 272 + hh * 16;
#pragma unroll
        for (int ks = 0; ks < 8; ++ks) d = __builtin_amdgcn_mfma_f32_32x32x16_bf16(*(const LAS bf16x8*)(ap + ks * 32), *(const LAS bf16x8*)(bp + ks * 32), d, 0, 0, 0);
        const int j = jt * 32 + q; const float gj = gcs[j];
#pragma unroll
        for (int r = 0; r < 16; ++r) { const int i = it * 32 + (r & 3) + 8 * (r >> 2) + 4 * hh; const float dec = __expf(fminf(gcs[i] - gj, 0.f));
            if (!isq) Am[(j & 1) * 2304 + i * 36 + (j >> 1)] = i > j ? d[r] * bet[i] * dec : 0.f;
            else ((bf16*)(ob + 65536))[((((i >> 4) * 2 + (j >> 5)) * 64 + (i & 15) + 16 * ((j >> 3) & 3)) * 8) + (j & 7)] = (bf16)f2bf(i >= j ? d[r] * SC * dec : 0.f); } }
    else if (wave == 6) { const v4u z4 = {0u, 0u, 0u, 0u}; *(v4u*)(ob + 65536 + ((0 * 2 + 1) * 64 + lane) * 16) = z4; *(v4u*)(ob + 65536 + ((1 * 2 + 1) * 64 + lane) * 16) = z4; }
    __syncthreads();
    if (tid < 256) { const int cp = tid >> 1, par = tid & 1, c = 2 * cp; LAS const float* Ap = Am + par * 2304; f2v x[32];
#pragma unroll
      for (int jj = 0; jj < 32; ++jj) x[jj] = (f2v){0.f, 0.f};
      f32x4 ab[2][8]; f2v rb[2]; f2v xl[4] = {{0.f, 0.f}, {0.f, 0.f}, {0.f, 0.f}, {0.f, 0.f}};
      rb[0] = *(const LAS f2v*)(rhs + c);
      unsigned* wp = (unsigned*)((bf16*)ob + (((c >> 5) * 64 + 16 * ((c >> 3) & 3)) * 8) + (c & 7));
      const int dv = c - 128; unsigned char* up = ob + 49152 + (((dv >> 4) * 4) * 64 + (dv & 15)) * 8;
#pragma unroll
      for (int i = 0; i < 64; ++i) {
          if (i + 1 < 64) {
#pragma unroll
              for (int j4 = 0; j4 < ((i + 2) / 2 + 3) / 4; ++j4) ab[(i + 1) & 1][j4] = *(const LAS f32x4*)(Ap + (i + 1) * 36 + 4 * j4);
              rb[(i + 1) & 1] = *(const LAS f2v*)(rhs + (i + 1) * 256 + c); }
          __builtin_amdgcn_sched_barrier(0);
          f2v ac4[4] = {{0.f, 0.f}, {0.f, 0.f}, {0.f, 0.f}, {0.f, 0.f}};
#pragma unroll
          for (int jj = 0; jj < (i + 1) / 2; ++jj) { const float a = ab[i & 1][jj >> 2][jj & 3]; ac4[jj & 3] = ac4[jj & 3] + (f2v){a, a} * x[jj]; }
          f2v acc = (ac4[0] + ac4[1]) + (ac4[2] + ac4[3]);
          acc.x += __int_as_float(__builtin_amdgcn_update_dpp(0, __float_as_int(acc.x), 0xB1, 0xF, 0xF, true)); acc.y += __int_as_float(__builtin_amdgcn_update_dpp(0, __float_as_int(acc.y), 0xB1, 0xF, 0xF, true));
          const f2v xi = rb[i & 1] - acc;
          x[i >> 1] = ((i & 1) == par) ? xi : x[i >> 1];
          xl[i & 3] = xi;
          if (tid < 128) { if ((i & 1) == par) wp[(((i >> 4) * 4) * 64 + (i & 15)) * 4] = cvtpk(xi.x, xi.y); }
          else if ((i & 3) == 3 && ((i >> 2) & 1) == par) { v2u w0, w1; w0.x = cvtpk(xl[0].x, xl[1].x); w0.y = cvtpk(xl[2].x, xl[3].x); w1.x = cvtpk(xl[0].y, xl[1].y); w1.y = cvtpk(xl[2].y, xl[3].y);
              unsigned char* u0 = up + (((i >> 2) >> 2) * 64 + 16 * ((i >> 2) & 3)) * 8; *(v2u*)u0 = w0; *(v2u*)(u0 + 8) = w1; }
          __builtin_amdgcn_sched_barrier(0);
      } }
    __syncthreads();
}
__device__ __forceinline__ void phase_dna(const Params& P, LAS unsigned char* lds) { for (int it = blockIdx.x; it < 2048; it += gridDim.x) dna_item(P, lds, it); }

typedef float f32x4v __attribute__((ext_vector_type(4)));
struct DnFrag { bf16x8 m1[4]; bf16x8 at[2]; bf16x8 kd[2]; v2u u; float eg; };
__device__ __forceinline__ void dnb_load(DnFrag& f, const unsigned char* base, const float* egl, int n, int wave, int lane, int sl) {
    const unsigned char* cb = base + (size_t)n * DN_CHUNK_BYTES; const int ct = wave & 3;
    const unsigned char* m1 = cb + (wave < 4 ? 0 : 16384) + ((ct * 4) * 64 + lane) * 16;
#pragma unroll
    for (int ks = 0; ks < 4; ++ks) f.m1[ks] = *(const bf16x8*)(m1 + ks * 1024);
#pragma unroll
    for (int ks = 0; ks < 2; ++ks) f.kd[ks] = *(const bf16x8*)(cb + 32768 + ((wave * 2 + ks) * 64 + lane) * 16);
    if (wave < 4) f.u = *(const v2u*)(cb + 49152 + ((sl * 4 + ct) * 64 + lane) * 8);
    else {
#pragma unroll
        for (int ks = 0; ks < 2; ++ks) f.at[ks] = *(const bf16x8*)(cb + 65536 + ((ct * 2 + ks) * 64 + lane) * 16); }
    f.eg = egl[n];
}
__device__ __forceinline__ void phase_dnb(const Params& P, LAS unsigned char* lds) {
    int tid_l = threadIdx.x; asm volatile("" : "+v"(tid_l)); const int tid = tid_l, lane = tid & 63, wave = __builtin_amdgcn_readfirstlane(tid >> 6);
    const int x = blockIdx.x; if (x >= 256) return;
    const int xcd = x & 7, idx = x >> 3, bh = xcd * 4 + (idx >> 3), sl = idx & 7, b = bh >> 2, h = bh & 3, ct = wave & 3;
    const unsigned char* base = P.ws + WS_DN + (size_t)bh * 64 * DN_CHUNK_BYTES; const float* egl = (const float*)(P.ws + WS_EGL) + bh * 64;
    bf16* yo = (bf16*)(P.ws + WS_Y) + ((size_t)b * SEQ + 16 * ct + 4 * (lane >> 4)) * DM + 512 + h * 128 + sl * 16 + (lane & 15);
    LAS unsigned char* St = lds; LAS unsigned char* vnT = lds + 4352;
    LAS const unsigned char* stb = St + (lane & 15) * 272 + (lane >> 4) * 16; LAS const unsigned char* vnb = vnT + (lane & 15) * 144 + (lane >> 4) * 16;
    if (tid < 272) *(LAS v4u*)(St + tid * 16) = (v4u){0u, 0u, 0u, 0u};
    f32x4v Sacc = {0.f, 0.f, 0.f, 0.f};
    DnFrag fr[4];
#pragma unroll
    for (int u = 0; u < 4; ++u) dnb_load(fr[u], base, egl, u, wave, lane, sl);
    __syncthreads();
#pragma unroll 1
    for (int n0 = 0; n0 < 64; n0 += 4) {
#pragma unroll
        for (int u = 0; u < 4; ++u) { const int n = n0 + u;
            f32x4v acc = {0.f, 0.f, 0.f, 0.f};
#pragma unroll
            for (int ks = 0; ks < 4; ++ks) acc = __builtin_amdgcn_mfma_f32_16x16x32_bf16(fr[u].m1[ks], *(const LAS bf16x8*)(stb + ks * 64), acc, 0, 0, 0);
            if (wave < 4) { const float u0 = bf2f(fr[u].u.x & 0xffff), u1 = bf2f(fr[u].u.x >> 16), u2 = bf2f(fr[u].u.y & 0xffff), u3 = bf2f(fr[u].u.y >> 16);
                v2u w; w.x = cvtpk(u0 - acc[0], u1 - acc[1]); w.y = cvtpk(u2 - acc[2], u3 - acc[3]); *(LAS v2u*)(vnT + (lane & 15) * 144 + (16 * ct + 4 * (lane >> 4)) * 2) = w; }
            __syncthreads();
            const bf16x8 v0 = *(const LAS bf16x8*)(vnb), v1 = *(const LAS bf16x8*)(vnb + 64);
            if (wave >= 4) { acc = __builtin_amdgcn_mfma_f32_16x16x32_bf16(fr[u].at[0], v0, acc, 0, 0, 0); acc = __builtin_amdgcn_mfma_f32_16x16x32_bf16(fr[u].at[1], v1, acc, 0, 0, 0);
                bf16* yp = yo + (size_t)n * 64 * DM;
#pragma unroll
                for (int r = 0; r < 4; ++r) yp[(size_t)r * DM] = (bf16)f2bf(acc[r]); }
            Sacc = Sacc * fr[u].eg;
            Sacc = __builtin_amdgcn_mfma_f32_16x16x32_bf16(fr[u].kd[0], v0, Sacc, 0, 0, 0); Sacc = __builtin_amdgcn_mfma_f32_16x16x32_bf16(fr[u].kd[1], v1, Sacc, 0, 0, 0);
            { v2u w; w.x = cvtpk(Sacc[0], Sacc[1]); w.y = cvtpk(Sacc[2], Sacc[3]); *(LAS v2u*)(St + (lane & 15) * 272 + (16 * wave + 4 * (lane >> 4)) * 2) = w; }
            dnb_load(fr[u], base, egl, n + 4 < 64 ? n + 4 : 63, wave, lane, sl);
            __syncthreads();
        }
    }
}
__device__ __forceinline__ void phase_dnc(const Params& P, LAS unsigned char* lds) {
    int tid_l = threadIdx.x; asm volatile("" : "+v"(tid_l)); const int tid = tid_l, lane = tid & 63, wave = tid >> 6;
    const int gw = blockIdx.x * NWAVES + wave, NGW = gridDim.x * NWAVES;
    const bf16* z = (const bf16*)(P.ws + WS_Z); bf16* y = (bf16*)(P.ws + WS_Y);
    float on[8];
#pragma unroll
    for (int e = 0; e < 8; ++e) on[e] = P.in[I_A_ONORM][(lane & 15) * 8 + e];
    for (int it0 = gw; it0 < T; it0 += 4 * NGW) {
        const int hh = lane >> 4, d0 = (lane & 15) * 8; v4u ov[4], gv[4];
#pragma unroll
        for (int u = 0; u < 4; ++u) { const int it = it0 + u * NGW; if (it < T) { ov[u] = *(const v4u*)(y + (size_t)it * DM + 512 + hh * 128 + d0); gv[u] = *(const v4u*)(z + (size_t)it * 2560 + 2048 + hh * 128 + d0); } }
#pragma unroll
        for (int u = 0; u < 4; ++u) { const int it = it0 + u * NGW; if (it >= T) break;
            float o[8] = {bf2f(ov[u].x & 0xffff), bf2f(ov[u].x >> 16), bf2f(ov[u].y & 0xffff), bf2f(ov[u].y >> 16), bf2f(ov[u].z & 0xffff), bf2f(ov[u].z >> 16), bf2f(ov[u].w & 0xffff), bf2f(ov[u].w >> 16)};
            const float g[8] = {bf2f(gv[u].x & 0xffff), bf2f(gv[u].x >> 16), bf2f(gv[u].y & 0xffff), bf2f(gv[u].y >> 16), bf2f(gv[u].z & 0xffff), bf2f(gv[u].z >> 16), bf2f(gv[u].w & 0xffff), bf2f(gv[u].w >> 16)};
            float s = 0.f;
#pragma unroll
            for (int e = 0; e < 8; ++e) s += o[e] * o[e];
            s += __shfl_xor(s, 1); s += __shfl_xor(s, 2); s += __shfl_xor(s, 4); s += __shfl_xor(s, 8);
            const float rs = rsqrtf(s * (1.f / 128.f) + EPS);
#pragma unroll
            for (int e = 0; e < 8; ++e) o[e] = o[e] * rs * on[e] * (g[e] * __builtin_amdgcn_rcpf(1.f + __builtin_amdgcn_exp2f(-LOG2E_F * g[e])));
            v4u w; w.x = cvtpk(o[0], o[1]); w.y = cvtpk(o[2], o[3]); w.z = cvtpk(o[4], o[5]); w.w = cvtpk(o[6], o[7]);
            *(v4u*)(y + (size_t)it * DM + 512 + hh * 128 + d0) = w; } }
    phase_pool(P, lds);
}

constexpr size_t WS_CTL = 118 * MiB; constexpr int CTL_BYTES = 16384, LDS_CTL_OFF = 147392;
#define XB_TMO      128
#define XB_XCNT(j)  (256  + 64 * (j))
#define XB_XSUB(j)  (1280 + 64 * (j))
#define XB_XGEN(j)  (2304 + 64 * (j))
#define XB_TOP      3328
#define XB_TOPGEN   3392
#define XCD_BAR_WORDS 3456
#define XB_SPIN_CAP (1u << 18)

__device__ __forceinline__ unsigned xb_ld(unsigned* p)              { return __hip_atomic_load(p, __ATOMIC_RELAXED, __HIP_MEMORY_SCOPE_AGENT); }
__device__ __forceinline__ unsigned xb_add(unsigned* p, unsigned v) { return __hip_atomic_fetch_add(p, v, __ATOMIC_RELAXED, __HIP_MEMORY_SCOPE_AGENT); }
__device__ __forceinline__ unsigned xb_xcc_id() { return (unsigned)__builtin_amdgcn_s_getreg((3 << 11) | 20) & 0xFu; }
#define XB_SPIN(cond, bar) do { unsigned _sp = 0; while (cond) { __builtin_amdgcn_s_sleep(1); \
    if ((++_sp & 255u) == 0u) { if (xb_ld(&(bar)[XB_TMO])) break; if (_sp > XB_SPIN_CAP) { atomicAdd(&(bar)[XB_TMO], 1u); break; } } } } while (0)

struct XcdBarrier {
    unsigned* bar; unsigned x;
    volatile LAS unsigned* st;
};

__device__ __forceinline__ XcdBarrier xcd_barrier_post(unsigned* bar, volatile LAS unsigned* st) {
    XcdBarrier b; b.bar = bar; b.x = xb_xcc_id(); b.st = st;
    if (threadIdx.x == 0) (void)xb_add(&bar[XB_XCNT(b.x)], 1u);
    return b;
}
__device__ __forceinline__ void xcd_barrier_complete(unsigned* bar, unsigned x, unsigned& nloc, unsigned& nx) {
    const unsigned G = gridDim.x * gridDim.y * gridDim.z;
    unsigned sum, cnt, mine, sp = 0u;
    for (;;) {
        sum = 0u; cnt = 0u; mine = 0u;
#pragma unroll
        for (unsigned j = 0; j < 16; ++j) { const unsigned c = xb_ld(&bar[XB_XCNT(j)]); sum += c; cnt += (c > 0u) ? 1u : 0u; mine = (j == x) ? c : mine; }
        if (sum == G) break;
        __builtin_amdgcn_s_sleep(1);
        if ((++sp & 255u) == 0u) { if (xb_ld(&bar[XB_TMO])) break; if (sp > XB_SPIN_CAP) { atomicAdd(&bar[XB_TMO], 1u); break; } }
    }
    nloc = mine > 0u ? mine : 1u; nx = cnt > 0u ? cnt : 1u;
}

__device__ __forceinline__ void xcd_barrier(const XcdBarrier& b) {
    asm volatile("s_waitcnt vmcnt(0)" ::: "memory");
    __syncthreads();
    if (threadIdx.x == 0) {
        unsigned* bar = b.bar;
        __builtin_amdgcn_s_waitcnt(0);
        unsigned nloc = b.st[0], nx = b.st[1];
        if (nloc == 0u) { xcd_barrier_complete(bar, b.x, nloc, nx); b.st[0] = nloc; b.st[1] = nx; }
        const unsigned old = xb_add(&bar[XB_XSUB(b.x)], 1u);
        const unsigned gen = old / nloc;
        if (old + 1u == (gen + 1u) * nloc) {
            __builtin_amdgcn_fence(__ATOMIC_RELEASE, "agent");
            asm volatile("s_waitcnt vmcnt(0)" ::: "memory");
            const unsigned og = xb_add(&bar[XB_TOP], 1u);
            const unsigned tg = og / nx;
            if (og + 1u == (tg + 1u) * nx) xb_add(&bar[XB_TOPGEN], 1u);
            else XB_SPIN(xb_ld(&bar[XB_TOPGEN]) == tg, bar);
            __builtin_amdgcn_fence(__ATOMIC_ACQUIRE, "agent");
            xb_add(&bar[XB_XGEN(b.x)], 1u);
            asm volatile("s_waitcnt vmcnt(0)" ::: "memory");
        } else {
            XB_SPIN(xb_ld(&bar[XB_XGEN(b.x)]) == gen, bar);
            __builtin_amdgcn_fence(__ATOMIC_ACQUIRE, "agent");
            asm volatile("s_waitcnt vmcnt(0)" ::: "memory");
        }
    }
    __syncthreads();
}

constexpr int LDS_RS_OFF = 131072;
template <class E> __device__ __forceinline__ void run_gemm(LAS unsigned char* lds, const bf16* A, const bf16* Bt, int M, int N, int K, const E& e, const float* ss = nullptr) {
    pg8::Gemm g{A, Bt, M, N, K}; pg8::StaticOrder So; So.init(M, N, (int)gridDim.x, (int)blockIdx.x);
    if (ss) { pg8::Unit u; LAS float* rs = (LAS float*)(lds + LDS_RS_OFF);
        for (int i = 0; So.next(i, u); ++i) { const int r = threadIdx.x; if (r < 256) rs[256 * i + r] = pg8::row_rstd(ss, u.pm * 256 + r); }
        __syncthreads(); }
    pg8::gemm_phase<E, pg8::StaticOrder, true, true>(lds, g, So, e);
}
constexpr int N_PHASES = 22;
#ifndef MK_PER_PHASE
#define MK_PER_PHASE 0
#endif

template <int ph> __device__ __forceinline__ void do_phase(const Params& P, LAS unsigned char* lds) {
    unsigned char* ws = P.ws;
    bf16* xh = (bf16*)(ws + WS_XH); float* ss = (float*)(ws + WS_SS); bf16* yb = (bf16*)(ws + WS_Y); bf16* zb = (bf16*)(ws + WS_Z);
    if constexpr (ph == 0) phase_prologue(P, lds);
    else if constexpr (ph == 1) {
        pg8::Gemm g{xh, (const bf16*)(ws + WS_AIN), T, 2816, 1024, (const bf16*)(ws + WS_MEMH), (const bf16*)(ws + WS_XKV)};
        pg8::DualOrder So; So.init(T, 2816, 2048, 4096, (int)gridDim.x, (int)blockIdx.x);
        { pg8::Unit u; LAS float* rs = (LAS float*)(lds + LDS_RS_OFF);
          for (int i = 0; So.next(i, u); ++i) { const int r = threadIdx.x; if (r < 256 && u.kind == 0) rs[256 * i + r] = pg8::row_rstd(ss, u.pm * 256 + r); }
          __syncthreads(); }
        pg8::EpiDual<pg8::EpiInA, pg8::EpiBf<0>> e{{zb, (float*)(ws + WS_BA), (LAS float*)(lds + LDS_RS_OFF)}, {(bf16*)(ws + WS_MEMKV), 4096, nullptr, 1.f}};
        pg8::gemm_phase<pg8::EpiDual<pg8::EpiInA, pg8::EpiBf<0>>, pg8::DualOrder, true, true>(lds, g, So, e); }
    else if constexpr (ph == 2) phase_dna(P, lds);
    else if constexpr (ph == 3) phase_dnb(P, lds);
    else if constexpr (ph == 4) phase_dnc(P, lds);
    else if constexpr (ph == 11) { pg8::EpiInC e{zb, zb + (size_t)T * 1024, (float*)(ws + WS_GATES), (LAS float*)(lds + LDS_RS_OFF)}; run_gemm(lds, xh, (const bf16*)(ws + WS_CIN), T, 2816, 1024, e, ss); }
    else if constexpr (ph == 12) { const int kvs = (int)blockIdx.x >> 5;
        if (kvs < 2) { pg8::EpiF32 e{(float*)(ws + (kvs ? WS_P01V : WS_P01K)), 256};
            pg8::Gemm g{zb + (size_t)T * 1024 + (size_t)kvs * KV_KIND, (const bf16*)(ws + (kvs ? WS_CMPV : WS_CMPK)), 8192, 256, 1024}; pg8::StaticOrder So; So.init(8192, 256, (int)gridDim.x, (int)blockIdx.x & 31);
            pg8::gemm_phase<pg8::EpiF32, pg8::StaticOrder, true, true>(lds, g, So, e);
            pg8::Unit u; So.next(0, u);
            __builtin_amdgcn_fence(__ATOMIC_RELEASE, "agent"); asm volatile("s_waitcnt vmcnt(0)" ::: "memory"); __syncthreads(); __builtin_amdgcn_fence(__ATOMIC_ACQUIRE, "agent"); asm volatile("s_waitcnt vmcnt(0)" ::: "memory");
            cmpfin_bg(P, lds, kvs, u.pm); }
        else phase_conv_late(P, lds, ((int)blockIdx.x - 64) * NWAVES + (int)(threadIdx.x >> 6), ((int)gridDim.x - 64) * NWAVES); }
    else if constexpr (ph == 13) { }
    else if constexpr (ph == 14) phase_nsa(P, lds);
    else if constexpr (ph == 21) phase_final(P);
    else { constexpr int l = ph >= 15 ? 1 : 0, k = ph - (l ? 15 : 5);
        if constexpr (k == 1) {
            { pg8::EpiBf<0> e{(bf16*)(ws + WS_QXA), 1024, (LAS float*)(lds + LDS_RS_OFF), 1.f}; run_gemm(lds, xh, (const bf16*)(ws + WS_XQ) + (size_t)l * 1048576, T, 1024, 1024, e, ss); } }
        else if constexpr (k == 2) phase_xatt(P, lds, l);
        else if constexpr (k == 4) { pg8::EpiBf<1> e{(bf16*)(ws + WS_HMID), 4096, (LAS float*)(lds + LDS_RS_OFF), 1.f}; run_gemm(lds, xh, (const bf16*)(ws + WS_F1) + (size_t)l * 4194304, T, 4096, 1024, e, ss); }
        else { const bf16* A = k == 5 ? (const bf16*)(ws + WS_HMID) : yb; constexpr int K = k == 5 ? 4096 : 1024;
            const bf16* Bt = k == 0 ? (const bf16*)(ws + (l ? WS_COUT : WS_AOUT)) : k == 3 ? (const bf16*)(ws + WS_XO) + (size_t)l * 1048576 : (const bf16*)(ws + WS_F2) + (size_t)l * 4194304;
            if constexpr (ph == 5) { pg8::EpiRes<true> e{xh, ss, P.in[I_X]}; run_gemm(lds, A, Bt, T, 1024, K, e); }
            else { pg8::EpiRes<false> e{xh, ss, nullptr}; run_gemm(lds, A, Bt, T, 1024, K, e); } } }
}
__global__ void __launch_bounds__(NTHR, 2) trunk_fwd(Params P) {
    extern __shared__ __attribute__((aligned(16))) unsigned char lds_raw[];
    LAS unsigned char* lds = (LAS unsigned char*)lds_raw;
    cg::grid_group grid = cg::this_grid();
    const int lo = P.ph_lo, hi = P.ph_hi;
#ifndef PROBE_PH
#define PROBE_PH -1
#endif
    if (threadIdx.x < 2) ((LAS unsigned*)(lds + LDS_CTL_OFF))[threadIdx.x] = 0u;
    __syncthreads();
    const XcdBarrier bar = xcd_barrier_post((unsigned*)(P.ws + WS_CTL), (volatile LAS unsigned*)(lds + LDS_CTL_OFF));
    if (P.ph_lo < 0) grid.sync();
#define SEAM(k) { xcd_barrier(bar); }
#define RUN(k) if (lo <= (k) && (k) < hi) { if ((k) == PROBE_PH) { do_phase<(k)>(P, lds); SEAM(k) } do_phase<(k)>(P, lds); if ((k) + 1 < hi) SEAM(k) }
    RUN(0) RUN(1) RUN(2) RUN(3) RUN(4) RUN(5) RUN(6) RUN(7) RUN(8) RUN(9) RUN(10) RUN(11) RUN(12) RUN(14) RUN(15) RUN(16) RUN(17) RUN(18) RUN(19) RUN(20) RUN(21)
#undef RUN
}

extern "C" void kernel_launch(void* const* d_in, const int* in_sizes, int n_in, void* d_out, int out_size, void* d_ws, size_t ws_size, hipStream_t stream) {
    static int grid = 0;
    if (grid == 0) {
        if (n_in != N_IN || in_sizes[0] != T * DM || out_size != T * DM || ws_size < WS_END) { fprintf(stderr, "kernel_launch: unexpected shapes (n_in %d, in0 %d, out %d, ws %zu)\n", n_in, n_in > 0 ? in_sizes[0] : -1, out_size, ws_size); grid = -1; return; }
        int dev = 0, cus = 0, per_cu = 0;
        if (hipGetDevice(&dev) != hipSuccess || hipDeviceGetAttribute(&cus, hipDeviceAttributeMultiprocessorCount, dev) != hipSuccess) { grid = -1; return; }
        if (hipFuncSetAttribute((const void*)trunk_fwd, hipFuncAttributeMaxDynamicSharedMemorySize, LDS_BYTES) != hipSuccess) { fprintf(stderr, "kernel_launch: hipFuncSetAttribute failed\n"); grid = -1; return; }
        if (hipOccupancyMaxActiveBlocksPerMultiprocessor(&per_cu, (const void*)trunk_fwd, NTHR, LDS_BYTES) != hipSuccess || per_cu < 1) { fprintf(stderr, "kernel_launch: occupancy query says %d blocks/CU\n", per_cu); (void)hipGetLastError(); grid = -1; return; }
        grid = cus;
        fprintf(stderr, "kernel_launch: %d CUs, %d blocks/CU by the occupancy query, grid %d\n", cus, per_cu, grid);
    }
    if (grid < 0) return;
    Params p{};
    for (int i = 0; i < N_IN; ++i) p.in[i] = (const float*)d_in[i];
    p.out = (float*)d_out; p.ws = (unsigned char*)d_ws;
#if MK_PER_PHASE
    for (int ph = 0; ph < N_PHASES; ++ph) { p.ph_lo = ph; p.ph_hi = ph + 1; hipLaunchKernelGGL(trunk_fwd, dim3(grid), dim3(NTHR), LDS_BYTES, stream, p); }
#else
    p.ph_lo = 0; p.ph_hi = N_PHASES;
    if (hipMemsetAsync((char*)d_ws + WS_CTL, 0, CTL_BYTES, stream) != hipSuccess) { fprintf(stderr, "kernel_launch: memset of the barrier words failed\n"); return; }
    void* args[] = {&p};
    hipError_t e = hipLaunchCooperativeKernel((const void*)trunk_fwd, dim3(grid), dim3(NTHR), args, LDS_BYTES, stream);
    if (e != hipSuccess) fprintf(stderr, "kernel_launch: cooperative launch failed: %s (grid %d)\n", hipGetErrorString(e), grid);
#endif
}
```

```cpp
#include <hip/hip_runtime.h>
#include <hip/hip_cooperative_groups.h>
#include <cstdio>
#include <cstdint>
namespace cg = cooperative_groups;
namespace pg8 {
#define PG8_LAS __attribute__((address_space(3)))
typedef unsigned short bf16_t;
typedef short bf16x8 __attribute__((ext_vector_type(8)));
typedef float f32x4 __attribute__((ext_vector_type(4)));
typedef unsigned u32x4 __attribute__((ext_vector_type(4)));
constexpr int BM = 256, BK = 64, HALF = 128, HTB = HALF * BK * 2  , STAGE_BYTES = 8 * HTB, NXCD = 8, WGM = 8;

__host__ __device__ __forceinline__ int lds_byte(int r, int c) { const int st = (r >> 4) * 2 + (c >> 5), rr = r & 15, cc = c & 31, ob = rr * 64 + cc * 2; return st * 1024 + (ob ^ (((ob >> 9) & 1) << 5)); }
__host__ __device__ __forceinline__ void stage_rc(int b, int& R, int& C) { const int st = b / 1024, sb = b % 1024, swz = sb ^ (((sb >> 9) & 1) << 5); R = (st >> 1) * 16 + swz / 64; C = (st & 1) * 32 + (swz % 64) / 2; }
__host__ __device__ __forceinline__ int perm32(int rho) { const int n = rho >> 4, i = rho & 15; return 8 * (i >> 2) + 4 * n + (i & 3); }

struct Unit { int pm, pn, ui, kind; };
struct Gemm { const bf16_t* A; const bf16_t* Bt; int M, N, K; const bf16_t* A2 = nullptr; const bf16_t* Bt2 = nullptr; };

struct StaticOrder {
    int nM, nN, nwg, G, c;
    __host__ __device__ void init(int M, int N, int G_, int c_) { nM = M / BM; nN = N / BM; nwg = nM * nN; G = G_; c = c_; }
    __host__ __device__ bool next(int i, Unit& u) const {
        const long L = (long)i * G + c; if (L >= nwg) return false;
        int wgid = (int)L; { const int q = nwg / NXCD, r = nwg % NXCD, xcd = wgid % NXCD, off = wgid / NXCD; wgid = (xcd < r ? xcd * (q + 1) : r * (q + 1) + (xcd - r) * q) + off; }
        const int nig = WGM * nN, gid = wgid / nig, fm = gid * WGM, gsz = (nM - fm) < WGM ? (nM - fm) : WGM;
        u.pm = fm + ((wgid % nig) % gsz); u.pn = (wgid % nig) / gsz; u.ui = i; u.kind = 0; return true;
    }
    __device__ __forceinline__ void a_ready(const Unit&) const {}
    __device__ __forceinline__ void done(const Unit&) const {}
};
__device__ __forceinline__ unsigned cvt_pk_bf16(float lo, float hi) { unsigned r; asm volatile("v_cvt_pk_bf16_f32 %0, %1, %2" : "=v"(r) : "v"(lo), "v"(hi)); return r; }
typedef float f32x2 __attribute__((ext_vector_type(2)));
typedef float f32x2 __attribute__((ext_vector_type(2)));
template <class Epi, class Sched, bool ALIGN_EPI = false, bool SP2 = false>
__device__ __forceinline__ void gemm_phase(PG8_LAS unsigned char* lds, const Gemm g, const Sched& S, const Epi& E) {
    int tid_l = threadIdx.x; asm volatile("" : "+v"(tid_l));
    const int tid = tid_l, wid = __builtin_amdgcn_readfirstlane(tid >> 6), lane = tid & 63, wr = wid >> 2, wc = wid & 3, fr = lane & 15, fq = lane >> 4;
    const int K = g.K, nt = K / BK;
    unsigned voffA[2], voffB[2];
#pragma unroll
    for (int i = 0; i < 2; ++i) { int R, C; stage_rc(tid * 16 + i * 8192, R, C); const int Rb = Epi::PERM ? ((R & ~31) + perm32(R & 31)) : R;
        voffA[i] = (unsigned)(R * K + C) * 2u; voffB[i] = (unsigned)(Rb * K + C) * 2u; }
    const size_t kstep = (size_t)(BK * 2);
    const size_t hstep = (size_t)HALF * K * 2;
    const size_t tstep = 2 * hstep;
    const unsigned ldsw = (unsigned)wid * 1024u;
    const int aoff = lds_byte(wr * 64 + fr, fq * 8), boff = lds_byte(wc * 32 + fr, fq * 8);
#define PG8_SA(b, h) (((b) * 2 + (h)) * HTB)
#define PG8_SB(b, h) ((4 + (b) * 2 + (h)) * HTB)
#define PG8_STAGE(bufoff, gbase, voff) do { _Pragma("unroll") for (int _i = 0; _i < 2; ++_i) \
        __builtin_amdgcn_global_load_lds((const unsigned*)((const char*)(gbase) + (voff)[_i]), (PG8_LAS unsigned*)(lds + (bufoff) + ldsw + _i * 8192), 16, 0, 0); } while (0)
#define PG8_LDA(dst, b, h) do { _Pragma("unroll") for (int m = 0; m < 4; ++m) _Pragma("unroll") for (int k = 0; k < 2; ++k) dst[m][k] = *(const PG8_LAS bf16x8*)(lds + PG8_SA(b, h) + aoff + m * 2048 + k * 1024); } while (0)
#define PG8_LDB(dst, b, h) do { _Pragma("unroll") for (int n = 0; n < 2; ++n) _Pragma("unroll") for (int k = 0; k < 2; ++k) dst[n][k] = *(const PG8_LAS bf16x8*)(lds + PG8_SB(b, h) + boff + n * 2048 + k * 1024); } while (0)
#define PG8_MMA(ai, bj, At, Bt) do { __builtin_amdgcn_s_setprio(1); _Pragma("unroll") for (int m = 0; m < 4; ++m) _Pragma("unroll") for (int n = 0; n < 2; ++n) _Pragma("unroll") for (int k = 0; k < 2; ++k) \
        acc[ai][bj][m][n] = __builtin_amdgcn_mfma_f32_16x16x32_bf16(Bt[n][k], At[m][k], acc[ai][bj][m][n], 0, 0, 0); __builtin_amdgcn_s_setprio(0); } while (0)
#define PG8_WAIT_V(n) asm volatile("s_waitcnt vmcnt(" #n ")" ::: "memory")
#define PG8_WAIT_L(n) asm volatile("s_waitcnt lgkmcnt(" #n ")" ::: "memory")
#define PG8_BAR __builtin_amdgcn_s_barrier()
#define PG8_SCHED __builtin_amdgcn_sched_barrier(0)
    Unit cur, nxt; int ui = 0;
    if (!S.next(0, cur)) return;
    f32x4 acc[2][2][4][2];
#pragma unroll
    for (int a = 0; a < 2; ++a)
#pragma unroll
        for (int b = 0; b < 2; ++b)
#pragma unroll
            for (int m = 0; m < 4; ++m)
#pragma unroll
                for (int n = 0; n < 2; ++n) acc[a][b][m][n] = (f32x4){0.f, 0.f, 0.f, 0.f};
    bf16x8 At[4][2], B0[2][2], B1[2][2];
    const char* cA = (const char*)(cur.kind ? g.A2 : g.A) + (size_t)cur.pm * tstep; const char* cB = (const char*)(cur.kind ? g.Bt2 : g.Bt) + (size_t)cur.pn * tstep;
    S.a_ready(cur);
    if constexpr (SP2) {
        PG8_STAGE(PG8_SB(0, 0), cB, voffB); PG8_STAGE(PG8_SB(0, 1), cB + hstep, voffB); PG8_STAGE(PG8_SA(0, 0), cA, voffA); PG8_STAGE(PG8_SA(0, 1), cA + hstep, voffA);
        if (wr == 1) PG8_BAR;
        PG8_WAIT_V(2); PG8_BAR;
        PG8_STAGE(PG8_SB(1, 0), cB + kstep, voffB); PG8_STAGE(PG8_SA(1, 0), cA + kstep, voffA); PG8_STAGE(PG8_SB(1, 1), cB + hstep + kstep, voffB);
        PG8_WAIT_V(6); PG8_BAR;
    } else {
        PG8_STAGE(PG8_SB(0, 0), cB, voffB); PG8_STAGE(PG8_SA(0, 0), cA, voffA); PG8_STAGE(PG8_SB(0, 1), cB + hstep, voffB); PG8_STAGE(PG8_SA(0, 1), cA + hstep, voffA);
        if (wr == 1) PG8_BAR;
        PG8_WAIT_V(4); PG8_BAR;
        PG8_STAGE(PG8_SB(1, 0), cB + kstep, voffB); PG8_STAGE(PG8_SA(1, 0), cA + kstep, voffA); PG8_STAGE(PG8_SB(1, 1), cB + hstep + kstep, voffB);
        PG8_WAIT_V(6); PG8_BAR;
    }
    for (;;) {
        const bool has_next = S.next(ui + 1, nxt);
        const char* nA = has_next ? (const char*)(nxt.kind ? g.A2 : g.A) + (size_t)nxt.pm * tstep : cA; const char* nB = has_next ? (const char*)(nxt.kind ? g.Bt2 : g.Bt) + (size_t)nxt.pn * tstep : cB;
        for (int t = 0; t < nt; t += 2) {
            const bool last = (t == nt - 2);
            const char* a1 = cA + (size_t)(t + 1) * kstep;
            const char* a2 = last ? nA : cA + (size_t)(t + 2) * kstep; const char* b2 = last ? nB : cB + (size_t)(t + 2) * kstep;
            const char* a3 = a2 + kstep; const char* b3 = b2 + kstep;
            if (last && has_next) S.a_ready(nxt);
            if constexpr (SP2) {
            PG8_LDB(B0, 0, 0); PG8_LDB(B1, 0, 1); PG8_SCHED; PG8_LDA(At, 0, 0); PG8_STAGE(PG8_SA(1, 1), a1 + hstep, voffA);
            PG8_WAIT_V(8); PG8_WAIT_L(0); PG8_BAR; PG8_MMA(0, 0, At, B0); PG8_MMA(0, 1, At, B1); PG8_BAR; PG8_SCHED;
            PG8_LDA(At, 0, 1); PG8_STAGE(PG8_SB(0, 0), b2, voffB); PG8_STAGE(PG8_SB(0, 1), b2 + hstep, voffB); PG8_STAGE(PG8_SA(0, 0), a2, voffA);
            PG8_WAIT_V(8); PG8_WAIT_L(0); PG8_BAR; PG8_MMA(1, 0, At, B0); PG8_MMA(1, 1, At, B1); PG8_BAR; PG8_SCHED;
            PG8_LDB(B0, 1, 0); PG8_LDB(B1, 1, 1); PG8_SCHED; PG8_LDA(At, 1, 0); PG8_STAGE(PG8_SA(0, 1), a2 + hstep, voffA);
            PG8_WAIT_V(8); PG8_WAIT_L(0); PG8_BAR; PG8_MMA(0, 0, At, B0); PG8_MMA(0, 1, At, B1); PG8_BAR; PG8_SCHED;
            PG8_LDA(At, 1, 1); PG8_STAGE(PG8_SB(1, 0), b3, voffB); PG8_STAGE(PG8_SB(1, 1), b3 + hstep, voffB); PG8_STAGE(PG8_SA(1, 0), a3, voffA);
            PG8_WAIT_V(8); PG8_WAIT_L(0); PG8_BAR; PG8_MMA(1, 0, At, B0); PG8_MMA(1, 1, At, B1); PG8_BAR; PG8_SCHED;
            } else {
            PG8_LDB(B0, 0, 0); PG8_SCHED; PG8_LDA(At, 0, 0); PG8_STAGE(PG8_SA(1, 1), a1 + hstep, voffA);
            PG8_WAIT_L(8); PG8_BAR; PG8_WAIT_L(0); PG8_MMA(0, 0, At, B0); PG8_BAR; PG8_SCHED;
            PG8_LDB(B1, 0, 1); PG8_STAGE(PG8_SB(0, 0), b2, voffB);
            PG8_BAR; PG8_WAIT_L(0); PG8_MMA(0, 1, At, B1); PG8_BAR;
            PG8_LDA(At, 0, 1); PG8_STAGE(PG8_SA(0, 0), a2, voffA);
            PG8_BAR; PG8_WAIT_L(0); PG8_MMA(1, 0, At, B0); PG8_BAR; PG8_SCHED;
            PG8_STAGE(PG8_SB(0, 1), b2 + hstep, voffB);
            PG8_WAIT_V(6); PG8_BAR; PG8_MMA(1, 1, At, B1); PG8_BAR;
            PG8_LDB(B0, 1, 0); PG8_SCHED; PG8_LDA(At, 1, 0); PG8_STAGE(PG8_SA(0, 1), a2 + hstep, voffA);
            PG8_WAIT_L(8); PG8_BAR; PG8_WAIT_L(0); PG8_MMA(0, 0, At, B0); PG8_BAR; PG8_SCHED;
            PG8_LDB(B1, 1, 1); PG8_STAGE(PG8_SB(1, 0), b3, voffB);
            PG8_BAR; PG8_WAIT_L(0); PG8_MMA(0, 1, At, B1); PG8_BAR;
            PG8_LDA(At, 1, 1); PG8_STAGE(PG8_SA(1, 0), a3, voffA);
            PG8_BAR; PG8_WAIT_L(0); PG8_MMA(1, 0, At, B0); PG8_BAR; PG8_SCHED;
            PG8_STAGE(PG8_SB(1, 1), b3 + hstep, voffB);
            PG8_WAIT_V(6); PG8_BAR; PG8_MMA(1, 1, At, B1); PG8_BAR;
            }
        }
        if constexpr (ALIGN_EPI) { if (wr == 0) PG8_BAR; }
        if constexpr (!Epi::AFTER_DRAIN) { E(acc, cur, wr, wc, fr, fq); S.done(cur); }
        if (!has_next) break;
#pragma unroll
        for (int a = 0; a < 2; ++a)
#pragma unroll
            for (int b = 0; b < 2; ++b)
#pragma unroll
                for (int m = 0; m < 4; ++m)
#pragma unroll
                    for (int n = 0; n < 2; ++n) acc[a][b][m][n] = (f32x4){0.f, 0.f, 0.f, 0.f};
        cur = nxt; cA = nA; cB = nB; ++ui;
        if constexpr (ALIGN_EPI) { if (wr == 1) PG8_BAR; }
    }
    PG8_WAIT_V(0);
    if constexpr (!ALIGN_EPI) { if (wr == 0) PG8_BAR; }
    PG8_BAR;
    if constexpr (Epi::AFTER_DRAIN) { E.fused(acc, cur, wr, wc, fr, fq, lds, wid, lane); S.done(cur); }
#undef PG8_SA
#undef PG8_SB
#undef PG8_STAGE
#undef PG8_LDA
#undef PG8_LDB
#undef PG8_MMA
#undef PG8_WAIT_V
#undef PG8_WAIT_L
#undef PG8_BAR
#undef PG8_SCHED
}
}
namespace pg8 {
struct DualOrder {
    StaticOrder s1, s2; int G, c;
    __host__ __device__ void init(int M1, int N1, int M2, int N2, int G_, int c_) { s1.init(M1, N1, 1, 0); s2.init(M2, N2, 1, 0); G = G_; c = c_; }
    __host__ __device__ bool next(int i, Unit& u) const {
        const long L = (long)i * G + c; if (L >= s1.nwg + s2.nwg) return false;
        if (L < s1.nwg) { s1.next((int)L, u); u.kind = 0; } else { s2.next((int)(L - s1.nwg), u); u.kind = 1; }
        u.ui = i; return true;
    }
    __device__ __forceinline__ void a_ready(const Unit&) const {}
    __device__ __forceinline__ void done(const Unit&) const {}
};
__device__ __forceinline__ float row_rstd(const float* ss, int row) {
    const f32x4* p = (const f32x4*)(ss + (size_t)row * 16);
    const f32x4 a = p[0], b = p[1], c = p[2], d = p[3];
    const float s = (((a[0] + a[1]) + (a[2] + a[3])) + ((b[0] + b[1]) + (b[2] + b[3]))) + (((c[0] + c[1]) + (c[2] + c[3])) + ((d[0] + d[1]) + (d[2] + d[3])));
    return rsqrtf(s * (1.0f / 1024.0f) + 1e-6f);
}
__device__ __forceinline__ u32x4 pack8(f32x4 v0, f32x4 v1) { u32x4 w; w.x = cvt_pk_bf16(v0[0], v0[1]); w.y = cvt_pk_bf16(v0[2], v0[3]); w.z = cvt_pk_bf16(v1[0], v1[1]); w.w = cvt_pk_bf16(v1[2], v1[3]); return w; }

template <int ACT  > struct EpiBf {
    static constexpr bool PERM = true, AFTER_DRAIN = false;
    bf16_t* O; int ldc; const PG8_LAS float* rs; float mul;
    __device__ __forceinline__ void operator()(const f32x4 (&acc)[2][2][4][2], const Unit& u, int wr, int wc, int fr, int fq) const {
        const int row0 = u.pm * BM + wr * 64 + fr, col0 = u.pn * BM + wc * 32 + 8 * fq;
#pragma unroll
        for (int ai = 0; ai < 2; ++ai)
#pragma unroll
            for (int m = 0; m < 4; ++m) { const int row = row0 + ai * HALF + m * 16; const float sc = rs ? mul * rs[256 * u.ui + ai * HALF + wr * 64 + m * 16 + fr] : mul; bf16_t* rowp = O + (size_t)row * ldc + col0;
#pragma unroll
                for (int bj = 0; bj < 2; ++bj) { f32x4 v0 = acc[ai][bj][m][0] * sc, v1 = acc[ai][bj][m][1] * sc;
                    if (ACT == 1) {
#pragma unroll
                        for (int j = 0; j < 4; ++j) { const float a = fmaxf(v0[j], 0.f), b = fmaxf(v1[j], 0.f); v0[j] = a * a; v1[j] = b * b; } }
                    *(u32x4*)(rowp + bj * HALF) = pack8(v0, v1); } }
    }
};
struct EpiF32 {
    static constexpr bool PERM = true, AFTER_DRAIN = false;
    float* C; int ldc;
    __device__ __forceinline__ void operator()(const f32x4 (&acc)[2][2][4][2], const Unit& u, int wr, int wc, int fr, int fq) const {
        const int row0 = u.pm * BM + wr * 64 + fr, col0 = u.pn * BM + wc * 32 + 8 * fq;
#pragma unroll
        for (int ai = 0; ai < 2; ++ai)
#pragma unroll
            for (int m = 0; m < 4; ++m) { float* rowp = C + (size_t)(row0 + ai * HALF + m * 16) * ldc + col0;
#pragma unroll
                for (int bj = 0; bj < 2; ++bj) { *(f32x4*)(rowp + bj * HALF) = acc[ai][bj][m][0]; *(f32x4*)(rowp + bj * HALF + 4) = acc[ai][bj][m][1]; } }
    }
};
template <bool F32RES> struct EpiRes {
    static constexpr bool PERM = true, AFTER_DRAIN = false;
    bf16_t* xh; float* ssout; const float* r32;
    __device__ __forceinline__ void operator()(const f32x4 (&acc)[2][2][4][2], const Unit& u, int wr, int wc, int fr, int fq) const {
        const int row0 = u.pm * BM + wr * 64 + fr, col0 = u.pn * BM + wc * 32 + 8 * fq;
#pragma unroll
        for (int ai = 0; ai < 2; ++ai) {
            u32x4 pre[4][2]; f32x4 pf[4][2][2];
#pragma unroll
            for (int m = 0; m < 4; ++m)
#pragma unroll
                for (int bj = 0; bj < 2; ++bj) { const size_t off = (size_t)(row0 + ai * HALF + m * 16) * 1024 + col0 + bj * HALF;
                    if (F32RES) { pf[m][bj][0] = *(const f32x4*)(r32 + off); pf[m][bj][1] = *(const f32x4*)(r32 + off + 4); } else pre[m][bj] = *(const u32x4*)(xh + off); }
            asm volatile("" ::: "memory"); __builtin_amdgcn_sched_barrier(0);
#pragma unroll
            for (int m = 0; m < 4; ++m) { const int row = row0 + ai * HALF + m * 16; float q = 0.f;
#pragma unroll
                for (int bj = 0; bj < 2; ++bj) { const size_t off = (size_t)row * 1024 + col0 + bj * HALF; f32x4 r0, r1;
                    if (F32RES) { r0 = pf[m][bj][0]; r1 = pf[m][bj][1]; }
                    else { const u32x4 p = pre[m][bj];
                        r0 = (f32x4){__uint_as_float(p.x << 16), __uint_as_float(p.x & 0xffff0000u), __uint_as_float(p.y << 16), __uint_as_float(p.y & 0xffff0000u)};
                        r1 = (f32x4){__uint_as_float(p.z << 16), __uint_as_float(p.z & 0xffff0000u), __uint_as_float(p.w << 16), __uint_as_float(p.w & 0xffff0000u)}; }
                    const f32x4 v0 = acc[ai][bj][m][0] + r0, v1 = acc[ai][bj][m][1] + r1;
                    q += ((v0[0] * v0[0] + v0[1] * v0[1]) + (v0[2] * v0[2] + v0[3] * v0[3])) + ((v1[0] * v1[0] + v1[1] * v1[1]) + (v1[2] * v1[2] + v1[3] * v1[3]));
                    *(u32x4*)(xh + off) = pack8(v0, v1); }
                q += __shfl_xor(q, 16); q += __shfl_xor(q, 32);
                if (fq == 0) ssout[(size_t)row * 16 + u.pn * 4 + wc] = q; }
            asm volatile("" ::: "memory"); __builtin_amdgcn_sched_barrier(0); }
    }
};
struct EpiInA {
    static constexpr bool PERM = true, AFTER_DRAIN = false;
    bf16_t* z; float* ba; const PG8_LAS float* rs;
    __device__ __forceinline__ void operator()(const f32x4 (&acc)[2][2][4][2], const Unit& u, int wr, int wc, int fr, int fq) const {
        const int row0 = u.pm * BM + wr * 64 + fr, col0 = u.pn * BM + wc * 32 + 8 * fq;
#pragma unroll
        for (int ai = 0; ai < 2; ++ai)
#pragma unroll
            for (int m = 0; m < 4; ++m) { const int row = row0 + ai * HALF + m * 16; const float sc = rs[256 * u.ui + ai * HALF + wr * 64 + m * 16 + fr];
                if (u.pn < 10) { bf16_t* rowp = z + (size_t)row * 2560 + col0;
#pragma unroll
                    for (int bj = 0; bj < 2; ++bj) *(u32x4*)(rowp + bj * HALF) = pack8(acc[ai][bj][m][0] * sc, acc[ai][bj][m][1] * sc);
                } else if (wc == 0 && fq == 0) { *(f32x4*)(ba + (size_t)row * 8) = acc[ai][0][m][0] * sc; *(f32x4*)(ba + (size_t)row * 8 + 4) = acc[ai][0][m][1] * sc; } }
    }
};
struct EpiInC {
    static constexpr bool PERM = true, AFTER_DRAIN = false;
    bf16_t* q; bf16_t* kv; float* gates; const PG8_LAS float* rs;
    __device__ __forceinline__ void operator()(const f32x4 (&acc)[2][2][4][2], const Unit& u, int wr, int wc, int fr, int fq) const {
        const int row0 = u.pm * BM + wr * 64 + fr, col0 = u.pn * BM + wc * 32 + 8 * fq;
#pragma unroll
        for (int ai = 0; ai < 2; ++ai)
#pragma unroll
            for (int m = 0; m < 4; ++m) { const int row = row0 + ai * HALF + m * 16; const float sc = rs[256 * u.ui + ai * HALF + wr * 64 + m * 16 + fr];
                if (u.pn < 4) { bf16_t* rowp = q + (size_t)row * 1024 + col0; const float sq = sc * 0.18033688011112042f;
#pragma unroll
                    for (int bj = 0; bj < 2; ++bj) *(u32x4*)(rowp + bj * HALF) = pack8(acc[ai][bj][m][0] * sq, acc[ai][bj][m][1] * sq);
                } else if (u.pn < 10) { const int b = row >> 12, s = row & 4095;
#pragma unroll
                    for (int bj = 0; bj < 2; ++bj) { const int cp = col0 + bj * HALF - 1024, kind = cp >> 8, g = (cp >> 6) & 3, d = cp & 63;
                        *(u32x4*)(kv + (size_t)kind * ((size_t)32768 * 256) + ((size_t)((b * 4 + g) * 4096 + s)) * 64 + d) = pack8(acc[ai][bj][m][0] * sc, acc[ai][bj][m][1] * sc); }
                } else { const int cl = wc * 32 + 8 * fq; if (cl < 48) { *(f32x4*)(gates + (size_t)row * 48 + cl) = acc[ai][0][m][0] * sc; *(f32x4*)(gates + (size_t)row * 48 + cl + 4) = acc[ai][0][m][1] * sc; } } }
    }
};
template <class E0, class E1> struct EpiDual {
    static constexpr bool PERM = true, AFTER_DRAIN = false;
    E0 e0; E1 e1;
    __device__ __forceinline__ void operator()(const f32x4 (&acc)[2][2][4][2], const Unit& u, int wr, int wc, int fr, int fq) const { if (u.kind) e1(acc, u, wr, wc, fr, fq); else e0(acc, u, wr, wc, fr, fq); }
};
}
#define LAS __attribute__((address_space(3)))
typedef unsigned short bf16;
typedef float f32x4 __attribute__((ext_vector_type(4)));
typedef unsigned v4u __attribute__((ext_vector_type(4)));
typedef unsigned v2u __attribute__((ext_vector_type(2)));
typedef short bf16x8 __attribute__((ext_vector_type(8)));
typedef float f32x16 __attribute__((ext_vector_type(16)));
typedef short v4i16 __attribute__((ext_vector_type(4)));
typedef float f32x2_t __attribute__((ext_vector_type(2))); typedef __bf16 bf16x2_t __attribute__((ext_vector_type(2)));
__device__ __forceinline__ unsigned cvtpk(float lo, float hi) { f32x2_t v = {lo, hi}; bf16x2_t b = __builtin_convertvector(v, bf16x2_t); return __builtin_bit_cast(unsigned, b); }

constexpr int NWAVES = 8, NTHR = 512;
constexpr int T = 32768, SEQ = 4096, DM = 1024, FF = 4096;
constexpr int LDS_BYTES = 147456;
constexpr float EPS = 1e-6f;

enum { I_X = 0, I_MEM, I_A_LN, I_A_WIN, I_A_POOLW, I_A_POOLS, I_A_CONV, I_A_ALOG, I_A_DTB, I_A_ONORM, I_A_WOUT,
       I_C_LN, I_C_WIN, I_C_PEK, I_C_W1K, I_C_W2K, I_C_PEV, I_C_W1V, I_C_W2V, I_C_WOUT,
       I_XA_LN, I_XA_MLN, I_XA_WQ, I_XA_WK, I_XA_WV, I_XA_WO, I_FF_LN, I_FF_W1, I_FF_W2, I_FLN, N_IN };

constexpr size_t MiB = (size_t)1 << 20;
constexpr size_t WS_AIN = 0, WS_AOUT = 6 * MiB, WS_CIN = 8 * MiB, WS_COUT = 14 * MiB, WS_XQ = 16 * MiB, WS_XKV = 20 * MiB, WS_XO = 28 * MiB;
constexpr size_t WS_F1 = 32 * MiB, WS_F2 = 48 * MiB, WS_CMPK = 64 * MiB, WS_CMPV = 64 * MiB + 512 * 1024, WS_CBIAS = 65 * MiB;
constexpr size_t WS_MEMH = 66 * MiB, WS_MEMKV = 74 * MiB, WS_SS = 90 * MiB, WS_BA = 92 * MiB, WS_GATES = 93 * MiB, WS_CK = 99 * MiB, WS_CV = 100 * MiB;
constexpr size_t WS_P01K = 101 * MiB, WS_P01V = 109 * MiB, WS_POOLW = 117 * MiB;
constexpr size_t WS_Z = 120 * MiB, WS_Y = 280 * MiB, WS_QXA = 344 * MiB, WS_XH = 408 * MiB, WS_HMID = 120 * MiB, WS_END = 489 * MiB;
constexpr size_t KV_KIND = (size_t)T * 256;

struct Params { const float* in[N_IN]; float* out; unsigned char* ws; int ph_lo, ph_hi; };

__device__ __forceinline__ float bf2f(unsigned v) { return __uint_as_float(v << 16); }
__device__ __forceinline__ unsigned f2bf(float f) { unsigned u = __float_as_uint(f); return (u + 0x7fffu + ((u >> 16) & 1u)) >> 16; }
__device__ __forceinline__ unsigned pk2(float lo, float hi) { return f2bf(lo) | (f2bf(hi) << 16); }
__device__ __forceinline__ float wave_sum(float v) {
#pragma unroll
    for (int o = 1; o < 64; o <<= 1) v += __shfl_xor(v, o);
    return v;
}
__device__ __forceinline__ float wave_max(float v) {
#pragma unroll
    for (int o = 1; o < 64; o <<= 1) v = fmaxf(v, __shfl_xor(v, o));
    return v;
}
__device__ __forceinline__ float silu_f(float x) { return x / (1.f + __expf(-x)); }
__device__ __forceinline__ float sigmoid_f(float x) { return 1.f / (1.f + __expf(-x)); }
#define LDS_WAIT() asm volatile("s_waitcnt lgkmcnt(0)" ::: "memory")

__device__ __forceinline__ void transpose_item(const float* W, int K, int N, int ld, const float* gain, bf16* WT, int row_off, LAS float* scr, int item, int lane) {
    const int nblk = N / 32, kb = item / nblk, nb = item % nblk, k0 = 64 * kb, n0 = 32 * nb;
#pragma unroll
    for (int i = 0; i < 8; ++i) { const int kk = 8 * i + (lane >> 3), nn = (lane & 7) * 4; f32x4 v = *(const f32x4*)(W + (size_t)(k0 + kk) * ld + n0 + nn); if (gain) v = v * gain[k0 + kk];
        scr[kk * 33 + nn] = v.x; scr[kk * 33 + nn + 1] = v.y; scr[kk * 33 + nn + 2] = v.z; scr[kk * 33 + nn + 3] = v.w; }
    LDS_WAIT();
    const int c = lane & 7;
#pragma unroll
    for (int j = 0; j < 4; ++j) { const int n = (lane >> 3) + 8 * j; const LAS float* s = scr + (8 * c) * 33 + n;
        v4u o; o.x = pk2(s[0 * 33], s[1 * 33]); o.y = pk2(s[2 * 33], s[3 * 33]); o.z = pk2(s[4 * 33], s[5 * 33]); o.w = pk2(s[6 * 33], s[7 * 33]);
        *(v4u*)(WT + (size_t)(row_off + n0 + n) * K + k0 + 8 * c) = o; }
    LDS_WAIT();
}
#define TJOB(W_, K_, N_, LD_, G_, WT_, RO_) { const int ni_ = ((K_) / 64) * ((N_) / 32); if (r < ni_) { transpose_item((W_), (K_), (N_), (LD_), (G_), (WT_), (RO_), scr, r, lane); continue; } r -= ni_; }

__device__ __forceinline__ void phase_prologue(const Params& P, LAS unsigned char* lds) {
    int tid_l = threadIdx.x; asm volatile("" : "+v"(tid_l)); const int tid = tid_l, lane = tid & 63, wave = tid >> 6;
    const int gw = blockIdx.x * NWAVES + wave, NGW = gridDim.x * NWAVES;
    unsigned char* ws = P.ws;
    LAS float* scr = (LAS float*)(lds + wave * 16384);
    constexpr int NITEMS = 1280 + 512 + 1280 + 512 + 4 * 512 + 512 + 2048 + 2048 + 4 * 64;
    for (int it = gw; it < NITEMS; it += NGW) {
        int r = it;
        TJOB(P.in[I_A_WIN], 1024, 2560, 2568, P.in[I_A_LN], (bf16*)(ws + WS_AIN), 0)
        TJOB(P.in[I_A_WOUT], 1024, 1024, 1024, nullptr, (bf16*)(ws + WS_AOUT), 0)
        TJOB(P.in[I_C_WIN], 1024, 2560, 2608, P.in[I_C_LN], (bf16*)(ws + WS_CIN), 0)
        TJOB(P.in[I_XA_WQ], 1024, 1024, 1024, P.in[I_XA_LN], (bf16*)(ws + WS_XQ), 0)
        TJOB(P.in[I_XA_WK], 1024, 1024, 1024, P.in[I_XA_MLN], (bf16*)(ws + WS_XKV), 0)
        TJOB(P.in[I_XA_WV], 1024, 1024, 1024, P.in[I_XA_MLN], (bf16*)(ws + WS_XKV), 1024)
        TJOB(P.in[I_XA_WK] + 1048576, 1024, 1024, 1024, P.in[I_XA_MLN] + 1024, (bf16*)(ws + WS_XKV) + 2097152, 0)
        TJOB(P.in[I_XA_WV] + 1048576, 1024, 1024, 1024, P.in[I_XA_MLN] + 1024, (bf16*)(ws + WS_XKV) + 2097152, 1024)
        TJOB(P.in[I_XA_WO], 1024, 1024, 1024, nullptr, (bf16*)(ws + WS_XO), 0)
        TJOB(P.in[I_FF_W1], 1024, 4096, 4096, P.in[I_FF_LN], (bf16*)(ws + WS_F1), 0)
        TJOB(P.in[I_FF_W2], 4096, 1024, 1024, nullptr, (bf16*)(ws + WS_F2), 0)
        TJOB(P.in[I_C_W1K], 1024, 128, 128, nullptr, (bf16*)(ws + WS_CMPK), 0)
        TJOB(P.in[I_C_W1K] + 131072, 1024, 128, 128, nullptr, (bf16*)(ws + WS_CMPK), 128)
        TJOB(P.in[I_C_W1V], 1024, 128, 128, nullptr, (bf16*)(ws + WS_CMPV), 0)
        TJOB(P.in[I_C_W1V] + 131072, 1024, 128, 128, nullptr, (bf16*)(ws + WS_CMPV), 128)
    }
    const int gt = blockIdx.x * NTHR + tid, NGT = gridDim.x * NTHR;
    for (int i = gt; i < 56 * 1024; i += NGT) { const int j = i >> 10, kk = i & 1023;
        if (j < 8) ((bf16*)(ws + WS_AIN))[(size_t)(2560 + j) * 1024 + kk] = (bf16)f2bf(P.in[I_A_LN][kk] * P.in[I_A_WIN][(size_t)kk * 2568 + 2560 + j]);
        else ((bf16*)(ws + WS_CIN))[(size_t)(2560 + j - 8) * 1024 + kk] = (bf16)f2bf(P.in[I_C_LN][kk] * P.in[I_C_WIN][(size_t)kk * 2608 + 2560 + j - 8]); }
    for (int i = gt; i < (248 + 208) * 128; i += NGT) { const int row = i >> 7, pc = i & 127; const v4u z4 = {0u, 0u, 0u, 0u};
        if (row < 248) *(v4u*)((bf16*)(ws + WS_AIN) + (size_t)(2568 + row) * 1024 + pc * 8) = z4; else *(v4u*)((bf16*)(ws + WS_CIN) + (size_t)(2608 + row - 248) * 1024 + pc * 8) = z4; }
    for (int i = gt; i < 4 * 128 * 128; i += NGT) { const int g = i >> 14, d = (i >> 7) & 127, c = i & 127; ((bf16*)(ws + WS_POOLW))[i] = (bf16)f2bf(P.in[I_A_POOLW][(size_t)g * 16384 + c * 128 + d] * P.in[I_A_POOLS][g * 128 + d]); }
    if (gw < 256) { const int n = gw & 127; const float* pe = gw < 128 ? P.in[I_C_PEK] : P.in[I_C_PEV]; const float* w1 = gw < 128 ? P.in[I_C_W1K] : P.in[I_C_W1V];
        float s = 0.f;
#pragma unroll 8
        for (int j = 0; j < 32; ++j) { const int i = lane + 64 * j; s += pe[i] * w1[(size_t)i * 128 + n]; }
        s = wave_sum(s); if (lane == 0) ((float*)(ws + WS_CBIAS))[gw] = s; }
    { bf16* xh = (bf16*)(ws + WS_XH); float* ss = (float*)(ws + WS_SS);
      for (int m0 = gw; m0 < T; m0 += 4 * NGW) { f32x4 v[4][4];
#pragma unroll
          for (int u = 0; u < 4; ++u) { const int m = m0 + u * NGW; if (m < T) { const f32x4* xr = (const f32x4*)(P.in[I_X] + (size_t)m * DM) + lane;
#pragma unroll
                  for (int j = 0; j < 4; ++j) v[u][j] = xr[64 * j]; } }
#pragma unroll
          for (int u = 0; u < 4; ++u) { const int m = m0 + u * NGW; if (m >= T) break; float s = 0.f;
#pragma unroll
              for (int j = 0; j < 4; ++j) s += (v[u][j].x * v[u][j].x + v[u][j].y * v[u][j].y) + (v[u][j].z * v[u][j].z + v[u][j].w * v[u][j].w);
              s = wave_sum(s);
              v2u* o8 = (v2u*)(xh + (size_t)m * DM) + lane;
#pragma unroll
              for (int j = 0; j < 4; ++j) { v2u w; w.x = pk2(v[u][j].x, v[u][j].y); w.y = pk2(v[u][j].z, v[u][j].w); o8[64 * j] = w; }
              if (lane < 16) ss[(size_t)m * 16 + lane] = lane == 0 ? s : 0.f; } } }
    { bf16* mh = (bf16*)(ws + WS_MEMH);
      for (int m = gw; m < 2048; m += NGW) { const f32x4* xr = (const f32x4*)(P.in[I_MEM] + (size_t)m * DM) + lane; f32x4 v[4]; float s = 0.f;
#pragma unroll
          for (int j = 0; j < 4; ++j) { v[j] = xr[64 * j]; s += (v[j].x * v[j].x + v[j].y * v[j].y) + (v[j].z * v[j].z + v[j].w * v[j].w); }
          const float rs = rsqrtf(wave_sum(s) * (1.f / DM) + EPS);
          v2u* o8 = (v2u*)(mh + (size_t)m * DM) + lane;
#pragma unroll
          for (int j = 0; j < 4; ++j) { v2u w; w.x = pk2(v[j].x * rs, v[j].y * rs); w.y = pk2(v[j].z * rs, v[j].w * rs); o8[64 * j] = w; } } }
}

__device__ __forceinline__ void phase_conv_late(const Params& P, LAS unsigned char* lds, int gw, int NGW) {
    const int tid = threadIdx.x, lane = tid & 63, wave = tid >> 6; unsigned char* ws = P.ws;
    LAS float* scr = (LAS float*)(lds + wave * 16384);
    constexpr int NITEMS = 512 + 512 + 512 + 2048 + 2048;
    for (int it = gw; it < NITEMS; it += NGW) {
        int r = it;
        TJOB(P.in[I_C_WOUT], 1024, 1024, 1024, nullptr, (bf16*)(ws + WS_COUT), 0)
        TJOB(P.in[I_XA_WQ] + 1048576, 1024, 1024, 1024, P.in[I_XA_LN] + 1024, (bf16*)(ws + WS_XQ) + 1048576, 0)
        TJOB(P.in[I_XA_WO] + 1048576, 1024, 1024, 1024, nullptr, (bf16*)(ws + WS_XO) + 1048576, 0)
        TJOB(P.in[I_FF_W1] + 4194304, 1024, 4096, 4096, P.in[I_FF_LN] + 1024, (bf16*)(ws + WS_F1) + 4194304, 0)
        TJOB(P.in[I_FF_W2] + 4194304, 4096, 1024, 1024, nullptr, (bf16*)(ws + WS_F2) + 4194304, 0)
    }
}
__device__ __forceinline__ void phase_gates(const Params& P, LAS unsigned char* lds, int gw, int NGW) {
    const int tid = threadIdx.x, lane = tid & 63; unsigned char* ws = P.ws;
    const bf16* wg = (const bf16*)(ws + WS_CIN) + (size_t)2560 * 1024; const bf16* xh = (const bf16*)(ws + WS_XH); const float* ss = (const float*)(ws + WS_SS); float* gates = (float*)(ws + WS_GATES);
    for (int p = tid; p < 48 * 128; p += NTHR) *(LAS v4u*)(lds + p * 16) = *(const v4u*)(wg + (size_t)p * 8);
    __syncthreads();
    for (int rg = gw; rg < T / 16; rg += NGW) { const int t0 = rg * 16;
        f32x4 acc[3] = {{0.f, 0.f, 0.f, 0.f}, {0.f, 0.f, 0.f, 0.f}, {0.f, 0.f, 0.f, 0.f}};
        const bf16* ap = xh + (size_t)(t0 + (lane & 15)) * DM + 8 * (lane >> 4); LAS const unsigned char* bp = lds + (lane & 15) * 2048 + (lane >> 4) * 16;
#pragma unroll 4
        for (int ks = 0; ks < 32; ++ks) { const bf16x8 a = *(const bf16x8*)(ap + 32 * ks);
#pragma unroll
            for (int ct = 0; ct < 3; ++ct) acc[ct] = __builtin_amdgcn_mfma_f32_16x16x32_bf16(a, *(const LAS bf16x8*)(bp + ct * 32768 + ks * 64), acc[ct], 0, 0, 0); }
#pragma unroll
        for (int r = 0; r < 4; ++r) { const int t = t0 + 4 * (lane >> 4) + r; const float rs = pg8::row_rstd(ss, t);
#pragma unroll
            for (int ct = 0; ct < 3; ++ct) gates[(size_t)t * 48 + ct * 16 + (lane & 15)] = acc[ct][r] * rs; } }
    __syncthreads();
}
__device__ __forceinline__ void phase_final(const Params& P) {
    const int tid = threadIdx.x, lane = tid & 63, wave = tid >> 6;
    const int gw = blockIdx.x * NWAVES + wave, NGW = gridDim.x * NWAVES;
    const float* ss = (const float*)(P.ws + WS_SS); const bf16* xh = (const bf16*)(P.ws + WS_XH);
    for (int m = gw; m < T; m += NGW) { f32x4* orow = (f32x4*)(P.out + (size_t)m * DM); const f32x4* gr = (const f32x4*)P.in[I_FLN];
        const float rs = pg8::row_rstd(ss, m);
#pragma unroll
        for (int j = 0; j < 2; ++j) { const v4u p = *(const v4u*)(xh + (size_t)m * DM + (j * 64 + lane) * 8); const f32x4 g0 = gr[(j * 64 + lane) * 2], g1 = gr[(j * 64 + lane) * 2 + 1];
            orow[(j * 64 + lane) * 2] = (f32x4){bf2f(p.x & 0xffff) * rs * g0.x, bf2f(p.x >> 16) * rs * g0.y, bf2f(p.y & 0xffff) * rs * g0.z, bf2f(p.y >> 16) * rs * g0.w};
            orow[(j * 64 + lane) * 2 + 1] = (f32x4){bf2f(p.z & 0xffff) * rs * g1.x, bf2f(p.z >> 16) * rs * g1.y, bf2f(p.w & 0xffff) * rs * g1.z, bf2f(p.w >> 16) * rs * g1.w}; } }
}
__device__ __forceinline__ void phase_pool(const Params& P, LAS unsigned char* lds) {
    int tid_l = threadIdx.x; asm volatile("" : "+v"(tid_l)); const int tid = tid_l, lane = tid & 63, wave = tid >> 6; const int g = blockIdx.x & 3, win = 2 << g;
    const bf16* z = (const bf16*)(P.ws + WS_Z); bf16* y = (bf16*)(P.ws + WS_Y);
    LAS unsigned short* ur = (LAS unsigned short*)lds;
    LAS unsigned char* yp = lds + 20480;
    const int nt = wave & 3, mt = wave >> 2, q = lane & 31, h = lane >> 5;
    bf16x8 bfr[8];
    { const bf16* bt = (const bf16*)(P.ws + WS_POOLW) + (size_t)g * 16384 + (size_t)(nt * 32 + q) * 128 + 8 * h;
#pragma unroll
      for (int ks = 0; ks < 8; ++ks) bfr[ks] = *(const bf16x8*)(bt + 16 * ks); }
    v4u pre[3];
#define POOL_LOAD(it_) { const int t0_ = ((it_) >> 2) * 64, s0_ = t0_ & (SEQ - 1); _Pragma("unroll") for (int j = 0; j < 3; ++j) { const int p = tid + 512 * j, row = p >> 4, pc = p & 15; pre[j] = (v4u){0u, 0u, 0u, 0u}; \
        if (p < 79 * 16 && s0_ + row - 15 >= 0) pre[j] = *(const v4u*)(z + (size_t)(t0_ + row - 15) * 2560 + g * 128 + pc * 8); } }
    int it = blockIdx.x; if (it < 2048) POOL_LOAD(it)
    for (; it < 2048; it += gridDim.x) { const int t0 = (it >> 2) * 64, s0 = t0 & (SEQ - 1);
#pragma unroll
        for (int j = 0; j < 3; ++j) { const int p = tid + 512 * j; if (p < 79 * 16) *(LAS v4u*)(lds + (p >> 4) * 256 + (p & 15) * 16) = pre[j]; }
        __syncthreads();
        if (it + (int)gridDim.x < 2048) POOL_LOAD(it + (int)gridDim.x)
        { const int c = tid & 127, tq = tid >> 7; float sum = 0.f;
          for (int j = 1; j < win; ++j) sum += bf2f(ur[(tq * 16 + 15 - j) * 128 + c]);
#pragma unroll 4
          for (int i = 0; i < 16; ++i) { const int tl = tq * 16 + i, s = s0 + tl; const float u = bf2f(ur[(tl + 15) * 128 + c]); sum += u;
              const float cnt = (float)((s + 1 < win) ? s + 1 : win);
              *(LAS unsigned short*)(yp + tl * 272 + c * 2) = (unsigned short)f2bf(sum / cnt - u);
              sum -= bf2f(ur[(tl + 16 - win) * 128 + c]); } }
        __syncthreads();
        { f32x16 acc;
#pragma unroll
          for (int r = 0; r < 16; ++r) acc[r] = 0.f;
          LAS const unsigned char* ap = yp + (mt * 32 + q) * 272 + h * 16;
#pragma unroll
          for (int ks = 0; ks < 8; ++ks) acc = __builtin_amdgcn_mfma_f32_32x32x16_bf16(bfr[ks], *(const LAS bf16x8*)(ap + ks * 32), acc, 0, 0, 0);
          bf16* yo = y + (size_t)(t0 + mt * 32 + q) * DM + g * 128 + nt * 32 + 4 * h;
#pragma unroll
          for (int a = 0; a < 4; ++a) { v2u w; w.x = cvtpk(acc[4 * a], acc[4 * a + 1]); w.y = cvtpk(acc[4 * a + 2], acc[4 * a + 3]); *(v2u*)(yo + 8 * a) = w; } }
    }
#undef POOL_LOAD
    __syncthreads();
}
__device__ __forceinline__ void dn_naive_item(const Params& P, LAS unsigned char* lds, int item) {
    int tid_l = threadIdx.x; asm volatile("" : "+v"(tid_l)); const int tid = tid_l, lane = tid & 63, wave = tid >> 6; const int b = item >> 2, h = item & 3;
    const bf16* z = (const bf16*)(P.ws + WS_Z); bf16* y = (bf16*)(P.ws + WS_Y); const float* ba = (const float*)(P.ws + WS_BA);
    LAS float* qs = (LAS float*)lds; LAS float* ks = qs + 8192; LAS float* vs = ks + 8192; LAS float* ot = vs + 8192; LAS float* bet = ot + 8192; LAS float* egs = bet + 64;
    const float* cw = P.in[I_A_CONV];
    const float a_exp = __expf(P.in[I_A_ALOG][h]), dtb = P.in[I_A_DTB][h];
    float Sreg[32];
#pragma unroll
    for (int i = 0; i < 32; ++i) Sreg[i] = 0.f;
    const int kq = tid & 3, dv = tid >> 2;
    for (int n = 0; n < 64; ++n) {
        const int sb = n * 64; const size_t rb = (size_t)b * SEQ;
        for (int idx = tid; idx < 64 * 384; idx += NTHR) { const int tl = idx / 384, cc = idx % 384, part = cc >> 7, d = cc & 127; const int ch = part * 512 + h * 128 + d, s = sb + tl; float a = 0.f;
#pragma unroll
            for (int kk = 0; kk < 4; ++kk) { const int sp = s - 3 + kk; if (sp >= 0) a += cw[kk * 1536 + ch] * bf2f(z[(rb + sp) * 2560 + 512 + ch]); }
            qs[part * 8192 + tl * 128 + d] = silu_f(a); }
        if (tid < 64) { const size_t t = rb + sb + tid; const float bl = ba[t * 8 + h], al = ba[t * 8 + 4 + h] + dtb; const float sp = al > 20.f ? al : log1pf(__expf(al));
            bet[tid] = sigmoid_f(bl); egs[tid] = __expf(-a_exp * sp); }
        __syncthreads();
        for (int r = wave * 16; r < wave * 16 + 16; ++r) { LAS float* row = qs + (r >> 6) * 8192 + (r & 63) * 128; const float a = row[lane], c2 = row[lane + 64];
            const float sc = rsqrtf(wave_sum(a * a + c2 * c2) + EPS); row[lane] = a * sc; row[lane + 64] = c2 * sc; }
        __syncthreads();
        for (int tl = 0; tl < 64; ++tl) {
            float kr[32], kS = 0.f;
#pragma unroll
            for (int i = 0; i < 8; ++i) { const f32x4 v = *(const LAS f32x4*)(ks + tl * 128 + kq * 32 + 4 * i); kr[4 * i] = v.x; kr[4 * i + 1] = v.y; kr[4 * i + 2] = v.z; kr[4 * i + 3] = v.w; }
#pragma unroll
            for (int i = 0; i < 32; ++i) kS += kr[i] * Sreg[i];
            kS += __shfl_xor(kS, 1); kS += __shfl_xor(kS, 2);
            const float e = egs[tl], cf = bet[tl] * (vs[tl * 128 + dv] - e * kS);
            float o = 0.f;
#pragma unroll
            for (int i = 0; i < 8; ++i) { const f32x4 qv = *(const LAS f32x4*)(qs + tl * 128 + kq * 32 + 4 * i);
                Sreg[4 * i] = e * Sreg[4 * i] + kr[4 * i] * cf; Sreg[4 * i + 1] = e * Sreg[4 * i + 1] + kr[4 * i + 1] * cf; Sreg[4 * i + 2] = e * Sreg[4 * i + 2] + kr[4 * i + 2] * cf; Sreg[4 * i + 3] = e * Sreg[4 * i + 3] + kr[4 * i + 3] * cf;
                o += (qv.x * Sreg[4 * i] + qv.y * Sreg[4 * i + 1]) + (qv.z * Sreg[4 * i + 2] + qv.w * Sreg[4 * i + 3]); }
            o += __shfl_xor(o, 1); o += __shfl_xor(o, 2);
            if (kq == 0) ot[tl * 128 + dv] = o * 0.08838834764831845f;
        }
        __syncthreads();
        for (int tl = wave * 8; tl < wave * 8 + 8; ++tl) { const float a = ot[tl * 128 + lane], c2 = ot[tl * 128 + lane + 64]; const float rs = rsqrtf(wave_sum(a * a + c2 * c2) * (1.f / 128.f) + EPS);
            const size_t t = rb + sb + tl; const float g0 = bf2f(z[t * 2560 + 2048 + h * 128 + lane]), g1 = bf2f(z[t * 2560 + 2048 + h * 128 + lane + 64]);
            y[t * DM + 512 + h * 128 + lane] = (bf16)f2bf(a * rs * P.in[I_A_ONORM][lane] * silu_f(g0));
            y[t * DM + 512 + h * 128 + lane + 64] = (bf16)f2bf(c2 * rs * P.in[I_A_ONORM][lane + 64] * silu_f(g1)); }
        __syncthreads();
    }
}

__device__ __forceinline__ void phase_xatt_naive(const Params& P, LAS unsigned char* lds, int l) {
    int tid_l = threadIdx.x; asm volatile("" : "+v"(tid_l)); const int tid = tid_l, lane = tid & 63, wave = tid >> 6;
    const int gw = blockIdx.x * NWAVES + wave, NGW = gridDim.x * NWAVES;
    const bf16* qx = (const bf16*)(P.ws + WS_QXA); const bf16* kv = (const bf16*)(P.ws + WS_MEMKV) + (size_t)l * 2048 * 2048; bf16* y = (bf16*)(P.ws + WS_Y);
    LAS float* qf = (LAS float*)(lds + wave * 8192); LAS float* pw = qf + 1024;
    for (int t = gw; t < T; t += NGW) { const int b = t >> 12;
        { const v4u a = *(const v4u*)(qx + (size_t)t * DM + lane * 16), c = *(const v4u*)(qx + (size_t)t * DM + lane * 16 + 8); LAS float* d = qf + lane * 16;
          d[0] = bf2f(a.x & 0xffff); d[1] = bf2f(a.x >> 16); d[2] = bf2f(a.y & 0xffff); d[3] = bf2f(a.y >> 16); d[4] = bf2f(a.z & 0xffff); d[5] = bf2f(a.z >> 16); d[6] = bf2f(a.w & 0xffff); d[7] = bf2f(a.w >> 16);
          d[8] = bf2f(c.x & 0xffff); d[9] = bf2f(c.x >> 16); d[10] = bf2f(c.y & 0xffff); d[11] = bf2f(c.y >> 16); d[12] = bf2f(c.z & 0xffff); d[13] = bf2f(c.z >> 16); d[14] = bf2f(c.w & 0xffff); d[15] = bf2f(c.w >> 16); }
        LDS_WAIT();
        for (int hh = 0; hh < 4; ++hh) { float sc[4];
#pragma unroll
            for (int i = 0; i < 4; ++i) { const bf16* kr = kv + (size_t)(b * 256 + lane + 64 * i) * 2048 + hh * 256; float s = 0.f;
                for (int c8 = 0; c8 < 32; ++c8) { const v4u kk = *(const v4u*)(kr + c8 * 8); const f32x4 q0 = *(const LAS f32x4*)(qf + hh * 256 + c8 * 8), q1 = *(const LAS f32x4*)(qf + hh * 256 + c8 * 8 + 4);
                    s += (q0.x * bf2f(kk.x & 0xffff) + q0.y * bf2f(kk.x >> 16)) + (q0.z * bf2f(kk.y & 0xffff) + q0.w * bf2f(kk.y >> 16)) + (q1.x * bf2f(kk.z & 0xffff) + q1.y * bf2f(kk.z >> 16)) + (q1.z * bf2f(kk.w & 0xffff) + q1.w * bf2f(kk.w >> 16)); }
                sc[i] = s * 0.0625f; }
            const float mx = wave_max(fmaxf(fmaxf(sc[0], sc[1]), fmaxf(sc[2], sc[3])));
            float ps = 0.f;
#pragma unroll
            for (int i = 0; i < 4; ++i) { sc[i] = __expf(sc[i] - mx); ps += sc[i]; }
            const float inv = 1.f / wave_sum(ps);
#pragma unroll
            for (int i = 0; i < 4; ++i) pw[lane + 64 * i] = sc[i] * inv;
            LDS_WAIT();
            float o0 = 0.f, o1 = 0.f, o2 = 0.f, o3 = 0.f; const bf16* vb = kv + (size_t)(b * 256) * 2048 + 1024 + hh * 256 + lane * 4;
            for (int j = 0; j < 256; ++j) { const v2u vv = *(const v2u*)(vb + (size_t)j * 2048); const float p = pw[j];
                o0 += p * bf2f(vv.x & 0xffff); o1 += p * bf2f(vv.x >> 16); o2 += p * bf2f(vv.y & 0xffff); o3 += p * bf2f(vv.y >> 16); }
            v2u w; w.x = pk2(o0, o1); w.y = pk2(o2, o3); *(v2u*)(y + (size_t)t * DM + hh * 256 + lane * 4) = w;
            LDS_WAIT();
        }
    }
}

__device__ __forceinline__ void cmpfin_bg(const Params& P, LAS unsigned char* lds, int kvs, int bg) {
    const int tid = threadIdx.x, lane = tid & 63, wave = tid >> 6;
    const float* p01 = (const float*)(P.ws + (kvs ? WS_P01V : WS_P01K)) + (size_t)bg * 256 * 256; const float* bias = (const float*)(P.ws + WS_CBIAS) + kvs * 128; const float* w2 = P.in[kvs ? I_C_W2V : I_C_W2K];
    bf16* outp = (bf16*)(P.ws + (kvs ? WS_CV : WS_CK)) + (size_t)bg * 256 * 64;
    LAS float* hb = (LAS float*)(lds + wave * 1024);
    unsigned w2p[64];
#pragma unroll
    for (int j = 0; j < 64; ++j) w2p[j] = pk2(w2[(2 * j) * 64 + lane], w2[(2 * j + 1) * 64 + lane]);
    for (int c = wave; c < 255; c += NWAVES) {
#pragma unroll
        for (int i = 0; i < 2; ++i) { const int j = lane + 64 * i; hb[j] = silu_f(p01[(size_t)c * 256 + j] + p01[(size_t)(c + 1) * 256 + 128 + j] + bias[j]); }
        LDS_WAIT();
        float o0 = 0.f, o1 = 0.f;
#pragma unroll
        for (int j = 0; j < 128; j += 4) { if ((j & 31) == 0) __builtin_amdgcn_sched_barrier(0); const f32x4 hv = *(const LAS f32x4*)(hb + j); const unsigned wa = w2p[j >> 1], wb = w2p[(j >> 1) + 1];
            o0 += hv.x * bf2f(wa & 0xffff) + hv.z * bf2f(wb & 0xffff); o1 += hv.y * __uint_as_float(wa & 0xffff0000u) + hv.w * __uint_as_float(wb & 0xffff0000u); }
        outp[(size_t)c * 64 + lane] = (bf16)f2bf(o0 + o1);
        LDS_WAIT();
    }
}
__device__ __forceinline__ void dot4(const bf16* kr, const LAS float* qf, float (&s)[4]) {
    s[0] = s[1] = s[2] = s[3] = 0.f;
#pragma unroll
    for (int c8 = 0; c8 < 8; ++c8) { const v4u kk = *(const v4u*)(kr + c8 * 8);
        const float k0 = bf2f(kk.x & 0xffff), k1 = bf2f(kk.x >> 16), k2 = bf2f(kk.y & 0xffff), k3 = bf2f(kk.y >> 16), k4 = bf2f(kk.z & 0xffff), k5 = bf2f(kk.z >> 16), k6 = bf2f(kk.w & 0xffff), k7 = bf2f(kk.w >> 16);
#pragma unroll
        for (int r = 0; r < 4; ++r) { const f32x4 q0 = *(const LAS f32x4*)(qf + r * 64 + c8 * 8), q1 = *(const LAS f32x4*)(qf + r * 64 + c8 * 8 + 4);
            s[r] += ((q0.x * k0 + q0.y * k1) + (q0.z * k2 + q0.w * k3)) + ((q1.x * k4 + q1.y * k5) + (q1.z * k6 + q1.w * k7)); } }
}
__device__ __forceinline__ void phase_nsa_naive(const Params& P, LAS unsigned char* lds) {
    int tid_l = threadIdx.x; asm volatile("" : "+v"(tid_l)); const int tid = tid_l, lane = tid & 63, wave = tid >> 6;
    const int gw = blockIdx.x * NWAVES + wave, NGW = gridDim.x * NWAVES;
    const bf16* qb = (const bf16*)(P.ws + WS_Z); const bf16* kvb = qb + (size_t)T * 1024;
    const bf16* ck = (const bf16*)(P.ws + WS_CK); const bf16* cv = (const bf16*)(P.ws + WS_CV);
    const float* gates = (const float*)(P.ws + WS_GATES); bf16* y = (bf16*)(P.ws + WS_Y);
    LAS float* qf = (LAS float*)(lds + wave * 8192); LAS float* pc = qf + 256; LAS float* ps = pc + 1024;
    for (int it = gw; it < 4 * T; it += NGW) {
        const int t = it & 4095, g = (it >> 12) & 3, b = it >> 14; const size_t tg = (size_t)b * SEQ + t; const int bg = b * 4 + g;
        float slope[4];
#pragma unroll
        for (int r = 0; r < 4; ++r) slope[r] = exp2f(-0.5f * (float)(g * 4 + r + 1));
#pragma unroll
        for (int r = 0; r < 4; ++r) qf[r * 64 + lane] = bf2f(qb[tg * 1024 + g * 256 + r * 64 + lane]);
        LDS_WAIT();
        const int ncv = t >= 31 ? ((t - 31) >> 4) + 1 : 0;
#pragma unroll 1
        for (int cc = 0; cc < 4; ++cc) { const int c = lane + 64 * cc; float s[4] = {0.f, 0.f, 0.f, 0.f};
            if (cc * 64 < ncv) dot4(ck + ((size_t)bg * 256 + c) * 64, qf, s);
#pragma unroll
            for (int r = 0; r < 4; ++r) pc[r * 256 + c] = c < ncv ? s[r] * 0.125f - slope[r] * (float)(t - (16 * c + 31)) : -INFINITY; }
        LDS_WAIT();
#pragma unroll 1
        for (int r = 0; r < 4; ++r) { float v0 = pc[r * 256 + lane], v1 = pc[r * 256 + lane + 64], v2 = pc[r * 256 + lane + 128], v3 = pc[r * 256 + lane + 192];
            const float mx = wave_max(fmaxf(fmaxf(v0, v1), fmaxf(v2, v3)));
            v0 = lane < ncv ? __expf(v0 - mx) : 0.f; v1 = lane + 64 < ncv ? __expf(v1 - mx) : 0.f; v2 = lane + 128 < ncv ? __expf(v2 - mx) : 0.f; v3 = lane + 192 < ncv ? __expf(v3 - mx) : 0.f;
            const float sm = wave_sum((v0 + v1) + (v2 + v3)); const float inv = ncv > 0 ? 1.f / sm : 0.f;
            pc[r * 256 + lane] = v0 * inv; pc[r * 256 + lane + 64] = v1 * inv; pc[r * 256 + lane + 128] = v2 * inv; pc[r * 256 + lane + 192] = v3 * inv; }
        LDS_WAIT();
        float osum[4];
        { float ocmp[4] = {0.f, 0.f, 0.f, 0.f};
          const bf16* cvp = cv + (size_t)bg * 256 * 64 + lane;
#pragma unroll 2
          for (int c = 0; c < ncv; ++c) { const float v = bf2f(cvp[c * 64]);
#pragma unroll
              for (int r = 0; r < 4; ++r) ocmp[r] += pc[r * 256 + c] * v; }
#pragma unroll
          for (int r = 0; r < 4; ++r) osum[r] = sigmoid_f(gates[tg * 48 + (g * 4 + r) * 3]) * ocmp[r]; }
        unsigned long long mask;
        { const int n = lane, cur = t >> 6; float imp = 0.f;
#pragma unroll
          for (int r = 0; r < 4; ++r) { const f32x4 v = *(const LAS f32x4*)(pc + r * 256 + 4 * n); imp += v.x + v.y + v.z + 0.5f * v.w; if (n > 0) imp += 0.5f * pc[r * 256 + 4 * n - 1]; }
          const bool forced = (n == 0) || (n == cur) || (n == cur - 1);
          const float val = forced ? 1e4f : (n <= cur ? imp : -1.f);
          int rank = 0;
#pragma unroll 4
          for (int m = 0; m < 64; ++m) { const float vm = __shfl(val, m); rank += (vm > val || (vm == val && m < n)) ? 1 : 0; }
          mask = __ballot(rank < 16 && n <= cur); }
#pragma unroll 1
        for (int br = 0; br < 2; ++br) {
            const bf16* kp = kvb + (size_t)(br == 0 ? 2 : 4) * KV_KIND + (size_t)bg * SEQ * 64; const bf16* vp = kvb + (size_t)(br == 0 ? 3 : 5) * KV_KIND + (size_t)bg * SEQ * 64;
            float m_[4] = {-INFINITY, -INFINITY, -INFINITY, -INFINITY}, l_[4] = {0.f, 0.f, 0.f, 0.f}, acc[4] = {0.f, 0.f, 0.f, 0.f};
            const int jlo = br == 0 ? 0 : (t >= 511 ? t - 511 : 0);
            unsigned long long todo = br == 0 ? mask : 0ull; int j0 = jlo & ~63;
#pragma unroll 1
            for (;;) {
                if (br == 0) { if (!todo) break; j0 = (__ffsll((long long)todo) - 1) * 64; todo &= todo - 1; } else { if (j0 > t) break; }
                const int j = j0 + lane; const bool valid = j >= jlo && j <= t;
                float s[4]; dot4(kp + (size_t)j * 64, qf, s);
#pragma unroll
                for (int r = 0; r < 4; ++r) { const float sv = valid ? s[r] * 0.125f - slope[r] * (float)(t - j) : -INFINITY; const float mn = fmaxf(m_[r], wave_max(sv));
                    const float p = valid ? __expf(sv - mn) : 0.f; const float f = __expf(m_[r] - mn); l_[r] = l_[r] * f + wave_sum(p); acc[r] *= f; m_[r] = mn; ps[r * 64 + lane] = p; }
                LDS_WAIT();
                const bf16* vr = vp + (size_t)j0 * 64 + lane;
#pragma unroll 2
                for (int jj = 0; jj < 64; jj += 4) { const float v0 = bf2f(vr[jj * 64]), v1 = bf2f(vr[(jj + 1) * 64]), v2 = bf2f(vr[(jj + 2) * 64]), v3 = bf2f(vr[(jj + 3) * 64]);
#pragma unroll
                    for (int r = 0; r < 4; ++r) { const f32x4 pv = *(const LAS f32x4*)(ps + r * 64 + jj); acc[r] += (pv.x * v0 + pv.y * v1) + (pv.z * v2 + pv.w * v3); } }
                LDS_WAIT();
                if (br == 1) j0 += 64;
            }
#pragma unroll
            for (int r = 0; r < 4; ++r) osum[r] += sigmoid_f(gates[tg * 48 + (g * 4 + r) * 3 + 1 + br]) * (acc[r] / l_[r]);
        }
#pragma unroll
        for (int r = 0; r < 4; ++r) y[tg * DM + g * 256 + r * 64 + lane] = (bf16)f2bf(osum[r]);
        LDS_WAIT();
    }
}
constexpr int NSA_KB = 0, NSA_VB = 18432, NSA_IMPA = 34816, NSA_IMPB = 51200, NSA_MASK = 67584, NSA_UNI = 68096;
constexpr float LOG2E_F = 1.4426950408889634f;

__device__ __forceinline__ float quad_sum(float x) {
    x += __int_as_float(__builtin_amdgcn_update_dpp(0, __float_as_int(x), 0xB1, 0xF, 0xF, true));
    x += __int_as_float(__builtin_amdgcn_update_dpp(0, __float_as_int(x), 0x4E, 0xF, 0xF, true));
    return x;
}
__device__ __forceinline__ void nsa_qk(f32x16& p0, f32x16& p1, LAS const unsigned char* kb, const bf16x8 (&qf)[4], int q, int h, const f32x16& init) {
    p0 = init; p1 = init;
#pragma unroll
    for (int ks = 0; ks < 4; ++ks) { const bf16x8 a0 = *(const LAS bf16x8*)(kb + q * 144 + ks * 32 + h * 16), a1 = *(const LAS bf16x8*)(kb + (q + 32) * 144 + ks * 32 + h * 16);
        p0 = __builtin_amdgcn_mfma_f32_32x32x16_bf16(a0, qf[ks], p0, 0, 0, 0); p1 = __builtin_amdgcn_mfma_f32_32x32x16_bf16(a1, qf[ks], p1, 0, 0, 0); }
}
template <bool CHECK> __device__ __forceinline__ void nsa_bias(f32x16& p0, f32x16& p1, float basef, float slopeK, float cst, float klo, float khi, int h) {
    const float C = 1.f; const float i0 = basef + 4.f * (float)h; const float t0v = fmaf(slopeK, i0, cst);
#pragma unroll
    for (int r = 0; r < 16; ++r) { const float off = (float)((r & 3) + 8 * (r >> 2));
        float v0 = fmaf(p0[r], C, fmaf(slopeK, off, t0v)), v1 = fmaf(p1[r], C, fmaf(slopeK, off + 32.f, t0v));
        if (CHECK) { const float x0 = i0 + off, x1 = i0 + off + 32.f; v0 = (x0 >= klo && x0 <= khi) ? v0 : -INFINITY; v1 = (x1 >= klo && x1 <= khi) ? v1 : -INFINITY; }
        p0[r] = v0; p1[r] = v1; }
}
__device__ __forceinline__ float nsa_rowmax(const f32x16& p0, const f32x16& p1) {
    float a = fmaxf(p0[0], p1[0]);
#pragma unroll
    for (int r = 1; r < 16; ++r) a = fmaxf(a, fmaxf(p0[r], p1[r]));
    return fmaxf(a, __shfl_xor(a, 32));
}
__device__ __forceinline__ void nsa_pv(f32x16 (&o)[2], const f32x16& p0, const f32x16& p1, LAS const unsigned char* vb, int lane, int h) {
    bf16x8 pk[4];
#pragma unroll
    for (int s = 0; s < 4; ++s) { v4u w;
        if (s < 2) { w.x = cvtpk(p0[8 * s + 0], p0[8 * s + 1]); w.y = cvtpk(p0[8 * s + 2], p0[8 * s + 3]); w.z = cvtpk(p0[8 * s + 4], p0[8 * s + 5]); w.w = cvtpk(p0[8 * s + 6], p0[8 * s + 7]); }
        else { w.x = cvtpk(p1[8 * (s - 2) + 0], p1[8 * (s - 2) + 1]); w.y = cvtpk(p1[8 * (s - 2) + 2], p1[8 * (s - 2) + 3]); w.z = cvtpk(p1[8 * (s - 2) + 4], p1[8 * (s - 2) + 5]); w.w = cvtpk(p1[8 * (s - 2) + 6], p1[8 * (s - 2) + 7]); }
        pk[s] = __builtin_bit_cast(bf16x8, w); }
    LAS const unsigned char* vp = vb + (4 * h + ((lane & 15) >> 2)) * 64 + ((lane >> 4) & 1) * 32 + (lane & 3) * 8;
#pragma unroll
    for (int dt = 0; dt < 2; ++dt)
#pragma unroll
        for (int s = 0; s < 4; ++s) { const v4i16 lo = __builtin_amdgcn_ds_read_tr16_b64_v4i16((LAS v4i16*)(vp + dt * 4096 + s * 1024)), hi = __builtin_amdgcn_ds_read_tr16_b64_v4i16((LAS v4i16*)(vp + dt * 4096 + s * 1024 + 512));
            const bf16x8 a = (bf16x8){lo[0], lo[1], lo[2], lo[3], hi[0], hi[1], hi[2], hi[3]};
            o[dt] = __builtin_amdgcn_mfma_f32_32x32x16_bf16(a, pk[s], o[dt], 0, 0, 0); }
}
__device__ __forceinline__ void nsa_online(f32x16& p0, f32x16& p1, float& m, float& l, f32x16 (&o)[2]) {
    const float mx = nsa_rowmax(p0, p1), mn = fmaxf(m, mx), mu = (mn == -INFINITY) ? 0.f : mn; const float f = __builtin_amdgcn_exp2f(m - mu);
    float sum = 0.f;
#pragma unroll
    for (int r = 0; r < 16; ++r) { p0[r] = __builtin_amdgcn_exp2f(p0[r] - mu); p1[r] = __builtin_amdgcn_exp2f(p1[r] - mu); sum += p0[r] + p1[r]; }
    l = l * f + sum; m = mn;
    if (__any(f != 1.f)) {
#pragma unroll
        for (int r = 0; r < 16; ++r) { o[0][r] *= f; o[1][r] *= f; } }
}

typedef float f2v __attribute__((ext_vector_type(2)));
__device__ __forceinline__ void nsa_fast(f32x16& p0, f32x16& p1, float c32, float t0v, float& m, float& l, f32x16 (&o)[2]) {
    float mx0 = p0[0], mx1 = p1[0];
#pragma unroll
    for (int r = 1; r < 16; r += 2) { mx0 = __builtin_fmaxf(__builtin_fmaxf(mx0, p0[r]), p0[r < 15 ? r + 1 : r]); mx1 = __builtin_fmaxf(__builtin_fmaxf(mx1, p1[r]), p1[r < 15 ? r + 1 : r]); }
    float mx = __builtin_fmaxf(mx0, mx1 + c32) + t0v; mx = __builtin_fmaxf(mx, __shfl_xor(mx, 32));
    const float mn = __builtin_fmaxf(m, mx), mu = (mn == -INFINITY) ? 0.f : mn; const float f = __builtin_amdgcn_exp2f(m - mu), d = mu - t0v, d1 = d - c32; const f2v d2 = {d, d}, d12 = {d1, d1};
    f2v s2 = {0.f, 0.f};
#pragma unroll
    for (int k = 0; k < 8; ++k) { f2v a = {p0[2 * k], p0[2 * k + 1]}, b = {p1[2 * k], p1[2 * k + 1]}; a = a - d2; b = b - d12;
        a.x = __builtin_amdgcn_exp2f(a.x); a.y = __builtin_amdgcn_exp2f(a.y); b.x = __builtin_amdgcn_exp2f(b.x); b.y = __builtin_amdgcn_exp2f(b.y);
        s2 = s2 + a; s2 = s2 + b; p0[2 * k] = a.x; p0[2 * k + 1] = a.y; p1[2 * k] = b.x; p1[2 * k + 1] = b.y; }
    l = l * f + (s2.x + s2.y); m = mn;
    if (__any(f != 1.f)) {
#pragma unroll
        for (int r = 0; r < 16; ++r) { o[0][r] *= f; o[1][r] *= f; } }
}
__device__ __forceinline__ void nsa_item(const Params& P, LAS unsigned char* lds, int bg, int tile) {
    int tid_l = threadIdx.x; asm volatile("" : "+v"(tid_l)); const int tid = tid_l, lane = tid & 63, wave = tid >> 6, q = lane & 31, h = lane >> 5;
    const int b = bg >> 2, g = bg & 3, t0 = tile * 64, cur = tile;
    const int tl = 8 * wave + (q >> 2), t = t0 + tl, r = q & 3; const size_t tg = (size_t)b * SEQ + t;
    const bf16* qb = (const bf16*)(P.ws + WS_Z); const bf16* kvb = qb + (size_t)T * 1024;
    const bf16* ckp = (const bf16*)(P.ws + WS_CK) + (size_t)bg * 256 * 64; const bf16* cvp = (const bf16*)(P.ws + WS_CV) + (size_t)bg * 256 * 64;
    const bf16* ksp = kvb + 2 * KV_KIND + (size_t)bg * SEQ * 64; const bf16* vsp = kvb + 3 * KV_KIND + (size_t)bg * SEQ * 64;
    const bf16* kwp = kvb + 4 * KV_KIND + (size_t)bg * SEQ * 64; const bf16* vwp = kvb + 5 * KV_KIND + (size_t)bg * SEQ * 64;
    const float* gp = (const float*)(P.ws + WS_GATES) + tg * 48 + (g * 4 + r) * 3;
    LAS float* impA = (LAS float*)(lds + NSA_IMPA); LAS float* impB = (LAS float*)(lds + NSA_IMPB);
    LAS unsigned long long* masks = (LAS unsigned long long*)(lds + NSA_MASK); LAS unsigned long long* uni = (LAS unsigned long long*)(lds + NSA_UNI);
    const int srow = tid >> 3, spc = tid & 7; const unsigned koff = srow * 144 + spc * 16, voff = (spc >> 2) * 4096 + srow * 64 + (spc & 3) * 16; const size_t goff = (size_t)srow * 64 + spc * 8;
    const float slope2 = exp2f(-0.5f * (float)(g * 4 + r + 1)) * LOG2E_F; const float tf = (float)t;
    bf16x8 qf[4];
#pragma unroll
    for (int ks = 0; ks < 4; ++ks) qf[ks] = *(const bf16x8*)(qb + tg * 1024 + g * 256 + r * 64 + 16 * ks + 8 * h);
    { const v4u z4 = {0u, 0u, 0u, 0u};
#pragma unroll
      for (int i = 0; i < 4; ++i) *(LAS v4u*)(lds + NSA_IMPA + (tid * 4 + i) * 16) = z4; }
    if (tid < 8) uni[tid] = 0ull;
    v4u kreg, vreg;
#define KBUF(i) (lds + NSA_KB + (i) * 9216)
#define VBUF(i) (lds + NSA_VB + (i) * 8192)
    f32x16 osum[2], o[2], p0, p1, bo0, zero16;
#pragma unroll
    for (int rr = 0; rr < 16; ++rr) zero16[rr] = 0.f;
    const int nct = (((t0 + 32) >> 4) >> 6) + 1;
    const float cmaxf = t >= 31 ? (float)((t - 31) >> 4) : -1.f; const float cstc = slope2 * (31.f - tf), slopec = 16.f * slope2;
    float m1 = -INFINITY, l1 = 0.f;
    kreg = *(const v4u*)(ckp + (size_t)(nct - 1) * 4096 + goff); *(LAS v4u*)(KBUF(0) + koff) = kreg; __syncthreads();
#pragma unroll 1
    for (int i = 0; i < nct; ++i) { const int ct = nct - 1 - i;
        if (i + 1 < nct) kreg = *(const v4u*)(ckp + (size_t)(ct - 1) * 4096 + goff);
        else { kreg = *(const v4u*)(ckp + (size_t)(nct - 1) * 4096 + goff); vreg = *(const v4u*)(cvp + (size_t)(nct - 1) * 4096 + goff); }
        nsa_qk(p0, p1, KBUF(i & 1), qf, q, h, zero16); nsa_bias<true>(p0, p1, (float)(ct * 64), slopec, cstc, 0.f, cmaxf, h);
        { const float mx = nsa_rowmax(p0, p1), mn = fmaxf(m1, mx), mu = (mn == -INFINITY) ? 0.f : mn; float sum = 0.f;
#pragma unroll
          for (int rr = 0; rr < 16; ++rr) sum += __builtin_amdgcn_exp2f(p0[rr] - mu) + __builtin_amdgcn_exp2f(p1[rr] - mu);
          l1 = l1 * __builtin_amdgcn_exp2f(m1 - mu) + sum; m1 = mn; }
        if (i + 1 < nct) *(LAS v4u*)(KBUF((i + 1) & 1) + koff) = kreg;
        __syncthreads(); }
    l1 += __shfl_xor(l1, 32);
    const float inv1 = l1 > 0.f ? 1.f / l1 : 0.f, mu1 = (m1 == -INFINITY) ? 0.f : m1;
#pragma unroll
    for (int rr = 0; rr < 16; ++rr) { o[0][rr] = 0.f; o[1][rr] = 0.f; }
    *(LAS v4u*)(KBUF(0) + koff) = kreg; *(LAS v4u*)(VBUF(0) + voff) = vreg; __syncthreads();
#pragma unroll 1
    for (int i = 0; i < nct; ++i) { const int ct = nct - 1 - i;
        if (i + 1 < nct) { kreg = *(const v4u*)(ckp + (size_t)(ct - 1) * 4096 + goff); vreg = *(const v4u*)(cvp + (size_t)(ct - 1) * 4096 + goff); }
        else { kreg = *(const v4u*)(ksp + (size_t)cur * 4096 + goff); vreg = *(const v4u*)(vsp + (size_t)cur * 4096 + goff); }
        nsa_qk(p0, p1, KBUF(i & 1), qf, q, h, zero16); nsa_bias<true>(p0, p1, (float)(ct * 64), slopec, cstc, 0.f, cmaxf, h);
#pragma unroll
        for (int rr = 0; rr < 16; ++rr) { p0[rr] = __builtin_amdgcn_exp2f(p0[rr] - mu1) * inv1; p1[rr] = __builtin_amdgcn_exp2f(p1[rr] - mu1) * inv1; }
#pragma unroll
        for (int a = 0; a < 4; ++a) {
            float A0 = quad_sum(p0[4 * a] + p0[4 * a + 1] + p0[4 * a + 2] + 0.5f * p0[4 * a + 3]), B0 = quad_sum(0.5f * p0[4 * a + 3]);
            float A1 = quad_sum(p1[4 * a] + p1[4 * a + 1] + p1[4 * a + 2] + 0.5f * p1[4 * a + 3]), B1 = quad_sum(0.5f * p1[4 * a + 3]);
            if (r == 0) { const int n0 = 16 * ct + 2 * a + h, n1 = n0 + 8; impA[tl * 64 + n0] = A0; impA[tl * 64 + n1] = A1; impB[tl * 64 + n0 + 1] = B0; if (n1 < 63) impB[tl * 64 + n1 + 1] = B1; } }
        nsa_pv(o, p0, p1, VBUF(i & 1), lane, h);
        if (i + 1 < nct) { *(LAS v4u*)(KBUF((i + 1) & 1) + koff) = kreg; *(LAS v4u*)(VBUF((i + 1) & 1) + voff) = vreg; }
        __syncthreads(); }
    { const float g0 = sigmoid_f(gp[0]);
#pragma unroll
      for (int rr = 0; rr < 16; ++rr) { osum[0][rr] = g0 * o[0][rr]; osum[1][rr] = g0 * o[1][rr]; } }
    { const int tkl = lane >> 3, part = lane & 7, tk = 8 * wave + tkl; unsigned key[8];
      { const f32x4 a0 = *(const LAS f32x4*)(impA + tk * 64 + part * 8), a1 = *(const LAS f32x4*)(impA + tk * 64 + part * 8 + 4), b0 = *(const LAS f32x4*)(impB + tk * 64 + part * 8), b1 = *(const LAS f32x4*)(impB + tk * 64 + part * 8 + 4);
        const float im[8] = {a0.x + b0.x, a0.y + b0.y, a0.z + b0.z, a0.w + b0.w, a1.x + b1.x, a1.y + b1.y, a1.z + b1.z, a1.w + b1.w};
#pragma unroll
        for (int e2 = 0; e2 < 8; ++e2) { const int n = part * 8 + e2; const bool forced = (n == 0) || (n == cur) || (n == cur - 1); key[e2] = n <= cur ? (forced ? 0x7F000000u : __float_as_uint(im[e2]) + 1u) : 0u; } }
      unsigned Tk = 0u;
#pragma unroll 1
      for (int bb = 30; bb >= 0; --bb) { const unsigned cand = Tk | (1u << bb); int c = 0;
#pragma unroll
          for (int e2 = 0; e2 < 8; ++e2) c += key[e2] >= cand ? 1 : 0;
          c += __builtin_amdgcn_update_dpp(0, c, 0xB1, 0xF, 0xF, true); c += __builtin_amdgcn_update_dpp(0, c, 0x4E, 0xF, 0xF, true); c += __builtin_amdgcn_update_dpp(0, c, 0x141, 0xF, 0xF, true);
          Tk = c >= 16 ? cand : Tk; }
      int cg = 0, le = 0;
#pragma unroll
      for (int e2 = 0; e2 < 8; ++e2) { cg += key[e2] > Tk ? 1 : 0; le += key[e2] == Tk ? 1 : 0; }
      cg += __builtin_amdgcn_update_dpp(0, cg, 0xB1, 0xF, 0xF, true); cg += __builtin_amdgcn_update_dpp(0, cg, 0x4E, 0xF, 0xF, true); cg += __builtin_amdgcn_update_dpp(0, cg, 0x141, 0xF, 0xF, true);
      int incl = le;
#pragma unroll
      for (int o2 = 1; o2 < 8; o2 <<= 1) { const int v = __shfl_up(incl, o2, 8); if (part >= o2) incl += v; }
      int before = incl - le; const int need = 16 - cg; unsigned byte = 0u;
#pragma unroll
      for (int e2 = 0; e2 < 8; ++e2) { const bool eq = key[e2] == Tk; const bool selb = (key[e2] > Tk || (eq && before < need)) && (part * 8 + e2 <= cur); before += eq ? 1 : 0; byte |= selb ? (1u << e2) : 0u; }
      ((LAS unsigned char*)masks)[tk * 8 + part] = (unsigned char)byte;
      __hip_atomic_fetch_or(uni, (unsigned long long)byte << (8 * part), __ATOMIC_RELAXED, __HIP_MEMORY_SCOPE_WORKGROUP); }
    __syncthreads();
    unsigned long long todo = uni[0]; const unsigned long long mymask = masks[tl];
#define NSA_LOAD(kp_, vp_, n_) { kreg = *(const v4u*)((kp_) + (size_t)(n_) * 4096 + goff); vreg = *(const v4u*)((vp_) + (size_t)(n_) * 4096 + goff); }
#define NSA_STORE(i_) { *(LAS v4u*)(KBUF((i_) & 1) + koff) = kreg; *(LAS v4u*)(VBUF((i_) & 1) + voff) = vreg; }
#define NSA_FAST(i_, t0v_) { nsa_qk(p0, p1, KBUF((i_) & 1), qf, q, h, bo0); nsa_fast(p0, p1, 32.f * slope2, (t0v_), m, l, o); nsa_pv(o, p0, p1, VBUF((i_) & 1), lane, h); }
#define NSA_STEP(CHECK_, i_, basef_, cst_, klo_, khi_) { nsa_qk(p0, p1, KBUF((i_) & 1), qf, q, h, zero16); nsa_bias<CHECK_>(p0, p1, (basef_), slope2, (cst_), (klo_), (khi_), h); nsa_online(p0, p1, m, l, o); nsa_pv(o, p0, p1, VBUF((i_) & 1), lane, h); }
    {
        float m = -INFINITY, l = 0.f; const float cst = -slope2 * tf;
#pragma unroll
        for (int rr = 0; rr < 16; ++rr) { o[0][rr] = 0.f; o[1][rr] = 0.f; bo0[rr] = slope2 * (float)((rr & 3) + 8 * (rr >> 2)); }
        todo &= ~(1ull << cur);
        NSA_STORE(0) __syncthreads();
        int i = 0, nn = todo ? 63 - __clzll((long long)todo) : -1; if (nn >= 0) todo &= ~(1ull << nn);
        if (nn >= 0) NSA_LOAD(ksp, vsp, nn) else NSA_LOAD(kwp, vwp, tile)
        NSA_STEP(true, 0, (float)(cur * 64), cst, 0.f, tf)
        if (nn >= 0) NSA_STORE(1)
        __syncthreads();
#pragma unroll 1
        while (nn >= 0) { const int n = nn; ++i; nn = todo ? 63 - __clzll((long long)todo) : -1; if (nn >= 0) todo &= ~(1ull << nn);
            if (nn >= 0) NSA_LOAD(ksp, vsp, nn) else NSA_LOAD(kwp, vwp, tile)
            const bool sel = (mymask >> n) & 1ull;
            NSA_FAST(i, sel ? fmaf(slope2, (float)(n * 64 + 4 * h), cst) : -INFINITY)
            if (nn >= 0) NSA_STORE(i + 1)
            __syncthreads(); }
        l += __shfl_xor(l, 32); const float gs = sigmoid_f(gp[1]) / l;
#pragma unroll
        for (int rr = 0; rr < 16; ++rr) { osum[0][rr] += gs * o[0][rr]; osum[1][rr] += gs * o[1][rr]; }
    }
    {
        float m = -INFINITY, l = 0.f; const float cst = -slope2 * tf;
#pragma unroll
        for (int rr = 0; rr < 16; ++rr) { o[0][rr] = 0.f; o[1][rr] = 0.f; }
        const int nw = tile < 8 ? tile + 1 : 9, nmid = nw < 8 ? nw : 8;
        NSA_STORE(0) __syncthreads();
        if (nw > 1) NSA_LOAD(kwp, vwp, tile - 1)
        NSA_STEP(true, 0, (float)(tile * 64), cst, 0.f, tf)
        if (nw > 1) NSA_STORE(1)
        __syncthreads();
#pragma unroll 1
        for (int i = 1; i < nmid; ++i) { const int jt = tile - i;
            if (i + 1 < nw) NSA_LOAD(kwp, vwp, jt - 1)
            NSA_FAST(i, fmaf(slope2, (float)(jt * 64 + 4 * h), cst))
            if (i + 1 < nw) NSA_STORE(i + 1)
            __syncthreads(); }
        if (nw == 9) { NSA_STEP(true, 8, (float)((tile - 8) * 64), cst, tf - 511.f, 1e9f) __syncthreads(); }
        l += __shfl_xor(l, 32); const float gs = sigmoid_f(gp[2]) / l;
#pragma unroll
        for (int rr = 0; rr < 16; ++rr) { osum[0][rr] += gs * o[0][rr]; osum[1][rr] += gs * o[1][rr]; }
    }
#undef NSA_LOAD
#undef NSA_STORE
#undef NSA_STEP
#undef NSA_FAST
    { bf16* yp = (bf16*)(P.ws + WS_Y) + tg * DM + g * 256 + r * 64 + 4 * h;
#pragma unroll
      for (int dt = 0; dt < 2; ++dt)
#pragma unroll
          for (int a = 0; a < 4; ++a) { v2u w; w.x = cvtpk(osum[dt][4 * a], osum[dt][4 * a + 1]); w.y = cvtpk(osum[dt][4 * a + 2], osum[dt][4 * a + 3]); *(v2u*)(yp + dt * 32 + a * 8) = w; } }
#undef KBUF
#undef VBUF
}
__device__ __forceinline__ void phase_nsa(const Params& P, LAS unsigned char* lds) {
    for (int it = blockIdx.x; it < 2048; it += gridDim.x) { const int rnd = it / 256, c = it % 256; const int bg = c & 31, tile = 63 - 8 * rnd - (c >> 5); nsa_item(P, lds, bg, tile); }
}

__device__ __forceinline__ void xatt_item(const Params& P, LAS unsigned char* lds, int l, int bh, int blk) {
    int tid_l = threadIdx.x; asm volatile("" : "+v"(tid_l)); const int tid = tid_l, lane = tid & 63, wave = tid >> 6, q = lane & 31, h = lane >> 5;
    const int b = bh >> 2, hh = bh & 3; const size_t t = (size_t)b * SEQ + blk * 256 + wave * 32 + q;
    const bf16* kvp = (const bf16*)(P.ws + WS_MEMKV) + (size_t)(b * 256) * 4096 + l * 2048 + hh * 256;
    const bf16* qp = (const bf16*)(P.ws + WS_QXA) + t * DM + hh * 256 + 8 * h;
#pragma unroll
    for (int half = 0; half < 2; ++half) { v4u kr[8];
#pragma unroll
        for (int i = 0; i < 8; ++i) { const int p = tid + 512 * (half * 8 + i); kr[i] = *(const v4u*)(kvp + (size_t)(p >> 5) * 4096 + (p & 31) * 8); }
#pragma unroll
        for (int i = 0; i < 8; ++i) { const int p = tid + 512 * (half * 8 + i); *(LAS v4u*)(lds + (p >> 5) * 528 + (p & 31) * 16) = kr[i]; } }
    bf16x8 qf[16];
#pragma unroll
    for (int ks = 0; ks < 16; ++ks) qf[ks] = *(const bf16x8*)(qp + 16 * ks);
    __syncthreads();
    const float C = 0.0625f * LOG2E_F;
    v4u pk[16]; float m = 0.f, lsum = 0.f, f0 = 1.f;
#pragma unroll
    for (int half = 0; half < 2; ++half) {
        f32x16 s[4];
#pragma unroll
        for (int kt = 0; kt < 4; ++kt) {
#pragma unroll
            for (int r = 0; r < 16; ++r) s[kt][r] = 0.f;
            LAS const unsigned char* kb = lds + (half * 128 + kt * 32 + q) * 528 + h * 16;
#pragma unroll
            for (int ks = 0; ks < 16; ++ks) s[kt] = __builtin_amdgcn_mfma_f32_32x32x16_bf16(*(const LAS bf16x8*)(kb + ks * 32), qf[ks], s[kt], 0, 0, 0); }
        float mx = s[0][0];
#pragma unroll
        for (int kt = 0; kt < 4; ++kt)
#pragma unroll
            for (int r = 0; r < 16; ++r) mx = fmaxf(mx, s[kt][r]);
        mx = fmaxf(mx, __shfl_xor(mx, 32)) * C;
        const float mn = half == 0 ? mx : fmaxf(m, mx);
        if (half == 1) { f0 = __builtin_amdgcn_exp2f(m - mn); lsum *= f0; }
        m = mn;
        float sum = 0.f;
#pragma unroll
        for (int kt = 0; kt < 4; ++kt) {
#pragma unroll
            for (int r = 0; r < 16; ++r) { s[kt][r] = __builtin_amdgcn_exp2f(fmaf(s[kt][r], C, -mn)); sum += s[kt][r]; }
#pragma unroll
            for (int e = 0; e < 2; ++e) { v4u w; w.x = cvtpk(s[kt][8 * e + 0], s[kt][8 * e + 1]); w.y = cvtpk(s[kt][8 * e + 2], s[kt][8 * e + 3]); w.z = cvtpk(s[kt][8 * e + 4], s[kt][8 * e + 5]); w.w = cvtpk(s[kt][8 * e + 6], s[kt][8 * e + 7]); pk[half * 8 + kt * 2 + e] = w; } }
        lsum += sum;
    }
    lsum += __shfl_xor(lsum, 32); const float invl = 1.f / lsum;
    __syncthreads();
#pragma unroll
    for (int c = 0; c < 2; ++c) { v4u vr[8];
#pragma unroll
        for (int i = 0; i < 8; ++i) { const int p = tid + 512 * i; vr[i] = *(const v4u*)(kvp + 1024 + (size_t)(p >> 4) * 4096 + c * 128 + (p & 15) * 8); }
#pragma unroll
        for (int i = 0; i < 8; ++i) { const int p = tid + 512 * i; *(LAS v4u*)(lds + c * 65536 + ((p & 15) >> 2) * 16384 + (p >> 4) * 64 + (p & 3) * 16) = vr[i]; } }
    __syncthreads();
    bf16* yp = (bf16*)(P.ws + WS_Y) + t * DM + hh * 256 + 4 * h;
    LAS const unsigned char* vp = lds + (4 * h + ((lane & 15) >> 2)) * 64 + ((lane >> 4) & 1) * 32 + (lane & 3) * 8;
#pragma unroll 1
    for (int dt = 0; dt < 8; ++dt) { f32x16 o;
#pragma unroll
        for (int r = 0; r < 16; ++r) o[r] = 0.f;
        LAS const unsigned char* vd = vp + dt * 16384;
#pragma unroll
        for (int s = 0; s < 8; ++s) { const v4i16 lo = __builtin_amdgcn_ds_read_tr16_b64_v4i16((LAS v4i16*)(vd + s * 1024)), hi = __builtin_amdgcn_ds_read_tr16_b64_v4i16((LAS v4i16*)(vd + s * 1024 + 512));
            o = __builtin_amdgcn_mfma_f32_32x32x16_bf16((bf16x8){lo[0], lo[1], lo[2], lo[3], hi[0], hi[1], hi[2], hi[3]}, __builtin_bit_cast(bf16x8, pk[s]), o, 0, 0, 0); }
#pragma unroll
        for (int r = 0; r < 16; ++r) o[r] *= f0;
#pragma unroll
        for (int s = 8; s < 16; ++s) { const v4i16 lo = __builtin_amdgcn_ds_read_tr16_b64_v4i16((LAS v4i16*)(vd + s * 1024)), hi = __builtin_amdgcn_ds_read_tr16_b64_v4i16((LAS v4i16*)(vd + s * 1024 + 512));
            o = __builtin_amdgcn_mfma_f32_32x32x16_bf16((bf16x8){lo[0], lo[1], lo[2], lo[3], hi[0], hi[1], hi[2], hi[3]}, __builtin_bit_cast(bf16x8, pk[s]), o, 0, 0, 0); }
#pragma unroll
        for (int a = 0; a < 4; ++a) { v2u w; w.x = cvtpk(o[4 * a] * invl, o[4 * a + 1] * invl); w.y = cvtpk(o[4 * a + 2] * invl, o[4 * a + 3] * invl); *(v2u*)(yp + dt * 32 + a * 8) = w; } }
    __syncthreads();
}
__device__ __forceinline__ void phase_xatt(const Params& P, LAS unsigned char* lds, int l) {
    for (int it = blockIdx.x; it < 512; it += gridDim.x) { const int c = it % 256, k = it / 256; xatt_item(P, lds, l, c & 31, (c >> 5) + 8 * k); }
}

constexpr size_t WS_DN = 344 * MiB, DN_CHUNK_BYTES = 73728, WS_EGL = 488 * MiB;
constexpr int DNA_RHS = 0, DNA_QB = 65536, DNA_KB = 82944, DNA_AM = 100352, DNA_SSQ = 118784, DNA_GC = 126976;
__device__ __forceinline__ void dna_item(const Params& P, LAS unsigned char* lds, int item) {
    int tid_l = threadIdx.x; asm volatile("" : "+v"(tid_l)); const int tid = tid_l, lane = tid & 63, wave = tid >> 6;
    const int bh = item >> 6, n = item & 63, b = bh >> 2, h = bh & 3, sb = n * 64; const size_t rb = (size_t)b * SEQ;
    const bf16* z = (const bf16*)(P.ws + WS_Z); const float* ba = (const float*)(P.ws + WS_BA); const float* cw = P.in[I_A_CONV];
    unsigned char* ob = P.ws + WS_DN + (size_t)item * DN_CHUNK_BYTES;
    LAS float* rhs = (LAS float*)(lds + DNA_RHS); LAS float* Am = (LAS float*)(lds + DNA_AM); LAS float* ssq = (LAS float*)(lds + DNA_SSQ);
    LAS float* gcs = (LAS float*)(lds + DNA_GC); LAS float* bet = gcs + 64; LAS float* egc = gcs + 128; LAS float* ekd = gcs + 192;
    const float SC = 0.08838834764831845f;
    { const int gd = tid & 15, tq = tid >> 4, d0 = gd * 8;
      f32x4 wa[3][4][2]; v4u za[3][2][4];
#pragma unroll
      for (int part = 0; part < 3; ++part) { const int ch0 = part * 512 + h * 128 + d0;
#pragma unroll
          for (int kk = 0; kk < 4; ++kk) { wa[part][kk][0] = *(const f32x4*)(cw + kk * 1536 + ch0); wa[part][kk][1] = *(const f32x4*)(cw + kk * 1536 + ch0 + 4); }
#pragma unroll
          for (int tt = 0; tt < 2; ++tt)
#pragma unroll
              for (int kk = 0; kk < 4; ++kk) { const int sp = sb + tq + 32 * tt - 3 + kk; za[part][tt][kk] = (v4u){0u, 0u, 0u, 0u}; if (sp >= 0) za[part][tt][kk] = *(const v4u*)(z + (rb + sp) * 2560 + 512 + ch0); } }
      __builtin_amdgcn_sched_barrier(0);
    if (wave == 0) { const size_t t = rb + sb + lane; const float bl = ba[t * 8 + h], al = ba[t * 8 + 4 + h] + P.in[I_A_DTB][h]; const float sp = al > 20.f ? al : log1pf(__expf(al));
        float g = -__expf(P.in[I_A_ALOG][h]) * sp;
#pragma unroll
        for (int o = 1; o < 64; o <<= 1) { const float v = __shfl_up(g, o); if (lane >= o) g += v; }
        const float gl = __shfl(g, 63);
        gcs[lane] = g; bet[lane] = sigmoid_f(bl); egc[lane] = __expf(g); ekd[lane] = __expf(gl - g);
        if (lane == 63) ((float*)(P.ws + WS_EGL))[item] = __expf(g); }
      __syncthreads();
#pragma unroll
      for (int part = 0; part < 3; ++part) {
#pragma unroll
          for (int tt = 0; tt < 2; ++tt) { const int tl = tq + 32 * tt;
              float a[8];
#pragma unroll
              for (int e2 = 0; e2 < 8; ++e2) a[e2] = 0.f;
#pragma unroll
              for (int kk = 0; kk < 4; ++kk) { const v4u zv = za[part][tt][kk]; const f32x4 w0 = wa[part][kk][0], w1 = wa[part][kk][1];
                  a[0] += w0.x * bf2f(zv.x & 0xffff); a[1] += w0.y * bf2f(zv.x >> 16); a[2] += w0.z * bf2f(zv.y & 0xffff); a[3] += w0.w * bf2f(zv.y >> 16);
                  a[4] += w1.x * bf2f(zv.z & 0xffff); a[5] += w1.y * bf2f(zv.z >> 16); a[6] += w1.z * bf2f(zv.w & 0xffff); a[7] += w1.w * bf2f(zv.w >> 16); }
              float q2 = 0.f;
#pragma unroll
              for (int e2 = 0; e2 < 8; ++e2) { a[e2] = a[e2] * __builtin_amdgcn_rcpf(1.f + __builtin_amdgcn_exp2f(-LOG2E_F * a[e2])); q2 += a[e2] * a[e2]; }
              if (part < 2) {
                  q2 += __shfl_xor(q2, 1); q2 += __shfl_xor(q2, 2); q2 += __shfl_xor(q2, 4); q2 += __shfl_xor(q2, 8);
                  const float rs = rsqrtf(q2 + EPS);
#pragma unroll
                  for (int e2 = 0; e2 < 8; ++e2) a[e2] *= rs;
                  v4u wv; wv.x = cvtpk(a[0], a[1]); wv.y = cvtpk(a[2], a[3]); wv.z = cvtpk(a[4], a[5]); wv.w = cvtpk(a[6], a[7]);
                  *(LAS v4u*)(lds + (part == 0 ? DNA_QB : DNA_KB) + tl * 272 + d0 * 2) = wv;
                  if (part == 0) { const float f = SC * egc[tl]; v4u g4; g4.x = cvtpk(a[0] * f, a[1] * f); g4.y = cvtpk(a[2] * f, a[3] * f); g4.z = cvtpk(a[4] * f, a[5] * f); g4.w = cvtpk(a[6] * f, a[7] * f);
                      *(v4u*)(ob + 16384 + (((tl >> 4) * 4 + (d0 >> 5)) * 64 + (tl & 15) + 16 * ((d0 >> 3) & 3)) * 16) = g4; }
                  else { const float f = ekd[tl], fb = bet[tl] * egc[tl];
                      *(LAS f32x4*)(rhs + tl * 256 + d0) = (f32x4){a[0] * fb, a[1] * fb, a[2] * fb, a[3] * fb}; *(LAS f32x4*)(rhs + tl * 256 + d0 + 4) = (f32x4){a[4] * fb, a[5] * fb, a[6] * fb, a[7] * fb};
                      bf16* kd = (bf16*)(ob + 32768) + ((((d0 >> 4) * 2 + (tl >> 5)) * 64 + 16 * ((tl >> 3) & 3)) * 8) + (tl & 7);
#pragma unroll
                      for (int e2 = 0; e2 < 8; ++e2) kd[(((d0 & 15) + e2) * 8)] = (bf16)f2bf(a[e2] * f); } }
              else { const float fb = bet[tl];
                  *(LAS f32x4*)(rhs + tl * 256 + 128 + d0) = (f32x4){a[0] * fb, a[1] * fb, a[2] * fb, a[3] * fb}; *(LAS f32x4*)(rhs + tl * 256 + 128 + d0 + 4) = (f32x4){a[4] * fb, a[5] * fb, a[6] * fb, a[7] * fb}; } } } }
    __syncthreads();
    if (wave < 6) { const int isq = wave >= 3, jb = wave - 3 * isq, it = jb >= 1, jt = jb == 2; const int q = lane & 31, hh = lane >> 5;
        f32x16 d;
#pragma unroll
        for (int r = 0; r < 16; ++r) d[r] = 0.f;
        LAS const unsigned char* ap = lds + (isq ? DNA_QB : DNA_KB) + (it * 32 + q) * 272 + hh * 16; LAS const unsigned char* bp = lds + DNA_KB + (jt * 32 + q) * 272 + hh * 16;
#pragma unroll
        for (int ks = 0; ks < 8; ++ks) d = __builtin_amdgcn_mfma_f32_32x32x16_bf16(*(const LAS bf16x8*)(ap + ks * 32), *(const LAS bf16x8*)(bp + ks * 32), d, 0, 0, 0);
        const int j = jt * 32 + q; const float gj = gcs[j];
#pragma unroll
        for (int r = 0; r < 16; ++r) { const int i = it * 32 + (r & 3) + 8 * (r >> 2) + 4 * hh; const float dec = __expf(fminf(gcs[i] - gj, 0.f));
            if (!isq) Am[(j & 1) * 2304 + i * 36 + (j >> 1)] = i > j ? d[r] * bet[i] * dec : 0.f;
            else ((bf16*)(ob + 65536))[((((i >> 4) * 2 + (j >> 5)) * 64 + (i & 15) + 16 * ((j >> 3) & 3)) * 8) + (j & 7)] = (bf16)f2bf(i >= j ? d[r] * SC * dec : 0.f); } }
    else if (wave == 6) { const v4u z4 = {0u, 0u, 0u, 0u}; *(v4u*)(ob + 65536 + ((0 * 2 + 1) * 64 + lane) * 16) = z4; *(v4u*)(ob + 65536 + ((1 * 2 + 1) * 64 + lane) * 16) = z4; }
    __syncthreads();
    if (tid < 256) { const int cp = tid >> 1, par = tid & 1, c = 2 * cp; LAS const float* Ap = Am + par * 2304; f2v x[32];
#pragma unroll
      for (int jj = 0; jj < 32; ++jj) x[jj] = (f2v){0.f, 0.f};
      f32x4 ab[2][8]; f2v rb[2]; f2v xl[4] = {{0.f, 0.f}, {0.f, 0.f}, {0.f, 0.f}, {0.f, 0.f}};
      rb[0] = *(const LAS f2v*)(rhs + c);
      unsigned* wp = (unsigned*)((bf16*)ob + (((c >> 5) * 64 + 16 * ((c >> 3) & 3)) * 8) + (c & 7));
      const int dv = c - 128; unsigned char* up = ob + 49152 + (((dv >> 4) * 4) * 64 + (dv & 15)) * 8;
#pragma unroll
      for (int i = 0; i < 64; ++i) {
          if (i + 1 < 64) {
#pragma unroll
              for (int j4 = 0; j4 < ((i + 2) / 2 + 3) / 4; ++j4) ab[(i + 1) & 1][j4] = *(const LAS f32x4*)(Ap + (i + 1) * 36 + 4 * j4);
              rb[(i + 1) & 1] = *(const LAS f2v*)(rhs + (i + 1) * 256 + c); }
          __builtin_amdgcn_sched_barrier(0);
          f2v ac4[4] = {{0.f, 0.f}, {0.f, 0.f}, {0.f, 0.f}, {0.f, 0.f}};
#pragma unroll
          for (int jj = 0; jj < (i + 1) / 2; ++jj) { const float a = ab[i & 1][jj >> 2][jj & 3]; ac4[jj & 3] = ac4[jj & 3] + (f2v){a, a} * x[jj]; }
          f2v acc = (ac4[0] + ac4[1]) + (ac4[2] + ac4[3]);
          acc.x += __int_as_float(__builtin_amdgcn_update_dpp(0, __float_as_int(acc.x), 0xB1, 0xF, 0xF, true)); acc.y += __int_as_float(__builtin_amdgcn_update_dpp(0, __float_as_int(acc.y), 0xB1, 0xF, 0xF, true));
          const f2v xi = rb[i & 1] - acc;
          x[i >> 1] = ((i & 1) == par) ? xi : x[i >> 1];
          xl[i & 3] = xi;
          if (tid < 128) { if ((i & 1) == par) wp[(((i >> 4) * 4) * 64 + (i & 15)) * 4] = cvtpk(xi.x, xi.y); }
          else if ((i & 3) == 3 && ((i >> 2) & 1) == par) { v2u w0, w1; w0.x = cvtpk(xl[0].x, xl[1].x); w0.y = cvtpk(xl[2].x, xl[3].x); w1.x = cvtpk(xl[0].y, xl[1].y); w1.y = cvtpk(xl[2].y, xl[3].y);
              unsigned char* u0 = up + (((i >> 2) >> 2) * 64 + 16 * ((i >> 2) & 3)) * 8; *(v2u*)u0 = w0; *(v2u*)(u0 + 8) = w1; }
          __builtin_amdgcn_sched_barrier(0);
      } }
    __syncthreads();
}
__device__ __forceinline__ void phase_dna(const Params& P, LAS unsigned char* lds) { for (int it = blockIdx.x; it < 2048; it += gridDim.x) dna_item(P, lds, it); }

typedef float f32x4v __attribute__((ext_vector_type(4)));
struct DnFrag { bf16x8 m1[4]; bf16x8 at[2]; bf16x8 kd[2]; v2u u; float eg; };
__device__ __forceinline__ void dnb_load(DnFrag& f, const unsigned char* base, const float* egl, int n, int wave, int lane, int sl) {
    const unsigned char* cb = base + (size_t)n * DN_CHUNK_BYTES; const int ct = wave & 3;
    const unsigned char* m1 = cb + (wave < 4 ? 0 : 16384) + ((ct * 4) * 64 + lane) * 16;
#pragma unroll
    for (int ks = 0; ks < 4; ++ks) f.m1[ks] = *(const bf16x8*)(m1 + ks * 1024);
#pragma unroll
    for (int ks = 0; ks < 2; ++ks) f.kd[ks] = *(const bf16x8*)(cb + 32768 + ((wave * 2 + ks) * 64 + lane) * 16);
    if (wave < 4) f.u = *(const v2u*)(cb + 49152 + ((sl * 4 + ct) * 64 + lane) * 8);
    else {
#pragma unroll
        for (int ks = 0; ks < 2; ++ks) f.at[ks] = *(const bf16x8*)(cb + 65536 + ((ct * 2 + ks) * 64 + lane) * 16); }
    f.eg = egl[n];
}
__device__ __forceinline__ void phase_dnb(const Params& P, LAS unsigned char* lds) {
    int tid_l = threadIdx.x; asm volatile("" : "+v"(tid_l)); const int tid = tid_l, lane = tid & 63, wave = __builtin_amdgcn_readfirstlane(tid >> 6);
    const int x = blockIdx.x; if (x >= 256) return;
    const int xcd = x & 7, idx = x >> 3, bh = xcd * 4 + (idx >> 3), sl = idx & 7, b = bh >> 2, h = bh & 3, ct = wave & 3;
    const unsigned char* base = P.ws + WS_DN + (size_t)bh * 64 * DN_CHUNK_BYTES; const float* egl = (const float*)(P.ws + WS_EGL) + bh * 64;
    bf16* yo = (bf16*)(P.ws + WS_Y) + ((size_t)b * SEQ + 16 * ct + 4 * (lane >> 4)) * DM + 512 + h * 128 + sl * 16 + (lane & 15);
    LAS unsigned char* St = lds; LAS unsigned char* vnT = lds + 4352;
    LAS const unsigned char* stb = St + (lane & 15) * 272 + (lane >> 4) * 16; LAS const unsigned char* vnb = vnT + (lane & 15) * 144 + (lane >> 4) * 16;
    if (tid < 272) *(LAS v4u*)(St + tid * 16) = (v4u){0u, 0u, 0u, 0u};
    f32x4v Sacc = {0.f, 0.f, 0.f, 0.f};
    DnFrag fr[4];
#pragma unroll
    for (int u = 0; u < 4; ++u) dnb_load(fr[u], base, egl, u, wave, lane, sl);
    __syncthreads();
#pragma unroll 1
    for (int n0 = 0; n0 < 64; n0 += 4) {
#pragma unroll
        for (int u = 0; u < 4; ++u) { const int n = n0 + u;
            f32x4v acc = {0.f, 0.f, 0.f, 0.f};
#pragma unroll
            for (int ks = 0; ks < 4; ++ks) acc = __builtin_amdgcn_mfma_f32_16x16x32_bf16(fr[u].m1[ks], *(const LAS bf16x8*)(stb + ks * 64), acc, 0, 0, 0);
            if (wave < 4) { const float u0 = bf2f(fr[u].u.x & 0xffff), u1 = bf2f(fr[u].u.x >> 16), u2 = bf2f(fr[u].u.y & 0xffff), u3 = bf2f(fr[u].u.y >> 16);
                v2u w; w.x = cvtpk(u0 - acc[0], u1 - acc[1]); w.y = cvtpk(u2 - acc[2], u3 - acc[3]); *(LAS v2u*)(vnT + (lane & 15) * 144 + (16 * ct + 4 * (lane >> 4)) * 2) = w; }
            __syncthreads();
            const bf16x8 v0 = *(const LAS bf16x8*)(vnb), v1 = *(const LAS bf16x8*)(vnb + 64);
            if (wave >= 4) { acc = __builtin_amdgcn_mfma_f32_16x16x32_bf16(fr[u].at[0], v0, acc, 0, 0, 0); acc = __builtin_amdgcn_mfma_f32_16x16x32_bf16(fr[u].at[1], v1, acc, 0, 0, 0);
                bf16* yp = yo + (size_t)n * 64 * DM;
#pragma unroll
                for (int r = 0; r < 4; ++r) yp[(size_t)r * DM] = (bf16)f2bf(acc[r]); }
            Sacc = Sacc * fr[u].eg;
            Sacc = __builtin_amdgcn_mfma_f32_16x16x32_bf16(fr[u].kd[0], v0, Sacc, 0, 0, 0); Sacc = __builtin_amdgcn_mfma_f32_16x16x32_bf16(fr[u].kd[1], v1, Sacc, 0, 0, 0);
            { v2u w; w.x = cvtpk(Sacc[0], Sacc[1]); w.y = cvtpk(Sacc[2], Sacc[3]); *(LAS v2u*)(St + (lane & 15) * 272 + (16 * wave + 4 * (lane >> 4)) * 2) = w; }
            dnb_load(fr[u], base, egl, n + 4 < 64 ? n + 4 : 63, wave, lane, sl);
            __syncthreads();
        }
    }
}
__device__ __forceinline__ void phase_dnc(const Params& P, LAS unsigned char* lds) {
    int tid_l = threadIdx.x; asm volatile("" : "+v"(tid_l)); const int tid = tid_l, lane = tid & 63, wave = tid >> 6;
    const int gw = blockIdx.x * NWAVES + wave, NGW = gridDim.x * NWAVES;
    const bf16* z = (const bf16*)(P.ws + WS_Z); bf16* y = (bf16*)(P.ws + WS_Y);
    float on[8];
#pragma unroll
    for (int e = 0; e < 8; ++e) on[e] = P.in[I_A_ONORM][(lane & 15) * 8 + e];
    for (int it0 = gw; it0 < T; it0 += 4 * NGW) {
        const int hh = lane >> 4, d0 = (lane & 15) * 8; v4u ov[4], gv[4];
#pragma unroll
        for (int u = 0; u < 4; ++u) { const int it = it0 + u * NGW; if (it < T) { ov[u] = *(const v4u*)(y + (size_t)it * DM + 512 + hh * 128 + d0); gv[u] = *(const v4u*)(z + (size_t)it * 2560 + 2048 + hh * 128 + d0); } }
#pragma unroll
        for (int u = 0; u < 4; ++u) { const int it = it0 + u * NGW; if (it >= T) break;
            float o[8] = {bf2f(ov[u].x & 0xffff), bf2f(ov[u].x >> 16), bf2f(ov[u].y & 0xffff), bf2f(ov[u].y >> 16), bf2f(ov[u].z & 0xffff), bf2f(ov[u].z >> 16), bf2f(ov[u].w & 0xffff), bf2f(ov[u].w >> 16)};
            const float g[8] = {bf2f(gv[u].x & 0xffff), bf2f(gv[u].x >> 16), bf2f(gv[u].y & 0xffff), bf2f(gv[u].y >> 16), bf2f(gv[u].z & 0xffff), bf2f(gv[u].z >> 16), bf2f(gv[u].w & 0xffff), bf2f(gv[u].w >> 16)};
            float s = 0.f;
#pragma unroll
            for (int e = 0; e < 8; ++e) s += o[e] * o[e];
            s += __shfl_xor(s, 1); s += __shfl_xor(s, 2); s += __shfl_xor(s, 4); s += __shfl_xor(s, 8);
            const float rs = rsqrtf(s * (1.f / 128.f) + EPS);
#pragma unroll
            for (int e = 0; e < 8; ++e) o[e] = o[e] * rs * on[e] * (g[e] * __builtin_amdgcn_rcpf(1.f + __builtin_amdgcn_exp2f(-LOG2E_F * g[e])));
            v4u w; w.x = cvtpk(o[0], o[1]); w.y = cvtpk(o[2], o[3]); w.z = cvtpk(o[4], o[5]); w.w = cvtpk(o[6], o[7]);
            *(v4u*)(y + (size_t)it * DM + 512 + hh * 128 + d0) = w; } }
    phase_pool(P, lds);
}

constexpr size_t WS_CTL = 118 * MiB; constexpr int CTL_BYTES = 16384, LDS_CTL_OFF = 147392;
#define XB_TMO      128
#define XB_XCNT(j)  (256  + 64 * (j))
#define XB_XSUB(j)  (1280 + 64 * (j))
#define XB_XGEN(j)  (2304 + 64 * (j))
#define XB_TOP      3328
#define XB_TOPGEN   3392
#define XCD_BAR_WORDS 3456
#define XB_SPIN_CAP (1u << 18)

__device__ __forceinline__ unsigned xb_ld(unsigned* p)              { return __hip_atomic_load(p, __ATOMIC_RELAXED, __HIP_MEMORY_SCOPE_AGENT); }
__device__ __forceinline__ unsigned xb_add(unsigned* p, unsigned v) { return __hip_atomic_fetch_add(p, v, __ATOMIC_RELAXED, __HIP_MEMORY_SCOPE_AGENT); }
__device__ __forceinline__ unsigned xb_xcc_id() { return (unsigned)__builtin_amdgcn_s_getreg((3 << 11) | 20) & 0xFu; }
#define XB_SPIN(cond, bar) do { unsigned _sp = 0; while (cond) { __builtin_amdgcn_s_sleep(1); \
    if ((++_sp & 255u) == 0u) { if (xb_ld(&(bar)[XB_TMO])) break; if (_sp > XB_SPIN_CAP) { atomicAdd(&(bar)[XB_TMO], 1u); break; } } } } while (0)

struct XcdBarrier {
    unsigned* bar; unsigned x;
    volatile LAS unsigned* st;
};

__device__ __forceinline__ XcdBarrier xcd_barrier_post(unsigned* bar, volatile LAS unsigned* st) {
    XcdBarrier b; b.bar = bar; b.x = xb_xcc_id(); b.st = st;
    if (threadIdx.x == 0) (void)xb_add(&bar[XB_XCNT(b.x)], 1u);
    return b;
}
__device__ __forceinline__ void xcd_barrier_complete(unsigned* bar, unsigned x, unsigned& nloc, unsigned& nx) {
    const unsigned G = gridDim.x * gridDim.y * gridDim.z;
    unsigned sum, cnt, mine, sp = 0u;
    for (;;) {
        sum = 0u; cnt = 0u; mine = 0u;
#pragma unroll
        for (unsigned j = 0; j < 16; ++j) { const unsigned c = xb_ld(&bar[XB_XCNT(j)]); sum += c; cnt += (c > 0u) ? 1u : 0u; mine = (j == x) ? c : mine; }
        if (sum == G) break;
        __builtin_amdgcn_s_sleep(1);
        if ((++sp & 255u) == 0u) { if (xb_ld(&bar[XB_TMO])) break; if (sp > XB_SPIN_CAP) { atomicAdd(&bar[XB_TMO], 1u); break; } }
    }
    nloc = mine > 0u ? mine : 1u; nx = cnt > 0u ? cnt : 1u;
}

__device__ __forceinline__ void xcd_barrier(const XcdBarrier& b) {
    asm volatile("s_waitcnt vmcnt(0)" ::: "memory");
    __syncthreads();
    if (threadIdx.x == 0) {
        unsigned* bar = b.bar;
        __builtin_amdgcn_s_waitcnt(0);
        unsigned nloc = b.st[0], nx = b.st[1];
        if (nloc == 0u) { xcd_barrier_complete(bar, b.x, nloc, nx); b.st[0] = nloc; b.st[1] = nx; }
        const unsigned old = xb_add(&bar[XB_XSUB(b.x)], 1u);
        const unsigned gen = old / nloc;
        if (old + 1u == (gen + 1u) * nloc) {
            __builtin_amdgcn_fence(__ATOMIC_RELEASE, "agent");
            asm volatile("s_waitcnt vmcnt(0)" ::: "memory");
            const unsigned og = xb_add(&bar[XB_TOP], 1u);
            const unsigned tg = og / nx;
            if (og + 1u == (tg + 1u) * nx) xb_add(&bar[XB_TOPGEN], 1u);
            else XB_SPIN(xb_ld(&bar[XB_TOPGEN]) == tg, bar);
            __builtin_amdgcn_fence(__ATOMIC_ACQUIRE, "agent");
            xb_add(&bar[XB_XGEN(b.x)], 1u);
            asm volatile("s_waitcnt vmcnt(0)" ::: "memory");
        } else {
            XB_SPIN(xb_ld(&bar[XB_XGEN(b.x)]) == gen, bar);
            __builtin_amdgcn_fence(__ATOMIC_ACQUIRE, "agent");
            asm volatile("s_waitcnt vmcnt(0)" ::: "memory");
        }
    }
    __syncthreads();
}

constexpr int LDS_RS_OFF = 131072;
template <class E> __device__ __forceinline__ void run_gemm(LAS unsigned char* lds, const bf16* A, const bf16* Bt, int M, int N, int K, const E& e, const float* ss = nullptr) {
    pg8::Gemm g{A, Bt, M, N, K}; pg8::StaticOrder So; So.init(M, N, (int)gridDim.x, (int)blockIdx.x);
    if (ss) { pg8::Unit u; LAS float* rs = (LAS float*)(lds + LDS_RS_OFF);
        for (int i = 0; So.next(i, u); ++i) { const int r = threadIdx.x; if (r < 256) rs[256 * i + r] = pg8::row_rstd(ss, u.pm * 256 + r); }
        __syncthreads(); }
    pg8::gemm_phase<E, pg8::StaticOrder, true, true>(lds, g, So, e);
}
constexpr int N_PHASES = 22;
#ifndef MK_PER_PHASE
#define MK_PER_PHASE 0
#endif

template <int ph> __device__ __forceinline__ void do_phase(const Params& P, LAS unsigned char* lds) {
    unsigned char* ws = P.ws;
    bf16* xh = (bf16*)(ws + WS_XH); float* ss = (float*)(ws + WS_SS); bf16* yb = (bf16*)(ws + WS_Y); bf16* zb = (bf16*)(ws + WS_Z);
    if constexpr (ph == 0) phase_prologue(P, lds);
    else if constexpr (ph == 1) {
        pg8::Gemm g{xh, (const bf16*)(ws + WS_AIN), T, 2816, 1024, (const bf16*)(ws + WS_MEMH), (const bf16*)(ws + WS_XKV)};
        pg8::DualOrder So; So.init(T, 2816, 2048, 4096, (int)gridDim.x, (int)blockIdx.x);
        { pg8::Unit u; LAS float* rs = (LAS float*)(lds + LDS_RS_OFF);
          for (int i = 0; So.next(i, u); ++i) { const int r = threadIdx.x; if (r < 256 && u.kind == 0) rs[256 * i + r] = pg8::row_rstd(ss, u.pm * 256 + r); }
          __syncthreads(); }
        pg8::EpiDual<pg8::EpiInA, pg8::EpiBf<0>> e{{zb, (float*)(ws + WS_BA), (LAS float*)(lds + LDS_RS_OFF)}, {(bf16*)(ws + WS_MEMKV), 4096, nullptr, 1.f}};
        pg8::gemm_phase<pg8::EpiDual<pg8::EpiInA, pg8::EpiBf<0>>, pg8::DualOrder, true, true>(lds, g, So, e); }
    else if constexpr (ph == 2) phase_dna(P, lds);
    else if constexpr (ph == 3) phase_dnb(P, lds);
    else if constexpr (ph == 4) phase_dnc(P, lds);
    else if constexpr (ph == 11) { pg8::EpiInC e{zb, zb + (size_t)T * 1024, (float*)(ws + WS_GATES), (LAS float*)(lds + LDS_RS_OFF)}; run_gemm(lds, xh, (const bf16*)(ws + WS_CIN), T, 2560, 1024, e, ss);   }
    else if constexpr (ph == 12) { const int kvs = (int)blockIdx.x >> 5;
        if (kvs < 2) { pg8::EpiF32 e{(float*)(ws + (kvs ? WS_P01V : WS_P01K)), 256};
            pg8::Gemm g{zb + (size_t)T * 1024 + (size_t)kvs * KV_KIND, (const bf16*)(ws + (kvs ? WS_CMPV : WS_CMPK)), 8192, 256, 1024}; pg8::StaticOrder So; So.init(8192, 256, (int)gridDim.x, (int)blockIdx.x & 31);
            pg8::gemm_phase<pg8::EpiF32, pg8::StaticOrder, true, true>(lds, g, So, e);
            pg8::Unit u; So.next(0, u);
            __builtin_amdgcn_fence(__ATOMIC_RELEASE, "agent"); asm volatile("s_waitcnt vmcnt(0)" ::: "memory"); __syncthreads(); __builtin_amdgcn_fence(__ATOMIC_ACQUIRE, "agent"); asm volatile("s_waitcnt vmcnt(0)" ::: "memory");
            cmpfin_bg(P, lds, kvs, u.pm); }
        else { const int gwi = ((int)blockIdx.x - 64) * NWAVES + (int)(threadIdx.x >> 6), ngwi = ((int)gridDim.x - 64) * NWAVES; phase_gates(P, lds, gwi, ngwi); phase_conv_late(P, lds, gwi, ngwi); } }
    else if constexpr (ph == 13) { }
    else if constexpr (ph == 14) phase_nsa(P, lds);
    else if constexpr (ph == 21) phase_final(P);
    else { constexpr int l = ph >= 15 ? 1 : 0, k = ph - (l ? 15 : 5);
        if constexpr (k == 1) {
            { pg8::EpiBf<0> e{(bf16*)(ws + WS_QXA), 1024, (LAS float*)(lds + LDS_RS_OFF), 1.f}; run_gemm(lds, xh, (const bf16*)(ws + WS_XQ) + (size_t)l * 1048576, T, 1024, 1024, e, ss); } }
        else if constexpr (k == 2) phase_xatt(P, lds, l);
        else if constexpr (k == 4) { pg8::EpiBf<1> e{(bf16*)(ws + WS_HMID), 4096, (LAS float*)(lds + LDS_RS_OFF), 1.f}; run_gemm(lds, xh, (const bf16*)(ws + WS_F1) + (size_t)l * 4194304, T, 4096, 1024, e, ss); }
        else { const bf16* A = k == 5 ? (const bf16*)(ws + WS_HMID) : yb; constexpr int K = k == 5 ? 4096 : 1024;
            const bf16* Bt = k == 0 ? (const bf16*)(ws + (l ? WS_COUT : WS_AOUT)) : k == 3 ? (const bf16*)(ws + WS_XO) + (size_t)l * 1048576 : (const bf16*)(ws + WS_F2) + (size_t)l * 4194304;
            if constexpr (ph == 5) { pg8::EpiRes<true> e{xh, ss, P.in[I_X]}; run_gemm(lds, A, Bt, T, 1024, K, e); }
            else { pg8::EpiRes<false> e{xh, ss, nullptr}; run_gemm(lds, A, Bt, T, 1024, K, e); } } }
}
__global__ void __launch_bounds__(NTHR, 2) trunk_fwd(Params P) {
    extern __shared__ __attribute__((aligned(16))) unsigned char lds_raw[];
    LAS unsigned char* lds = (LAS unsigned char*)lds_raw;
    cg::grid_group grid = cg::this_grid();
    const int lo = P.ph_lo, hi = P.ph_hi;
#ifndef PROBE_PH
#define PROBE_PH -1
#endif
    if (threadIdx.x < 2) ((LAS unsigned*)(lds + LDS_CTL_OFF))[threadIdx.x] = 0u;
    __syncthreads();
    const XcdBarrier bar = xcd_barrier_post((unsigned*)(P.ws + WS_CTL), (volatile LAS unsigned*)(lds + LDS_CTL_OFF));
    if (P.ph_lo < 0) grid.sync();
#define SEAM(k) { xcd_barrier(bar); }
#define RUN(k) if (lo <= (k) && (k) < hi) { if ((k) == PROBE_PH) { do_phase<(k)>(P, lds); SEAM(k) } do_phase<(k)>(P, lds); if ((k) + 1 < hi) SEAM(k) }
    RUN(0) RUN(1) RUN(2) RUN(3) RUN(4) RUN(5) RUN(6) RUN(7) RUN(8) RUN(9) RUN(10) RUN(11) RUN(12) RUN(14) RUN(15) RUN(16) RUN(17) RUN(18) RUN(19) RUN(20) RUN(21)
#undef RUN
}

extern "C" void kernel_launch(void* const* d_in, const int* in_sizes, int n_in, void* d_out, int out_size, void* d_ws, size_t ws_size, hipStream_t stream) {
    static int grid = 0;
    if (grid == 0) {
        if (n_in != N_IN || in_sizes[0] != T * DM || out_size != T * DM || ws_size < WS_END) { fprintf(stderr, "kernel_launch: unexpected shapes (n_in %d, in0 %d, out %d, ws %zu)\n", n_in, n_in > 0 ? in_sizes[0] : -1, out_size, ws_size); grid = -1; return; }
        int dev = 0, cus = 0, per_cu = 0;
        if (hipGetDevice(&dev) != hipSuccess || hipDeviceGetAttribute(&cus, hipDeviceAttributeMultiprocessorCount, dev) != hipSuccess) { grid = -1; return; }
        if (hipFuncSetAttribute((const void*)trunk_fwd, hipFuncAttributeMaxDynamicSharedMemorySize, LDS_BYTES) != hipSuccess) { fprintf(stderr, "kernel_launch: hipFuncSetAttribute failed\n"); grid = -1; return; }
        if (hipOccupancyMaxActiveBlocksPerMultiprocessor(&per_cu, (const void*)trunk_fwd, NTHR, LDS_BYTES) != hipSuccess || per_cu < 1) { fprintf(stderr, "kernel_launch: occupancy query says %d blocks/CU\n", per_cu); (void)hipGetLastError(); grid = -1; return; }
        grid = cus;
        fprintf(stderr, "kernel_launch: %d CUs, %d blocks/CU by the occupancy query, grid %d\n", cus, per_cu, grid);
    }
    if (grid < 0) return;
    Params p{};
    for (int i = 0; i < N_IN; ++i) p.in[i] = (const float*)d_in[i];
    p.out = (float*)d_out; p.ws = (unsigned char*)d_ws;
#if MK_PER_PHASE
    for (int ph = 0; ph < N_PHASES; ++ph) { p.ph_lo = ph; p.ph_hi = ph + 1; hipLaunchKernelGGL(trunk_fwd, dim3(grid), dim3(NTHR), LDS_BYTES, stream, p); }
#else
    p.ph_lo = 0; p.ph_hi = N_PHASES;
    if (hipMemsetAsync((char*)d_ws + WS_CTL, 0, CTL_BYTES, stream) != hipSuccess) { fprintf(stderr, "kernel_launch: memset of the barrier words failed\n"); return; }
    void* args[] = {&p};
    hipError_t e = hipLaunchCooperativeKernel((const void*)trunk_fwd, dim3(grid), dim3(NTHR), args, LDS_BYTES, stream);
    if (e != hipSuccess) fprintf(stderr, "kernel_launch: cooperative launch failed: %s (grid %d)\n", hipGetErrorString(e), grid);
#endif
}
```

```cpp
#include <hip/hip_runtime.h>
#include <hip/hip_cooperative_groups.h>
#include <cstdio>
#include <cstdint>
namespace cg = cooperative_groups;
namespace pg8 {
#define PG8_LAS __attribute__((address_space(3)))
typedef unsigned short bf16_t;
typedef short bf16x8 __attribute__((ext_vector_type(8)));
typedef float f32x4 __attribute__((ext_vector_type(4)));
typedef unsigned u32x4 __attribute__((ext_vector_type(4)));
constexpr int BM = 256, BK = 64, HALF = 128, HTB = HALF * BK * 2  , STAGE_BYTES = 8 * HTB, NXCD = 8, WGM = 8;

__host__ __device__ __forceinline__ int lds_byte(int r, int c) { const int st = (r >> 4) * 2 + (c >> 5), rr = r & 15, cc = c & 31, ob = rr * 64 + cc * 2; return st * 1024 + (ob ^ (((ob >> 9) & 1) << 5)); }
__host__ __device__ __forceinline__ void stage_rc(int b, int& R, int& C) { const int st = b / 1024, sb = b % 1024, swz = sb ^ (((sb >> 9) & 1) << 5); R = (st >> 1) * 16 + swz / 64; C = (st & 1) * 32 + (swz % 64) / 2; }
__host__ __device__ __forceinline__ int perm32(int rho) { const int n = rho >> 4, i = rho & 15; return 8 * (i >> 2) + 4 * n + (i & 3); }

struct Unit { int pm, pn, ui, kind; };
struct Gemm { const bf16_t* A; const bf16_t* Bt; int M, N, K; const bf16_t* A2 = nullptr; const bf16_t* Bt2 = nullptr; };

struct StaticOrder {
    int nM, nN, nwg, G, c;
    __host__ __device__ void init(int M, int N, int G_, int c_) { nM = M / BM; nN = N / BM; nwg = nM * nN; G = G_; c = c_; }
    __host__ __device__ bool next(int i, Unit& u) const {
        const long L = (long)i * G + c; if (L >= nwg) return false;
        int wgid = (int)L; { const int q = nwg / NXCD, r = nwg % NXCD, xcd = wgid % NXCD, off = wgid / NXCD; wgid = (xcd < r ? xcd * (q + 1) : r * (q + 1) + (xcd - r) * q) + off; }
        const int nig = WGM * nN, gid = wgid / nig, fm = gid * WGM, gsz = (nM - fm) < WGM ? (nM - fm) : WGM;
        u.pm = fm + ((wgid % nig) % gsz); u.pn = (wgid % nig) / gsz; u.ui = i; u.kind = 0; return true;
    }
    __device__ __forceinline__ void a_ready(const Unit&) const {}
    __device__ __forceinline__ void done(const Unit&) const {}
};
__device__ __forceinline__ unsigned cvt_pk_bf16(float lo, float hi) { unsigned r; asm volatile("v_cvt_pk_bf16_f32 %0, %1, %2" : "=v"(r) : "v"(lo), "v"(hi)); return r; }
typedef float f32x2 __attribute__((ext_vector_type(2)));
typedef float f32x2 __attribute__((ext_vector_type(2)));
template <class Epi, class Sched, bool ALIGN_EPI = false, bool SP2 = false>
__device__ __forceinline__ void gemm_phase(PG8_LAS unsigned char* lds, const Gemm g, const Sched& S, const Epi& E) {
    int tid_l = threadIdx.x; asm volatile("" : "+v"(tid_l));
    const int tid = tid_l, wid = __builtin_amdgcn_readfirstlane(tid >> 6), lane = tid & 63, wr = wid >> 2, wc = wid & 3, fr = lane & 15, fq = lane >> 4;
    const int K = g.K, nt = K / BK;
    unsigned voffA[2], voffB[2];
#pragma unroll
    for (int i = 0; i < 2; ++i) { int R, C; stage_rc(tid * 16 + i * 8192, R, C); const int Rb = Epi::PERM ? ((R & ~31) + perm32(R & 31)) : R;
        voffA[i] = (unsigned)(R * K + C) * 2u; voffB[i] = (unsigned)(Rb * K + C) * 2u; }
    const size_t kstep = (size_t)(BK * 2);
    const size_t hstep = (size_t)HALF * K * 2;
    const size_t tstep = 2 * hstep;
    const unsigned ldsw = (unsigned)wid * 1024u;
    const int aoff = lds_byte(wr * 64 + fr, fq * 8), boff = lds_byte(wc * 32 + fr, fq * 8);
#define PG8_SA(b, h) (((b) * 2 + (h)) * HTB)
#define PG8_SB(b, h) ((4 + (b) * 2 + (h)) * HTB)
#define PG8_STAGE(bufoff, gbase, voff) do { _Pragma("unroll") for (int _i = 0; _i < 2; ++_i) \
        __builtin_amdgcn_global_load_lds((const unsigned*)((const char*)(gbase) + (voff)[_i]), (PG8_LAS unsigned*)(lds + (bufoff) + ldsw + _i * 8192), 16, 0, 0); } while (0)
#define PG8_LDA(dst, b, h) do { _Pragma("unroll") for (int m = 0; m < 4; ++m) _Pragma("unroll") for (int k = 0; k < 2; ++k) dst[m][k] = *(const PG8_LAS bf16x8*)(lds + PG8_SA(b, h) + aoff + m * 2048 + k * 1024); } while (0)
#define PG8_LDB(dst, b, h) do { _Pragma("unroll") for (int n = 0; n < 2; ++n) _Pragma("unroll") for (int k = 0; k < 2; ++k) dst[n][k] = *(const PG8_LAS bf16x8*)(lds + PG8_SB(b, h) + boff + n * 2048 + k * 1024); } while (0)
#define PG8_MMA(ai, bj, At, Bt) do { __builtin_amdgcn_s_setprio(1); _Pragma("unroll") for (int m = 0; m < 4; ++m) _Pragma("unroll") for (int n = 0; n < 2; ++n) _Pragma("unroll") for (int k = 0; k < 2; ++k) \
        acc[ai][bj][m][n] = __builtin_amdgcn_mfma_f32_16x16x32_bf16(Bt[n][k], At[m][k], acc[ai][bj][m][n], 0, 0, 0); __builtin_amdgcn_s_setprio(0); } while (0)
#define PG8_WAIT_V(n) asm volatile("s_waitcnt vmcnt(" #n ")" ::: "memory")
#define PG8_WAIT_L(n) asm volatile("s_waitcnt lgkmcnt(" #n ")" ::: "memory")
#define PG8_BAR __builtin_amdgcn_s_barrier()
#define PG8_SCHED __builtin_amdgcn_sched_barrier(0)
    Unit cur, nxt; int ui = 0;
    if (!S.next(0, cur)) return;
    f32x4 acc[2][2][4][2];
#pragma unroll
    for (int a = 0; a < 2; ++a)
#pragma unroll
        for (int b = 0; b < 2; ++b)
#pragma unroll
            for (int m = 0; m < 4; ++m)
#pragma unroll
                for (int n = 0; n < 2; ++n) acc[a][b][m][n] = (f32x4){0.f, 0.f, 0.f, 0.f};
    bf16x8 At[4][2], B0[2][2], B1[2][2];
    const char* cA = (const char*)(cur.kind ? g.A2 : g.A) + (size_t)cur.pm * tstep; const char* cB = (const char*)(cur.kind ? g.Bt2 : g.Bt) + (size_t)cur.pn * tstep;
    S.a_ready(cur);
    if constexpr (SP2) {
        PG8_STAGE(PG8_SB(0, 0), cB, voffB); PG8_STAGE(PG8_SB(0, 1), cB + hstep, voffB); PG8_STAGE(PG8_SA(0, 0), cA, voffA); PG8_STAGE(PG8_SA(0, 1), cA + hstep, voffA);
        if (wr == 1) PG8_BAR;
        PG8_WAIT_V(2); PG8_BAR;
        PG8_STAGE(PG8_SB(1, 0), cB + kstep, voffB); PG8_STAGE(PG8_SA(1, 0), cA + kstep, voffA); PG8_STAGE(PG8_SB(1, 1), cB + hstep + kstep, voffB);
        PG8_WAIT_V(6); PG8_BAR;
    } else {
        PG8_STAGE(PG8_SB(0, 0), cB, voffB); PG8_STAGE(PG8_SA(0, 0), cA, voffA); PG8_STAGE(PG8_SB(0, 1), cB + hstep, voffB); PG8_STAGE(PG8_SA(0, 1), cA + hstep, voffA);
        if (wr == 1) PG8_BAR;
        PG8_WAIT_V(4); PG8_BAR;
        PG8_STAGE(PG8_SB(1, 0), cB + kstep, voffB); PG8_STAGE(PG8_SA(1, 0), cA + kstep, voffA); PG8_STAGE(PG8_SB(1, 1), cB + hstep + kstep, voffB);
        PG8_WAIT_V(6); PG8_BAR;
    }
    for (;;) {
        const bool has_next = S.next(ui + 1, nxt);
        const char* nA = has_next ? (const char*)(nxt.kind ? g.A2 : g.A) + (size_t)nxt.pm * tstep : cA; const char* nB = has_next ? (const char*)(nxt.kind ? g.Bt2 : g.Bt) + (size_t)nxt.pn * tstep : cB;
        for (int t = 0; t < nt; t += 2) {
            const bool last = (t == nt - 2);
            const char* a1 = cA + (size_t)(t + 1) * kstep;
            const char* a2 = last ? nA : cA + (size_t)(t + 2) * kstep; const char* b2 = last ? nB : cB + (size_t)(t + 2) * kstep;
            const char* a3 = a2 + kstep; const char* b3 = b2 + kstep;
            if (last && has_next) S.a_ready(nxt);
            if constexpr (SP2) {
            PG8_LDB(B0, 0, 0); PG8_LDB(B1, 0, 1); PG8_SCHED; PG8_LDA(At, 0, 0); PG8_STAGE(PG8_SA(1, 1), a1 + hstep, voffA);
            PG8_WAIT_V(8); PG8_WAIT_L(0); PG8_BAR; PG8_MMA(0, 0, At, B0); PG8_MMA(0, 1, At, B1); PG8_BAR; PG8_SCHED;
            PG8_LDA(At, 0, 1); PG8_STAGE(PG8_SB(0, 0), b2, voffB); PG8_STAGE(PG8_SB(0, 1), b2 + hstep, voffB); PG8_STAGE(PG8_SA(0, 0), a2, voffA);
            PG8_WAIT_V(8); PG8_WAIT_L(0); PG8_BAR; PG8_MMA(1, 0, At, B0); PG8_MMA(1, 1, At, B1); PG8_BAR; PG8_SCHED;
            PG8_LDB(B0, 1, 0); PG8_LDB(B1, 1, 1); PG8_SCHED; PG8_LDA(At, 1, 0); PG8_STAGE(PG8_SA(0, 1), a2 + hstep, voffA);
            PG8_WAIT_V(8); PG8_WAIT_L(0); PG8_BAR; PG8_MMA(0, 0, At, B0); PG8_MMA(0, 1, At, B1); PG8_BAR; PG8_SCHED;
            PG8_LDA(At, 1, 1); PG8_STAGE(PG8_SB(1, 0), b3, voffB); PG8_STAGE(PG8_SB(1, 1), b3 + hstep, voffB); PG8_STAGE(PG8_SA(1, 0), a3, voffA);
            PG8_WAIT_V(8); PG8_WAIT_L(0); PG8_BAR; PG8_MMA(1, 0, At, B0); PG8_MMA(1, 1, At, B1); PG8_BAR; PG8_SCHED;
            } else {
            PG8_LDB(B0, 0, 0); PG8_SCHED; PG8_LDA(At, 0, 0); PG8_STAGE(PG8_SA(1, 1), a1 + hstep, voffA);
            PG8_WAIT_L(8); PG8_BAR; PG8_WAIT_L(0); PG8_MMA(0, 0, At, B0); PG8_BAR; PG8_SCHED;
            PG8_LDB(B1, 0, 1); PG8_STAGE(PG8_SB(0, 0), b2, voffB);
            PG8_BAR; PG8_WAIT_L(0); PG8_MMA(0, 1, At, B1); PG8_BAR;
            PG8_LDA(At, 0, 1); PG8_STAGE(PG8_SA(0, 0), a2, voffA);
            PG8_BAR; PG8_WAIT_L(0); PG8_MMA(1, 0, At, B0); PG8_BAR; PG8_SCHED;
            PG8_STAGE(PG8_SB(0, 1), b2 + hstep, voffB);
            PG8_WAIT_V(6); PG8_BAR; PG8_MMA(1, 1, At, B1); PG8_BAR;
            PG8_LDB(B0, 1, 0); PG8_SCHED; PG8_LDA(At, 1, 0); PG8_STAGE(PG8_SA(0, 1), a2 + hstep, voffA);
            PG8_WAIT_L(8); PG8_BAR; PG8_WAIT_L(0); PG8_MMA(0, 0, At, B0); PG8_BAR; PG8_SCHED;
            PG8_LDB(B1, 1, 1); PG8_STAGE(PG8_SB(1, 0), b3, voffB);
            PG8_BAR; PG8_WAIT_L(0); PG8_MMA(0, 1, At, B1); PG8_BAR;
            PG8_LDA(At, 1, 1); PG8_STAGE(PG8_SA(1, 0), a3, voffA);
            PG8_BAR; PG8_WAIT_L(0); PG8_MMA(1, 0, At, B0); PG8_BAR; PG8_SCHED;
            PG8_STAGE(PG8_SB(1, 1), b3 + hstep, voffB);
            PG8_WAIT_V(6); PG8_BAR; PG8_MMA(1, 1, At, B1); PG8_BAR;
            }
        }
        if constexpr (ALIGN_EPI) { if (wr == 0) PG8_BAR; }
        if constexpr (!Epi::AFTER_DRAIN) { E(acc, cur, wr, wc, fr, fq); S.done(cur); }
        if (!has_next) break;
#pragma unroll
        for (int a = 0; a < 2; ++a)
#pragma unroll
            for (int b = 0; b < 2; ++b)
#pragma unroll
                for (int m = 0; m < 4; ++m)
#pragma unroll
                    for (int n = 0; n < 2; ++n) acc[a][b][m][n] = (f32x4){0.f, 0.f, 0.f, 0.f};
        cur = nxt; cA = nA; cB = nB; ++ui;
        if constexpr (ALIGN_EPI) { if (wr == 1) PG8_BAR; }
    }
    PG8_WAIT_V(0);
    if constexpr (!ALIGN_EPI) { if (wr == 0) PG8_BAR; }
    PG8_BAR;
    if constexpr (Epi::AFTER_DRAIN) { E.fused(acc, cur, wr, wc, fr, fq, lds, wid, lane); S.done(cur); }
#undef PG8_SA
#undef PG8_SB
#undef PG8_STAGE
#undef PG8_LDA
#undef PG8_LDB
#undef PG8_MMA
#undef PG8_WAIT_V
#undef PG8_WAIT_L
#undef PG8_BAR
#undef PG8_SCHED
}
}
namespace pg8 {
struct DualOrder {
    StaticOrder s1, s2; int G, c;
    __host__ __device__ void init(int M1, int N1, int M2, int N2, int G_, int c_) { s1.init(M1, N1, 1, 0); s2.init(M2, N2, 1, 0); G = G_; c = c_; }
    __host__ __device__ bool next(int i, Unit& u) const {
        const long L = (long)i * G + c; if (L >= s1.nwg + s2.nwg) return false;
        if (L < s1.nwg) { s1.next((int)L, u); u.kind = 0; } else { s2.next((int)(L - s1.nwg), u); u.kind = 1; }
        u.ui = i; return true;
    }
    __device__ __forceinline__ void a_ready(const Unit&) const {}
    __device__ __forceinline__ void done(const Unit&) const {}
};
__device__ __forceinline__ float row_rstd(const float* ss, int row) {
    const f32x4* p = (const f32x4*)(ss + (size_t)row * 16);
    const f32x4 a = p[0], b = p[1], c = p[2], d = p[3];
    const float s = (((a[0] + a[1]) + (a[2] + a[3])) + ((b[0] + b[1]) + (b[2] + b[3]))) + (((c[0] + c[1]) + (c[2] + c[3])) + ((d[0] + d[1]) + (d[2] + d[3])));
    return rsqrtf(s * (1.0f / 1024.0f) + 1e-6f);
}
__device__ __forceinline__ u32x4 pack8(f32x4 v0, f32x4 v1) { u32x4 w; w.x = cvt_pk_bf16(v0[0], v0[1]); w.y = cvt_pk_bf16(v0[2], v0[3]); w.z = cvt_pk_bf16(v1[0], v1[1]); w.w = cvt_pk_bf16(v1[2], v1[3]); return w; }

template <int ACT  > struct EpiBf {
    static constexpr bool PERM = true, AFTER_DRAIN = false;
    bf16_t* O; int ldc; const PG8_LAS float* rs; float mul;
    __device__ __forceinline__ void operator()(const f32x4 (&acc)[2][2][4][2], const Unit& u, int wr, int wc, int fr, int fq) const {
        const int row0 = u.pm * BM + wr * 64 + fr, col0 = u.pn * BM + wc * 32 + 8 * fq;
#pragma unroll
        for (int ai = 0; ai < 2; ++ai)
#pragma unroll
            for (int m = 0; m < 4; ++m) { const int row = row0 + ai * HALF + m * 16; const float sc = rs ? mul * rs[256 * u.ui + ai * HALF + wr * 64 + m * 16 + fr] : mul; bf16_t* rowp = O + (size_t)row * ldc + col0;
#pragma unroll
                for (int bj = 0; bj < 2; ++bj) { f32x4 v0 = acc[ai][bj][m][0] * sc, v1 = acc[ai][bj][m][1] * sc;
                    if (ACT == 1) {
#pragma unroll
                        for (int j = 0; j < 4; ++j) { const float a = fmaxf(v0[j], 0.f), b = fmaxf(v1[j], 0.f); v0[j] = a * a; v1[j] = b * b; } }
                    *(u32x4*)(rowp + bj * HALF) = pack8(v0, v1); } }
    }
};
struct EpiF32 {
    static constexpr bool PERM = true, AFTER_DRAIN = false;
    float* C; int ldc;
    __device__ __forceinline__ void operator()(const f32x4 (&acc)[2][2][4][2], const Unit& u, int wr, int wc, int fr, int fq) const {
        const int row0 = u.pm * BM + wr * 64 + fr, col0 = u.pn * BM + wc * 32 + 8 * fq;
#pragma unroll
        for (int ai = 0; ai < 2; ++ai)
#pragma unroll
            for (int m = 0; m < 4; ++m) { float* rowp = C + (size_t)(row0 + ai * HALF + m * 16) * ldc + col0;
#pragma unroll
                for (int bj = 0; bj < 2; ++bj) { *(f32x4*)(rowp + bj * HALF) = acc[ai][bj][m][0]; *(f32x4*)(rowp + bj * HALF + 4) = acc[ai][bj][m][1]; } }
    }
};
template <bool F32RES> struct EpiRes {
    static constexpr bool PERM = true, AFTER_DRAIN = false;
    bf16_t* xh; float* ssout; const float* r32;
    __device__ __forceinline__ void operator()(const f32x4 (&acc)[2][2][4][2], const Unit& u, int wr, int wc, int fr, int fq) const {
        const int row0 = u.pm * BM + wr * 64 + fr, col0 = u.pn * BM + wc * 32 + 8 * fq;
#pragma unroll
        for (int ai = 0; ai < 2; ++ai) {
            u32x4 pre[4][2]; f32x4 pf[4][2][2];
#pragma unroll
            for (int m = 0; m < 4; ++m)
#pragma unroll
                for (int bj = 0; bj < 2; ++bj) { const size_t off = (size_t)(row0 + ai * HALF + m * 16) * 1024 + col0 + bj * HALF;
                    if (F32RES) { pf[m][bj][0] = *(const f32x4*)(r32 + off); pf[m][bj][1] = *(const f32x4*)(r32 + off + 4); } else pre[m][bj] = *(const u32x4*)(xh + off); }
            asm volatile("" ::: "memory"); __builtin_amdgcn_sched_barrier(0);
#pragma unroll
            for (int m = 0; m < 4; ++m) { const int row = row0 + ai * HALF + m * 16; float q = 0.f;
#pragma unroll
                for (int bj = 0; bj < 2; ++bj) { const size_t off = (size_t)row * 1024 + col0 + bj * HALF; f32x4 r0, r1;
                    if (F32RES) { r0 = pf[m][bj][0]; r1 = pf[m][bj][1]; }
                    else { const u32x4 p = pre[m][bj];
                        r0 = (f32x4){__uint_as_float(p.x << 16), __uint_as_float(p.x & 0xffff0000u), __uint_as_float(p.y << 16), __uint_as_float(p.y & 0xffff0000u)};
                        r1 = (f32x4){__uint_as_float(p.z << 16), __uint_as_float(p.z & 0xffff0000u), __uint_as_float(p.w << 16), __uint_as_float(p.w & 0xffff0000u)}; }
                    const f32x4 v0 = acc[ai][bj][m][0] + r0, v1 = acc[ai][bj][m][1] + r1;
                    q += ((v0[0] * v0[0] + v0[1] * v0[1]) + (v0[2] * v0[2] + v0[3] * v0[3])) + ((v1[0] * v1[0] + v1[1] * v1[1]) + (v1[2] * v1[2] + v1[3] * v1[3]));
                    *(u32x4*)(xh + off) = pack8(v0, v1); }
                q += __shfl_xor(q, 16); q += __shfl_xor(q, 32);
                if (fq == 0) ssout[(size_t)row * 16 + u.pn * 4 + wc] = q; }
            asm volatile("" ::: "memory"); __builtin_amdgcn_sched_barrier(0); }
    }
};
struct EpiInA {
    static constexpr bool PERM = true, AFTER_DRAIN = false;
    bf16_t* z; float* ba; const PG8_LAS float* rs;
    __device__ __forceinline__ void operator()(const f32x4 (&acc)[2][2][4][2], const Unit& u, int wr, int wc, int fr, int fq) const {
        const int row0 = u.pm * BM + wr * 64 + fr, col0 = u.pn * BM + wc * 32 + 8 * fq;
#pragma unroll
        for (int ai = 0; ai < 2; ++ai)
#pragma unroll
            for (int m = 0; m < 4; ++m) { const int row = row0 + ai * HALF + m * 16; const float sc = rs[256 * u.ui + ai * HALF + wr * 64 + m * 16 + fr];
                if (u.pn < 10) { bf16_t* rowp = z + (size_t)row * 2560 + col0;
#pragma unroll
                    for (int bj = 0; bj < 2; ++bj) *(u32x4*)(rowp + bj * HALF) = pack8(acc[ai][bj][m][0] * sc, acc[ai][bj][m][1] * sc);
                } else if (wc == 0 && fq == 0) { *(f32x4*)(ba + (size_t)row * 8) = acc[ai][0][m][0] * sc; *(f32x4*)(ba + (size_t)row * 8 + 4) = acc[ai][0][m][1] * sc; } }
    }
};
struct EpiInC {
    static constexpr bool PERM = true, AFTER_DRAIN = false;
    bf16_t* q; bf16_t* kv; float* gates; const PG8_LAS float* rs;
    __device__ __forceinline__ void operator()(const f32x4 (&acc)[2][2][4][2], const Unit& u, int wr, int wc, int fr, int fq) const {
        const int row0 = u.pm * BM + wr * 64 + fr, col0 = u.pn * BM + wc * 32 + 8 * fq;
#pragma unroll
        for (int ai = 0; ai < 2; ++ai)
#pragma unroll
            for (int m = 0; m < 4; ++m) { const int row = row0 + ai * HALF + m * 16; const float sc = rs[256 * u.ui + ai * HALF + wr * 64 + m * 16 + fr];
                if (u.pn < 4) { bf16_t* rowp = q + (size_t)row * 1024 + col0; const float sq = sc * 0.18033688011112042f;
#pragma unroll
                    for (int bj = 0; bj < 2; ++bj) *(u32x4*)(rowp + bj * HALF) = pack8(acc[ai][bj][m][0] * sq, acc[ai][bj][m][1] * sq);
                } else if (u.pn < 10) { const int b = row >> 12, s = row & 4095;
#pragma unroll
                    for (int bj = 0; bj < 2; ++bj) { const int cp = col0 + bj * HALF - 1024, kind = cp >> 8, g = (cp >> 6) & 3, d = cp & 63;
                        *(u32x4*)(kv + (size_t)kind * ((size_t)32768 * 256) + ((size_t)((b * 4 + g) * 4096 + s)) * 64 + d) = pack8(acc[ai][bj][m][0] * sc, acc[ai][bj][m][1] * sc); }
                } else { const int cl = wc * 32 + 8 * fq; if (cl < 48) { *(f32x4*)(gates + (size_t)row * 48 + cl) = acc[ai][0][m][0] * sc; *(f32x4*)(gates + (size_t)row * 48 + cl + 4) = acc[ai][0][m][1] * sc; } } }
    }
};
template <class E0, class E1> struct EpiDual {
    static constexpr bool PERM = true, AFTER_DRAIN = false;
    E0 e0; E1 e1;
    __device__ __forceinline__ void operator()(const f32x4 (&acc)[2][2][4][2], const Unit& u, int wr, int wc, int fr, int fq) const { if (u.kind) e1(acc, u, wr, wc, fr, fq); else e0(acc, u, wr, wc, fr, fq); }
};
}
#define LAS __attribute__((address_space(3)))
typedef unsigned short bf16;
typedef float f32x4 __attribute__((ext_vector_type(4)));
typedef unsigned v4u __attribute__((ext_vector_type(4)));
typedef unsigned v2u __attribute__((ext_vector_type(2)));
typedef short bf16x8 __attribute__((ext_vector_type(8)));
typedef float f32x16 __attribute__((ext_vector_type(16)));
typedef short v4i16 __attribute__((ext_vector_type(4)));
typedef float f32x2_t __attribute__((ext_vector_type(2))); typedef __bf16 bf16x2_t __attribute__((ext_vector_type(2)));
__device__ __forceinline__ unsigned cvtpk(float lo, float hi) { f32x2_t v = {lo, hi}; bf16x2_t b = __builtin_convertvector(v, bf16x2_t); return __builtin_bit_cast(unsigned, b); }

constexpr int NWAVES = 8, NTHR = 512;
constexpr int T = 32768, SEQ = 4096, DM = 1024, FF = 4096;
constexpr int LDS_BYTES = 147456;
constexpr float EPS = 1e-6f;

enum { I_X = 0, I_MEM, I_A_LN, I_A_WIN, I_A_POOLW, I_A_POOLS, I_A_CONV, I_A_ALOG, I_A_DTB, I_A_ONORM, I_A_WOUT,
       I_C_LN, I_C_WIN, I_C_PEK, I_C_W1K, I_C_W2K, I_C_PEV, I_C_W1V, I_C_W2V, I_C_WOUT,
       I_XA_LN, I_XA_MLN, I_XA_WQ, I_XA_WK, I_XA_WV, I_XA_WO, I_FF_LN, I_FF_W1, I_FF_W2, I_FLN, N_IN };

constexpr size_t MiB = (size_t)1 << 20;
constexpr size_t WS_AIN = 0, WS_AOUT = 6 * MiB, WS_CIN = 8 * MiB, WS_COUT = 14 * MiB, WS_XQ = 16 * MiB, WS_XKV = 20 * MiB, WS_XO = 28 * MiB;
constexpr size_t WS_F1 = 32 * MiB, WS_F2 = 48 * MiB, WS_CMPK = 64 * MiB, WS_CMPV = 64 * MiB + 512 * 1024, WS_CBIAS = 65 * MiB;
constexpr size_t WS_MEMH = 66 * MiB, WS_MEMKV = 74 * MiB, WS_SS = 90 * MiB, WS_BA = 92 * MiB, WS_GATES = 93 * MiB, WS_CK = 99 * MiB, WS_CV = 100 * MiB;
constexpr size_t WS_P01K = 101 * MiB, WS_P01V = 109 * MiB, WS_POOLW = 117 * MiB;
constexpr size_t WS_Z = 120 * MiB, WS_Y = 280 * MiB, WS_QXA = 344 * MiB, WS_XH = 408 * MiB, WS_HMID = 120 * MiB, WS_END = 489 * MiB;
constexpr size_t KV_KIND = (size_t)T * 256;

struct Params { const float* in[N_IN]; float* out; unsigned char* ws; int ph_lo, ph_hi; };

__device__ __forceinline__ float bf2f(unsigned v) { return __uint_as_float(v << 16); }
__device__ __forceinline__ unsigned f2bf(float f) { unsigned u = __float_as_uint(f); return (u + 0x7fffu + ((u >> 16) & 1u)) >> 16; }
__device__ __forceinline__ unsigned pk2(float lo, float hi) { return f2bf(lo) | (f2bf(hi) << 16); }
__device__ __forceinline__ float wave_sum(float v) {
#pragma unroll
    for (int o = 1; o < 64; o <<= 1) v += __shfl_xor(v, o);
    return v;
}
__device__ __forceinline__ float wave_max(float v) {
#pragma unroll
    for (int o = 1; o < 64; o <<= 1) v = fmaxf(v, __shfl_xor(v, o));
    return v;
}
__device__ __forceinline__ float silu_f(float x) { return x / (1.f + __expf(-x)); }
__device__ __forceinline__ float sigmoid_f(float x) { return 1.f / (1.f + __expf(-x)); }
#define LDS_WAIT() asm volatile("s_waitcnt lgkmcnt(0)" ::: "memory")

__device__ __forceinline__ void transpose_item(const float* W, int K, int N, int ld, const float* gain, bf16* WT, int row_off, LAS float* scr, int item, int lane) {
    const int nblk = N / 32, kb = item / nblk, nb = item % nblk, k0 = 64 * kb, n0 = 32 * nb;
#pragma unroll
    for (int i = 0; i < 8; ++i) { const int kk = 8 * i + (lane >> 3), nn = (lane & 7) * 4; f32x4 v = *(const f32x4*)(W + (size_t)(k0 + kk) * ld + n0 + nn); if (gain) v = v * gain[k0 + kk];
        scr[kk * 33 + nn] = v.x; scr[kk * 33 + nn + 1] = v.y; scr[kk * 33 + nn + 2] = v.z; scr[kk * 33 + nn + 3] = v.w; }
    LDS_WAIT();
    const int c = lane & 7;
#pragma unroll
    for (int j = 0; j < 4; ++j) { const int n = (lane >> 3) + 8 * j; const LAS float* s = scr + (8 * c) * 33 + n;
        v4u o; o.x = pk2(s[0 * 33], s[1 * 33]); o.y = pk2(s[2 * 33], s[3 * 33]); o.z = pk2(s[4 * 33], s[5 * 33]); o.w = pk2(s[6 * 33], s[7 * 33]);
        *(v4u*)(WT + (size_t)(row_off + n0 + n) * K + k0 + 8 * c) = o; }
    LDS_WAIT();
}
#define TJOB(W_, K_, N_, LD_, G_, WT_, RO_) { const int ni_ = ((K_) / 64) * ((N_) / 32); if (r < ni_) { transpose_item((W_), (K_), (N_), (LD_), (G_), (WT_), (RO_), scr, r, lane); continue; } r -= ni_; }

__device__ __forceinline__ void phase_prologue(const Params& P, LAS unsigned char* lds) {
    int tid_l = threadIdx.x; asm volatile("" : "+v"(tid_l)); const int tid = tid_l, lane = tid & 63, wave = tid >> 6;
    constexpr int NSMALL = 32; const bool small_role = (int)blockIdx.x >= (int)gridDim.x - NSMALL;
    const int gw = small_role ? 0x40000000 : (int)blockIdx.x * NWAVES + wave, NGW = ((int)gridDim.x - NSMALL) * NWAVES;
    unsigned char* ws = P.ws;
    LAS float* scr = (LAS float*)(lds + wave * 16384);
    constexpr int NITEMS = 1280 + 512 + 1280 + 512 + 4 * 512 + 512 + 2048 + 2048 + 4 * 64;
    for (int it = gw; it < NITEMS; it += NGW) {
        int r = it;
        TJOB(P.in[I_A_WIN], 1024, 2560, 2568, P.in[I_A_LN], (bf16*)(ws + WS_AIN), 0)
        TJOB(P.in[I_A_WOUT], 1024, 1024, 1024, nullptr, (bf16*)(ws + WS_AOUT), 0)
        TJOB(P.in[I_C_WIN], 1024, 2560, 2608, P.in[I_C_LN], (bf16*)(ws + WS_CIN), 0)
        TJOB(P.in[I_XA_WQ], 1024, 1024, 1024, P.in[I_XA_LN], (bf16*)(ws + WS_XQ), 0)
        TJOB(P.in[I_XA_WK], 1024, 1024, 1024, P.in[I_XA_MLN], (bf16*)(ws + WS_XKV), 0)
        TJOB(P.in[I_XA_WV], 1024, 1024, 1024, P.in[I_XA_MLN], (bf16*)(ws + WS_XKV), 1024)
        TJOB(P.in[I_XA_WK] + 1048576, 1024, 1024, 1024, P.in[I_XA_MLN] + 1024, (bf16*)(ws + WS_XKV) + 2097152, 0)
        TJOB(P.in[I_XA_WV] + 1048576, 1024, 1024, 1024, P.in[I_XA_MLN] + 1024, (bf16*)(ws + WS_XKV) + 2097152, 1024)
        TJOB(P.in[I_XA_WO], 1024, 1024, 1024, nullptr, (bf16*)(ws + WS_XO), 0)
        TJOB(P.in[I_FF_W1], 1024, 4096, 4096, P.in[I_FF_LN], (bf16*)(ws + WS_F1), 0)
        TJOB(P.in[I_FF_W2], 4096, 1024, 1024, nullptr, (bf16*)(ws + WS_F2), 0)
        TJOB(P.in[I_C_W1K], 1024, 128, 128, nullptr, (bf16*)(ws + WS_CMPK), 0)
        TJOB(P.in[I_C_W1K] + 131072, 1024, 128, 128, nullptr, (bf16*)(ws + WS_CMPK), 128)
        TJOB(P.in[I_C_W1V], 1024, 128, 128, nullptr, (bf16*)(ws + WS_CMPV), 0)
        TJOB(P.in[I_C_W1V] + 131072, 1024, 128, 128, nullptr, (bf16*)(ws + WS_CMPV), 128)
    }
    const int gt = small_role ? ((int)blockIdx.x - ((int)gridDim.x - NSMALL)) * NTHR + tid : 0x40000000, NGT = NSMALL * NTHR; const int gws = gt >> 6;
    for (int i = gt; i < 56 * 1024; i += NGT) { const int j = i >> 10, kk = i & 1023;
        if (j < 8) ((bf16*)(ws + WS_AIN))[(size_t)(2560 + j) * 1024 + kk] = (bf16)f2bf(P.in[I_A_LN][kk] * P.in[I_A_WIN][(size_t)kk * 2568 + 2560 + j]);
        else ((bf16*)(ws + WS_CIN))[(size_t)(2560 + j - 8) * 1024 + kk] = (bf16)f2bf(P.in[I_C_LN][kk] * P.in[I_C_WIN][(size_t)kk * 2608 + 2560 + j - 8]); }
    for (int i = gt; i < (248 + 208) * 128; i += NGT) { const int row = i >> 7, pc = i & 127; const v4u z4 = {0u, 0u, 0u, 0u};
        if (row < 248) *(v4u*)((bf16*)(ws + WS_AIN) + (size_t)(2568 + row) * 1024 + pc * 8) = z4; else *(v4u*)((bf16*)(ws + WS_CIN) + (size_t)(2608 + row - 248) * 1024 + pc * 8) = z4; }
    for (int i = gt; i < 4 * 128 * 128; i += NGT) { const int g = i >> 14, d = (i >> 7) & 127, c = i & 127; ((bf16*)(ws + WS_POOLW))[i] = (bf16)f2bf(P.in[I_A_POOLW][(size_t)g * 16384 + c * 128 + d] * P.in[I_A_POOLS][g * 128 + d]); }
    if (gws < 256) { const int n = gws & 127; const float* pe = gws < 128 ? P.in[I_C_PEK] : P.in[I_C_PEV]; const float* w1 = gws < 128 ? P.in[I_C_W1K] : P.in[I_C_W1V];
        float s = 0.f;
#pragma unroll 8
        for (int j = 0; j < 32; ++j) { const int i = lane + 64 * j; s += pe[i] * w1[(size_t)i * 128 + n]; }
        s = wave_sum(s); if (lane == 0) ((float*)(ws + WS_CBIAS))[gws] = s; }
    { bf16* xh = (bf16*)(ws + WS_XH); float* ss = (float*)(ws + WS_SS);
      for (int m0 = gw; m0 < T; m0 += 4 * NGW) { f32x4 v[4][4];
#pragma unroll
          for (int u = 0; u < 4; ++u) { const int m = m0 + u * NGW; if (m < T) { const f32x4* xr = (const f32x4*)(P.in[I_X] + (size_t)m * DM) + lane;
#pragma unroll
                  for (int j = 0; j < 4; ++j) v[u][j] = xr[64 * j]; } }
#pragma unroll
          for (int u = 0; u < 4; ++u) { const int m = m0 + u * NGW; if (m >= T) break; float s = 0.f;
#pragma unroll
              for (int j = 0; j < 4; ++j) s += (v[u][j].x * v[u][j].x + v[u][j].y * v[u][j].y) + (v[u][j].z * v[u][j].z + v[u][j].w * v[u][j].w);
              s = wave_sum(s);
              v2u* o8 = (v2u*)(xh + (size_t)m * DM) + lane;
#pragma unroll
              for (int j = 0; j < 4; ++j) { v2u w; w.x = pk2(v[u][j].x, v[u][j].y); w.y = pk2(v[u][j].z, v[u][j].w); o8[64 * j] = w; }
              if (lane < 16) ss[(size_t)m * 16 + lane] = lane == 0 ? s : 0.f; } } }
    { bf16* mh = (bf16*)(ws + WS_MEMH);
      for (int m = gw; m < 2048; m += NGW) { const f32x4* xr = (const f32x4*)(P.in[I_MEM] + (size_t)m * DM) + lane; f32x4 v[4]; float s = 0.f;
#pragma unroll
          for (int j = 0; j < 4; ++j) { v[j] = xr[64 * j]; s += (v[j].x * v[j].x + v[j].y * v[j].y) + (v[j].z * v[j].z + v[j].w * v[j].w); }
          const float rs = rsqrtf(wave_sum(s) * (1.f / DM) + EPS);
          v2u* o8 = (v2u*)(mh + (size_t)m * DM) + lane;
#pragma unroll
          for (int j = 0; j < 4; ++j) { v2u w; w.x = pk2(v[j].x * rs, v[j].y * rs); w.y = pk2(v[j].z * rs, v[j].w * rs); o8[64 * j] = w; } } }
}

__device__ __forceinline__ void phase_conv_late(const Params& P, LAS unsigned char* lds, int gw, int NGW) {
    const int tid = threadIdx.x, lane = tid & 63, wave = tid >> 6; unsigned char* ws = P.ws;
    LAS float* scr = (LAS float*)(lds + wave * 16384);
    constexpr int NITEMS = 512 + 512 + 512 + 2048 + 2048;
    for (int it = gw; it < NITEMS; it += NGW) {
        int r = it;
        TJOB(P.in[I_C_WOUT], 1024, 1024, 1024, nullptr, (bf16*)(ws + WS_COUT), 0)
        TJOB(P.in[I_XA_WQ] + 1048576, 1024, 1024, 1024, P.in[I_XA_LN] + 1024, (bf16*)(ws + WS_XQ) + 1048576, 0)
        TJOB(P.in[I_XA_WO] + 1048576, 1024, 1024, 1024, nullptr, (bf16*)(ws + WS_XO) + 1048576, 0)
        TJOB(P.in[I_FF_W1] + 4194304, 1024, 4096, 4096, P.in[I_FF_LN] + 1024, (bf16*)(ws + WS_F1) + 4194304, 0)
        TJOB(P.in[I_FF_W2] + 4194304, 4096, 1024, 1024, nullptr, (bf16*)(ws + WS_F2) + 4194304, 0)
    }
}
__device__ __forceinline__ void phase_gates(const Params& P, LAS unsigned char* lds, int gw, int NGW) {
    const int tid = threadIdx.x, lane = tid & 63; unsigned char* ws = P.ws;
    const bf16* wg = (const bf16*)(ws + WS_CIN) + (size_t)2560 * 1024; const bf16* xh = (const bf16*)(ws + WS_XH); const float* ss = (const float*)(ws + WS_SS); float* gates = (float*)(ws + WS_GATES);
    for (int p = tid; p < 48 * 128; p += NTHR) *(LAS v4u*)(lds + p * 16) = *(const v4u*)(wg + (size_t)p * 8);
    __syncthreads();
    for (int rg = gw; rg < T / 16; rg += NGW) { const int t0 = rg * 16;
        f32x4 acc[3] = {{0.f, 0.f, 0.f, 0.f}, {0.f, 0.f, 0.f, 0.f}, {0.f, 0.f, 0.f, 0.f}};
        const bf16* ap = xh + (size_t)(t0 + (lane & 15)) * DM + 8 * (lane >> 4); LAS const unsigned char* bp = lds + (lane & 15) * 2048 + (lane >> 4) * 16;
#pragma unroll 4
        for (int ks = 0; ks < 32; ++ks) { const bf16x8 a = *(const bf16x8*)(ap + 32 * ks);
#pragma unroll
            for (int ct = 0; ct < 3; ++ct) acc[ct] = __builtin_amdgcn_mfma_f32_16x16x32_bf16(a, *(const LAS bf16x8*)(bp + ct * 32768 + ks * 64), acc[ct], 0, 0, 0); }
#pragma unroll
        for (int r = 0; r < 4; ++r) { const int t = t0 + 4 * (lane >> 4) + r; const float rs = pg8::row_rstd(ss, t);
#pragma unroll
            for (int ct = 0; ct < 3; ++ct) gates[(size_t)t * 48 + ct * 16 + (lane & 15)] = acc[ct][r] * rs; } }
    __syncthreads();
}
__device__ __forceinline__ void phase_final(const Params& P) {
    const int tid = threadIdx.x, lane = tid & 63, wave = tid >> 6;
    const int gw = blockIdx.x * NWAVES + wave, NGW = gridDim.x * NWAVES;
    const float* ss = (const float*)(P.ws + WS_SS); const bf16* xh = (const bf16*)(P.ws + WS_XH);
    for (int m = gw; m < T; m += NGW) { f32x4* orow = (f32x4*)(P.out + (size_t)m * DM); const f32x4* gr = (const f32x4*)P.in[I_FLN];
        const float rs = pg8::row_rstd(ss, m);
#pragma unroll
        for (int j = 0; j < 2; ++j) { const v4u p = *(const v4u*)(xh + (size_t)m * DM + (j * 64 + lane) * 8); const f32x4 g0 = gr[(j * 64 + lane) * 2], g1 = gr[(j * 64 + lane) * 2 + 1];
            orow[(j * 64 + lane) * 2] = (f32x4){bf2f(p.x & 0xffff) * rs * g0.x, bf2f(p.x >> 16) * rs * g0.y, bf2f(p.y & 0xffff) * rs * g0.z, bf2f(p.y >> 16) * rs * g0.w};
            orow[(j * 64 + lane) * 2 + 1] = (f32x4){bf2f(p.z & 0xffff) * rs * g1.x, bf2f(p.z >> 16) * rs * g1.y, bf2f(p.w & 0xffff) * rs * g1.z, bf2f(p.w >> 16) * rs * g1.w}; } }
}
__device__ __forceinline__ void phase_pool(const Params& P, LAS unsigned char* lds) {
    int tid_l = threadIdx.x; asm volatile("" : "+v"(tid_l)); const int tid = tid_l, lane = tid & 63, wave = tid >> 6; const int g = blockIdx.x & 3, win = 2 << g;
    const bf16* z = (const bf16*)(P.ws + WS_Z); bf16* y = (bf16*)(P.ws + WS_Y);
    LAS unsigned short* ur = (LAS unsigned short*)lds;
    LAS unsigned char* yp = lds + 20480;
    const int nt = wave & 3, mt = wave >> 2, q = lane & 31, h = lane >> 5;
    bf16x8 bfr[8];
    { const bf16* bt = (const bf16*)(P.ws + WS_POOLW) + (size_t)g * 16384 + (size_t)(nt * 32 + q) * 128 + 8 * h;
#pragma unroll
      for (int ks = 0; ks < 8; ++ks) bfr[ks] = *(const bf16x8*)(bt + 16 * ks); }
    v4u pre[3];
#define POOL_LOAD(it_) { const int t0_ = ((it_) >> 2) * 64, s0_ = t0_ & (SEQ - 1); _Pragma("unroll") for (int j = 0; j < 3; ++j) { const int p = tid + 512 * j, row = p >> 4, pc = p & 15; pre[j] = (v4u){0u, 0u, 0u, 0u}; \
        if (p < 79 * 16 && s0_ + row - 15 >= 0) pre[j] = *(const v4u*)(z + (size_t)(t0_ + row - 15) * 2560 + g * 128 + pc * 8); } }
    int it = blockIdx.x; if (it < 2048) POOL_LOAD(it)
    for (; it < 2048; it += gridDim.x) { const int t0 = (it >> 2) * 64, s0 = t0 & (SEQ - 1);
#pragma unroll
        for (int j = 0; j < 3; ++j) { const int p = tid + 512 * j; if (p < 79 * 16) *(LAS v4u*)(lds + (p >> 4) * 256 + (p & 15) * 16) = pre[j]; }
        __syncthreads();
        if (it + (int)gridDim.x < 2048) POOL_LOAD(it + (int)gridDim.x)
        { const int c = tid & 127, tq = tid >> 7; float sum = 0.f;
          for (int j = 1; j < win; ++j) sum += bf2f(ur[(tq * 16 + 15 - j) * 128 + c]);
#pragma unroll 4
          for (int i = 0; i < 16; ++i) { const int tl = tq * 16 + i, s = s0 + tl; const float u = bf2f(ur[(tl + 15) * 128 + c]); sum += u;
              const float cnt = (float)((s + 1 < win) ? s + 1 : win);
              *(LAS unsigned short*)(yp + tl * 272 + c * 2) = (unsigned short)f2bf(sum / cnt - u);
              sum -= bf2f(ur[(tl + 16 - win) * 128 + c]); } }
        __syncthreads();
        { f32x16 acc;
#pragma unroll
          for (int r = 0; r < 16; ++r) acc[r] = 0.f;
          LAS const unsigned char* ap = yp + (mt * 32 + q) * 272 + h * 16;
#pragma unroll
          for (int ks = 0; ks < 8; ++ks) acc = __builtin_amdgcn_mfma_f32_32x32x16_bf16(bfr[ks], *(const LAS bf16x8*)(ap + ks * 32), acc, 0, 0, 0);
          bf16* yo = y + (size_t)(t0 + mt * 32 + q) * DM + g * 128 + nt * 32 + 4 * h;
#pragma unroll
          for (int a = 0; a < 4; ++a) { v2u w; w.x = cvtpk(acc[4 * a], acc[4 * a + 1]); w.y = cvtpk(acc[4 * a + 2], acc[4 * a + 3]); *(v2u*)(yo + 8 * a) = w; } }
    }
#undef POOL_LOAD
    __syncthreads();
}
__device__ __forceinline__ void dn_naive_item(const Params& P, LAS unsigned char* lds, int item) {
    int tid_l = threadIdx.x; asm volatile("" : "+v"(tid_l)); const int tid = tid_l, lane = tid & 63, wave = tid >> 6; const int b = item >> 2, h = item & 3;
    const bf16* z = (const bf16*)(P.ws + WS_Z); bf16* y = (bf16*)(P.ws + WS_Y); const float* ba = (const float*)(P.ws + WS_BA);
    LAS float* qs = (LAS float*)lds; LAS float* ks = qs + 8192; LAS float* vs = ks + 8192; LAS float* ot = vs + 8192; LAS float* bet = ot + 8192; LAS float* egs = bet + 64;
    const float* cw = P.in[I_A_CONV];
    const float a_exp = __expf(P.in[I_A_ALOG][h]), dtb = P.in[I_A_DTB][h];
    float Sreg[32];
#pragma unroll
    for (int i = 0; i < 32; ++i) Sreg[i] = 0.f;
    const int kq = tid & 3, dv = tid >> 2;
    for (int n = 0; n < 64; ++n) {
        const int sb = n * 64; const size_t rb = (size_t)b * SEQ;
        for (int idx = tid; idx < 64 * 384; idx += NTHR) { const int tl = idx / 384, cc = idx % 384, part = cc >> 7, d = cc & 127; const int ch = part * 512 + h * 128 + d, s = sb + tl; float a = 0.f;
#pragma unroll
            for (int kk = 0; kk < 4; ++kk) { const int sp = s - 3 + kk; if (sp >= 0) a += cw[kk * 1536 + ch] * bf2f(z[(rb + sp) * 2560 + 512 + ch]); }
            qs[part * 8192 + tl * 128 + d] = silu_f(a); }
        if (tid < 64) { const size_t t = rb + sb + tid; const float bl = ba[t * 8 + h], al = ba[t * 8 + 4 + h] + dtb; const float sp = al > 20.f ? al : log1pf(__expf(al));
            bet[tid] = sigmoid_f(bl); egs[tid] = __expf(-a_exp * sp); }
        __syncthreads();
        for (int r = wave * 16; r < wave * 16 + 16; ++r) { LAS float* row = qs + (r >> 6) * 8192 + (r & 63) * 128; const float a = row[lane], c2 = row[lane + 64];
            const float sc = rsqrtf(wave_sum(a * a + c2 * c2) + EPS); row[lane] = a * sc; row[lane + 64] = c2 * sc; }
        __syncthreads();
        for (int tl = 0; tl < 64; ++tl) {
            float kr[32], kS = 0.f;
#pragma unroll
            for (int i = 0; i < 8; ++i) { const f32x4 v = *(const LAS f32x4*)(ks + tl * 128 + kq * 32 + 4 * i); kr[4 * i] = v.x; kr[4 * i + 1] = v.y; kr[4 * i + 2] = v.z; kr[4 * i + 3] = v.w; }
#pragma unroll
            for (int i = 0; i < 32; ++i) kS += kr[i] * Sreg[i];
            kS += __shfl_xor(kS, 1); kS += __shfl_xor(kS, 2);
            const float e = egs[tl], cf = bet[tl] * (vs[tl * 128 + dv] - e * kS);
            float o = 0.f;
#pragma unroll
            for (int i = 0; i < 8; ++i) { const f32x4 qv = *(const LAS f32x4*)(qs + tl * 128 + kq * 32 + 4 * i);
                Sreg[4 * i] = e * Sreg[4 * i] + kr[4 * i] * cf; Sreg[4 * i + 1] = e * Sreg[4 * i + 1] + kr[4 * i + 1] * cf; Sreg[4 * i + 2] = e * Sreg[4 * i + 2] + kr[4 * i + 2] * cf; Sreg[4 * i + 3] = e * Sreg[4 * i + 3] + kr[4 * i + 3] * cf;
                o += (qv.x * Sreg[4 * i] + qv.y * Sreg[4 * i + 1]) + (qv.z * Sreg[4 * i + 2] + qv.w * Sreg[4 * i + 3]); }
            o += __shfl_xor(o, 1); o += __shfl_xor(o, 2);
            if (kq == 0) ot[tl * 128 + dv] = o * 0.08838834764831845f;
        }
        __syncthreads();
        for (int tl = wave * 8; tl < wave * 8 + 8; ++tl) { const float a = ot[tl * 128 + lane], c2 = ot[tl * 128 + lane + 64]; const float rs = rsqrtf(wave_sum(a * a + c2 * c2) * (1.f / 128.f) + EPS);
            const size_t t = rb + sb + tl; const float g0 = bf2f(z[t * 2560 + 2048 + h * 128 + lane]), g1 = bf2f(z[t * 2560 + 2048 + h * 128 + lane + 64]);
            y[t * DM + 512 + h * 128 + lane] = (bf16)f2bf(a * rs * P.in[I_A_ONORM][lane] * silu_f(g0));
            y[t * DM + 512 + h * 128 + lane + 64] = (bf16)f2bf(c2 * rs * P.in[I_A_ONORM][lane + 64] * silu_f(g1)); }
        __syncthreads();
    }
}

__device__ __forceinline__ void phase_xatt_naive(const Params& P, LAS unsigned char* lds, int l) {
    int tid_l = threadIdx.x; asm volatile("" : "+v"(tid_l)); const int tid = tid_l, lane = tid & 63, wave = tid >> 6;
    const int gw = blockIdx.x * NWAVES + wave, NGW = gridDim.x * NWAVES;
    const bf16* qx = (const bf16*)(P.ws + WS_QXA); const bf16* kv = (const bf16*)(P.ws + WS_MEMKV) + (size_t)l * 2048 * 2048; bf16* y = (bf16*)(P.ws + WS_Y);
    LAS float* qf = (LAS float*)(lds + wave * 8192); LAS float* pw = qf + 1024;
    for (int t = gw; t < T; t += NGW) { const int b = t >> 12;
        { const v4u a = *(const v4u*)(qx + (size_t)t * DM + lane * 16), c = *(const v4u*)(qx + (size_t)t * DM + lane * 16 + 8); LAS float* d = qf + lane * 16;
          d[0] = bf2f(a.x & 0xffff); d[1] = bf2f(a.x >> 16); d[2] = bf2f(a.y & 0xffff); d[3] = bf2f(a.y >> 16); d[4] = bf2f(a.z & 0xffff); d[5] = bf2f(a.z >> 16); d[6] = bf2f(a.w & 0xffff); d[7] = bf2f(a.w >> 16);
          d[8] = bf2f(c.x & 0xffff); d[9] = bf2f(c.x >> 16); d[10] = bf2f(c.y & 0xffff); d[11] = bf2f(c.y >> 16); d[12] = bf2f(c.z & 0xffff); d[13] = bf2f(c.z >> 16); d[14] = bf2f(c.w & 0xffff); d[15] = bf2f(c.w >> 16); }
        LDS_WAIT();
        for (int hh = 0; hh < 4; ++hh) { float sc[4];
#pragma unroll
            for (int i = 0; i < 4; ++i) { const bf16* kr = kv + (size_t)(b * 256 + lane + 64 * i) * 2048 + hh * 256; float s = 0.f;
                for (int c8 = 0; c8 < 32; ++c8) { const v4u kk = *(const v4u*)(kr + c8 * 8); const f32x4 q0 = *(const LAS f32x4*)(qf + hh * 256 + c8 * 8), q1 = *(const LAS f32x4*)(qf + hh * 256 + c8 * 8 + 4);
                    s += (q0.x * bf2f(kk.x & 0xffff) + q0.y * bf2f(kk.x >> 16)) + (q0.z * bf2f(kk.y & 0xffff) + q0.w * bf2f(kk.y >> 16)) + (q1.x * bf2f(kk.z & 0xffff) + q1.y * bf2f(kk.z >> 16)) + (q1.z * bf2f(kk.w & 0xffff) + q1.w * bf2f(kk.w >> 16)); }
                sc[i] = s * 0.0625f; }
            const float mx = wave_max(fmaxf(fmaxf(sc[0], sc[1]), fmaxf(sc[2], sc[3])));
            float ps = 0.f;
#pragma unroll
            for (int i = 0; i < 4; ++i) { sc[i] = __expf(sc[i] - mx); ps += sc[i]; }
            const float inv = 1.f / wave_sum(ps);
#pragma unroll
            for (int i = 0; i < 4; ++i) pw[lane + 64 * i] = sc[i] * inv;
            LDS_WAIT();
            float o0 = 0.f, o1 = 0.f, o2 = 0.f, o3 = 0.f; const bf16* vb = kv + (size_t)(b * 256) * 2048 + 1024 + hh * 256 + lane * 4;
            for (int j = 0; j < 256; ++j) { const v2u vv = *(const v2u*)(vb + (size_t)j * 2048); const float p = pw[j];
                o0 += p * bf2f(vv.x & 0xffff); o1 += p * bf2f(vv.x >> 16); o2 += p * bf2f(vv.y & 0xffff); o3 += p * bf2f(vv.y >> 16); }
            v2u w; w.x = pk2(o0, o1); w.y = pk2(o2, o3); *(v2u*)(y + (size_t)t * DM + hh * 256 + lane * 4) = w;
            LDS_WAIT();
        }
    }
}

__device__ __forceinline__ void cmpfin_bg(const Params& P, LAS unsigned char* lds, int kvs, int bg) {
    const int tid = threadIdx.x, lane = tid & 63, wave = tid >> 6, q = lane & 31, h = lane >> 5;
    const float* p01 = (const float*)(P.ws + (kvs ? WS_P01V : WS_P01K)) + (size_t)bg * 256 * 256; const float* bias = (const float*)(P.ws + WS_CBIAS) + kvs * 128; const float* w2 = P.in[kvs ? I_C_W2V : I_C_W2K];
    bf16* outp = (bf16*)(P.ws + (kvs ? WS_CV : WS_CK)) + (size_t)bg * 256 * 64;
    LAS unsigned char* Hb = lds;
    LAS unsigned char* Wt = lds + 69632;
    for (int p = tid; p < 256 * 16; p += NTHR) { const int c = p >> 4, j0 = (p & 15) * 8; v4u w = {0u, 0u, 0u, 0u};
        if (c < 255) { const f32x4 a0 = *(const f32x4*)(p01 + (size_t)c * 256 + j0), a1 = *(const f32x4*)(p01 + (size_t)c * 256 + j0 + 4), b0 = *(const f32x4*)(p01 + (size_t)(c + 1) * 256 + 128 + j0), b1 = *(const f32x4*)(p01 + (size_t)(c + 1) * 256 + 128 + j0 + 4);
            const f32x4 c0 = *(const f32x4*)(bias + j0), c1 = *(const f32x4*)(bias + j0 + 4);
            w.x = cvtpk(silu_f(a0.x + b0.x + c0.x), silu_f(a0.y + b0.y + c0.y)); w.y = cvtpk(silu_f(a0.z + b0.z + c0.z), silu_f(a0.w + b0.w + c0.w));
            w.z = cvtpk(silu_f(a1.x + b1.x + c1.x), silu_f(a1.y + b1.y + c1.y)); w.w = cvtpk(silu_f(a1.z + b1.z + c1.z), silu_f(a1.w + b1.w + c1.w)); }
        *(LAS v4u*)(Hb + c * 272 + j0 * 2) = w; }
    for (int p = tid; p < 128 * 64; p += NTHR) { const int j = p >> 6, d = p & 63; *(LAS unsigned short*)(Wt + d * 272 + j * 2) = (unsigned short)f2bf(w2[p]); }
    __syncthreads();
#pragma unroll
    for (int dt = 0; dt < 2; ++dt) { f32x16 acc;
#pragma unroll
        for (int r = 0; r < 16; ++r) acc[r] = 0.f;
#pragma unroll
        for (int ks = 0; ks < 8; ++ks) acc = __builtin_amdgcn_mfma_f32_32x32x16_bf16(*(const LAS bf16x8*)(Wt + (dt * 32 + q) * 272 + ks * 32 + h * 16), *(const LAS bf16x8*)(Hb + (wave * 32 + q) * 272 + ks * 32 + h * 16), acc, 0, 0, 0);
        const int c = wave * 32 + q;
        if (c < 255) {
#pragma unroll
            for (int a = 0; a < 4; ++a) { v2u w; w.x = cvtpk(acc[4 * a], acc[4 * a + 1]); w.y = cvtpk(acc[4 * a + 2], acc[4 * a + 3]); *(v2u*)(outp + (size_t)c * 64 + dt * 32 + 8 * a + 4 * h) = w; } } }
    __syncthreads();
}
__device__ __forceinline__ void dot4(const bf16* kr, const LAS float* qf, float (&s)[4]) {
    s[0] = s[1] = s[2] = s[3] = 0.f;
#pragma unroll
    for (int c8 = 0; c8 < 8; ++c8) { const v4u kk = *(const v4u*)(kr + c8 * 8);
        const float k0 = bf2f(kk.x & 0xffff), k1 = bf2f(kk.x >> 16), k2 = bf2f(kk.y & 0xffff), k3 = bf2f(kk.y >> 16), k4 = bf2f(kk.z & 0xffff), k5 = bf2f(kk.z >> 16), k6 = bf2f(kk.w & 0xffff), k7 = bf2f(kk.w >> 16);
#pragma unroll
        for (int r = 0; r < 4; ++r) { const f32x4 q0 = *(const LAS f32x4*)(qf + r * 64 + c8 * 8), q1 = *(const LAS f32x4*)(qf + r * 64 + c8 * 8 + 4);
            s[r] += ((q0.x * k0 + q0.y * k1) + (q0.z * k2 + q0.w * k3)) + ((q1.x * k4 + q1.y * k5) + (q1.z * k6 + q1.w * k7)); } }
}
__device__ __forceinline__ void phase_nsa_naive(const Params& P, LAS unsigned char* lds) {
    int tid_l = threadIdx.x; asm volatile("" : "+v"(tid_l)); const int tid = tid_l, lane = tid & 63, wave = tid >> 6;
    const int gw = blockIdx.x * NWAVES + wave, NGW = gridDim.x * NWAVES;
    const bf16* qb = (const bf16*)(P.ws + WS_Z); const bf16* kvb = qb + (size_t)T * 1024;
    const bf16* ck = (const bf16*)(P.ws + WS_CK); const bf16* cv = (const bf16*)(P.ws + WS_CV);
    const float* gates = (const float*)(P.ws + WS_GATES); bf16* y = (bf16*)(P.ws + WS_Y);
    LAS float* qf = (LAS float*)(lds + wave * 8192); LAS float* pc = qf + 256; LAS float* ps = pc + 1024;
    for (int it = gw; it < 4 * T; it += NGW) {
        const int t = it & 4095, g = (it >> 12) & 3, b = it >> 14; const size_t tg = (size_t)b * SEQ + t; const int bg = b * 4 + g;
        float slope[4];
#pragma unroll
        for (int r = 0; r < 4; ++r) slope[r] = exp2f(-0.5f * (float)(g * 4 + r + 1));
#pragma unroll
        for (int r = 0; r < 4; ++r) qf[r * 64 + lane] = bf2f(qb[tg * 1024 + g * 256 + r * 64 + lane]);
        LDS_WAIT();
        const int ncv = t >= 31 ? ((t - 31) >> 4) + 1 : 0;
#pragma unroll 1
        for (int cc = 0; cc < 4; ++cc) { const int c = lane + 64 * cc; float s[4] = {0.f, 0.f, 0.f, 0.f};
            if (cc * 64 < ncv) dot4(ck + ((size_t)bg * 256 + c) * 64, qf, s);
#pragma unroll
            for (int r = 0; r < 4; ++r) pc[r * 256 + c] = c < ncv ? s[r] * 0.125f - slope[r] * (float)(t - (16 * c + 31)) : -INFINITY; }
        LDS_WAIT();
#pragma unroll 1
        for (int r = 0; r < 4; ++r) { float v0 = pc[r * 256 + lane], v1 = pc[r * 256 + lane + 64], v2 = pc[r * 256 + lane + 128], v3 = pc[r * 256 + lane + 192];
            const float mx = wave_max(fmaxf(fmaxf(v0, v1), fmaxf(v2, v3)));
            v0 = lane < ncv ? __expf(v0 - mx) : 0.f; v1 = lane + 64 < ncv ? __expf(v1 - mx) : 0.f; v2 = lane + 128 < ncv ? __expf(v2 - mx) : 0.f; v3 = lane + 192 < ncv ? __expf(v3 - mx) : 0.f;
            const float sm = wave_sum((v0 + v1) + (v2 + v3)); const float inv = ncv > 0 ? 1.f / sm : 0.f;
            pc[r * 256 + lane] = v0 * inv; pc[r * 256 + lane + 64] = v1 * inv; pc[r * 256 + lane + 128] = v2 * inv; pc[r * 256 + lane + 192] = v3 * inv; }
        LDS_WAIT();
        float osum[4];
        { float ocmp[4] = {0.f, 0.f, 0.f, 0.f};
          const bf16* cvp = cv + (size_t)bg * 256 * 64 + lane;
#pragma unroll 2
          for (int c = 0; c < ncv; ++c) { const float v = bf2f(cvp[c * 64]);
#pragma unroll
              for (int r = 0; r < 4; ++r) ocmp[r] += pc[r * 256 + c] * v; }
#pragma unroll
          for (int r = 0; r < 4; ++r) osum[r] = sigmoid_f(gates[tg * 48 + (g * 4 + r) * 3]) * ocmp[r]; }
        unsigned long long mask;
        { const int n = lane, cur = t >> 6; float imp = 0.f;
#pragma unroll
          for (int r = 0; r < 4; ++r) { const f32x4 v = *(const LAS f32x4*)(pc + r * 256 + 4 * n); imp += v.x + v.y + v.z + 0.5f * v.w; if (n > 0) imp += 0.5f * pc[r * 256 + 4 * n - 1]; }
          const bool forced = (n == 0) || (n == cur) || (n == cur - 1);
          const float val = forced ? 1e4f : (n <= cur ? imp : -1.f);
          int rank = 0;
#pragma unroll 4
          for (int m = 0; m < 64; ++m) { const float vm = __shfl(val, m); rank += (vm > val || (vm == val && m < n)) ? 1 : 0; }
          mask = __ballot(rank < 16 && n <= cur); }
#pragma unroll 1
        for (int br = 0; br < 2; ++br) {
            const bf16* kp = kvb + (size_t)(br == 0 ? 2 : 4) * KV_KIND + (size_t)bg * SEQ * 64; const bf16* vp = kvb + (size_t)(br == 0 ? 3 : 5) * KV_KIND + (size_t)bg * SEQ * 64;
            float m_[4] = {-INFINITY, -INFINITY, -INFINITY, -INFINITY}, l_[4] = {0.f, 0.f, 0.f, 0.f}, acc[4] = {0.f, 0.f, 0.f, 0.f};
            const int jlo = br == 0 ? 0 : (t >= 511 ? t - 511 : 0);
            unsigned long long todo = br == 0 ? mask : 0ull; int j0 = jlo & ~63;
#pragma unroll 1
            for (;;) {
                if (br == 0) { if (!todo) break; j0 = (__ffsll((long long)todo) - 1) * 64; todo &= todo - 1; } else { if (j0 > t) break; }
                const int j = j0 + lane; const bool valid = j >= jlo && j <= t;
                float s[4]; dot4(kp + (size_t)j * 64, qf, s);
#pragma unroll
                for (int r = 0; r < 4; ++r) { const float sv = valid ? s[r] * 0.125f - slope[r] * (float)(t - j) : -INFINITY; const float mn = fmaxf(m_[r], wave_max(sv));
                    const float p = valid ? __expf(sv - mn) : 0.f; const float f = __expf(m_[r] - mn); l_[r] = l_[r] * f + wave_sum(p); acc[r] *= f; m_[r] = mn; ps[r * 64 + lane] = p; }
                LDS_WAIT();
                const bf16* vr = vp + (size_t)j0 * 64 + lane;
#pragma unroll 2
                for (int jj = 0; jj < 64; jj += 4) { const float v0 = bf2f(vr[jj * 64]), v1 = bf2f(vr[(jj + 1) * 64]), v2 = bf2f(vr[(jj + 2) * 64]), v3 = bf2f(vr[(jj + 3) * 64]);
#pragma unroll
                    for (int r = 0; r < 4; ++r) { const f32x4 pv = *(const LAS f32x4*)(ps + r * 64 + jj); acc[r] += (pv.x * v0 + pv.y * v1) + (pv.z * v2 + pv.w * v3); } }
                LDS_WAIT();
                if (br == 1) j0 += 64;
            }
#pragma unroll
            for (int r = 0; r < 4; ++r) osum[r] += sigmoid_f(gates[tg * 48 + (g * 4 + r) * 3 + 1 + br]) * (acc[r] / l_[r]);
        }
#pragma unroll
        for (int r = 0; r < 4; ++r) y[tg * DM + g * 256 + r * 64 + lane] = (bf16)f2bf(osum[r]);
        LDS_WAIT();
    }
}
constexpr int NSA_KB = 0, NSA_VB = 18432, NSA_IMPA = 34816, NSA_IMPB = 51200, NSA_MASK = 67584, NSA_UNI = 68096;
constexpr float LOG2E_F = 1.4426950408889634f;

__device__ __forceinline__ float quad_sum(float x) {
    x += __int_as_float(__builtin_amdgcn_update_dpp(0, __float_as_int(x), 0xB1, 0xF, 0xF, true));
    x += __int_as_float(__builtin_amdgcn_update_dpp(0, __float_as_int(x), 0x4E, 0xF, 0xF, true));
    return x;
}
__device__ __forceinline__ void nsa_qk(f32x16& p0, f32x16& p1, LAS const unsigned char* kb, const bf16x8 (&qf)[4], int q, int h, const f32x16& init) {
    p0 = init; p1 = init;
#pragma unroll
    for (int ks = 0; ks < 4; ++ks) { const bf16x8 a0 = *(const LAS bf16x8*)(kb + q * 144 + ks * 32 + h * 16), a1 = *(const LAS bf16x8*)(kb + (q + 32) * 144 + ks * 32 + h * 16);
        p0 = __builtin_amdgcn_mfma_f32_32x32x16_bf16(a0, qf[ks], p0, 0, 0, 0); p1 = __builtin_amdgcn_mfma_f32_32x32x16_bf16(a1, qf[ks], p1, 0, 0, 0); }
}
template <bool CHECK> __device__ __forceinline__ void nsa_bias(f32x16& p0, f32x16& p1, float basef, float slopeK, float cst, float klo, float khi, int h) {
    const float C = 1.f; const float i0 = basef + 4.f * (float)h; const float t0v = fmaf(slopeK, i0, cst);
#pragma unroll
    for (int r = 0; r < 16; ++r) { const float off = (float)((r & 3) + 8 * (r >> 2));
        float v0 = fmaf(p0[r], C, fmaf(slopeK, off, t0v)), v1 = fmaf(p1[r], C, fmaf(slopeK, off + 32.f, t0v));
        if (CHECK) { const float x0 = i0 + off, x1 = i0 + off + 32.f; v0 = (x0 >= klo && x0 <= khi) ? v0 : -INFINITY; v1 = (x1 >= klo && x1 <= khi) ? v1 : -INFINITY; }
        p0[r] = v0; p1[r] = v1; }
}
__device__ __forceinline__ float nsa_rowmax(const f32x16& p0, const f32x16& p1) {
    float a = fmaxf(p0[0], p1[0]);
#pragma unroll
    for (int r = 1; r < 16; ++r) a = fmaxf(a, fmaxf(p0[r], p1[r]));
    return fmaxf(a, __shfl_xor(a, 32));
}
__device__ __forceinline__ void nsa_pv(f32x16 (&o)[2], const f32x16& p0, const f32x16& p1, LAS const unsigned char* vb, int lane, int h) {
    bf16x8 pk[4];
#pragma unroll
    for (int s = 0; s < 4; ++s) { v4u w;
        if (s < 2) { w.x = cvtpk(p0[8 * s + 0], p0[8 * s + 1]); w.y = cvtpk(p0[8 * s + 2], p0[8 * s + 3]); w.z = cvtpk(p0[8 * s + 4], p0[8 * s + 5]); w.w = cvtpk(p0[8 * s + 6], p0[8 * s + 7]); }
        else { w.x = cvtpk(p1[8 * (s - 2) + 0], p1[8 * (s - 2) + 1]); w.y = cvtpk(p1[8 * (s - 2) + 2], p1[8 * (s - 2) + 3]); w.z = cvtpk(p1[8 * (s - 2) + 4], p1[8 * (s - 2) + 5]); w.w = cvtpk(p1[8 * (s - 2) + 6], p1[8 * (s - 2) + 7]); }
        pk[s] = __builtin_bit_cast(bf16x8, w); }
    LAS const unsigned char* vp = vb + (4 * h + ((lane & 15) >> 2)) * 64 + ((lane >> 4) & 1) * 32 + (lane & 3) * 8;
#pragma unroll
    for (int dt = 0; dt < 2; ++dt)
#pragma unroll
        for (int s = 0; s < 4; ++s) { const v4i16 lo = __builtin_amdgcn_ds_read_tr16_b64_v4i16((LAS v4i16*)(vp + dt * 4096 + s * 1024)), hi = __builtin_amdgcn_ds_read_tr16_b64_v4i16((LAS v4i16*)(vp + dt * 4096 + s * 1024 + 512));
            const bf16x8 a = (bf16x8){lo[0], lo[1], lo[2], lo[3], hi[0], hi[1], hi[2], hi[3]};
            o[dt] = __builtin_amdgcn_mfma_f32_32x32x16_bf16(a, pk[s], o[dt], 0, 0, 0); }
}
__device__ __forceinline__ void nsa_online(f32x16& p0, f32x16& p1, float& m, float& l, f32x16 (&o)[2]) {
    const float mx = nsa_rowmax(p0, p1), mn = fmaxf(m, mx), mu = (mn == -INFINITY) ? 0.f : mn; const float f = __builtin_amdgcn_exp2f(m - mu);
    float sum = 0.f;
#pragma unroll
    for (int r = 0; r < 16; ++r) { p0[r] = __builtin_amdgcn_exp2f(p0[r] - mu); p1[r] = __builtin_amdgcn_exp2f(p1[r] - mu); sum += p0[r] + p1[r]; }
    l = l * f + sum; m = mn;
    if (__any(f != 1.f)) {
#pragma unroll
        for (int r = 0; r < 16; ++r) { o[0][r] *= f; o[1][r] *= f; } }
}

typedef float f2v __attribute__((ext_vector_type(2)));
__device__ __forceinline__ void nsa_fast(f32x16& p0, f32x16& p1, float c32, float t0v, float& m, float& l, f32x16 (&o)[2]) {
    float mx0 = p0[0], mx1 = p1[0];
#pragma unroll
    for (int r = 1; r < 16; r += 2) { mx0 = __builtin_fmaxf(__builtin_fmaxf(mx0, p0[r]), p0[r < 15 ? r + 1 : r]); mx1 = __builtin_fmaxf(__builtin_fmaxf(mx1, p1[r]), p1[r < 15 ? r + 1 : r]); }
    float mx = __builtin_fmaxf(mx0, mx1 + c32) + t0v; mx = __builtin_fmaxf(mx, __shfl_xor(mx, 32));
    const float mn = __builtin_fmaxf(m, mx), mu = (mn == -INFINITY) ? 0.f : mn; const float f = __builtin_amdgcn_exp2f(m - mu), d = mu - t0v, d1 = d - c32; const f2v d2 = {d, d}, d12 = {d1, d1};
    f2v s2 = {0.f, 0.f};
#pragma unroll
    for (int k = 0; k < 8; ++k) { f2v a = {p0[2 * k], p0[2 * k + 1]}, b = {p1[2 * k], p1[2 * k + 1]}; a = a - d2; b = b - d12;
        a.x = __builtin_amdgcn_exp2f(a.x); a.y = __builtin_amdgcn_exp2f(a.y); b.x = __builtin_amdgcn_exp2f(b.x); b.y = __builtin_amdgcn_exp2f(b.y);
        s2 = s2 + a; s2 = s2 + b; p0[2 * k] = a.x; p0[2 * k + 1] = a.y; p1[2 * k] = b.x; p1[2 * k + 1] = b.y; }
    l = l * f + (s2.x + s2.y); m = mn;
    if (__any(f != 1.f)) {
#pragma unroll
        for (int r = 0; r < 16; ++r) { o[0][r] *= f; o[1][r] *= f; } }
}
__device__ __forceinline__ void nsa_item(const Params& P, LAS unsigned char* lds, int bg, int tile) {
    int tid_l = threadIdx.x; asm volatile("" : "+v"(tid_l)); const int tid = tid_l, lane = tid & 63, wave = tid >> 6, q = lane & 31, h = lane >> 5;
    const int b = bg >> 2, g = bg & 3, t0 = tile * 64, cur = tile;
    const int tl = 8 * wave + (q >> 2), t = t0 + tl, r = q & 3; const size_t tg = (size_t)b * SEQ + t;
    const bf16* qb = (const bf16*)(P.ws + WS_Z); const bf16* kvb = qb + (size_t)T * 1024;
    const bf16* ckp = (const bf16*)(P.ws + WS_CK) + (size_t)bg * 256 * 64; const bf16* cvp = (const bf16*)(P.ws + WS_CV) + (size_t)bg * 256 * 64;
    const bf16* ksp = kvb + 2 * KV_KIND + (size_t)bg * SEQ * 64; const bf16* vsp = kvb + 3 * KV_KIND + (size_t)bg * SEQ * 64;
    const bf16* kwp = kvb + 4 * KV_KIND + (size_t)bg * SEQ * 64; const bf16* vwp = kvb + 5 * KV_KIND + (size_t)bg * SEQ * 64;
    const float* gp = (const float*)(P.ws + WS_GATES) + tg * 48 + (g * 4 + r) * 3;
    LAS float* impA = (LAS float*)(lds + NSA_IMPA); LAS float* impB = (LAS float*)(lds + NSA_IMPB);
    LAS unsigned long long* masks = (LAS unsigned long long*)(lds + NSA_MASK); LAS unsigned long long* uni = (LAS unsigned long long*)(lds + NSA_UNI);
    const int srow = tid >> 3, spc = tid & 7; const unsigned koff = srow * 144 + spc * 16, voff = (spc >> 2) * 4096 + srow * 64 + (spc & 3) * 16; const size_t goff = (size_t)srow * 64 + spc * 8;
    const float slope2 = exp2f(-0.5f * (float)(g * 4 + r + 1)) * LOG2E_F; const float tf = (float)t;
    bf16x8 qf[4];
#pragma unroll
    for (int ks = 0; ks < 4; ++ks) qf[ks] = *(const bf16x8*)(qb + tg * 1024 + g * 256 + r * 64 + 16 * ks + 8 * h);
    { const v4u z4 = {0u, 0u, 0u, 0u};
#pragma unroll
      for (int i = 0; i < 4; ++i) *(LAS v4u*)(lds + NSA_IMPA + (tid * 4 + i) * 16) = z4; }
    if (tid < 8) uni[tid] = 0ull;
    v4u kreg, vreg;
#define KBUF(i) (lds + NSA_KB + (i) * 9216)
#define VBUF(i) (lds + NSA_VB + (i) * 8192)
    f32x16 osum[2], o[2], p0, p1, bo0, zero16;
#pragma unroll
    for (int rr = 0; rr < 16; ++rr) zero16[rr] = 0.f;
    const int nct = (((t0 + 32) >> 4) >> 6) + 1;
    const float cmaxf = t >= 31 ? (float)((t - 31) >> 4) : -1.f; const float cstc = slope2 * (31.f - tf), slopec = 16.f * slope2;
    float m1 = -INFINITY, l1 = 0.f;
    kreg = *(const v4u*)(ckp + (size_t)(nct - 1) * 4096 + goff); *(LAS v4u*)(KBUF(0) + koff) = kreg; __syncthreads();
#pragma unroll 1
    for (int i = 0; i < nct; ++i) { const int ct = nct - 1 - i;
        if (i + 1 < nct) kreg = *(const v4u*)(ckp + (size_t)(ct - 1) * 4096 + goff);
        else { kreg = *(const v4u*)(ckp + (size_t)(nct - 1) * 4096 + goff); vreg = *(const v4u*)(cvp + (size_t)(nct - 1) * 4096 + goff); }
        nsa_qk(p0, p1, KBUF(i & 1), qf, q, h, zero16); nsa_bias<true>(p0, p1, (float)(ct * 64), slopec, cstc, 0.f, cmaxf, h);
        { const float mx = nsa_rowmax(p0, p1), mn = fmaxf(m1, mx), mu = (mn == -INFINITY) ? 0.f : mn; float sum = 0.f;
#pragma unroll
          for (int rr = 0; rr < 16; ++rr) sum += __builtin_amdgcn_exp2f(p0[rr] - mu) + __builtin_amdgcn_exp2f(p1[rr] - mu);
          l1 = l1 * __builtin_amdgcn_exp2f(m1 - mu) + sum; m1 = mn; }
        if (i + 1 < nct) *(LAS v4u*)(KBUF((i + 1) & 1) + koff) = kreg;
        __syncthreads(); }
    l1 += __shfl_xor(l1, 32);
    const float inv1 = l1 > 0.f ? 1.f / l1 : 0.f, mu1 = (m1 == -INFINITY) ? 0.f : m1;
#pragma unroll
    for (int rr = 0; rr < 16; ++rr) { o[0][rr] = 0.f; o[1][rr] = 0.f; }
    *(LAS v4u*)(KBUF(0) + koff) = kreg; *(LAS v4u*)(VBUF(0) + voff) = vreg; __syncthreads();
#pragma unroll 1
    for (int i = 0; i < nct; ++i) { const int ct = nct - 1 - i;
        if (i + 1 < nct) { kreg = *(const v4u*)(ckp + (size_t)(ct - 1) * 4096 + goff); vreg = *(const v4u*)(cvp + (size_t)(ct - 1) * 4096 + goff); }
        else { kreg = *(const v4u*)(ksp + (size_t)cur * 4096 + goff); vreg = *(const v4u*)(vsp + (size_t)cur * 4096 + goff); }
        nsa_qk(p0, p1, KBUF(i & 1), qf, q, h, zero16); nsa_bias<true>(p0, p1, (float)(ct * 64), slopec, cstc, 0.f, cmaxf, h);
#pragma unroll
        for (int rr = 0; rr < 16; ++rr) { p0[rr] = __builtin_amdgcn_exp2f(p0[rr] - mu1) * inv1; p1[rr] = __builtin_amdgcn_exp2f(p1[rr] - mu1) * inv1; }
#pragma unroll
        for (int a = 0; a < 4; ++a) {
            float A0 = quad_sum(p0[4 * a] + p0[4 * a + 1] + p0[4 * a + 2] + 0.5f * p0[4 * a + 3]), B0 = quad_sum(0.5f * p0[4 * a + 3]);
            float A1 = quad_sum(p1[4 * a] + p1[4 * a + 1] + p1[4 * a + 2] + 0.5f * p1[4 * a + 3]), B1 = quad_sum(0.5f * p1[4 * a + 3]);
            if (r == 0) { const int n0 = 16 * ct + 2 * a + h, n1 = n0 + 8; impA[tl * 64 + n0] = A0; impA[tl * 64 + n1] = A1; impB[tl * 64 + n0 + 1] = B0; if (n1 < 63) impB[tl * 64 + n1 + 1] = B1; } }
        nsa_pv(o, p0, p1, VBUF(i & 1), lane, h);
        if (i + 1 < nct) { *(LAS v4u*)(KBUF((i + 1) & 1) + koff) = kreg; *(LAS v4u*)(VBUF((i + 1) & 1) + voff) = vreg; }
        __syncthreads(); }
    { const float g0 = sigmoid_f(gp[0]);
#pragma unroll
      for (int rr = 0; rr < 16; ++rr) { osum[0][rr] = g0 * o[0][rr]; osum[1][rr] = g0 * o[1][rr]; } }
    { const int tkl = lane >> 3, part = lane & 7, tk = 8 * wave + tkl; unsigned key[8];
      { const f32x4 a0 = *(const LAS f32x4*)(impA + tk * 64 + part * 8), a1 = *(const LAS f32x4*)(impA + tk * 64 + part * 8 + 4), b0 = *(const LAS f32x4*)(impB + tk * 64 + part * 8), b1 = *(const LAS f32x4*)(impB + tk * 64 + part * 8 + 4);
        const float im[8] = {a0.x + b0.x, a0.y + b0.y, a0.z + b0.z, a0.w + b0.w, a1.x + b1.x, a1.y + b1.y, a1.z + b1.z, a1.w + b1.w};
#pragma unroll
        for (int e2 = 0; e2 < 8; ++e2) { const int n = part * 8 + e2; const bool forced = (n == 0) || (n == cur) || (n == cur - 1); key[e2] = n <= cur ? (forced ? 0x7F000000u : __float_as_uint(im[e2]) + 1u) : 0u; } }
      unsigned Tk = 0u;
#pragma unroll 1
      for (int bb = 30; bb >= 0; --bb) { const unsigned cand = Tk | (1u << bb); int c = 0;
#pragma unroll
          for (int e2 = 0; e2 < 8; ++e2) c += key[e2] >= cand ? 1 : 0;
          c += __builtin_amdgcn_update_dpp(0, c, 0xB1, 0xF, 0xF, true); c += __builtin_amdgcn_update_dpp(0, c, 0x4E, 0xF, 0xF, true); c += __builtin_amdgcn_update_dpp(0, c, 0x141, 0xF, 0xF, true);
          Tk = c >= 16 ? cand : Tk; }
      int cg = 0, le = 0;
#pragma unroll
      for (int e2 = 0; e2 < 8; ++e2) { cg += key[e2] > Tk ? 1 : 0; le += key[e2] == Tk ? 1 : 0; }
      cg += __builtin_amdgcn_update_dpp(0, cg, 0xB1, 0xF, 0xF, true); cg += __builtin_amdgcn_update_dpp(0, cg, 0x4E, 0xF, 0xF, true); cg += __builtin_amdgcn_update_dpp(0, cg, 0x141, 0xF, 0xF, true);
      int incl = le;
#pragma unroll
      for (int o2 = 1; o2 < 8; o2 <<= 1) { const int v = __shfl_up(incl, o2, 8); if (part >= o2) incl += v; }
      int before = incl - le; const int need = 16 - cg; unsigned byte = 0u;
#pragma unroll
      for (int e2 = 0; e2 < 8; ++e2) { const bool eq = key[e2] == Tk; const bool selb = (key[e2] > Tk || (eq && before < need)) && (part * 8 + e2 <= cur); before += eq ? 1 : 0; byte |= selb ? (1u << e2) : 0u; }
      ((LAS unsigned char*)masks)[tk * 8 + part] = (unsigned char)byte;
      __hip_atomic_fetch_or(uni, (unsigned long long)byte << (8 * part), __ATOMIC_RELAXED, __HIP_MEMORY_SCOPE_WORKGROUP); }
    __syncthreads();
    unsigned long long todo = uni[0]; const unsigned long long mymask = masks[tl];
#define NSA_LOAD(kp_, vp_, n_) { kreg = *(const v4u*)((kp_) + (size_t)(n_) * 4096 + goff); vreg = *(const v4u*)((vp_) + (size_t)(n_) * 4096 + goff); }
#define NSA_STORE(i_) { *(LAS v4u*)(KBUF((i_) & 1) + koff) = kreg; *(LAS v4u*)(VBUF((i_) & 1) + voff) = vreg; }
#define NSA_FAST(i_, t0v_) { nsa_qk(p0, p1, KBUF((i_) & 1), qf, q, h, bo0); nsa_fast(p0, p1, 32.f * slope2, (t0v_), m, l, o); nsa_pv(o, p0, p1, VBUF((i_) & 1), lane, h); }
#define NSA_STEP(CHECK_, i_, basef_, cst_, klo_, khi_) { nsa_qk(p0, p1, KBUF((i_) & 1), qf, q, h, zero16); nsa_bias<CHECK_>(p0, p1, (basef_), slope2, (cst_), (klo_), (khi_), h); nsa_online(p0, p1, m, l, o); nsa_pv(o, p0, p1, VBUF((i_) & 1), lane, h); }
    {
        float m = -INFINITY, l = 0.f; const float cst = -slope2 * tf;
#pragma unroll
        for (int rr = 0; rr < 16; ++rr) { o[0][rr] = 0.f; o[1][rr] = 0.f; bo0[rr] = slope2 * (float)((rr & 3) + 8 * (rr >> 2)); }
        todo &= ~(1ull << cur);
        NSA_STORE(0) __syncthreads();
        int i = 0, nn = todo ? 63 - __clzll((long long)todo) : -1; if (nn >= 0) todo &= ~(1ull << nn);
        if (nn >= 0) NSA_LOAD(ksp, vsp, nn) else NSA_LOAD(kwp, vwp, tile)
        NSA_STEP(true, 0, (float)(cur * 64), cst, 0.f, tf)
        if (nn >= 0) NSA_STORE(1)
        __syncthreads();
#pragma unroll 1
        while (nn >= 0) { const int n = nn; ++i; nn = todo ? 63 - __clzll((long long)todo) : -1; if (nn >= 0) todo &= ~(1ull << nn);
            if (nn >= 0) NSA_LOAD(ksp, vsp, nn) else NSA_LOAD(kwp, vwp, tile)
            const bool sel = (mymask >> n) & 1ull;
            NSA_FAST(i, sel ? fmaf(slope2, (float)(n * 64 + 4 * h), cst) : -INFINITY)
            if (nn >= 0) NSA_STORE(i + 1)
            __syncthreads(); }
        l += __shfl_xor(l, 32); const float gs = sigmoid_f(gp[1]) / l;
#pragma unroll
        for (int rr = 0; rr < 16; ++rr) { osum[0][rr] += gs * o[0][rr]; osum[1][rr] += gs * o[1][rr]; }
    }
    {
        float m = -INFINITY, l = 0.f; const float cst = -slope2 * tf;
#pragma unroll
        for (int rr = 0; rr < 16; ++rr) { o[0][rr] = 0.f; o[1][rr] = 0.f; }
        const int nw = tile < 8 ? tile + 1 : 9, nmid = nw < 8 ? nw : 8;
        NSA_STORE(0) __syncthreads();
        if (nw > 1) NSA_LOAD(kwp, vwp, tile - 1)
        NSA_STEP(true, 0, (float)(tile * 64), cst, 0.f, tf)
        if (nw > 1) NSA_STORE(1)
        __syncthreads();
#pragma unroll 1
        for (int i = 1; i < nmid; ++i) { const int jt = tile - i;
            if (i + 1 < nw) NSA_LOAD(kwp, vwp, jt - 1)
            NSA_FAST(i, fmaf(slope2, (float)(jt * 64 + 4 * h), cst))
            if (i + 1 < nw) NSA_STORE(i + 1)
            __syncthreads(); }
        if (nw == 9) { NSA_STEP(true, 8, (float)((tile - 8) * 64), cst, tf - 511.f, 1e9f) __syncthreads(); }
        l += __shfl_xor(l, 32); const float gs = sigmoid_f(gp[2]) / l;
#pragma unroll
        for (int rr = 0; rr < 16; ++rr) { osum[0][rr] += gs * o[0][rr]; osum[1][rr] += gs * o[1][rr]; }
    }
#undef NSA_LOAD
#undef NSA_STORE
#undef NSA_STEP
#undef NSA_FAST
    { bf16* yp = (bf16*)(P.ws + WS_Y) + tg * DM + g * 256 + r * 64 + 4 * h;
#pragma unroll
      for (int dt = 0; dt < 2; ++dt)
#pragma unroll
          for (int a = 0; a < 4; ++a) { v2u w; w.x = cvtpk(osum[dt][4 * a], osum[dt][4 * a + 1]); w.y = cvtpk(osum[dt][4 * a + 2], osum[dt][4 * a + 3]); *(v2u*)(yp + dt * 32 + a * 8) = w; } }
#undef KBUF
#undef VBUF
}
__device__ __forceinline__ void phase_nsa(const Params& P, LAS unsigned char* lds) {
    for (int it = blockIdx.x; it < 2048; it += gridDim.x) { const int rnd = it / 256, c = it % 256; const int bg = c & 31, tile = 63 - 8 * rnd - (c >> 5); nsa_item(P, lds, bg, tile); }
}

__device__ __forceinline__ void xatt_item(const Params& P, LAS unsigned char* lds, int l, int bh, int blk) {
    int tid_l = threadIdx.x; asm volatile("" : "+v"(tid_l)); const int tid = tid_l, lane = tid & 63, wave = tid >> 6, q = lane & 31, h = lane >> 5;
    const int b = bh >> 2, hh = bh & 3; const size_t t = (size_t)b * SEQ + blk * 256 + wave * 32 + q;
    const bf16* kvp = (const bf16*)(P.ws + WS_MEMKV) + (size_t)(b * 256) * 4096 + l * 2048 + hh * 256;
    const bf16* qp = (const bf16*)(P.ws + WS_QXA) + t * DM + hh * 256 + 8 * h;
#pragma unroll
    for (int half = 0; half < 2; ++half) { v4u kr[8];
#pragma unroll
        for (int i = 0; i < 8; ++i) { const int p = tid + 512 * (half * 8 + i); kr[i] = *(const v4u*)(kvp + (size_t)(p >> 5) * 4096 + (p & 31) * 8); }
#pragma unroll
        for (int i = 0; i < 8; ++i) { const int p = tid + 512 * (half * 8 + i); *(LAS v4u*)(lds + (p >> 5) * 528 + (p & 31) * 16) = kr[i]; } }
    bf16x8 qf[16];
#pragma unroll
    for (int ks = 0; ks < 16; ++ks) qf[ks] = *(const bf16x8*)(qp + 16 * ks);
    __syncthreads();
    const float C = 0.0625f * LOG2E_F;
    v4u pk[16]; float m = 0.f, lsum = 0.f, f0 = 1.f;
#pragma unroll
    for (int half = 0; half < 2; ++half) {
        f32x16 s[4];
#pragma unroll
        for (int kt = 0; kt < 4; ++kt) {
#pragma unroll
            for (int r = 0; r < 16; ++r) s[kt][r] = 0.f;
            LAS const unsigned char* kb = lds + (half * 128 + kt * 32 + q) * 528 + h * 16;
#pragma unroll
            for (int ks = 0; ks < 16; ++ks) s[kt] = __builtin_amdgcn_mfma_f32_32x32x16_bf16(*(const LAS bf16x8*)(kb + ks * 32), qf[ks], s[kt], 0, 0, 0); }
        float mx = s[0][0];
#pragma unroll
        for (int kt = 0; kt < 4; ++kt)
#pragma unroll
            for (int r = 0; r < 16; ++r) mx = fmaxf(mx, s[kt][r]);
        mx = fmaxf(mx, __shfl_xor(mx, 32)) * C;
        const float mn = half == 0 ? mx : fmaxf(m, mx);
        if (half == 1) { f0 = __builtin_amdgcn_exp2f(m - mn); lsum *= f0; }
        m = mn;
        float sum = 0.f;
#pragma unroll
        for (int kt = 0; kt < 4; ++kt) {
#pragma unroll
            for (int r = 0; r < 16; ++r) { s[kt][r] = __builtin_amdgcn_exp2f(fmaf(s[kt][r], C, -mn)); sum += s[kt][r]; }
#pragma unroll
            for (int e = 0; e < 2; ++e) { v4u w; w.x = cvtpk(s[kt][8 * e + 0], s[kt][8 * e + 1]); w.y = cvtpk(s[kt][8 * e + 2], s[kt][8 * e + 3]); w.z = cvtpk(s[kt][8 * e + 4], s[kt][8 * e + 5]); w.w = cvtpk(s[kt][8 * e + 6], s[kt][8 * e + 7]); pk[half * 8 + kt * 2 + e] = w; } }
        lsum += sum;
    }
    lsum += __shfl_xor(lsum, 32); const float invl = 1.f / lsum;
    __syncthreads();
#pragma unroll
    for (int c = 0; c < 2; ++c) { v4u vr[8];
#pragma unroll
        for (int i = 0; i < 8; ++i) { const int p = tid + 512 * i; vr[i] = *(const v4u*)(kvp + 1024 + (size_t)(p >> 4) * 4096 + c * 128 + (p & 15) * 8); }
#pragma unroll
        for (int i = 0; i < 8; ++i) { const int p = tid + 512 * i; *(LAS v4u*)(lds + c * 65536 + ((p & 15) >> 2) * 16384 + (p >> 4) * 64 + (p & 3) * 16) = vr[i]; } }
    __syncthreads();
    bf16* yp = (bf16*)(P.ws + WS_Y) + t * DM + hh * 256 + 4 * h;
    LAS const unsigned char* vp = lds + (4 * h + ((lane & 15) >> 2)) * 64 + ((lane >> 4) & 1) * 32 + (lane & 3) * 8;
#pragma unroll 1
    for (int dt = 0; dt < 8; ++dt) { f32x16 o;
#pragma unroll
        for (int r = 0; r < 16; ++r) o[r] = 0.f;
        LAS const unsigned char* vd = vp + dt * 16384;
#pragma unroll
        for (int s = 0; s < 8; ++s) { const v4i16 lo = __builtin_amdgcn_ds_read_tr16_b64_v4i16((LAS v4i16*)(vd + s * 1024)), hi = __builtin_amdgcn_ds_read_tr16_b64_v4i16((LAS v4i16*)(vd + s * 1024 + 512));
            o = __builtin_amdgcn_mfma_f32_32x32x16_bf16((bf16x8){lo[0], lo[1], lo[2], lo[3], hi[0], hi[1], hi[2], hi[3]}, __builtin_bit_cast(bf16x8, pk[s]), o, 0, 0, 0); }
#pragma unroll
        for (int r = 0; r < 16; ++r) o[r] *= f0;
#pragma unroll
        for (int s = 8; s < 16; ++s) { const v4i16 lo = __builtin_amdgcn_ds_read_tr16_b64_v4i16((LAS v4i16*)(vd + s * 1024)), hi = __builtin_amdgcn_ds_read_tr16_b64_v4i16((LAS v4i16*)(vd + s * 1024 + 512));
            o = __builtin_amdgcn_mfma_f32_32x32x16_bf16((bf16x8){lo[0], lo[1], lo[2], lo[3], hi[0], hi[1], hi[2], hi[3]}, __builtin_bit_cast(bf16x8, pk[s]), o, 0, 0, 0); }
#pragma unroll
        for (int a = 0; a < 4; ++a) { v2u w; w.x = cvtpk(o[4 * a] * invl, o[4 * a + 1] * invl); w.y = cvtpk(o[4 * a + 2] * invl, o[4 * a + 3] * invl); *(v2u*)(yp + dt * 32 + a * 8) = w; } }
    __syncthreads();
}
__device__ __forceinline__ void phase_xatt(const Params& P, LAS unsigned char* lds, int l) {
    for (int it = blockIdx.x; it < 512; it += gridDim.x) { const int c = it % 256, k = it / 256; xatt_item(P, lds, l, c & 31, (c >> 5) + 8 * k); }
}

constexpr size_t WS_DN = 344 * MiB, DN_CHUNK_BYTES = 73728, WS_EGL = 488 * MiB;
constexpr int DNA_RHS = 0, DNA_QB = 65536, DNA_KB = 82944, DNA_AM = 100352, DNA_SSQ = 118784, DNA_GC = 126976;
__device__ __forceinline__ void dna_item(const Params& P, LAS unsigned char* lds, int item) {
    int tid_l = threadIdx.x; asm volatile("" : "+v"(tid_l)); const int tid = tid_l, lane = tid & 63, wave = tid >> 6;
    const int bh = item >> 6, n = item & 63, b = bh >> 2, h = bh & 3, sb = n * 64; const size_t rb = (size_t)b * SEQ;
    const bf16* z = (const bf16*)(P.ws + WS_Z); const float* ba = (const float*)(P.ws + WS_BA); const float* cw = P.in[I_A_CONV];
    unsigned char* ob = P.ws + WS_DN + (size_t)item * DN_CHUNK_BYTES;
    LAS float* rhs = (LAS float*)(lds + DNA_RHS); LAS float* Am = (LAS float*)(lds + DNA_AM); LAS float* ssq = (LAS float*)(lds + DNA_SSQ);
    LAS float* gcs = (LAS float*)(lds + DNA_GC); LAS float* bet = gcs + 64; LAS float* egc = gcs + 128; LAS float* ekd = gcs + 192;
    const float SC = 0.08838834764831845f;
    { const int gd = tid & 15, tq = tid >> 4, d0 = gd * 8;
      f32x4 wa[3][4][2]; v4u za[3][2][4];
#pragma unroll
      for (int part = 0; part < 3; ++part) { const int ch0 = part * 512 + h * 128 + d0;
#pragma unroll
          for (int kk = 0; kk < 4; ++kk) { wa[part][kk][0] = *(const f32x4*)(cw + kk * 1536 + ch0); wa[part][kk][1] = *(const f32x4*)(cw + kk * 1536 + ch0 + 4); }
#pragma unroll
          for (int tt = 0; tt < 2; ++tt)
#pragma unroll
              for (int kk = 0; kk < 4; ++kk) { const int sp = sb + tq + 32 * tt - 3 + kk; za[part][tt][kk] = (v4u){0u, 0u, 0u, 0u}; if (sp >= 0) za[part][tt][kk] = *(const v4u*)(z + (rb + sp) * 2560 + 512 + ch0); } }
      __builtin_amdgcn_sched_barrier(0);
    if (wave == 0) { const size_t t = rb + sb + lane; const float bl = ba[t * 8 + h], al = ba[t * 8 + 4 + h] + P.in[I_A_DTB][h]; const float sp = al > 20.f ? al : log1pf(__expf(al));
        float g = -__expf(P.in[I_A_ALOG][h]) * sp;
#pragma unroll
        for (int o = 1; o < 64; o <<= 1) { const float v = __shfl_up(g, o); if (lane >= o) g += v; }
        const float gl = __shfl(g, 63);
        gcs[lane] = g; bet[lane] = sigmoid_f(bl); egc[lane] = __expf(g); ekd[lane] = __expf(gl - g);
        if (lane == 63) ((float*)(P.ws + WS_EGL))[item] = __expf(g); }
      __syncthreads();
#pragma unroll
      for (int part = 0; part < 3; ++part) {
#pragma unroll
          for (int tt = 0; tt < 2; ++tt) { const int tl = tq + 32 * tt;
              float a[8];
#pragma unroll
              for (int e2 = 0; e2 < 8; ++e2) a[e2] = 0.f;
#pragma unroll
              for (int kk = 0; kk < 4; ++kk) { const v4u zv = za[part][tt][kk]; const f32x4 w0 = wa[part][kk][0], w1 = wa[part][kk][1];
                  a[0] += w0.x * bf2f(zv.x & 0xffff); a[1] += w0.y * bf2f(zv.x >> 16); a[2] += w0.z * bf2f(zv.y & 0xffff); a[3] += w0.w * bf2f(zv.y >> 16);
                  a[4] += w1.x * bf2f(zv.z & 0xffff); a[5] += w1.y * bf2f(zv.z >> 16); a[6] += w1.z * bf2f(zv.w & 0xffff); a[7] += w1.w * bf2f(zv.w >> 16); }
              float q2 = 0.f;
#pragma unroll
              for (int e2 = 0; e2 < 8; ++e2) { a[e2] = a[e2] * __builtin_amdgcn_rcpf(1.f + __builtin_amdgcn_exp2f(-LOG2E_F * a[e2])); q2 += a[e2] * a[e2]; }
              if (part < 2) {
                  q2 += __shfl_xor(q2, 1); q2 += __shfl_xor(q2, 2); q2 += __shfl_xor(q2, 4); q2 += __shfl_xor(q2, 8);
                  const float rs = rsqrtf(q2 + EPS);
#pragma unroll
                  for (int e2 = 0; e2 < 8; ++e2) a[e2] *= rs;
                  v4u wv; wv.x = cvtpk(a[0], a[1]); wv.y = cvtpk(a[2], a[3]); wv.z = cvtpk(a[4], a[5]); wv.w = cvtpk(a[6], a[7]);
                  *(LAS v4u*)(lds + (part == 0 ? DNA_QB : DNA_KB) + tl * 272 + d0 * 2) = wv;
                  if (part == 0) { const float f = SC * egc[tl]; v4u g4; g4.x = cvtpk(a[0] * f, a[1] * f); g4.y = cvtpk(a[2] * f, a[3] * f); g4.z = cvtpk(a[4] * f, a[5] * f); g4.w = cvtpk(a[6] * f, a[7] * f);
                      *(v4u*)(ob + 16384 + (((tl >> 4) * 4 + (d0 >> 5)) * 64 + (tl & 15) + 16 * ((d0 >> 3) & 3)) * 16) = g4; }
                  else { const float f = ekd[tl], fb = bet[tl] * egc[tl];
                      *(LAS f32x4*)(rhs + tl * 256 + d0) = (f32x4){a[0] * fb, a[1] * fb, a[2] * fb, a[3] * fb}; *(LAS f32x4*)(rhs + tl * 256 + d0 + 4) = (f32x4){a[4] * fb, a[5] * fb, a[6] * fb, a[7] * fb};
                      bf16* kd = (bf16*)(ob + 32768) + ((((d0 >> 4) * 2 + (tl >> 5)) * 64 + 16 * ((tl >> 3) & 3)) * 8) + (tl & 7);
#pragma unroll
                      for (int e2 = 0; e2 < 8; ++e2) kd[(((d0 & 15) + e2) * 8)] = (bf16)f2bf(a[e2] * f); } }
              else { const float fb = bet[tl];
                  *(LAS f32x4*)(rhs + tl * 256 + 128 + d0) = (f32x4){a[0] * fb, a[1] * fb, a[2] * fb, a[3] * fb}; *(LAS f32x4*)(rhs + tl * 256 + 128 + d0 + 4) = (f32x4){a[4] * fb, a[5] * fb, a[6] * fb, a[7] * fb}; } } } }
    __syncthreads();
    if (wave < 6) { const int isq = wave >= 3, jb = wave - 3 * isq, it = jb >= 1, jt = jb == 2; const int q = lane & 31, hh = lane >> 5;
        f32x16 d;
#pragma unroll
        for (int r = 0; r < 16; ++r) d[r] = 0.f;
        LAS const unsigned char* ap = lds + (isq ? DNA_QB : DNA_KB) + (it * 32 + q) * 272 + hh * 16; LAS const unsigned char* bp = lds + DNA_KB + (jt * 32 + q) * 272 + hh * 16;
#pragma unroll
        for (int ks = 0; ks < 8; ++ks) d = __builtin_amdgcn_mfma_f32_32x32x16_bf16(*(const LAS bf16x8*)(ap + ks * 32), *(const LAS bf16x8*)(bp + ks * 32), d, 0, 0, 0);
        const int j = jt * 32 + q; const float gj = gcs[j];
#pragma unroll
        for (int r = 0; r < 16; ++r) { const int i = it * 32 + (r & 3) + 8 * (r >> 2) + 4 * hh; const float dec = __expf(fminf(gcs[i] - gj, 0.f));
            if (!isq) Am[(j & 1) * 2304 + i * 36 + (j >> 1)] = i > j ? d[r] * bet[i] * dec : 0.f;
            else ((bf16*)(ob + 65536))[((((i >> 4) * 2 + (j >> 5)) * 64 + (i & 15) + 16 * ((j >> 3) & 3)) * 8) + (j & 7)] = (bf16)f2bf(i >= j ? d[r] * SC * dec : 0.f); } }
    else if (wave == 6) { const v4u z4 = {0u, 0u, 0u, 0u}; *(v4u*)(ob + 65536 + ((0 * 2 + 1) * 64 + lane) * 16) = z4; *(v4u*)(ob + 65536 + ((1 * 2 + 1) * 64 + lane) * 16) = z4; }
    __syncthreads();
    if (tid < 256) { const int cp = tid >> 1, par = tid & 1, c = 2 * cp; LAS const float* Ap = Am + par * 2304; f2v x[32];
#pragma unroll
      for (int jj = 0; jj < 32; ++jj) x[jj] = (f2v){0.f, 0.f};
      f32x4 ab[2][8]; f2v rb[2]; f2v xl[4] = {{0.f, 0.f}, {0.f, 0.f}, {0.f, 0.f}, {0.f, 0.f}};
      rb[0] = *(const LAS f2v*)(rhs + c);
      unsigned* wp = (unsigned*)((bf16*)ob + (((c >> 5) * 64 + 16 * ((c >> 3) & 3)) * 8) + (c & 7));
      const int dv = c - 128; unsigned char* up = ob + 49152 + (((dv >> 4) * 4) * 64 + (dv & 15)) * 8;
#pragma unroll
      for (int i = 0; i < 64; ++i) {
          if (i + 1 < 64) {
#pragma unroll
              for (int j4 = 0; j4 < ((i + 2) / 2 + 3) / 4; ++j4) ab[(i + 1) & 1][j4] = *(const LAS f32x4*)(Ap + (i + 1) * 36 + 4 * j4);
              rb[(i + 1) & 1] = *(const LAS f2v*)(rhs + (i + 1) * 256 + c); }
          __builtin_amdgcn_sched_barrier(0);
          f2v ac4[4] = {{0.f, 0.f}, {0.f, 0.f}, {0.f, 0.f}, {0.f, 0.f}};
#pragma unroll
          for (int jj = 0; jj < (i + 1) / 2; ++jj) { const float a = ab[i & 1][jj >> 2][jj & 3]; ac4[jj & 3] = ac4[jj & 3] + (f2v){a, a} * x[jj]; }
          f2v acc = (ac4[0] + ac4[1]) + (ac4[2] + ac4[3]);
          acc.x += __int_as_float(__builtin_amdgcn_update_dpp(0, __float_as_int(acc.x), 0xB1, 0xF, 0xF, true)); acc.y += __int_as_float(__builtin_amdgcn_update_dpp(0, __float_as_int(acc.y), 0xB1, 0xF, 0xF, true));
          const f2v xi = rb[i & 1] - acc;
          x[i >> 1] = ((i & 1) == par) ? xi : x[i >> 1];
          xl[i & 3] = xi;
          if (tid < 128) { if ((i & 1) == par) wp[(((i >> 4) * 4) * 64 + (i & 15)) * 4] = cvtpk(xi.x, xi.y); }
          else if ((i & 3) == 3 && ((i >> 2) & 1) == par) { v2u w0, w1; w0.x = cvtpk(xl[0].x, xl[1].x); w0.y = cvtpk(xl[2].x, xl[3].x); w1.x = cvtpk(xl[0].y, xl[1].y); w1.y = cvtpk(xl[2].y, xl[3].y);
              unsigned char* u0 = up + (((i >> 2) >> 2) * 64 + 16 * ((i >> 2) & 3)) * 8; *(v2u*)u0 = w0; *(v2u*)(u0 + 8) = w1; }
          __builtin_amdgcn_sched_barrier(0);
      } }
    __syncthreads();
}
__device__ __forceinline__ void phase_dna(const Params& P, LAS unsigned char* lds) { for (int it = blockIdx.x; it < 2048; it += gridDim.x) dna_item(P, lds, it); }

typedef float f32x4v __attribute__((ext_vector_type(4)));
struct DnFrag { bf16x8 m1[4]; bf16x8 at[2]; bf16x8 kd[2]; v2u u; float eg; };
__device__ __forceinline__ void dnb_load(DnFrag& f, const unsigned char* base, const float* egl, int n, int wave, int lane, int sl) {
    const unsigned char* cb = base + (size_t)n * DN_CHUNK_BYTES; const int ct = wave & 3;
    const unsigned char* m1 = cb + (wave < 4 ? 0 : 16384) + ((ct * 4) * 64 + lane) * 16;
#pragma unroll
    for (int ks = 0; ks < 4; ++ks) f.m1[ks] = *(const bf16x8*)(m1 + ks * 1024);
#pragma unroll
    for (int ks = 0; ks < 2; ++ks) f.kd[ks] = *(const bf16x8*)(cb + 32768 + ((wave * 2 + ks) * 64 + lane) * 16);
    if (wave < 4) f.u = *(const v2u*)(cb + 49152 + ((sl * 4 + ct) * 64 + lane) * 8);
    else {
#pragma unroll
        for (int ks = 0; ks < 2; ++ks) f.at[ks] = *(const bf16x8*)(cb + 65536 + ((ct * 2 + ks) * 64 + lane) * 16); }
    f.eg = egl[n];
}
__device__ __forceinline__ void phase_dnb(const Params& P, LAS unsigned char* lds) {
    int tid_l = threadIdx.x; asm volatile("" : "+v"(tid_l)); const int tid = tid_l, lane = tid & 63, wave = __builtin_amdgcn_readfirstlane(tid >> 6);
    const int x = blockIdx.x; if (x >= 256) return;
    const int xcd = x & 7, idx = x >> 3, bh = xcd * 4 + (idx >> 3), sl = idx & 7, b = bh >> 2, h = bh & 3, ct = wave & 3;
    const unsigned char* base = P.ws + WS_DN + (size_t)bh * 64 * DN_CHUNK_BYTES; const float* egl = (const float*)(P.ws + WS_EGL) + bh * 64;
    bf16* yo = (bf16*)(P.ws + WS_Y) + ((size_t)b * SEQ + 16 * ct + 4 * (lane >> 4)) * DM + 512 + h * 128 + sl * 16 + (lane & 15);
    LAS unsigned char* St = lds; LAS unsigned char* vnT = lds + 4352;
    LAS const unsigned char* stb = St + (lane & 15) * 272 + (lane >> 4) * 16; LAS const unsigned char* vnb = vnT + (lane & 15) * 144 + (lane >> 4) * 16;
    if (tid < 272) *(LAS v4u*)(St + tid * 16) = (v4u){0u, 0u, 0u, 0u};
    f32x4v Sacc = {0.f, 0.f, 0.f, 0.f};
    DnFrag fr[4];
#pragma unroll
    for (int u = 0; u < 4; ++u) dnb_load(fr[u], base, egl, u, wave, lane, sl);
    __syncthreads();
#pragma unroll 1
    for (int n0 = 0; n0 < 64; n0 += 4) {
#pragma unroll
        for (int u = 0; u < 4; ++u) { const int n = n0 + u;
            f32x4v acc = {0.f, 0.f, 0.f, 0.f};
#pragma unroll
            for (int ks = 0; ks < 4; ++ks) acc = __builtin_amdgcn_mfma_f32_16x16x32_bf16(fr[u].m1[ks], *(const LAS bf16x8*)(stb + ks * 64), acc, 0, 0, 0);
            if (wave < 4) { const float u0 = bf2f(fr[u].u.x & 0xffff), u1 = bf2f(fr[u].u.x >> 16), u2 = bf2f(fr[u].u.y & 0xffff), u3 = bf2f(fr[u].u.y >> 16);
                v2u w; w.x = cvtpk(u0 - acc[0], u1 - acc[1]); w.y = cvtpk(u2 - acc[2], u3 - acc[3]); *(LAS v2u*)(vnT + (lane & 15) * 144 + (16 * ct + 4 * (lane >> 4)) * 2) = w; }
            __syncthreads();
            const bf16x8 v0 = *(const LAS bf16x8*)(vnb), v1 = *(const LAS bf16x8*)(vnb + 64);
            if (wave >= 4) { acc = __builtin_amdgcn_mfma_f32_16x16x32_bf16(fr[u].at[0], v0, acc, 0, 0, 0); acc = __builtin_amdgcn_mfma_f32_16x16x32_bf16(fr[u].at[1], v1, acc, 0, 0, 0);
                bf16* yp = yo + (size_t)n * 64 * DM;
#pragma unroll
                for (int r = 0; r < 4; ++r) yp[(size_t)r * DM] = (bf16)f2bf(acc[r]); }
            Sacc = Sacc * fr[u].eg;
            Sacc = __builtin_amdgcn_mfma_f32_16x16x32_bf16(fr[u].kd[0], v0, Sacc, 0, 0, 0); Sacc = __builtin_amdgcn_mfma_f32_16x16x32_bf16(fr[u].kd[1], v1, Sacc, 0, 0, 0);
            { v2u w; w.x = cvtpk(Sacc[0], Sacc[1]); w.y = cvtpk(Sacc[2], Sacc[3]); *(LAS v2u*)(St + (lane & 15) * 272 + (16 * wave + 4 * (lane >> 4)) * 2) = w; }
            dnb_load(fr[u], base, egl, n + 4 < 64 ? n + 4 : 63, wave, lane, sl);
            __syncthreads();
        }
    }
}
__device__ __forceinline__ void phase_dnc(const Params& P, LAS unsigned char* lds) {
    int tid_l = threadIdx.x; asm volatile("" : "+v"(tid_l)); const int tid = tid_l, lane = tid & 63, wave = tid >> 6;
    const int gw = blockIdx.x * NWAVES + wave, NGW = gridDim.x * NWAVES;
    const bf16* z = (const bf16*)(P.ws + WS_Z); bf16* y = (bf16*)(P.ws + WS_Y);
    float on[8];
#pragma unroll
    for (int e = 0; e < 8; ++e) on[e] = P.in[I_A_ONORM][(lane & 15) * 8 + e];
    for (int it0 = gw; it0 < T; it0 += 4 * NGW) {
        const int hh = lane >> 4, d0 = (lane & 15) * 8; v4u ov[4], gv[4];
#pragma unroll
        for (int u = 0; u < 4; ++u) { const int it = it0 + u * NGW; if (it < T) { ov[u] = *(const v4u*)(y + (size_t)it * DM + 512 + hh * 128 + d0); gv[u] = *(const v4u*)(z + (size_t)it * 2560 + 2048 + hh * 128 + d0); } }
#pragma unroll
        for (int u = 0; u < 4; ++u) { const int it = it0 + u * NGW; if (it >= T) break;
            float o[8] = {bf2f(ov[u].x & 0xffff), bf2f(ov[u].x >> 16), bf2f(ov[u].y & 0xffff), bf2f(ov[u].y >> 16), bf2f(ov[u].z & 0xffff), bf2f(ov[u].z >> 16), bf2f(ov[u].w & 0xffff), bf2f(ov[u].w >> 16)};
            const float g[8] = {bf2f(gv[u].x & 0xffff), bf2f(gv[u].x >> 16), bf2f(gv[u].y & 0xffff), bf2f(gv[u].y >> 16), bf2f(gv[u].z & 0xffff), bf2f(gv[u].z >> 16), bf2f(gv[u].w & 0xffff), bf2f(gv[u].w >> 16)};
            float s = 0.f;
#pragma unroll
            for (int e = 0; e < 8; ++e) s += o[e] * o[e];
            s += __shfl_xor(s, 1); s += __shfl_xor(s, 2); s += __shfl_xor(s, 4); s += __shfl_xor(s, 8);
            const float rs = rsqrtf(s * (1.f / 128.f) + EPS);
#pragma unroll
            for (int e = 0; e < 8; ++e) o[e] = o[e] * rs * on[e] * (g[e] * __builtin_amdgcn_rcpf(1.f + __builtin_amdgcn_exp2f(-LOG2E_F * g[e])));
            v4u w; w.x = cvtpk(o[0], o[1]); w.y = cvtpk(o[2], o[3]); w.z = cvtpk(o[4], o[5]); w.w = cvtpk(o[6], o[7]);
            *(v4u*)(y + (size_t)it * DM + 512 + hh * 128 + d0) = w; } }
    phase_pool(P, lds);
}

constexpr size_t WS_CTL = 118 * MiB; constexpr int CTL_BYTES = 16384, LDS_CTL_OFF = 147392;
#define XB_TMO      128
#define XB_XCNT(j)  (256  + 64 * (j))
#define XB_XSUB(j)  (1280 + 64 * (j))
#define XB_XGEN(j)  (2304 + 64 * (j))
#define XB_TOP      3328
#define XB_TOPGEN   3392
#define XCD_BAR_WORDS 3456
#define XB_SPIN_CAP (1u << 18)

__device__ __forceinline__ unsigned xb_ld(unsigned* p)              { return __hip_atomic_load(p, __ATOMIC_RELAXED, __HIP_MEMORY_SCOPE_AGENT); }
__device__ __forceinline__ unsigned xb_add(unsigned* p, unsigned v) { return __hip_atomic_fetch_add(p, v, __ATOMIC_RELAXED, __HIP_MEMORY_SCOPE_AGENT); }
__device__ __forceinline__ unsigned xb_xcc_id() { return (unsigned)__builtin_amdgcn_s_getreg((3 << 11) | 20) & 0xFu; }
#define XB_SPIN(cond, bar) do { unsigned _sp = 0; while (cond) { __builtin_amdgcn_s_sleep(1); \
    if ((++_sp & 255u) == 0u) { if (xb_ld(&(bar)[XB_TMO])) break; if (_sp > XB_SPIN_CAP) { atomicAdd(&(bar)[XB_TMO], 1u); break; } } } } while (0)

struct XcdBarrier {
    unsigned* bar; unsigned x;
    volatile LAS unsigned* st;
};

__device__ __forceinline__ XcdBarrier xcd_barrier_post(unsigned* bar, volatile LAS unsigned* st) {
    XcdBarrier b; b.bar = bar; b.x = xb_xcc_id(); b.st = st;
    if (threadIdx.x == 0) (void)xb_add(&bar[XB_XCNT(b.x)], 1u);
    return b;
}
__device__ __forceinline__ void xcd_barrier_complete(unsigned* bar, unsigned x, unsigned& nloc, unsigned& nx) {
    const unsigned G = gridDim.x * gridDim.y * gridDim.z;
    unsigned sum, cnt, mine, sp = 0u;
    for (;;) {
        sum = 0u; cnt = 0u; mine = 0u;
#pragma unroll
        for (unsigned j = 0; j < 16; ++j) { const unsigned c = xb_ld(&bar[XB_XCNT(j)]); sum += c; cnt += (c > 0u) ? 1u : 0u; mine = (j == x) ? c : mine; }
        if (sum == G) break;
        __builtin_amdgcn_s_sleep(1);
        if ((++sp & 255u) == 0u) { if (xb_ld(&bar[XB_TMO])) break; if (sp > XB_SPIN_CAP) { atomicAdd(&bar[XB_TMO], 1u); break; } }
    }
    nloc = mine > 0u ? mine : 1u; nx = cnt > 0u ? cnt : 1u;
}

__device__ __forceinline__ void xcd_barrier(const XcdBarrier& b) {
    asm volatile("s_waitcnt vmcnt(0)" ::: "memory");
    __syncthreads();
    if (threadIdx.x == 0) {
        unsigned* bar = b.bar;
        __builtin_amdgcn_s_waitcnt(0);
        unsigned nloc = b.st[0], nx = b.st[1];
        if (nloc == 0u) { xcd_barrier_complete(bar, b.x, nloc, nx); b.st[0] = nloc; b.st[1] = nx; }
        const unsigned old = xb_add(&bar[XB_XSUB(b.x)], 1u);
        const unsigned gen = old / nloc;
        if (old + 1u == (gen + 1u) * nloc) {
            __builtin_amdgcn_fence(__ATOMIC_RELEASE, "agent");
            asm volatile("s_waitcnt vmcnt(0)" ::: "memory");
            const unsigned og = xb_add(&bar[XB_TOP], 1u);
            const unsigned tg = og / nx;
            if (og + 1u == (tg + 1u) * nx) xb_add(&bar[XB_TOPGEN], 1u);
            else XB_SPIN(xb_ld(&bar[XB_TOPGEN]) == tg, bar);
            __builtin_amdgcn_fence(__ATOMIC_ACQUIRE, "agent");
            xb_add(&bar[XB_XGEN(b.x)], 1u);
            asm volatile("s_waitcnt vmcnt(0)" ::: "memory");
        } else {
            XB_SPIN(xb_ld(&bar[XB_XGEN(b.x)]) == gen, bar);
            __builtin_amdgcn_fence(__ATOMIC_ACQUIRE, "agent");
            asm volatile("s_waitcnt vmcnt(0)" ::: "memory");
        }
    }
    __syncthreads();
}

constexpr int LDS_RS_OFF = 131072;
template <class E> __device__ __forceinline__ void run_gemm(LAS unsigned char* lds, const bf16* A, const bf16* Bt, int M, int N, int K, const E& e, const float* ss = nullptr) {
    pg8::Gemm g{A, Bt, M, N, K}; pg8::StaticOrder So; So.init(M, N, (int)gridDim.x, (int)blockIdx.x);
    if (ss) { pg8::Unit u; LAS float* rs = (LAS float*)(lds + LDS_RS_OFF);
        for (int i = 0; So.next(i, u); ++i) { const int r = threadIdx.x; if (r < 256) rs[256 * i + r] = pg8::row_rstd(ss, u.pm * 256 + r); }
        __syncthreads(); }
    pg8::gemm_phase<E, pg8::StaticOrder, true, true>(lds, g, So, e);
}
constexpr int N_PHASES = 22;
#ifndef MK_PER_PHASE
#define MK_PER_PHASE 0
#endif

template <int ph> __device__ __forceinline__ void do_phase(const Params& P, LAS unsigned char* lds) {
    unsigned char* ws = P.ws;
    bf16* xh = (bf16*)(ws + WS_XH); float* ss = (float*)(ws + WS_SS); bf16* yb = (bf16*)(ws + WS_Y); bf16* zb = (bf16*)(ws + WS_Z);
    if constexpr (ph == 0) phase_prologue(P, lds);
    else if constexpr (ph == 1) {
        pg8::Gemm g{xh, (const bf16*)(ws + WS_AIN), T, 2816, 1024, (const bf16*)(ws + WS_MEMH), (const bf16*)(ws + WS_XKV)};
        pg8::DualOrder So; So.init(T, 2816, 2048, 4096, (int)gridDim.x, (int)blockIdx.x);
        { pg8::Unit u; LAS float* rs = (LAS float*)(lds + LDS_RS_OFF);
          for (int i = 0; So.next(i, u); ++i) { const int r = threadIdx.x; if (r < 256 && u.kind == 0) rs[256 * i + r] = pg8::row_rstd(ss, u.pm * 256 + r); }
          __syncthreads(); }
        pg8::EpiDual<pg8::EpiInA, pg8::EpiBf<0>> e{{zb, (float*)(ws + WS_BA), (LAS float*)(lds + LDS_RS_OFF)}, {(bf16*)(ws + WS_MEMKV), 4096, nullptr, 1.f}};
        pg8::gemm_phase<pg8::EpiDual<pg8::EpiInA, pg8::EpiBf<0>>, pg8::DualOrder, true, true>(lds, g, So, e); }
    else if constexpr (ph == 2) phase_dna(P, lds);
    else if constexpr (ph == 3) phase_dnb(P, lds);
    else if constexpr (ph == 4) phase_dnc(P, lds);
    else if constexpr (ph == 11) { pg8::EpiInC e{zb, zb + (size_t)T * 1024, (float*)(ws + WS_GATES), (LAS float*)(lds + LDS_RS_OFF)}; run_gemm(lds, xh, (const bf16*)(ws + WS_CIN), T, 2560, 1024, e, ss);   }
    else if constexpr (ph == 12) { const int kvs = (int)blockIdx.x >> 5;
        if (kvs < 2) { pg8::EpiF32 e{(float*)(ws + (kvs ? WS_P01V : WS_P01K)), 256};
            pg8::Gemm g{zb + (size_t)T * 1024 + (size_t)kvs * KV_KIND, (const bf16*)(ws + (kvs ? WS_CMPV : WS_CMPK)), 8192, 256, 1024}; pg8::StaticOrder So; So.init(8192, 256, (int)gridDim.x, (int)blockIdx.x & 31);
            pg8::gemm_phase<pg8::EpiF32, pg8::StaticOrder, true, true>(lds, g, So, e);
            pg8::Unit u; So.next(0, u);
            __builtin_amdgcn_fence(__ATOMIC_RELEASE, "agent"); asm volatile("s_waitcnt vmcnt(0)" ::: "memory"); __syncthreads(); __builtin_amdgcn_fence(__ATOMIC_ACQUIRE, "agent"); asm volatile("s_waitcnt vmcnt(0)" ::: "memory");
            cmpfin_bg(P, lds, kvs, u.pm); }
        else { const int gwi = ((int)blockIdx.x - 64) * NWAVES + (int)(threadIdx.x >> 6), ngwi = ((int)gridDim.x - 64) * NWAVES; phase_gates(P, lds, gwi, ngwi); phase_conv_late(P, lds, gwi, ngwi); } }
    else if constexpr (ph == 13) { }
    else if constexpr (ph == 14) phase_nsa(P, lds);
    else if constexpr (ph == 21) phase_final(P);
    else { constexpr int l = ph >= 15 ? 1 : 0, k = ph - (l ? 15 : 5);
        if constexpr (k == 1) {
            { pg8::EpiBf<0> e{(bf16*)(ws + WS_QXA), 1024, (LAS float*)(lds + LDS_RS_OFF), 1.f}; run_gemm(lds, xh, (const bf16*)(ws + WS_XQ) + (size_t)l * 1048576, T, 1024, 1024, e, ss); } }
        else if constexpr (k == 2) phase_xatt(P, lds, l);
        else if constexpr (k == 4) { pg8::EpiBf<1> e{(bf16*)(ws + WS_HMID), 4096, (LAS float*)(lds + LDS_RS_OFF), 1.f}; run_gemm(lds, xh, (const bf16*)(ws + WS_F1) + (size_t)l * 4194304, T, 4096, 1024, e, ss); }
        else { const bf16* A = k == 5 ? (const bf16*)(ws + WS_HMID) : yb; constexpr int K = k == 5 ? 4096 : 1024;
            const bf16* Bt = k == 0 ? (const bf16*)(ws + (l ? WS_COUT : WS_AOUT)) : k == 3 ? (const bf16*)(ws + WS_XO) + (size_t)l * 1048576 : (const bf16*)(ws + WS_F2) + (size_t)l * 4194304;
            if constexpr (ph == 5) { pg8::EpiRes<true> e{xh, ss, P.in[I_X]}; run_gemm(lds, A, Bt, T, 1024, K, e); }
            else { pg8::EpiRes<false> e{xh, ss, nullptr}; run_gemm(lds, A, Bt, T, 1024, K, e); } } }
}
__global__ void __launch_bounds__(NTHR, 2) trunk_fwd(Params P) {
    extern __shared__ __attribute__((aligned(16))) unsigned char lds_raw[];
    LAS unsigned char* lds = (LAS unsigned char*)lds_raw;
    cg::grid_group grid = cg::this_grid();
    const int lo = P.ph_lo, hi = P.ph_hi;
#ifndef PROBE_PH
#define PROBE_PH -1
#endif
    if (threadIdx.x < 2) ((LAS unsigned*)(lds + LDS_CTL_OFF))[threadIdx.x] = 0u;
    __syncthreads();
    const XcdBarrier bar = xcd_barrier_post((unsigned*)(P.ws + WS_CTL), (volatile LAS unsigned*)(lds + LDS_CTL_OFF));
    if (P.ph_lo < 0) grid.sync();
#define SEAM(k) { xcd_barrier(bar); }
#define RUN(k) if (lo <= (k) && (k) < hi) { if ((k) == PROBE_PH) { do_phase<(k)>(P, lds); SEAM(k) } do_phase<(k)>(P, lds); if ((k) + 1 < hi) SEAM(k) }
    RUN(0) RUN(1) RUN(2) RUN(3) RUN(4) RUN(5) RUN(6) RUN(7) RUN(8) RUN(9) RUN(10) RUN(11) RUN(12) RUN(14) RUN(15) RUN(16) RUN(17) RUN(18) RUN(19) RUN(20) RUN(21)
#undef RUN
}

extern "C" void kernel_launch(void* const* d_in, const int* in_sizes, int n_in, void* d_out, int out_size, void* d_ws, size_t ws_size, hipStream_t stream) {
    static int grid = 0;
    if (grid == 0) {
        if (n_in != N_IN || in_sizes[0] != T * DM || out_size != T * DM || ws_size < WS_END) { fprintf(stderr, "kernel_launch: unexpected shapes (n_in %d, in0 %d, out %d, ws %zu)\n", n_in, n_in > 0 ? in_sizes[0] : -1, out_size, ws_size); grid = -1; return; }
        int dev = 0, cus = 0, per_cu = 0;
        if (hipGetDevice(&dev) != hipSuccess || hipDeviceGetAttribute(&cus, hipDeviceAttributeMultiprocessorCount, dev) != hipSuccess) { grid = -1; return; }
        if (hipFuncSetAttribute((const void*)trunk_fwd, hipFuncAttributeMaxDynamicSharedMemorySize, LDS_BYTES) != hipSuccess) { fprintf(stderr, "kernel_launch: hipFuncSetAttribute failed\n"); grid = -1; return; }
        if (hipOccupancyMaxActiveBlocksPerMultiprocessor(&per_cu, (const void*)trunk_fwd, NTHR, LDS_BYTES) != hipSuccess || per_cu < 1) { fprintf(stderr, "kernel_launch: occupancy query says %d blocks/CU\n", per_cu); (void)hipGetLastError(); grid = -1; return; }
        grid = cus;
        fprintf(stderr, "kernel_launch: %d CUs, %d blocks/CU by the occupancy query, grid %d\n", cus, per_cu, grid);
    }
    if (grid < 0) return;
    Params p{};
    for (int i = 0; i < N_IN; ++i) p.in[i] = (const float*)d_in[i];
    p.out = (float*)d_out; p.ws = (unsigned char*)d_ws;
#if MK_PER_PHASE
    for (int ph = 0; ph < N_PHASES; ++ph) { p.ph_lo = ph; p.ph_hi = ph + 1; hipLaunchKernelGGL(trunk_fwd, dim3(grid), dim3(NTHR), LDS_BYTES, stream, p); }
#else
    p.ph_lo = 0; p.ph_hi = N_PHASES;
    if (hipMemsetAsync((char*)d_ws + WS_CTL, 0, CTL_BYTES, stream) != hipSuccess) { fprintf(stderr, "kernel_launch: memset of the barrier words failed\n"); return; }
    void* args[] = {&p};
    hipError_t e = hipLaunchCooperativeKernel((const void*)trunk_fwd, dim3(grid), dim3(NTHR), args, LDS_BYTES, stream);
    if (e != hipSuccess) fprintf(stderr, "kernel_launch: cooperative launch failed: %s (grid %d)\n", hipGetErrorString(e), grid);
#endif
}
```

```cpp
#include <hip/hip_runtime.h>
#include <hip/hip_cooperative_groups.h>
#include <cstdio>
#include <cstdint>
namespace cg = cooperative_groups;
namespace pg8 {
#define PG8_LAS __attribute__((address_space(3)))
typedef unsigned short bf16_t;
typedef short bf16x8 __attribute__((ext_vector_type(8)));
typedef float f32x4 __attribute__((ext_vector_type(4)));
typedef unsigned u32x4 __attribute__((ext_vector_type(4)));
constexpr int BM = 256, BK = 64, HALF = 128, HTB = HALF * BK * 2  , STAGE_BYTES = 8 * HTB, NXCD = 8, WGM = 8;

__host__ __device__ __forceinline__ int lds_byte(int r, int c) { const int st = (r >> 4) * 2 + (c >> 5), rr = r & 15, cc = c & 31, ob = rr * 64 + cc * 2; return st * 1024 + (ob ^ (((ob >> 9) & 1) << 5)); }
__host__ __device__ __forceinline__ void stage_rc(int b, int& R, int& C) { const int st = b / 1024, sb = b % 1024, swz = sb ^ (((sb >> 9) & 1) << 5); R = (st >> 1) * 16 + swz / 64; C = (st & 1) * 32 + (swz % 64) / 2; }
__host__ __device__ __forceinline__ int perm32(int rho) { const int n = rho >> 4, i = rho & 15; return 8 * (i >> 2) + 4 * n + (i & 3); }

struct Unit { int pm, pn, ui, kind; };
struct Gemm { const bf16_t* A; const bf16_t* Bt; int M, N, K; const bf16_t* A2 = nullptr; const bf16_t* Bt2 = nullptr; };

struct StaticOrder {
    int nM, nN, nwg, G, c;
    __host__ __device__ void init(int M, int N, int G_, int c_) { nM = M / BM; nN = N / BM; nwg = nM * nN; G = G_; c = c_; }
    __host__ __device__ bool next(int i, Unit& u) const {
        const long L = (long)i * G + c; if (L >= nwg) return false;
        int wgid = (int)L; { const int q = nwg / NXCD, r = nwg % NXCD, xcd = wgid % NXCD, off = wgid / NXCD; wgid = (xcd < r ? xcd * (q + 1) : r * (q + 1) + (xcd - r) * q) + off; }
        const int nig = WGM * nN, gid = wgid / nig, fm = gid * WGM, gsz = (nM - fm) < WGM ? (nM - fm) : WGM;
        u.pm = fm + ((wgid % nig) % gsz); u.pn = (wgid % nig) / gsz; u.ui = i; u.kind = 0; return true;
    }
    __device__ __forceinline__ void a_ready(const Unit&) const {}
    __device__ __forceinline__ void done(const Unit&) const {}
};
__device__ __forceinline__ unsigned cvt_pk_bf16(float lo, float hi) { unsigned r; asm volatile("v_cvt_pk_bf16_f32 %0, %1, %2" : "=v"(r) : "v"(lo), "v"(hi)); return r; }
typedef float f32x2 __attribute__((ext_vector_type(2)));
typedef float f32x2 __attribute__((ext_vector_type(2)));
template <class Epi, class Sched, bool ALIGN_EPI = false, bool SP2 = false>
__device__ __forceinline__ void gemm_phase(PG8_LAS unsigned char* lds, const Gemm g, const Sched& S, const Epi& E) {
    int tid_l = threadIdx.x; asm volatile("" : "+v"(tid_l));
    const int tid = tid_l, wid = __builtin_amdgcn_readfirstlane(tid >> 6), lane = tid & 63, wr = wid >> 2, wc = wid & 3, fr = lane & 15, fq = lane >> 4;
    const int K = g.K, nt = K / BK;
    unsigned voffA[2], voffB[2];
#pragma unroll
    for (int i = 0; i < 2; ++i) { int R, C; stage_rc(tid * 16 + i * 8192, R, C); const int Rb = Epi::PERM ? ((R & ~31) + perm32(R & 31)) : R;
        voffA[i] = (unsigned)(R * K + C) * 2u; voffB[i] = (unsigned)(Rb * K + C) * 2u; }
    const size_t kstep = (size_t)(BK * 2);
    const size_t hstep = (size_t)HALF * K * 2;
    const size_t tstep = 2 * hstep;
    const unsigned ldsw = (unsigned)wid * 1024u;
    const int aoff = lds_byte(wr * 64 + fr, fq * 8), boff = lds_byte(wc * 32 + fr, fq * 8);
#define PG8_SA(b, h) (((b) * 2 + (h)) * HTB)
#define PG8_SB(b, h) ((4 + (b) * 2 + (h)) * HTB)
#define PG8_STAGE(bufoff, gbase, voff) do { _Pragma("unroll") for (int _i = 0; _i < 2; ++_i) \
        __builtin_amdgcn_global_load_lds((const unsigned*)((const char*)(gbase) + (voff)[_i]), (PG8_LAS unsigned*)(lds + (bufoff) + ldsw + _i * 8192), 16, 0, 0); } while (0)
#define PG8_LDA(dst, b, h) do { _Pragma("unroll") for (int m = 0; m < 4; ++m) _Pragma("unroll") for (int k = 0; k < 2; ++k) dst[m][k] = *(const PG8_LAS bf16x8*)(lds + PG8_SA(b, h) + aoff + m * 2048 + k * 1024); } while (0)
#define PG8_LDB(dst, b, h) do { _Pragma("unroll") for (int n = 0; n < 2; ++n) _Pragma("unroll") for (int k = 0; k < 2; ++k) dst[n][k] = *(const PG8_LAS bf16x8*)(lds + PG8_SB(b, h) + boff + n * 2048 + k * 1024); } while (0)
#define PG8_MMA(ai, bj, At, Bt) do { __builtin_amdgcn_s_setprio(1); _Pragma("unroll") for (int m = 0; m < 4; ++m) _Pragma("unroll") for (int n = 0; n < 2; ++n) _Pragma("unroll") for (int k = 0; k < 2; ++k) \
        acc[ai][bj][m][n] = __builtin_amdgcn_mfma_f32_16x16x32_bf16(Bt[n][k], At[m][k], acc[ai][bj][m][n], 0, 0, 0); __builtin_amdgcn_s_setprio(0); } while (0)
#define PG8_WAIT_V(n) asm volatile("s_waitcnt vmcnt(" #n ")" ::: "memory")
#define PG8_WAIT_L(n) asm volatile("s_waitcnt lgkmcnt(" #n ")" ::: "memory")
#define PG8_BAR __builtin_amdgcn_s_barrier()
#define PG8_SCHED __builtin_amdgcn_sched_barrier(0)
    Unit cur, nxt; int ui = 0;
    if (!S.next(0, cur)) return;
    f32x4 acc[2][2][4][2];
#pragma unroll
    for (int a = 0; a < 2; ++a)
#pragma unroll
        for (int b = 0; b < 2; ++b)
#pragma unroll
            for (int m = 0; m < 4; ++m)
#pragma unroll
                for (int n = 0; n < 2; ++n) acc[a][b][m][n] = (f32x4){0.f, 0.f, 0.f, 0.f};
    bf16x8 At[4][2], B0[2][2], B1[2][2];
    const char* cA = (const char*)(cur.kind ? g.A2 : g.A) + (size_t)cur.pm * tstep; const char* cB = (const char*)(cur.kind ? g.Bt2 : g.Bt) + (size_t)cur.pn * tstep;
    S.a_ready(cur);
    if constexpr (SP2) {
        PG8_STAGE(PG8_SB(0, 0), cB, voffB); PG8_STAGE(PG8_SB(0, 1), cB + hstep, voffB); PG8_STAGE(PG8_SA(0, 0), cA, voffA); PG8_STAGE(PG8_SA(0, 1), cA + hstep, voffA);
        if (wr == 1) PG8_BAR;
        PG8_WAIT_V(2); PG8_BAR;
        PG8_STAGE(PG8_SB(1, 0), cB + kstep, voffB); PG8_STAGE(PG8_SA(1, 0), cA + kstep, voffA); PG8_STAGE(PG8_SB(1, 1), cB + hstep + kstep, voffB);
        PG8_WAIT_V(6); PG8_BAR;
    } else {
        PG8_STAGE(PG8_SB(0, 0), cB, voffB); PG8_STAGE(PG8_SA(0, 0), cA, voffA); PG8_STAGE(PG8_SB(0, 1), cB + hstep, voffB); PG8_STAGE(PG8_SA(0, 1), cA + hstep, voffA);
        if (wr == 1) PG8_BAR;
        PG8_WAIT_V(4); PG8_BAR;
        PG8_STAGE(PG8_SB(1, 0), cB + kstep, voffB); PG8_STAGE(PG8_SA(1, 0), cA + kstep, voffA); PG8_STAGE(PG8_SB(1, 1), cB + hstep + kstep, voffB);
        PG8_WAIT_V(6); PG8_BAR;
    }
    for (;;) {
        const bool has_next = S.next(ui + 1, nxt);
        const char* nA = has_next ? (const char*)(nxt.kind ? g.A2 : g.A) + (size_t)nxt.pm * tstep : cA; const char* nB = has_next ? (const char*)(nxt.kind ? g.Bt2 : g.Bt) + (size_t)nxt.pn * tstep : cB;
        for (int t = 0; t < nt; t += 2) {
            const bool last = (t == nt - 2);
            const char* a1 = cA + (size_t)(t + 1) * kstep;
            const char* a2 = last ? nA : cA + (size_t)(t + 2) * kstep; const char* b2 = last ? nB : cB + (size_t)(t + 2) * kstep;
            const char* a3 = a2 + kstep; const char* b3 = b2 + kstep;
            if (last && has_next) S.a_ready(nxt);
            if constexpr (SP2) {
            PG8_LDB(B0, 0, 0); PG8_LDB(B1, 0, 1); PG8_SCHED; PG8_LDA(At, 0, 0); PG8_STAGE(PG8_SA(1, 1), a1 + hstep, voffA);
            PG8_WAIT_V(8); PG8_WAIT_L(0); PG8_BAR; PG8_MMA(0, 0, At, B0); PG8_MMA(0, 1, At, B1); PG8_BAR; PG8_SCHED;
            PG8_LDA(At, 0, 1); PG8_STAGE(PG8_SB(0, 0), b2, voffB); PG8_STAGE(PG8_SB(0, 1), b2 + hstep, voffB); PG8_STAGE(PG8_SA(0, 0), a2, voffA);
            PG8_WAIT_V(8); PG8_WAIT_L(0); PG8_BAR; PG8_MMA(1, 0, At, B0); PG8_MMA(1, 1, At, B1); PG8_BAR; PG8_SCHED;
            PG8_LDB(B0, 1, 0); PG8_LDB(B1, 1, 1); PG8_SCHED; PG8_LDA(At, 1, 0); PG8_STAGE(PG8_SA(0, 1), a2 + hstep, voffA);
            PG8_WAIT_V(8); PG8_WAIT_L(0); PG8_BAR; PG8_MMA(0, 0, At, B0); PG8_MMA(0, 1, At, B1); PG8_BAR; PG8_SCHED;
            PG8_LDA(At, 1, 1); PG8_STAGE(PG8_SB(1, 0), b3, voffB); PG8_STAGE(PG8_SB(1, 1), b3 + hstep, voffB); PG8_STAGE(PG8_SA(1, 0), a3, voffA);
            PG8_WAIT_V(8); PG8_WAIT_L(0); PG8_BAR; PG8_MMA(1, 0, At, B0); PG8_MMA(1, 1, At, B1); PG8_BAR; PG8_SCHED;
            } else {
            PG8_LDB(B0, 0, 0); PG8_SCHED; PG8_LDA(At, 0, 0); PG8_STAGE(PG8_SA(1, 1), a1 + hstep, voffA);
            PG8_WAIT_L(8); PG8_BAR; PG8_WAIT_L(0); PG8_MMA(0, 0, At, B0); PG8_BAR; PG8_SCHED;
            PG8_LDB(B1, 0, 1); PG8_STAGE(PG8_SB(0, 0), b2, voffB);
            PG8_BAR; PG8_WAIT_L(0); PG8_MMA(0, 1, At, B1); PG8_BAR;
            PG8_LDA(At, 0, 1); PG8_STAGE(PG8_SA(0, 0), a2, voffA);
            PG8_BAR; PG8_WAIT_L(0); PG8_MMA(1, 0, At, B0); PG8_BAR; PG8_SCHED;
            PG8_STAGE(PG8_SB(0, 1), b2 + hstep, voffB);
            PG8_WAIT_V(6); PG8_BAR; PG8_MMA(1, 1, At, B1); PG8_BAR;
            PG8_LDB(B0, 1, 0); PG8_SCHED; PG8_LDA(At, 1, 0); PG8_STAGE(PG8_SA(0, 1), a2 + hstep, voffA);
            PG8_WAIT_L(8); PG8_BAR; PG8_WAIT_L(0); PG8_MMA(0, 0, At, B0); PG8_BAR; PG8_SCHED;
            PG8_LDB(B1, 1, 1); PG8_STAGE(PG8_SB(1, 0), b3, voffB);
            PG8_BAR; PG8_WAIT_L(0); PG8_MMA(0, 1, At, B1); PG8_BAR;
            PG8_LDA(At, 1, 1); PG8_STAGE(PG8_SA(1, 0), a3, voffA);
            PG8_BAR; PG8_WAIT_L(0); PG8_MMA(1, 0, At, B0); PG8_BAR; PG8_SCHED;
            PG8_STAGE(PG8_SB(1, 1), b3 + hstep, voffB);
            PG8_WAIT_V(6); PG8_BAR; PG8_MMA(1, 1, At, B1); PG8_BAR;
            }
        }
        if constexpr (ALIGN_EPI) { if (wr == 0) PG8_BAR; }
        if constexpr (!Epi::AFTER_DRAIN) { E(acc, cur, wr, wc, fr, fq); S.done(cur); }
        if (!has_next) break;
#pragma unroll
        for (int a = 0; a < 2; ++a)
#pragma unroll
            for (int b = 0; b < 2; ++b)
#pragma unroll
                for (int m = 0; m < 4; ++m)
#pragma unroll
                    for (int n = 0; n < 2; ++n) acc[a][b][m][n] = (f32x4){0.f, 0.f, 0.f, 0.f};
        cur = nxt; cA = nA; cB = nB; ++ui;
        if constexpr (ALIGN_EPI) { if (wr == 1) PG8_BAR; }
    }
    PG8_WAIT_V(0);
    if constexpr (!ALIGN_EPI) { if (wr == 0) PG8_BAR; }
    PG8_BAR;
    if constexpr (Epi::AFTER_DRAIN) { E.fused(acc, cur, wr, wc, fr, fq, lds, wid, lane); S.done(cur); }
#undef PG8_SA
#undef PG8_SB
#undef PG8_STAGE
#undef PG8_LDA
#undef PG8_LDB
#undef PG8_MMA
#undef PG8_WAIT_V
#undef PG8_WAIT_L
#undef PG8_BAR
#undef PG8_SCHED
}
}
namespace pg8 {
struct DualOrder {
    StaticOrder s1, s2; int G, c;
    __host__ __device__ void init(int M1, int N1, int M2, int N2, int G_, int c_) { s1.init(M1, N1, 1, 0); s2.init(M2, N2, 1, 0); G = G_; c = c_; }
    __host__ __device__ bool next(int i, Unit& u) const {
        const long L = (long)i * G + c; if (L >= s1.nwg + s2.nwg) return false;
        if (L < s1.nwg) { s1.next((int)L, u); u.kind = 0; } else { s2.next((int)(L - s1.nwg), u); u.kind = 1; }
        u.ui = i; return true;
    }
    __device__ __forceinline__ void a_ready(const Unit&) const {}
    __device__ __forceinline__ void done(const Unit&) const {}
};
__device__ __forceinline__ float row_rstd(const float* ss, int row) {
    const f32x4* p = (const f32x4*)(ss + (size_t)row * 16);
    const f32x4 a = p[0], b = p[1], c = p[2], d = p[3];
    const float s = (((a[0] + a[1]) + (a[2] + a[3])) + ((b[0] + b[1]) + (b[2] + b[3]))) + (((c[0] + c[1]) + (c[2] + c[3])) + ((d[0] + d[1]) + (d[2] + d[3])));
    return rsqrtf(s * (1.0f / 1024.0f) + 1e-6f);
}
__device__ __forceinline__ u32x4 pack8(f32x4 v0, f32x4 v1) { u32x4 w; w.x = cvt_pk_bf16(v0[0], v0[1]); w.y = cvt_pk_bf16(v0[2], v0[3]); w.z = cvt_pk_bf16(v1[0], v1[1]); w.w = cvt_pk_bf16(v1[2], v1[3]); return w; }

template <int ACT  > struct EpiBf {
    static constexpr bool PERM = true, AFTER_DRAIN = false;
    bf16_t* O; int ldc; const PG8_LAS float* rs; float mul;
    __device__ __forceinline__ void operator()(const f32x4 (&acc)[2][2][4][2], const Unit& u, int wr, int wc, int fr, int fq) const {
        const int row0 = u.pm * BM + wr * 64 + fr, col0 = u.pn * BM + wc * 32 + 8 * fq;
#pragma unroll
        for (int ai = 0; ai < 2; ++ai)
#pragma unroll
            for (int m = 0; m < 4; ++m) { const int row = row0 + ai * HALF + m * 16; const float sc = rs ? mul * rs[256 * u.ui + ai * HALF + wr * 64 + m * 16 + fr] : mul; bf16_t* rowp = O + (size_t)row * ldc + col0;
#pragma unroll
                for (int bj = 0; bj < 2; ++bj) { f32x4 v0 = acc[ai][bj][m][0] * sc, v1 = acc[ai][bj][m][1] * sc;
                    if (ACT == 1) {
#pragma unroll
                        for (int j = 0; j < 4; ++j) { const float a = fmaxf(v0[j], 0.f), b = fmaxf(v1[j], 0.f); v0[j] = a * a; v1[j] = b * b; } }
                    *(u32x4*)(rowp + bj * HALF) = pack8(v0, v1); } }
    }
};
struct EpiF32 {
    static constexpr bool PERM = true, AFTER_DRAIN = false;
    float* C; int ldc;
    __device__ __forceinline__ void operator()(const f32x4 (&acc)[2][2][4][2], const Unit& u, int wr, int wc, int fr, int fq) const {
        const int row0 = u.pm * BM + wr * 64 + fr, col0 = u.pn * BM + wc * 32 + 8 * fq;
#pragma unroll
        for (int ai = 0; ai < 2; ++ai)
#pragma unroll
            for (int m = 0; m < 4; ++m) { float* rowp = C + (size_t)(row0 + ai * HALF + m * 16) * ldc + col0;
#pragma unroll
                for (int bj = 0; bj < 2; ++bj) { *(f32x4*)(rowp + bj * HALF) = acc[ai][bj][m][0]; *(f32x4*)(rowp + bj * HALF + 4) = acc[ai][bj][m][1]; } }
    }
};
template <bool F32RES> struct EpiRes {
    static constexpr bool PERM = true, AFTER_DRAIN = false;
    bf16_t* xh; float* ssout; const float* r32;
    __device__ __forceinline__ void operator()(const f32x4 (&acc)[2][2][4][2], const Unit& u, int wr, int wc, int fr, int fq) const {
        const int row0 = u.pm * BM + wr * 64 + fr, col0 = u.pn * BM + wc * 32 + 8 * fq;
#pragma unroll
        for (int ai = 0; ai < 2; ++ai) {
            u32x4 pre[4][2]; f32x4 pf[4][2][2];
#pragma unroll
            for (int m = 0; m < 4; ++m)
#pragma unroll
                for (int bj = 0; bj < 2; ++bj) { const size_t off = (size_t)(row0 + ai * HALF + m * 16) * 1024 + col0 + bj * HALF;
                    if (F32RES) { pf[m][bj][0] = *(const f32x4*)(r32 + off); pf[m][bj][1] = *(const f32x4*)(r32 + off + 4); } else pre[m][bj] = *(const u32x4*)(xh + off); }
            asm volatile("" ::: "memory"); __builtin_amdgcn_sched_barrier(0);
#pragma unroll
            for (int m = 0; m < 4; ++m) { const int row = row0 + ai * HALF + m * 16; float q = 0.f;
#pragma unroll
                for (int bj = 0; bj < 2; ++bj) { const size_t off = (size_t)row * 1024 + col0 + bj * HALF; f32x4 r0, r1;
                    if (F32RES) { r0 = pf[m][bj][0]; r1 = pf[m][bj][1]; }
                    else { const u32x4 p = pre[m][bj];
                        r0 = (f32x4){__uint_as_float(p.x << 16), __uint_as_float(p.x & 0xffff0000u), __uint_as_float(p.y << 16), __uint_as_float(p.y & 0xffff0000u)};
                        r1 = (f32x4){__uint_as_float(p.z << 16), __uint_as_float(p.z & 0xffff0000u), __uint_as_float(p.w << 16), __uint_as_float(p.w & 0xffff0000u)}; }
                    const f32x4 v0 = acc[ai][bj][m][0] + r0, v1 = acc[ai][bj][m][1] + r1;
                    q += ((v0[0] * v0[0] + v0[1] * v0[1]) + (v0[2] * v0[2] + v0[3] * v0[3])) + ((v1[0] * v1[0] + v1[1] * v1[1]) + (v1[2] * v1[2] + v1[3] * v1[3]));
                    *(u32x4*)(xh + off) = pack8(v0, v1); }
                q += __shfl_xor(q, 16); q += __shfl_xor(q, 32);
                if (fq == 0) ssout[(size_t)row * 16 + u.pn * 4 + wc] = q; }
            asm volatile("" ::: "memory"); __builtin_amdgcn_sched_barrier(0); }
    }
};
struct EpiInA {
    static constexpr bool PERM = true, AFTER_DRAIN = false;
    bf16_t* z; float* ba; const PG8_LAS float* rs;
    __device__ __forceinline__ void operator()(const f32x4 (&acc)[2][2][4][2], const Unit& u, int wr, int wc, int fr, int fq) const {
        const int row0 = u.pm * BM + wr * 64 + fr, col0 = u.pn * BM + wc * 32 + 8 * fq;
#pragma unroll
        for (int ai = 0; ai < 2; ++ai)
#pragma unroll
            for (int m = 0; m < 4; ++m) { const int row = row0 + ai * HALF + m * 16; const float sc = rs[256 * u.ui + ai * HALF + wr * 64 + m * 16 + fr];
                if (u.pn < 10) { bf16_t* rowp = z + (size_t)row * 2560 + col0;
#pragma unroll
                    for (int bj = 0; bj < 2; ++bj) *(u32x4*)(rowp + bj * HALF) = pack8(acc[ai][bj][m][0] * sc, acc[ai][bj][m][1] * sc);
                } else if (wc == 0 && fq == 0) { *(f32x4*)(ba + (size_t)row * 8) = acc[ai][0][m][0] * sc; *(f32x4*)(ba + (size_t)row * 8 + 4) = acc[ai][0][m][1] * sc; } }
    }
};
struct EpiInC {
    static constexpr bool PERM = true, AFTER_DRAIN = false;
    bf16_t* q; bf16_t* kv; float* gates; const PG8_LAS float* rs;
    __device__ __forceinline__ void operator()(const f32x4 (&acc)[2][2][4][2], const Unit& u, int wr, int wc, int fr, int fq) const {
        const int row0 = u.pm * BM + wr * 64 + fr, col0 = u.pn * BM + wc * 32 + 8 * fq;
#pragma unroll
        for (int ai = 0; ai < 2; ++ai)
#pragma unroll
            for (int m = 0; m < 4; ++m) { const int row = row0 + ai * HALF + m * 16; const float sc = rs[256 * u.ui + ai * HALF + wr * 64 + m * 16 + fr];
                if (u.pn < 4) { bf16_t* rowp = q + (size_t)row * 1024 + col0; const float sq = sc * 0.18033688011112042f;
#pragma unroll
                    for (int bj = 0; bj < 2; ++bj) *(u32x4*)(rowp + bj * HALF) = pack8(acc[ai][bj][m][0] * sq, acc[ai][bj][m][1] * sq);
                } else if (u.pn < 10) { const int b = row >> 12, s = row & 4095;
#pragma unroll
                    for (int bj = 0; bj < 2; ++bj) { const int cp = col0 + bj * HALF - 1024, kind = cp >> 8, g = (cp >> 6) & 3, d = cp & 63;
                        *(u32x4*)(kv + (size_t)kind * ((size_t)32768 * 256) + ((size_t)((b * 4 + g) * 4096 + s)) * 64 + d) = pack8(acc[ai][bj][m][0] * sc, acc[ai][bj][m][1] * sc); }
                } else { const int cl = wc * 32 + 8 * fq; if (cl < 48) { *(f32x4*)(gates + (size_t)row * 48 + cl) = acc[ai][0][m][0] * sc; *(f32x4*)(gates + (size_t)row * 48 + cl + 4) = acc[ai][0][m][1] * sc; } } }
    }
};
template <class E0, class E1> struct EpiDual {
    static constexpr bool PERM = true, AFTER_DRAIN = false;
    E0 e0; E1 e1;
    __device__ __forceinline__ void operator()(const f32x4 (&acc)[2][2][4][2], const Unit& u, int wr, int wc, int fr, int fq) const { if (u.kind) e1(acc, u, wr, wc, fr, fq); else e0(acc, u, wr, wc, fr, fq); }
};
}
#define LAS __attribute__((address_space(3)))
typedef unsigned short bf16;
typedef float f32x4 __attribute__((ext_vector_type(4)));
typedef unsigned v4u __attribute__((ext_vector_type(4)));
typedef unsigned v2u __attribute__((ext_vector_type(2)));
typedef short bf16x8 __attribute__((ext_vector_type(8)));
typedef float f32x16 __attribute__((ext_vector_type(16)));
typedef short v4i16 __attribute__((ext_vector_type(4)));
typedef float f32x2_t __attribute__((ext_vector_type(2))); typedef __bf16 bf16x2_t __attribute__((ext_vector_type(2)));
__device__ __forceinline__ unsigned cvtpk(float lo, float hi) { f32x2_t v = {lo, hi}; bf16x2_t b = __builtin_convertvector(v, bf16x2_t); return __builtin_bit_cast(unsigned, b); }

constexpr int NWAVES = 8, NTHR = 512;
constexpr int T = 32768, SEQ = 4096, DM = 1024, FF = 4096;
constexpr int LDS_BYTES = 147456;
constexpr float EPS = 1e-6f;

enum { I_X = 0, I_MEM, I_A_LN, I_A_WIN, I_A_POOLW, I_A_POOLS, I_A_CONV, I_A_ALOG, I_A_DTB, I_A_ONORM, I_A_WOUT,
       I_C_LN, I_C_WIN, I_C_PEK, I_C_W1K, I_C_W2K, I_C_PEV, I_C_W1V, I_C_W2V, I_C_WOUT,
       I_XA_LN, I_XA_MLN, I_XA_WQ, I_XA_WK, I_XA_WV, I_XA_WO, I_FF_LN, I_FF_W1, I_FF_W2, I_FLN, N_IN };

constexpr size_t MiB = (size_t)1 << 20;
constexpr size_t WS_AIN = 0, WS_AOUT = 6 * MiB, WS_CIN = 8 * MiB, WS_COUT = 14 * MiB, WS_XQ = 16 * MiB, WS_XKV = 20 * MiB, WS_XO = 28 * MiB;
constexpr size_t WS_F1 = 32 * MiB, WS_F2 = 48 * MiB, WS_CMPK = 64 * MiB, WS_CMPV = 64 * MiB + 512 * 1024, WS_CBIAS = 65 * MiB;
constexpr size_t WS_MEMH = 66 * MiB, WS_MEMKV = 74 * MiB, WS_SS = 90 * MiB, WS_BA = 92 * MiB, WS_GATES = 93 * MiB, WS_CK = 99 * MiB, WS_CV = 100 * MiB;
constexpr size_t WS_P01K = 101 * MiB, WS_P01V = 109 * MiB, WS_POOLW = 117 * MiB;
constexpr size_t WS_Z = 120 * MiB, WS_Y = 280 * MiB, WS_QXA = 344 * MiB, WS_XH = 408 * MiB, WS_HMID = 120 * MiB, WS_END = 490 * MiB;
constexpr size_t KV_KIND = (size_t)T * 256;

struct Params { const float* in[N_IN]; float* out; unsigned char* ws; int ph_lo, ph_hi; };

__device__ __forceinline__ float bf2f(unsigned v) { return __uint_as_float(v << 16); }
__device__ __forceinline__ unsigned f2bf(float f) { unsigned u = __float_as_uint(f); return (u + 0x7fffu + ((u >> 16) & 1u)) >> 16; }
__device__ __forceinline__ unsigned pk2(float lo, float hi) { return f2bf(lo) | (f2bf(hi) << 16); }
__device__ __forceinline__ float wave_sum(float v) {
#pragma unroll
    for (int o = 1; o < 64; o <<= 1) v += __shfl_xor(v, o);
    return v;
}
__device__ __forceinline__ float wave_max(float v) {
#pragma unroll
    for (int o = 1; o < 64; o <<= 1) v = fmaxf(v, __shfl_xor(v, o));
    return v;
}
__device__ __forceinline__ float silu_f(float x) { return x / (1.f + __expf(-x)); }
__device__ __forceinline__ float sigmoid_f(float x) { return 1.f / (1.f + __expf(-x)); }
#define LDS_WAIT() asm volatile("s_waitcnt lgkmcnt(0)" ::: "memory")

__device__ __forceinline__ void transpose_item(const float* W, int K, int N, int ld, const float* gain, bf16* WT, int row_off, LAS float* scr, int item, int lane) {
    const int nblk = N / 32, kb = item / nblk, nb = item % nblk, k0 = 64 * kb, n0 = 32 * nb;
#pragma unroll
    for (int i = 0; i < 8; ++i) { const int kk = 8 * i + (lane >> 3), nn = (lane & 7) * 4; f32x4 v = *(const f32x4*)(W + (size_t)(k0 + kk) * ld + n0 + nn); if (gain) v = v * gain[k0 + kk];
        scr[kk * 33 + nn] = v.x; scr[kk * 33 + nn + 1] = v.y; scr[kk * 33 + nn + 2] = v.z; scr[kk * 33 + nn + 3] = v.w; }
    LDS_WAIT();
    const int c = lane & 7;
#pragma unroll
    for (int j = 0; j < 4; ++j) { const int n = (lane >> 3) + 8 * j; const LAS float* s = scr + (8 * c) * 33 + n;
        v4u o; o.x = pk2(s[0 * 33], s[1 * 33]); o.y = pk2(s[2 * 33], s[3 * 33]); o.z = pk2(s[4 * 33], s[5 * 33]); o.w = pk2(s[6 * 33], s[7 * 33]);
        *(v4u*)(WT + (size_t)(row_off + n0 + n) * K + k0 + 8 * c) = o; }
    LDS_WAIT();
}
#define TJOB(W_, K_, N_, LD_, G_, WT_, RO_) { const int ni_ = ((K_) / 64) * ((N_) / 32); if (r < ni_) { transpose_item((W_), (K_), (N_), (LD_), (G_), (WT_), (RO_), scr, r, lane); continue; } r -= ni_; }

__device__ __forceinline__ void phase_prologue(const Params& P, LAS unsigned char* lds) {
    int tid_l = threadIdx.x; asm volatile("" : "+v"(tid_l)); const int tid = tid_l, lane = tid & 63, wave = tid >> 6;
    constexpr int NSMALL = 32; const bool small_role = (int)blockIdx.x >= (int)gridDim.x - NSMALL;
    const int gw = small_role ? 0x40000000 : (int)blockIdx.x * NWAVES + wave, NGW = ((int)gridDim.x - NSMALL) * NWAVES;
    unsigned char* ws = P.ws;
    LAS float* scr = (LAS float*)(lds + wave * 16384);
    constexpr int NITEMS = 1280 + 512 + 1280 + 512 + 4 * 512 + 512 + 2048 + 2048 + 4 * 64;
    for (int it = gw; it < NITEMS; it += NGW) {
        int r = it;
        TJOB(P.in[I_A_WIN], 1024, 2560, 2568, P.in[I_A_LN], (bf16*)(ws + WS_AIN), 0)
        TJOB(P.in[I_A_WOUT], 1024, 1024, 1024, nullptr, (bf16*)(ws + WS_AOUT), 0)
        TJOB(P.in[I_C_WIN], 1024, 2560, 2608, P.in[I_C_LN], (bf16*)(ws + WS_CIN), 0)
        TJOB(P.in[I_XA_WQ], 1024, 1024, 1024, P.in[I_XA_LN], (bf16*)(ws + WS_XQ), 0)
        TJOB(P.in[I_XA_WK], 1024, 1024, 1024, P.in[I_XA_MLN], (bf16*)(ws + WS_XKV), 0)
        TJOB(P.in[I_XA_WV], 1024, 1024, 1024, P.in[I_XA_MLN], (bf16*)(ws + WS_XKV), 1024)
        TJOB(P.in[I_XA_WK] + 1048576, 1024, 1024, 1024, P.in[I_XA_MLN] + 1024, (bf16*)(ws + WS_XKV) + 2097152, 0)
        TJOB(P.in[I_XA_WV] + 1048576, 1024, 1024, 1024, P.in[I_XA_MLN] + 1024, (bf16*)(ws + WS_XKV) + 2097152, 1024)
        TJOB(P.in[I_XA_WO], 1024, 1024, 1024, nullptr, (bf16*)(ws + WS_XO), 0)
        TJOB(P.in[I_FF_W1], 1024, 4096, 4096, P.in[I_FF_LN], (bf16*)(ws + WS_F1), 0)
        TJOB(P.in[I_FF_W2], 4096, 1024, 1024, nullptr, (bf16*)(ws + WS_F2), 0)
        TJOB(P.in[I_C_W1K], 1024, 128, 128, nullptr, (bf16*)(ws + WS_CMPK), 0)
        TJOB(P.in[I_C_W1K] + 131072, 1024, 128, 128, nullptr, (bf16*)(ws + WS_CMPK), 128)
        TJOB(P.in[I_C_W1V], 1024, 128, 128, nullptr, (bf16*)(ws + WS_CMPV), 0)
        TJOB(P.in[I_C_W1V] + 131072, 1024, 128, 128, nullptr, (bf16*)(ws + WS_CMPV), 128)
    }
    const int gt = small_role ? ((int)blockIdx.x - ((int)gridDim.x - NSMALL)) * NTHR + tid : 0x40000000, NGT = NSMALL * NTHR; const int gws = gt >> 6;
    for (int i = gt; i < 56 * 1024; i += NGT) { const int j = i >> 10, kk = i & 1023;
        if (j < 8) ((bf16*)(ws + WS_AIN))[(size_t)(2560 + j) * 1024 + kk] = (bf16)f2bf(P.in[I_A_LN][kk] * P.in[I_A_WIN][(size_t)kk * 2568 + 2560 + j]);
        else ((bf16*)(ws + WS_CIN))[(size_t)(2560 + j - 8) * 1024 + kk] = (bf16)f2bf(P.in[I_C_LN][kk] * P.in[I_C_WIN][(size_t)kk * 2608 + 2560 + j - 8]); }
    for (int i = gt; i < (248 + 208) * 128; i += NGT) { const int row = i >> 7, pc = i & 127; const v4u z4 = {0u, 0u, 0u, 0u};
        if (row < 248) *(v4u*)((bf16*)(ws + WS_AIN) + (size_t)(2568 + row) * 1024 + pc * 8) = z4; else *(v4u*)((bf16*)(ws + WS_CIN) + (size_t)(2608 + row - 248) * 1024 + pc * 8) = z4; }
    for (int i = gt; i < 4 * 128 * 128; i += NGT) { const int g = i >> 14, d = (i >> 7) & 127, c = i & 127; ((bf16*)(ws + WS_POOLW))[i] = (bf16)f2bf(P.in[I_A_POOLW][(size_t)g * 16384 + c * 128 + d] * P.in[I_A_POOLS][g * 128 + d]); }
    if (gws < 256) { const int n = gws & 127; const float* pe = gws < 128 ? P.in[I_C_PEK] : P.in[I_C_PEV]; const float* w1 = gws < 128 ? P.in[I_C_W1K] : P.in[I_C_W1V];
        float s = 0.f;
#pragma unroll 8
        for (int j = 0; j < 32; ++j) { const int i = lane + 64 * j; s += pe[i] * w1[(size_t)i * 128 + n]; }
        s = wave_sum(s); if (lane == 0) ((float*)(ws + WS_CBIAS))[gws] = s; }
    { bf16* xh = (bf16*)(ws + WS_XH); float* ss = (float*)(ws + WS_SS);
      for (int m0 = gw; m0 < T; m0 += 4 * NGW) { f32x4 v[4][4];
#pragma unroll
          for (int u = 0; u < 4; ++u) { const int m = m0 + u * NGW; if (m < T) { const f32x4* xr = (const f32x4*)(P.in[I_X] + (size_t)m * DM) + lane;
#pragma unroll
                  for (int j = 0; j < 4; ++j) v[u][j] = xr[64 * j]; } }
#pragma unroll
          for (int u = 0; u < 4; ++u) { const int m = m0 + u * NGW; if (m >= T) break; float s = 0.f;
#pragma unroll
              for (int j = 0; j < 4; ++j) s += (v[u][j].x * v[u][j].x + v[u][j].y * v[u][j].y) + (v[u][j].z * v[u][j].z + v[u][j].w * v[u][j].w);
              s = wave_sum(s);
              v2u* o8 = (v2u*)(xh + (size_t)m * DM) + lane;
#pragma unroll
              for (int j = 0; j < 4; ++j) { v2u w; w.x = pk2(v[u][j].x, v[u][j].y); w.y = pk2(v[u][j].z, v[u][j].w); o8[64 * j] = w; }
              if (lane < 16) ss[(size_t)m * 16 + lane] = lane == 0 ? s : 0.f; } } }
    { bf16* mh = (bf16*)(ws + WS_MEMH);
      for (int m = gw; m < 2048; m += NGW) { const f32x4* xr = (const f32x4*)(P.in[I_MEM] + (size_t)m * DM) + lane; f32x4 v[4]; float s = 0.f;
#pragma unroll
          for (int j = 0; j < 4; ++j) { v[j] = xr[64 * j]; s += (v[j].x * v[j].x + v[j].y * v[j].y) + (v[j].z * v[j].z + v[j].w * v[j].w); }
          const float rs = rsqrtf(wave_sum(s) * (1.f / DM) + EPS);
          v2u* o8 = (v2u*)(mh + (size_t)m * DM) + lane;
#pragma unroll
          for (int j = 0; j < 4; ++j) { v2u w; w.x = pk2(v[j].x * rs, v[j].y * rs); w.y = pk2(v[j].z * rs, v[j].w * rs); o8[64 * j] = w; } } }
}

__device__ __forceinline__ void phase_conv_late(const Params& P, LAS unsigned char* lds, int gw, int NGW) {
    const int tid = threadIdx.x, lane = tid & 63, wave = tid >> 6; unsigned char* ws = P.ws;
    LAS float* scr = (LAS float*)(lds + wave * 16384);
    constexpr int NITEMS = 512 + 512 + 512 + 2048 + 2048;
    for (int it = gw; it < NITEMS; it += NGW) {
        int r = it;
        TJOB(P.in[I_C_WOUT], 1024, 1024, 1024, nullptr, (bf16*)(ws + WS_COUT), 0)
        TJOB(P.in[I_XA_WQ] + 1048576, 1024, 1024, 1024, P.in[I_XA_LN] + 1024, (bf16*)(ws + WS_XQ) + 1048576, 0)
        TJOB(P.in[I_XA_WO] + 1048576, 1024, 1024, 1024, nullptr, (bf16*)(ws + WS_XO) + 1048576, 0)
        TJOB(P.in[I_FF_W1] + 4194304, 1024, 4096, 4096, P.in[I_FF_LN] + 1024, (bf16*)(ws + WS_F1) + 4194304, 0)
        TJOB(P.in[I_FF_W2] + 4194304, 4096, 1024, 1024, nullptr, (bf16*)(ws + WS_F2) + 4194304, 0)
    }
}
__device__ __forceinline__ void phase_gates(const Params& P, LAS unsigned char* lds, int gw, int NGW) {
    const int tid = threadIdx.x, lane = tid & 63; unsigned char* ws = P.ws;
    const bf16* wg = (const bf16*)(ws + WS_CIN) + (size_t)2560 * 1024; const bf16* xh = (const bf16*)(ws + WS_XH); const float* ss = (const float*)(ws + WS_SS); float* gates = (float*)(ws + WS_GATES);
    for (int p = tid; p < 48 * 128; p += NTHR) *(LAS v4u*)(lds + p * 16) = *(const v4u*)(wg + (size_t)p * 8);
    __syncthreads();
    for (int rg = gw; rg < T / 16; rg += NGW) { const int t0 = rg * 16;
        f32x4 acc[3] = {{0.f, 0.f, 0.f, 0.f}, {0.f, 0.f, 0.f, 0.f}, {0.f, 0.f, 0.f, 0.f}};
        const bf16* ap = xh + (size_t)(t0 + (lane & 15)) * DM + 8 * (lane >> 4); LAS const unsigned char* bp = lds + (lane & 15) * 2048 + (lane >> 4) * 16;
#pragma unroll 4
        for (int ks = 0; ks < 32; ++ks) { const bf16x8 a = *(const bf16x8*)(ap + 32 * ks);
#pragma unroll
            for (int ct = 0; ct < 3; ++ct) acc[ct] = __builtin_amdgcn_mfma_f32_16x16x32_bf16(a, *(const LAS bf16x8*)(bp + ct * 32768 + ks * 64), acc[ct], 0, 0, 0); }
#pragma unroll
        for (int r = 0; r < 4; ++r) { const int t = t0 + 4 * (lane >> 4) + r; const float rs = pg8::row_rstd(ss, t);
#pragma unroll
            for (int ct = 0; ct < 3; ++ct) gates[(size_t)t * 48 + ct * 16 + (lane & 15)] = acc[ct][r] * rs; } }
    __syncthreads();
}
__device__ __forceinline__ void phase_final(const Params& P) {
    const int tid = threadIdx.x, lane = tid & 63, wave = tid >> 6;
    const int gw = blockIdx.x * NWAVES + wave, NGW = gridDim.x * NWAVES;
    const float* ss = (const float*)(P.ws + WS_SS); const bf16* xh = (const bf16*)(P.ws + WS_XH);
    for (int m = gw; m < T; m += NGW) { f32x4* orow = (f32x4*)(P.out + (size_t)m * DM); const f32x4* gr = (const f32x4*)P.in[I_FLN];
        const float rs = pg8::row_rstd(ss, m);
#pragma unroll
        for (int j = 0; j < 2; ++j) { const v4u p = *(const v4u*)(xh + (size_t)m * DM + (j * 64 + lane) * 8); const f32x4 g0 = gr[(j * 64 + lane) * 2], g1 = gr[(j * 64 + lane) * 2 + 1];
            orow[(j * 64 + lane) * 2] = (f32x4){bf2f(p.x & 0xffff) * rs * g0.x, bf2f(p.x >> 16) * rs * g0.y, bf2f(p.y & 0xffff) * rs * g0.z, bf2f(p.y >> 16) * rs * g0.w};
            orow[(j * 64 + lane) * 2 + 1] = (f32x4){bf2f(p.z & 0xffff) * rs * g1.x, bf2f(p.z >> 16) * rs * g1.y, bf2f(p.w & 0xffff) * rs * g1.z, bf2f(p.w >> 16) * rs * g1.w}; } }
}
__device__ __forceinline__ void phase_pool(const Params& P, LAS unsigned char* lds) {
    int tid_l = threadIdx.x; asm volatile("" : "+v"(tid_l)); const int tid = tid_l, lane = tid & 63, wave = tid >> 6; const int g = blockIdx.x & 3, win = 2 << g;
    const bf16* z = (const bf16*)(P.ws + WS_Z); bf16* y = (bf16*)(P.ws + WS_Y);
    LAS unsigned short* ur = (LAS unsigned short*)lds;
    LAS unsigned char* yp = lds + 20480;
    const int nt = wave & 3, mt = wave >> 2, q = lane & 31, h = lane >> 5;
    bf16x8 bfr[8];
    { const bf16* bt = (const bf16*)(P.ws + WS_POOLW) + (size_t)g * 16384 + (size_t)(nt * 32 + q) * 128 + 8 * h;
#pragma unroll
      for (int ks = 0; ks < 8; ++ks) bfr[ks] = *(const bf16x8*)(bt + 16 * ks); }
    v4u pre[3];
#define POOL_LOAD(it_) { const int t0_ = ((it_) >> 2) * 64, s0_ = t0_ & (SEQ - 1); _Pragma("unroll") for (int j = 0; j < 3; ++j) { const int p = tid + 512 * j, row = p >> 4, pc = p & 15; pre[j] = (v4u){0u, 0u, 0u, 0u}; \
        if (p < 79 * 16 && s0_ + row - 15 >= 0) pre[j] = *(const v4u*)(z + (size_t)(t0_ + row - 15) * 2560 + g * 128 + pc * 8); } }
    int it = blockIdx.x; if (it < 2048) POOL_LOAD(it)
    for (; it < 2048; it += gridDim.x) { const int t0 = (it >> 2) * 64, s0 = t0 & (SEQ - 1);
#pragma unroll
        for (int j = 0; j < 3; ++j) { const int p = tid + 512 * j; if (p < 79 * 16) *(LAS v4u*)(lds + (p >> 4) * 256 + (p & 15) * 16) = pre[j]; }
        __syncthreads();
        if (it + (int)gridDim.x < 2048) POOL_LOAD(it + (int)gridDim.x)
        { const int c = tid & 127, tq = tid >> 7; float sum = 0.f;
          for (int j = 1; j < win; ++j) sum += bf2f(ur[(tq * 16 + 15 - j) * 128 + c]);
#pragma unroll 4
          for (int i = 0; i < 16; ++i) { const int tl = tq * 16 + i, s = s0 + tl; const float u = bf2f(ur[(tl + 15) * 128 + c]); sum += u;
              const float cnt = (float)((s + 1 < win) ? s + 1 : win);
              *(LAS unsigned short*)(yp + tl * 272 + c * 2) = (unsigned short)f2bf(sum / cnt - u);
              sum -= bf2f(ur[(tl + 16 - win) * 128 + c]); } }
        __syncthreads();
        { f32x16 acc;
#pragma unroll
          for (int r = 0; r < 16; ++r) acc[r] = 0.f;
          LAS const unsigned char* ap = yp + (mt * 32 + q) * 272 + h * 16;
#pragma unroll
          for (int ks = 0; ks < 8; ++ks) acc = __builtin_amdgcn_mfma_f32_32x32x16_bf16(bfr[ks], *(const LAS bf16x8*)(ap + ks * 32), acc, 0, 0, 0);
          bf16* yo = y + (size_t)(t0 + mt * 32 + q) * DM + g * 128 + nt * 32 + 4 * h;
#pragma unroll
          for (int a = 0; a < 4; ++a) { v2u w; w.x = cvtpk(acc[4 * a], acc[4 * a + 1]); w.y = cvtpk(acc[4 * a + 2], acc[4 * a + 3]); *(v2u*)(yo + 8 * a) = w; } }
    }
#undef POOL_LOAD
    __syncthreads();
}
__device__ __forceinline__ void dn_naive_item(const Params& P, LAS unsigned char* lds, int item) {
    int tid_l = threadIdx.x; asm volatile("" : "+v"(tid_l)); const int tid = tid_l, lane = tid & 63, wave = tid >> 6; const int b = item >> 2, h = item & 3;
    const bf16* z = (const bf16*)(P.ws + WS_Z); bf16* y = (bf16*)(P.ws + WS_Y); const float* ba = (const float*)(P.ws + WS_BA);
    LAS float* qs = (LAS float*)lds; LAS float* ks = qs + 8192; LAS float* vs = ks + 8192; LAS float* ot = vs + 8192; LAS float* bet = ot + 8192; LAS float* egs = bet + 64;
    const float* cw = P.in[I_A_CONV];
    const float a_exp = __expf(P.in[I_A_ALOG][h]), dtb = P.in[I_A_DTB][h];
    float Sreg[32];
#pragma unroll
    for (int i = 0; i < 32; ++i) Sreg[i] = 0.f;
    const int kq = tid & 3, dv = tid >> 2;
    for (int n = 0; n < 64; ++n) {
        const int sb = n * 64; const size_t rb = (size_t)b * SEQ;
        for (int idx = tid; idx < 64 * 384; idx += NTHR) { const int tl = idx / 384, cc = idx % 384, part = cc >> 7, d = cc & 127; const int ch = part * 512 + h * 128 + d, s = sb + tl; float a = 0.f;
#pragma unroll
            for (int kk = 0; kk < 4; ++kk) { const int sp = s - 3 + kk; if (sp >= 0) a += cw[kk * 1536 + ch] * bf2f(z[(rb + sp) * 2560 + 512 + ch]); }
            qs[part * 8192 + tl * 128 + d] = silu_f(a); }
        if (tid < 64) { const size_t t = rb + sb + tid; const float bl = ba[t * 8 + h], al = ba[t * 8 + 4 + h] + dtb; const float sp = al > 20.f ? al : log1pf(__expf(al));
            bet[tid] = sigmoid_f(bl); egs[tid] = __expf(-a_exp * sp); }
        __syncthreads();
        for (int r = wave * 16; r < wave * 16 + 16; ++r) { LAS float* row = qs + (r >> 6) * 8192 + (r & 63) * 128; const float a = row[lane], c2 = row[lane + 64];
            const float sc = rsqrtf(wave_sum(a * a + c2 * c2) + EPS); row[lane] = a * sc; row[lane + 64] = c2 * sc; }
        __syncthreads();
        for (int tl = 0; tl < 64; ++tl) {
            float kr[32], kS = 0.f;
#pragma unroll
            for (int i = 0; i < 8; ++i) { const f32x4 v = *(const LAS f32x4*)(ks + tl * 128 + kq * 32 + 4 * i); kr[4 * i] = v.x; kr[4 * i + 1] = v.y; kr[4 * i + 2] = v.z; kr[4 * i + 3] = v.w; }
#pragma unroll
            for (int i = 0; i < 32; ++i) kS += kr[i] * Sreg[i];
            kS += __shfl_xor(kS, 1); kS += __shfl_xor(kS, 2);
            const float e = egs[tl], cf = bet[tl] * (vs[tl * 128 + dv] - e * kS);
            float o = 0.f;
#pragma unroll
            for (int i = 0; i < 8; ++i) { const f32x4 qv = *(const LAS f32x4*)(qs + tl * 128 + kq * 32 + 4 * i);
                Sreg[4 * i] = e * Sreg[4 * i] + kr[4 * i] * cf; Sreg[4 * i + 1] = e * Sreg[4 * i + 1] + kr[4 * i + 1] * cf; Sreg[4 * i + 2] = e * Sreg[4 * i + 2] + kr[4 * i + 2] * cf; Sreg[4 * i + 3] = e * Sreg[4 * i + 3] + kr[4 * i + 3] * cf;
                o += (qv.x * Sreg[4 * i] + qv.y * Sreg[4 * i + 1]) + (qv.z * Sreg[4 * i + 2] + qv.w * Sreg[4 * i + 3]); }
            o += __shfl_xor(o, 1); o += __shfl_xor(o, 2);
            if (kq == 0) ot[tl * 128 + dv] = o * 0.08838834764831845f;
        }
        __syncthreads();
        for (int tl = wave * 8; tl < wave * 8 + 8; ++tl) { const float a = ot[tl * 128 + lane], c2 = ot[tl * 128 + lane + 64]; const float rs = rsqrtf(wave_sum(a * a + c2 * c2) * (1.f / 128.f) + EPS);
            const size_t t = rb + sb + tl; const float g0 = bf2f(z[t * 2560 + 2048 + h * 128 + lane]), g1 = bf2f(z[t * 2560 + 2048 + h * 128 + lane + 64]);
            y[t * DM + 512 + h * 128 + lane] = (bf16)f2bf(a * rs * P.in[I_A_ONORM][lane] * silu_f(g0));
            y[t * DM + 512 + h * 128 + lane + 64] = (bf16)f2bf(c2 * rs * P.in[I_A_ONORM][lane + 64] * silu_f(g1)); }
        __syncthreads();
    }
}

__device__ __forceinline__ void phase_xatt_naive(const Params& P, LAS unsigned char* lds, int l) {
    int tid_l = threadIdx.x; asm volatile("" : "+v"(tid_l)); const int tid = tid_l, lane = tid & 63, wave = tid >> 6;
    const int gw = blockIdx.x * NWAVES + wave, NGW = gridDim.x * NWAVES;
    const bf16* qx = (const bf16*)(P.ws + WS_QXA); const bf16* kv = (const bf16*)(P.ws + WS_MEMKV) + (size_t)l * 2048 * 2048; bf16* y = (bf16*)(P.ws + WS_Y);
    LAS float* qf = (LAS float*)(lds + wave * 8192); LAS float* pw = qf + 1024;
    for (int t = gw; t < T; t += NGW) { const int b = t >> 12;
        { const v4u a = *(const v4u*)(qx + (size_t)t * DM + lane * 16), c = *(const v4u*)(qx + (size_t)t * DM + lane * 16 + 8); LAS float* d = qf + lane * 16;
          d[0] = bf2f(a.x & 0xffff); d[1] = bf2f(a.x >> 16); d[2] = bf2f(a.y & 0xffff); d[3] = bf2f(a.y >> 16); d[4] = bf2f(a.z & 0xffff); d[5] = bf2f(a.z >> 16); d[6] = bf2f(a.w & 0xffff); d[7] = bf2f(a.w >> 16);
          d[8] = bf2f(c.x & 0xffff); d[9] = bf2f(c.x >> 16); d[10] = bf2f(c.y & 0xffff); d[11] = bf2f(c.y >> 16); d[12] = bf2f(c.z & 0xffff); d[13] = bf2f(c.z >> 16); d[14] = bf2f(c.w & 0xffff); d[15] = bf2f(c.w >> 16); }
        LDS_WAIT();
        for (int hh = 0; hh < 4; ++hh) { float sc[4];
#pragma unroll
            for (int i = 0; i < 4; ++i) { const bf16* kr = kv + (size_t)(b * 256 + lane + 64 * i) * 2048 + hh * 256; float s = 0.f;
                for (int c8 = 0; c8 < 32; ++c8) { const v4u kk = *(const v4u*)(kr + c8 * 8); const f32x4 q0 = *(const LAS f32x4*)(qf + hh * 256 + c8 * 8), q1 = *(const LAS f32x4*)(qf + hh * 256 + c8 * 8 + 4);
                    s += (q0.x * bf2f(kk.x & 0xffff) + q0.y * bf2f(kk.x >> 16)) + (q0.z * bf2f(kk.y & 0xffff) + q0.w * bf2f(kk.y >> 16)) + (q1.x * bf2f(kk.z & 0xffff) + q1.y * bf2f(kk.z >> 16)) + (q1.z * bf2f(kk.w & 0xffff) + q1.w * bf2f(kk.w >> 16)); }
                sc[i] = s * 0.0625f; }
            const float mx = wave_max(fmaxf(fmaxf(sc[0], sc[1]), fmaxf(sc[2], sc[3])));
            float ps = 0.f;
#pragma unroll
            for (int i = 0; i < 4; ++i) { sc[i] = __expf(sc[i] - mx); ps += sc[i]; }
            const float inv = 1.f / wave_sum(ps);
#pragma unroll
            for (int i = 0; i < 4; ++i) pw[lane + 64 * i] = sc[i] * inv;
            LDS_WAIT();
            float o0 = 0.f, o1 = 0.f, o2 = 0.f, o3 = 0.f; const bf16* vb = kv + (size_t)(b * 256) * 2048 + 1024 + hh * 256 + lane * 4;
            for (int j = 0; j < 256; ++j) { const v2u vv = *(const v2u*)(vb + (size_t)j * 2048); const float p = pw[j];
                o0 += p * bf2f(vv.x & 0xffff); o1 += p * bf2f(vv.x >> 16); o2 += p * bf2f(vv.y & 0xffff); o3 += p * bf2f(vv.y >> 16); }
            v2u w; w.x = pk2(o0, o1); w.y = pk2(o2, o3); *(v2u*)(y + (size_t)t * DM + hh * 256 + lane * 4) = w;
            LDS_WAIT();
        }
    }
}

__device__ __forceinline__ void cmpfin_bg(const Params& P, LAS unsigned char* lds, int kvs, int bg) {
    const int tid = threadIdx.x, lane = tid & 63, wave = tid >> 6, q = lane & 31, h = lane >> 5;
    const float* p01 = (const float*)(P.ws + (kvs ? WS_P01V : WS_P01K)) + (size_t)bg * 256 * 256; const float* bias = (const float*)(P.ws + WS_CBIAS) + kvs * 128; const float* w2 = P.in[kvs ? I_C_W2V : I_C_W2K];
    bf16* outp = (bf16*)(P.ws + (kvs ? WS_CV : WS_CK)) + (size_t)bg * 256 * 64;
    LAS unsigned char* Hb = lds;
    LAS unsigned char* Wt = lds + 69632;
    for (int p = tid; p < 256 * 16; p += NTHR) { const int c = p >> 4, j0 = (p & 15) * 8; v4u w = {0u, 0u, 0u, 0u};
        if (c < 255) { const f32x4 a0 = *(const f32x4*)(p01 + (size_t)c * 256 + j0), a1 = *(const f32x4*)(p01 + (size_t)c * 256 + j0 + 4), b0 = *(const f32x4*)(p01 + (size_t)(c + 1) * 256 + 128 + j0), b1 = *(const f32x4*)(p01 + (size_t)(c + 1) * 256 + 128 + j0 + 4);
            const f32x4 c0 = *(const f32x4*)(bias + j0), c1 = *(const f32x4*)(bias + j0 + 4);
            w.x = cvtpk(silu_f(a0.x + b0.x + c0.x), silu_f(a0.y + b0.y + c0.y)); w.y = cvtpk(silu_f(a0.z + b0.z + c0.z), silu_f(a0.w + b0.w + c0.w));
            w.z = cvtpk(silu_f(a1.x + b1.x + c1.x), silu_f(a1.y + b1.y + c1.y)); w.w = cvtpk(silu_f(a1.z + b1.z + c1.z), silu_f(a1.w + b1.w + c1.w)); }
        *(LAS v4u*)(Hb + c * 272 + j0 * 2) = w; }
    for (int p = tid; p < 128 * 64; p += NTHR) { const int j = p >> 6, d = p & 63; *(LAS unsigned short*)(Wt + d * 272 + j * 2) = (unsigned short)f2bf(w2[p]); }
    __syncthreads();
#pragma unroll
    for (int dt = 0; dt < 2; ++dt) { f32x16 acc;
#pragma unroll
        for (int r = 0; r < 16; ++r) acc[r] = 0.f;
#pragma unroll
        for (int ks = 0; ks < 8; ++ks) acc = __builtin_amdgcn_mfma_f32_32x32x16_bf16(*(const LAS bf16x8*)(Wt + (dt * 32 + q) * 272 + ks * 32 + h * 16), *(const LAS bf16x8*)(Hb + (wave * 32 + q) * 272 + ks * 32 + h * 16), acc, 0, 0, 0);
        const int c = wave * 32 + q;
        if (c < 255) {
#pragma unroll
            for (int a = 0; a < 4; ++a) { v2u w; w.x = cvtpk(acc[4 * a], acc[4 * a + 1]); w.y = cvtpk(acc[4 * a + 2], acc[4 * a + 3]); *(v2u*)(outp + (size_t)c * 64 + dt * 32 + 8 * a + 4 * h) = w; } } }
    __syncthreads();
}
__device__ __forceinline__ void dot4(const bf16* kr, const LAS float* qf, float (&s)[4]) {
    s[0] = s[1] = s[2] = s[3] = 0.f;
#pragma unroll
    for (int c8 = 0; c8 < 8; ++c8) { const v4u kk = *(const v4u*)(kr + c8 * 8);
        const float k0 = bf2f(kk.x & 0xffff), k1 = bf2f(kk.x >> 16), k2 = bf2f(kk.y & 0xffff), k3 = bf2f(kk.y >> 16), k4 = bf2f(kk.z & 0xffff), k5 = bf2f(kk.z >> 16), k6 = bf2f(kk.w & 0xffff), k7 = bf2f(kk.w >> 16);
#pragma unroll
        for (int r = 0; r < 4; ++r) { const f32x4 q0 = *(const LAS f32x4*)(qf + r * 64 + c8 * 8), q1 = *(const LAS f32x4*)(qf + r * 64 + c8 * 8 + 4);
            s[r] += ((q0.x * k0 + q0.y * k1) + (q0.z * k2 + q0.w * k3)) + ((q1.x * k4 + q1.y * k5) + (q1.z * k6 + q1.w * k7)); } }
}
__device__ __forceinline__ void phase_nsa_naive(const Params& P, LAS unsigned char* lds) {
    int tid_l = threadIdx.x; asm volatile("" : "+v"(tid_l)); const int tid = tid_l, lane = tid & 63, wave = tid >> 6;
    const int gw = blockIdx.x * NWAVES + wave, NGW = gridDim.x * NWAVES;
    const bf16* qb = (const bf16*)(P.ws + WS_Z); const bf16* kvb = qb + (size_t)T * 1024;
    const bf16* ck = (const bf16*)(P.ws + WS_CK); const bf16* cv = (const bf16*)(P.ws + WS_CV);
    const float* gates = (const float*)(P.ws + WS_GATES); bf16* y = (bf16*)(P.ws + WS_Y);
    LAS float* qf = (LAS float*)(lds + wave * 8192); LAS float* pc = qf + 256; LAS float* ps = pc + 1024;
    for (int it = gw; it < 4 * T; it += NGW) {
        const int t = it & 4095, g = (it >> 12) & 3, b = it >> 14; const size_t tg = (size_t)b * SEQ + t; const int bg = b * 4 + g;
        float slope[4];
#pragma unroll
        for (int r = 0; r < 4; ++r) slope[r] = exp2f(-0.5f * (float)(g * 4 + r + 1));
#pragma unroll
        for (int r = 0; r < 4; ++r) qf[r * 64 + lane] = bf2f(qb[tg * 1024 + g * 256 + r * 64 + lane]);
        LDS_WAIT();
        const int ncv = t >= 31 ? ((t - 31) >> 4) + 1 : 0;
#pragma unroll 1
        for (int cc = 0; cc < 4; ++cc) { const int c = lane + 64 * cc; float s[4] = {0.f, 0.f, 0.f, 0.f};
            if (cc * 64 < ncv) dot4(ck + ((size_t)bg * 256 + c) * 64, qf, s);
#pragma unroll
            for (int r = 0; r < 4; ++r) pc[r * 256 + c] = c < ncv ? s[r] * 0.125f - slope[r] * (float)(t - (16 * c + 31)) : -INFINITY; }
        LDS_WAIT();
#pragma unroll 1
        for (int r = 0; r < 4; ++r) { float v0 = pc[r * 256 + lane], v1 = pc[r * 256 + lane + 64], v2 = pc[r * 256 + lane + 128], v3 = pc[r * 256 + lane + 192];
            const float mx = wave_max(fmaxf(fmaxf(v0, v1), fmaxf(v2, v3)));
            v0 = lane < ncv ? __expf(v0 - mx) : 0.f; v1 = lane + 64 < ncv ? __expf(v1 - mx) : 0.f; v2 = lane + 128 < ncv ? __expf(v2 - mx) : 0.f; v3 = lane + 192 < ncv ? __expf(v3 - mx) : 0.f;
            const float sm = wave_sum((v0 + v1) + (v2 + v3)); const float inv = ncv > 0 ? 1.f / sm : 0.f;
            pc[r * 256 + lane] = v0 * inv; pc[r * 256 + lane + 64] = v1 * inv; pc[r * 256 + lane + 128] = v2 * inv; pc[r * 256 + lane + 192] = v3 * inv; }
        LDS_WAIT();
        float osum[4];
        { float ocmp[4] = {0.f, 0.f, 0.f, 0.f};
          const bf16* cvp = cv + (size_t)bg * 256 * 64 + lane;
#pragma unroll 2
          for (int c = 0; c < ncv; ++c) { const float v = bf2f(cvp[c * 64]);
#pragma unroll
              for (int r = 0; r < 4; ++r) ocmp[r] += pc[r * 256 + c] * v; }
#pragma unroll
          for (int r = 0; r < 4; ++r) osum[r] = sigmoid_f(gates[tg * 48 + (g * 4 + r) * 3]) * ocmp[r]; }
        unsigned long long mask;
        { const int n = lane, cur = t >> 6; float imp = 0.f;
#pragma unroll
          for (int r = 0; r < 4; ++r) { const f32x4 v = *(const LAS f32x4*)(pc + r * 256 + 4 * n); imp += v.x + v.y + v.z + 0.5f * v.w; if (n > 0) imp += 0.5f * pc[r * 256 + 4 * n - 1]; }
          const bool forced = (n == 0) || (n == cur) || (n == cur - 1);
          const float val = forced ? 1e4f : (n <= cur ? imp : -1.f);
          int rank = 0;
#pragma unroll 4
          for (int m = 0; m < 64; ++m) { const float vm = __shfl(val, m); rank += (vm > val || (vm == val && m < n)) ? 1 : 0; }
          mask = __ballot(rank < 16 && n <= cur); }
#pragma unroll 1
        for (int br = 0; br < 2; ++br) {
            const bf16* kp = kvb + (size_t)(br == 0 ? 2 : 4) * KV_KIND + (size_t)bg * SEQ * 64; const bf16* vp = kvb + (size_t)(br == 0 ? 3 : 5) * KV_KIND + (size_t)bg * SEQ * 64;
            float m_[4] = {-INFINITY, -INFINITY, -INFINITY, -INFINITY}, l_[4] = {0.f, 0.f, 0.f, 0.f}, acc[4] = {0.f, 0.f, 0.f, 0.f};
            const int jlo = br == 0 ? 0 : (t >= 511 ? t - 511 : 0);
            unsigned long long todo = br == 0 ? mask : 0ull; int j0 = jlo & ~63;
#pragma unroll 1
            for (;;) {
                if (br == 0) { if (!todo) break; j0 = (__ffsll((long long)todo) - 1) * 64; todo &= todo - 1; } else { if (j0 > t) break; }
                const int j = j0 + lane; const bool valid = j >= jlo && j <= t;
                float s[4]; dot4(kp + (size_t)j * 64, qf, s);
#pragma unroll
                for (int r = 0; r < 4; ++r) { const float sv = valid ? s[r] * 0.125f - slope[r] * (float)(t - j) : -INFINITY; const float mn = fmaxf(m_[r], wave_max(sv));
                    const float p = valid ? __expf(sv - mn) : 0.f; const float f = __expf(m_[r] - mn); l_[r] = l_[r] * f + wave_sum(p); acc[r] *= f; m_[r] = mn; ps[r * 64 + lane] = p; }
                LDS_WAIT();
                const bf16* vr = vp + (size_t)j0 * 64 + lane;
#pragma unroll 2
                for (int jj = 0; jj < 64; jj += 4) { const float v0 = bf2f(vr[jj * 64]), v1 = bf2f(vr[(jj + 1) * 64]), v2 = bf2f(vr[(jj + 2) * 64]), v3 = bf2f(vr[(jj + 3) * 64]);
#pragma unroll
                    for (int r = 0; r < 4; ++r) { const f32x4 pv = *(const LAS f32x4*)(ps + r * 64 + jj); acc[r] += (pv.x * v0 + pv.y * v1) + (pv.z * v2 + pv.w * v3); } }
                LDS_WAIT();
                if (br == 1) j0 += 64;
            }
#pragma unroll
            for (int r = 0; r < 4; ++r) osum[r] += sigmoid_f(gates[tg * 48 + (g * 4 + r) * 3 + 1 + br]) * (acc[r] / l_[r]);
        }
#pragma unroll
        for (int r = 0; r < 4; ++r) y[tg * DM + g * 256 + r * 64 + lane] = (bf16)f2bf(osum[r]);
        LDS_WAIT();
    }
}
constexpr int NSA_KB = 0, NSA_VB = 18432, NSA_IMPA = 34816, NSA_IMPB = 51200, NSA_MASK = 67584, NSA_UNI = 68096;
constexpr float LOG2E_F = 1.4426950408889634f;

__device__ __forceinline__ float quad_sum(float x) {
    x += __int_as_float(__builtin_amdgcn_update_dpp(0, __float_as_int(x), 0xB1, 0xF, 0xF, true));
    x += __int_as_float(__builtin_amdgcn_update_dpp(0, __float_as_int(x), 0x4E, 0xF, 0xF, true));
    return x;
}
__device__ __forceinline__ void nsa_qk(f32x16& p0, f32x16& p1, LAS const unsigned char* kb, const bf16x8 (&qf)[4], int q, int h, const f32x16& init) {
    p0 = init; p1 = init;
#pragma unroll
    for (int ks = 0; ks < 4; ++ks) { const bf16x8 a0 = *(const LAS bf16x8*)(kb + q * 144 + ks * 32 + h * 16), a1 = *(const LAS bf16x8*)(kb + (q + 32) * 144 + ks * 32 + h * 16);
        p0 = __builtin_amdgcn_mfma_f32_32x32x16_bf16(a0, qf[ks], p0, 0, 0, 0); p1 = __builtin_amdgcn_mfma_f32_32x32x16_bf16(a1, qf[ks], p1, 0, 0, 0); }
}
template <bool CHECK> __device__ __forceinline__ void nsa_bias(f32x16& p0, f32x16& p1, float basef, float slopeK, float cst, float klo, float khi, int h) {
    const float C = 1.f; const float i0 = basef + 4.f * (float)h; const float t0v = fmaf(slopeK, i0, cst);
#pragma unroll
    for (int r = 0; r < 16; ++r) { const float off = (float)((r & 3) + 8 * (r >> 2));
        float v0 = fmaf(p0[r], C, fmaf(slopeK, off, t0v)), v1 = fmaf(p1[r], C, fmaf(slopeK, off + 32.f, t0v));
        if (CHECK) { const float x0 = i0 + off, x1 = i0 + off + 32.f; v0 = (x0 >= klo && x0 <= khi) ? v0 : -INFINITY; v1 = (x1 >= klo && x1 <= khi) ? v1 : -INFINITY; }
        p0[r] = v0; p1[r] = v1; }
}
__device__ __forceinline__ float nsa_rowmax(const f32x16& p0, const f32x16& p1) {
    float a = fmaxf(p0[0], p1[0]);
#pragma unroll
    for (int r = 1; r < 16; ++r) a = fmaxf(a, fmaxf(p0[r], p1[r]));
    return fmaxf(a, __shfl_xor(a, 32));
}
__device__ __forceinline__ void nsa_pv(f32x16 (&o)[2], const f32x16& p0, const f32x16& p1, LAS const unsigned char* vb, int lane, int h) {
    bf16x8 pk[4];
#pragma unroll
    for (int s = 0; s < 4; ++s) { v4u w;
        if (s < 2) { w.x = cvtpk(p0[8 * s + 0], p0[8 * s + 1]); w.y = cvtpk(p0[8 * s + 2], p0[8 * s + 3]); w.z = cvtpk(p0[8 * s + 4], p0[8 * s + 5]); w.w = cvtpk(p0[8 * s + 6], p0[8 * s + 7]); }
        else { w.x = cvtpk(p1[8 * (s - 2) + 0], p1[8 * (s - 2) + 1]); w.y = cvtpk(p1[8 * (s - 2) + 2], p1[8 * (s - 2) + 3]); w.z = cvtpk(p1[8 * (s - 2) + 4], p1[8 * (s - 2) + 5]); w.w = cvtpk(p1[8 * (s - 2) + 6], p1[8 * (s - 2) + 7]); }
        pk[s] = __builtin_bit_cast(bf16x8, w); }
    LAS const unsigned char* vp = vb + (4 * h + ((lane & 15) >> 2)) * 64 + ((lane >> 4) & 1) * 32 + (lane & 3) * 8;
#pragma unroll
    for (int dt = 0; dt < 2; ++dt)
#pragma unroll
        for (int s = 0; s < 4; ++s) { const v4i16 lo = __builtin_amdgcn_ds_read_tr16_b64_v4i16((LAS v4i16*)(vp + dt * 4096 + s * 1024)), hi = __builtin_amdgcn_ds_read_tr16_b64_v4i16((LAS v4i16*)(vp + dt * 4096 + s * 1024 + 512));
            const bf16x8 a = (bf16x8){lo[0], lo[1], lo[2], lo[3], hi[0], hi[1], hi[2], hi[3]};
            o[dt] = __builtin_amdgcn_mfma_f32_32x32x16_bf16(a, pk[s], o[dt], 0, 0, 0); }
}
__device__ __forceinline__ void nsa_online(f32x16& p0, f32x16& p1, float& m, float& l, f32x16 (&o)[2]) {
    const float mx = nsa_rowmax(p0, p1), mn = fmaxf(m, mx), mu = (mn == -INFINITY) ? 0.f : mn; const float f = __builtin_amdgcn_exp2f(m - mu);
    float sum = 0.f;
#pragma unroll
    for (int r = 0; r < 16; ++r) { p0[r] = __builtin_amdgcn_exp2f(p0[r] - mu); p1[r] = __builtin_amdgcn_exp2f(p1[r] - mu); sum += p0[r] + p1[r]; }
    l = l * f + sum; m = mn;
    if (__any(f != 1.f)) {
#pragma unroll
        for (int r = 0; r < 16; ++r) { o[0][r] *= f; o[1][r] *= f; } }
}

typedef float f2v __attribute__((ext_vector_type(2)));
__device__ __forceinline__ void nsa_fast(f32x16& p0, f32x16& p1, float c32, float t0v, float& m, float& l, f32x16 (&o)[2]) {
    float mx0 = p0[0], mx1 = p1[0];
#pragma unroll
    for (int r = 1; r < 16; r += 2) { mx0 = __builtin_fmaxf(__builtin_fmaxf(mx0, p0[r]), p0[r < 15 ? r + 1 : r]); mx1 = __builtin_fmaxf(__builtin_fmaxf(mx1, p1[r]), p1[r < 15 ? r + 1 : r]); }
    float mx = __builtin_fmaxf(mx0, mx1 + c32) + t0v; mx = __builtin_fmaxf(mx, __shfl_xor(mx, 32));
    const float mn = __builtin_fmaxf(m, mx), mu = (mn == -INFINITY) ? 0.f : mn; const float f = __builtin_amdgcn_exp2f(m - mu), d = mu - t0v, d1 = d - c32; const f2v d2 = {d, d}, d12 = {d1, d1};
    f2v s2 = {0.f, 0.f};
#pragma unroll
    for (int k = 0; k < 8; ++k) { f2v a = {p0[2 * k], p0[2 * k + 1]}, b = {p1[2 * k], p1[2 * k + 1]}; a = a - d2; b = b - d12;
        a.x = __builtin_amdgcn_exp2f(a.x); a.y = __builtin_amdgcn_exp2f(a.y); b.x = __builtin_amdgcn_exp2f(b.x); b.y = __builtin_amdgcn_exp2f(b.y);
        s2 = s2 + a; s2 = s2 + b; p0[2 * k] = a.x; p0[2 * k + 1] = a.y; p1[2 * k] = b.x; p1[2 * k + 1] = b.y; }
    l = l * f + (s2.x + s2.y); m = mn;
    if (__any(f != 1.f)) {
#pragma unroll
        for (int r = 0; r < 16; ++r) { o[0][r] *= f; o[1][r] *= f; } }
}
__device__ __forceinline__ void nsa_item(const Params& P, LAS unsigned char* lds, int bg, int tile) {
    int tid_l = threadIdx.x; asm volatile("" : "+v"(tid_l)); const int tid = tid_l, lane = tid & 63, wave = tid >> 6, q = lane & 31, h = lane >> 5;
    const int b = bg >> 2, g = bg & 3, t0 = tile * 64, cur = tile;
    const int tl = 8 * wave + (q >> 2), t = t0 + tl, r = q & 3; const size_t tg = (size_t)b * SEQ + t;
    const bf16* qb = (const bf16*)(P.ws + WS_Z); const bf16* kvb = qb + (size_t)T * 1024;
    const bf16* ckp = (const bf16*)(P.ws + WS_CK) + (size_t)bg * 256 * 64; const bf16* cvp = (const bf16*)(P.ws + WS_CV) + (size_t)bg * 256 * 64;
    const bf16* ksp = kvb + 2 * KV_KIND + (size_t)bg * SEQ * 64; const bf16* vsp = kvb + 3 * KV_KIND + (size_t)bg * SEQ * 64;
    const bf16* kwp = kvb + 4 * KV_KIND + (size_t)bg * SEQ * 64; const bf16* vwp = kvb + 5 * KV_KIND + (size_t)bg * SEQ * 64;
    const float* gp = (const float*)(P.ws + WS_GATES) + tg * 48 + (g * 4 + r) * 3;
    LAS float* impA = (LAS float*)(lds + NSA_IMPA); LAS float* impB = (LAS float*)(lds + NSA_IMPB);
    LAS unsigned long long* masks = (LAS unsigned long long*)(lds + NSA_MASK); LAS unsigned long long* uni = (LAS unsigned long long*)(lds + NSA_UNI);
    const int srow = tid >> 3, spc = tid & 7; const unsigned koff = srow * 144 + spc * 16, voff = (spc >> 2) * 4096 + srow * 64 + (spc & 3) * 16; const size_t goff = (size_t)srow * 64 + spc * 8;
    const float slope2 = exp2f(-0.5f * (float)(g * 4 + r + 1)) * LOG2E_F; const float tf = (float)t;
    bf16x8 qf[4];
#pragma unroll
    for (int ks = 0; ks < 4; ++ks) qf[ks] = *(const bf16x8*)(qb + tg * 1024 + g * 256 + r * 64 + 16 * ks + 8 * h);
    { const v4u z4 = {0u, 0u, 0u, 0u};
#pragma unroll
      for (int i = 0; i < 4; ++i) *(LAS v4u*)(lds + NSA_IMPA + (tid * 4 + i) * 16) = z4; }
    if (tid < 8) uni[tid] = 0ull;
    v4u kreg, vreg;
#define KBUF(i) (lds + NSA_KB + (i) * 9216)
#define VBUF(i) (lds + NSA_VB + (i) * 8192)
    f32x16 osum[2], o[2], p0, p1, bo0, zero16;
#pragma unroll
    for (int rr = 0; rr < 16; ++rr) zero16[rr] = 0.f;
    const int nct = (((t0 + 32) >> 4) >> 6) + 1;
    const float cmaxf = t >= 31 ? (float)((t - 31) >> 4) : -1.f; const float cstc = slope2 * (31.f - tf), slopec = 16.f * slope2;
    float m1 = -INFINITY, l1 = 0.f;
    kreg = *(const v4u*)(ckp + (size_t)(nct - 1) * 4096 + goff); *(LAS v4u*)(KBUF(0) + koff) = kreg; __syncthreads();
#pragma unroll 1
    for (int i = 0; i < nct; ++i) { const int ct = nct - 1 - i;
        if (i + 1 < nct) kreg = *(const v4u*)(ckp + (size_t)(ct - 1) * 4096 + goff);
        else { kreg = *(const v4u*)(ckp + (size_t)(nct - 1) * 4096 + goff); vreg = *(const v4u*)(cvp + (size_t)(nct - 1) * 4096 + goff); }
        nsa_qk(p0, p1, KBUF(i & 1), qf, q, h, zero16); nsa_bias<true>(p0, p1, (float)(ct * 64), slopec, cstc, 0.f, cmaxf, h);
        { const float mx = nsa_rowmax(p0, p1), mn = fmaxf(m1, mx), mu = (mn == -INFINITY) ? 0.f : mn; float sum = 0.f;
#pragma unroll
          for (int rr = 0; rr < 16; ++rr) sum += __builtin_amdgcn_exp2f(p0[rr] - mu) + __builtin_amdgcn_exp2f(p1[rr] - mu);
          l1 = l1 * __builtin_amdgcn_exp2f(m1 - mu) + sum; m1 = mn; }
        if (i + 1 < nct) *(LAS v4u*)(KBUF((i + 1) & 1) + koff) = kreg;
        __syncthreads(); }
    l1 += __shfl_xor(l1, 32);
    const float inv1 = l1 > 0.f ? 1.f / l1 : 0.f, mu1 = (m1 == -INFINITY) ? 0.f : m1;
#pragma unroll
    for (int rr = 0; rr < 16; ++rr) { o[0][rr] = 0.f; o[1][rr] = 0.f; }
    *(LAS v4u*)(KBUF(0) + koff) = kreg; *(LAS v4u*)(VBUF(0) + voff) = vreg; __syncthreads();
#pragma unroll 1
    for (int i = 0; i < nct; ++i) { const int ct = nct - 1 - i;
        if (i + 1 < nct) { kreg = *(const v4u*)(ckp + (size_t)(ct - 1) * 4096 + goff); vreg = *(const v4u*)(cvp + (size_t)(ct - 1) * 4096 + goff); }
        else { kreg = *(const v4u*)(ksp + (size_t)cur * 4096 + goff); vreg = *(const v4u*)(vsp + (size_t)cur * 4096 + goff); }
        nsa_qk(p0, p1, KBUF(i & 1), qf, q, h, zero16); nsa_bias<true>(p0, p1, (float)(ct * 64), slopec, cstc, 0.f, cmaxf, h);
#pragma unroll
        for (int rr = 0; rr < 16; ++rr) { p0[rr] = __builtin_amdgcn_exp2f(p0[rr] - mu1) * inv1; p1[rr] = __builtin_amdgcn_exp2f(p1[rr] - mu1) * inv1; }
#pragma unroll
        for (int a = 0; a < 4; ++a) {
            float A0 = quad_sum(p0[4 * a] + p0[4 * a + 1] + p0[4 * a + 2] + 0.5f * p0[4 * a + 3]), B0 = quad_sum(0.5f * p0[4 * a + 3]);
            float A1 = quad_sum(p1[4 * a] + p1[4 * a + 1] + p1[4 * a + 2] + 0.5f * p1[4 * a + 3]), B1 = quad_sum(0.5f * p1[4 * a + 3]);
            if (r == 0) { const int n0 = 16 * ct + 2 * a + h, n1 = n0 + 8; impA[tl * 64 + n0] = A0; impA[tl * 64 + n1] = A1; impB[tl * 64 + n0 + 1] = B0; if (n1 < 63) impB[tl * 64 + n1 + 1] = B1; } }
        nsa_pv(o, p0, p1, VBUF(i & 1), lane, h);
        if (i + 1 < nct) { *(LAS v4u*)(KBUF((i + 1) & 1) + koff) = kreg; *(LAS v4u*)(VBUF((i + 1) & 1) + voff) = vreg; }
        __syncthreads(); }
    { const float g0 = sigmoid_f(gp[0]);
#pragma unroll
      for (int rr = 0; rr < 16; ++rr) { osum[0][rr] = g0 * o[0][rr]; osum[1][rr] = g0 * o[1][rr]; } }
    { const int tkl = lane >> 3, part = lane & 7, tk = 8 * wave + tkl; unsigned key[8];
      { const f32x4 a0 = *(const LAS f32x4*)(impA + tk * 64 + part * 8), a1 = *(const LAS f32x4*)(impA + tk * 64 + part * 8 + 4), b0 = *(const LAS f32x4*)(impB + tk * 64 + part * 8), b1 = *(const LAS f32x4*)(impB + tk * 64 + part * 8 + 4);
        const float im[8] = {a0.x + b0.x, a0.y + b0.y, a0.z + b0.z, a0.w + b0.w, a1.x + b1.x, a1.y + b1.y, a1.z + b1.z, a1.w + b1.w};
#pragma unroll
        for (int e2 = 0; e2 < 8; ++e2) { const int n = part * 8 + e2; const bool forced = (n == 0) || (n == cur) || (n == cur - 1); key[e2] = n <= cur ? (forced ? 0x7F000000u : __float_as_uint(im[e2]) + 1u) : 0u; } }
      unsigned Tk = 0u;
#pragma unroll 1
      for (int bb = 30; bb >= 0; --bb) { const unsigned cand = Tk | (1u << bb); int c = 0;
#pragma unroll
          for (int e2 = 0; e2 < 8; ++e2) c += key[e2] >= cand ? 1 : 0;
          c += __builtin_amdgcn_update_dpp(0, c, 0xB1, 0xF, 0xF, true); c += __builtin_amdgcn_update_dpp(0, c, 0x4E, 0xF, 0xF, true); c += __builtin_amdgcn_update_dpp(0, c, 0x141, 0xF, 0xF, true);
          Tk = c >= 16 ? cand : Tk; }
      int cg = 0, le = 0;
#pragma unroll
      for (int e2 = 0; e2 < 8; ++e2) { cg += key[e2] > Tk ? 1 : 0; le += key[e2] == Tk ? 1 : 0; }
      cg += __builtin_amdgcn_update_dpp(0, cg, 0xB1, 0xF, 0xF, true); cg += __builtin_amdgcn_update_dpp(0, cg, 0x4E, 0xF, 0xF, true); cg += __builtin_amdgcn_update_dpp(0, cg, 0x141, 0xF, 0xF, true);
      int incl = le;
#pragma unroll
      for (int o2 = 1; o2 < 8; o2 <<= 1) { const int v = __shfl_up(incl, o2, 8); if (part >= o2) incl += v; }
      int before = incl - le; const int need = 16 - cg; unsigned byte = 0u;
#pragma unroll
      for (int e2 = 0; e2 < 8; ++e2) { const bool eq = key[e2] == Tk; const bool selb = (key[e2] > Tk || (eq && before < need)) && (part * 8 + e2 <= cur); before += eq ? 1 : 0; byte |= selb ? (1u << e2) : 0u; }
      ((LAS unsigned char*)masks)[tk * 8 + part] = (unsigned char)byte;
      __hip_atomic_fetch_or(uni, (unsigned long long)byte << (8 * part), __ATOMIC_RELAXED, __HIP_MEMORY_SCOPE_WORKGROUP); }
    __syncthreads();
    unsigned long long todo = uni[0]; const unsigned long long mymask = masks[tl];
#define NSA_LOAD(kp_, vp_, n_) { kreg = *(const v4u*)((kp_) + (size_t)(n_) * 4096 + goff); vreg = *(const v4u*)((vp_) + (size_t)(n_) * 4096 + goff); }
#define NSA_STORE(i_) { *(LAS v4u*)(KBUF((i_) & 1) + koff) = kreg; *(LAS v4u*)(VBUF((i_) & 1) + voff) = vreg; }
#define NSA_FAST(i_, t0v_) { nsa_qk(p0, p1, KBUF((i_) & 1), qf, q, h, bo0); nsa_fast(p0, p1, 32.f * slope2, (t0v_), m, l, o); nsa_pv(o, p0, p1, VBUF((i_) & 1), lane, h); }
#define NSA_STEP(CHECK_, i_, basef_, cst_, klo_, khi_) { nsa_qk(p0, p1, KBUF((i_) & 1), qf, q, h, zero16); nsa_bias<CHECK_>(p0, p1, (basef_), slope2, (cst_), (klo_), (khi_), h); nsa_online(p0, p1, m, l, o); nsa_pv(o, p0, p1, VBUF((i_) & 1), lane, h); }
    {
        float m = -INFINITY, l = 0.f; const float cst = -slope2 * tf;
#pragma unroll
        for (int rr = 0; rr < 16; ++rr) { o[0][rr] = 0.f; o[1][rr] = 0.f; bo0[rr] = slope2 * (float)((rr & 3) + 8 * (rr >> 2)); }
        todo &= ~(1ull << cur);
        NSA_STORE(0) __syncthreads();
        int i = 0, nn = todo ? 63 - __clzll((long long)todo) : -1; if (nn >= 0) todo &= ~(1ull << nn);
        if (nn >= 0) NSA_LOAD(ksp, vsp, nn) else NSA_LOAD(kwp, vwp, tile)
        NSA_STEP(true, 0, (float)(cur * 64), cst, 0.f, tf)
        if (nn >= 0) NSA_STORE(1)
        __syncthreads();
#pragma unroll 1
        while (nn >= 0) { const int n = nn; ++i; nn = todo ? 63 - __clzll((long long)todo) : -1; if (nn >= 0) todo &= ~(1ull << nn);
            if (nn >= 0) NSA_LOAD(ksp, vsp, nn) else NSA_LOAD(kwp, vwp, tile)
            const bool sel = (mymask >> n) & 1ull;
            NSA_FAST(i, sel ? fmaf(slope2, (float)(n * 64 + 4 * h), cst) : -INFINITY)
            if (nn >= 0) NSA_STORE(i + 1)
            __syncthreads(); }
        l += __shfl_xor(l, 32); const float gs = sigmoid_f(gp[1]) / l;
#pragma unroll
        for (int rr = 0; rr < 16; ++rr) { osum[0][rr] += gs * o[0][rr]; osum[1][rr] += gs * o[1][rr]; }
    }
    {
        float m = -INFINITY, l = 0.f; const float cst = -slope2 * tf;
#pragma unroll
        for (int rr = 0; rr < 16; ++rr) { o[0][rr] = 0.f; o[1][rr] = 0.f; }
        const int nw = tile < 8 ? tile + 1 : 9, nmid = nw < 8 ? nw : 8;
        NSA_STORE(0) __syncthreads();
        if (nw > 1) NSA_LOAD(kwp, vwp, tile - 1)
        NSA_STEP(true, 0, (float)(tile * 64), cst, 0.f, tf)
        if (nw > 1) NSA_STORE(1)
        __syncthreads();
#pragma unroll 1
        for (int i = 1; i < nmid; ++i) { const int jt = tile - i;
            if (i + 1 < nw) NSA_LOAD(kwp, vwp, jt - 1)
            NSA_FAST(i, fmaf(slope2, (float)(jt * 64 + 4 * h), cst))
            if (i + 1 < nw) NSA_STORE(i + 1)
            __syncthreads(); }
        if (nw == 9) { NSA_STEP(true, 8, (float)((tile - 8) * 64), cst, tf - 511.f, 1e9f) __syncthreads(); }
        l += __shfl_xor(l, 32); const float gs = sigmoid_f(gp[2]) / l;
#pragma unroll
        for (int rr = 0; rr < 16; ++rr) { osum[0][rr] += gs * o[0][rr]; osum[1][rr] += gs * o[1][rr]; }
    }
#undef NSA_LOAD
#undef NSA_STORE
#undef NSA_STEP
#undef NSA_FAST
    { bf16* yp = (bf16*)(P.ws + WS_Y) + tg * DM + g * 256 + r * 64 + 4 * h;
#pragma unroll
      for (int dt = 0; dt < 2; ++dt)
#pragma unroll
          for (int a = 0; a < 4; ++a) { v2u w; w.x = cvtpk(osum[dt][4 * a], osum[dt][4 * a + 1]); w.y = cvtpk(osum[dt][4 * a + 2], osum[dt][4 * a + 3]); *(v2u*)(yp + dt * 32 + a * 8) = w; } }
#undef KBUF
#undef VBUF
}
__device__ __forceinline__ void phase_nsa(const Params& P, LAS unsigned char* lds) {
    for (int it = blockIdx.x; it < 2048; it += gridDim.x) { const int rnd = it / 256, c = it % 256; const int bg = c & 31, tile = 63 - 8 * rnd - (c >> 5); nsa_item(P, lds, bg, tile); }
}

__device__ __forceinline__ void xatt_item(const Params& P, LAS unsigned char* lds, int l, int bh, int blk) {
    int tid_l = threadIdx.x; asm volatile("" : "+v"(tid_l)); const int tid = tid_l, lane = tid & 63, wave = tid >> 6, q = lane & 31, h = lane >> 5;
    const int b = bh >> 2, hh = bh & 3; const size_t t = (size_t)b * SEQ + blk * 256 + wave * 32 + q;
    const bf16* kvp = (const bf16*)(P.ws + WS_MEMKV) + (size_t)(b * 256) * 4096 + l * 2048 + hh * 256;
    const bf16* qp = (const bf16*)(P.ws + WS_QXA) + t * DM + hh * 256 + 8 * h;
#pragma unroll
    for (int half = 0; half < 2; ++half) { v4u kr[8];
#pragma unroll
        for (int i = 0; i < 8; ++i) { const int p = tid + 512 * (half * 8 + i); kr[i] = *(const v4u*)(kvp + (size_t)(p >> 5) * 4096 + (p & 31) * 8); }
#pragma unroll
        for (int i = 0; i < 8; ++i) { const int p = tid + 512 * (half * 8 + i); *(LAS v4u*)(lds + (p >> 5) * 528 + (p & 31) * 16) = kr[i]; } }
    bf16x8 qf[16];
#pragma unroll
    for (int ks = 0; ks < 16; ++ks) qf[ks] = *(const bf16x8*)(qp + 16 * ks);
    __syncthreads();
    const float C = 0.0625f * LOG2E_F;
    v4u pk[16]; float m = 0.f, lsum = 0.f, f0 = 1.f;
#pragma unroll
    for (int half = 0; half < 2; ++half) {
        f32x16 s[4];
#pragma unroll
        for (int kt = 0; kt < 4; ++kt) {
#pragma unroll
            for (int r = 0; r < 16; ++r) s[kt][r] = 0.f;
            LAS const unsigned char* kb = lds + (half * 128 + kt * 32 + q) * 528 + h * 16;
#pragma unroll
            for (int ks = 0; ks < 16; ++ks) s[kt] = __builtin_amdgcn_mfma_f32_32x32x16_bf16(*(const LAS bf16x8*)(kb + ks * 32), qf[ks], s[kt], 0, 0, 0); }
        float mx = s[0][0];
#pragma unroll
        for (int kt = 0; kt < 4; ++kt)
#pragma unroll
            for (int r = 0; r < 16; ++r) mx = fmaxf(mx, s[kt][r]);
        mx = fmaxf(mx, __shfl_xor(mx, 32)) * C;
        const float mn = half == 0 ? mx : fmaxf(m, mx);
        if (half == 1) { f0 = __builtin_amdgcn_exp2f(m - mn); lsum *= f0; }
        m = mn;
        float sum = 0.f;
#pragma unroll
        for (int kt = 0; kt < 4; ++kt) {
#pragma unroll
            for (int r = 0; r < 16; ++r) { s[kt][r] = __builtin_amdgcn_exp2f(fmaf(s[kt][r], C, -mn)); sum += s[kt][r]; }
#pragma unroll
            for (int e = 0; e < 2; ++e) { v4u w; w.x = cvtpk(s[kt][8 * e + 0], s[kt][8 * e + 1]); w.y = cvtpk(s[kt][8 * e + 2], s[kt][8 * e + 3]); w.z = cvtpk(s[kt][8 * e + 4], s[kt][8 * e + 5]); w.w = cvtpk(s[kt][8 * e + 6], s[kt][8 * e + 7]); pk[half * 8 + kt * 2 + e] = w; } }
        lsum += sum;
    }
    lsum += __shfl_xor(lsum, 32); const float invl = 1.f / lsum;
    __syncthreads();
#pragma unroll
    for (int c = 0; c < 2; ++c) { v4u vr[8];
#pragma unroll
        for (int i = 0; i < 8; ++i) { const int p = tid + 512 * i; vr[i] = *(const v4u*)(kvp + 1024 + (size_t)(p >> 4) * 4096 + c * 128 + (p & 15) * 8); }
#pragma unroll
        for (int i = 0; i < 8; ++i) { const int p = tid + 512 * i; *(LAS v4u*)(lds + c * 65536 + ((p & 15) >> 2) * 16384 + (p >> 4) * 64 + (p & 3) * 16) = vr[i]; } }
    __syncthreads();
    bf16* yp = (bf16*)(P.ws + WS_Y) + t * DM + hh * 256 + 4 * h;
    LAS const unsigned char* vp = lds + (4 * h + ((lane & 15) >> 2)) * 64 + ((lane >> 4) & 1) * 32 + (lane & 3) * 8;
#pragma unroll 1
    for (int dt = 0; dt < 8; ++dt) { f32x16 o;
#pragma unroll
        for (int r = 0; r < 16; ++r) o[r] = 0.f;
        LAS const unsigned char* vd = vp + dt * 16384;
#pragma unroll
        for (int s = 0; s < 8; ++s) { const v4i16 lo = __builtin_amdgcn_ds_read_tr16_b64_v4i16((LAS v4i16*)(vd + s * 1024)), hi = __builtin_amdgcn_ds_read_tr16_b64_v4i16((LAS v4i16*)(vd + s * 1024 + 512));
            o = __builtin_amdgcn_mfma_f32_32x32x16_bf16((bf16x8){lo[0], lo[1], lo[2], lo[3], hi[0], hi[1], hi[2], hi[3]}, __builtin_bit_cast(bf16x8, pk[s]), o, 0, 0, 0); }
#pragma unroll
        for (int r = 0; r < 16; ++r) o[r] *= f0;
#pragma unroll
        for (int s = 8; s < 16; ++s) { const v4i16 lo = __builtin_amdgcn_ds_read_tr16_b64_v4i16((LAS v4i16*)(vd + s * 1024)), hi = __builtin_amdgcn_ds_read_tr16_b64_v4i16((LAS v4i16*)(vd + s * 1024 + 512));
            o = __builtin_amdgcn_mfma_f32_32x32x16_bf16((bf16x8){lo[0], lo[1], lo[2], lo[3], hi[0], hi[1], hi[2], hi[3]}, __builtin_bit_cast(bf16x8, pk[s]), o, 0, 0, 0); }
#pragma unroll
        for (int a = 0; a < 4; ++a) { v2u w; w.x = cvtpk(o[4 * a] * invl, o[4 * a + 1] * invl); w.y = cvtpk(o[4 * a + 2] * invl, o[4 * a + 3] * invl); *(v2u*)(yp + dt * 32 + a * 8) = w; } }
    __syncthreads();
}
__device__ __forceinline__ void phase_xatt(const Params& P, LAS unsigned char* lds, int l) {
    for (int it = blockIdx.x; it < 512; it += gridDim.x) { const int c = it % 256, k = it / 256; xatt_item(P, lds, l, c & 31, (c >> 5) + 8 * k); }
}

constexpr size_t WS_DN2 = 472 * MiB, DN_CHUNK_BYTES = 73728, WS_EGL = 489 * MiB; constexpr int DN_IN_OUT = 1820;
__device__ __forceinline__ unsigned char* dn_rec(const Params& P, int item) { return item < DN_IN_OUT ? (unsigned char*)P.out + (size_t)item * DN_CHUNK_BYTES : P.ws + WS_DN2 + (size_t)(item - DN_IN_OUT) * DN_CHUNK_BYTES; }
constexpr int DNA_RHS = 0, DNA_QB = 65536, DNA_KB = 82944, DNA_AM = 100352, DNA_SSQ = 118784, DNA_GC = 126976;
__device__ __forceinline__ void dna_item(const Params& P, LAS unsigned char* lds, int item) {
    int tid_l = threadIdx.x; asm volatile("" : "+v"(tid_l)); const int tid = tid_l, lane = tid & 63, wave = tid >> 6;
    const int bh = item >> 6, n = item & 63, b = bh >> 2, h = bh & 3, sb = n * 64; const size_t rb = (size_t)b * SEQ;
    const bf16* z = (const bf16*)(P.ws + WS_Z); const float* ba = (const float*)(P.ws + WS_BA); const float* cw = P.in[I_A_CONV];
    unsigned char* ob = dn_rec(P, item);
    LAS float* rhs = (LAS float*)(lds + DNA_RHS); LAS float* Am = (LAS float*)(lds + DNA_AM); LAS float* ssq = (LAS float*)(lds + DNA_SSQ);
    LAS float* gcs = (LAS float*)(lds + DNA_GC); LAS float* bet = gcs + 64; LAS float* egc = gcs + 128; LAS float* ekd = gcs + 192;
    const float SC = 0.08838834764831845f;
    { const int gd = tid & 15, tq = tid >> 4, d0 = gd * 8;
      f32x4 wa[3][4][2]; v4u za[3][2][4];
#pragma unroll
      for (int part = 0; part < 3; ++part) { const int ch0 = part * 512 + h * 128 + d0;
#pragma unroll
          for (int kk = 0; kk < 4; ++kk) { wa[part][kk][0] = *(const f32x4*)(cw + kk * 1536 + ch0); wa[part][kk][1] = *(const f32x4*)(cw + kk * 1536 + ch0 + 4); }
#pragma unroll
          for (int tt = 0; tt < 2; ++tt)
#pragma unroll
              for (int kk = 0; kk < 4; ++kk) { const int sp = sb + tq + 32 * tt - 3 + kk; za[part][tt][kk] = (v4u){0u, 0u, 0u, 0u}; if (sp >= 0) za[part][tt][kk] = *(const v4u*)(z + (rb + sp) * 2560 + 512 + ch0); } }
      __builtin_amdgcn_sched_barrier(0);
    if (wave == 0) { const size_t t = rb + sb + lane; const float bl = ba[t * 8 + h], al = ba[t * 8 + 4 + h] + P.in[I_A_DTB][h]; const float sp = al > 20.f ? al : log1pf(__expf(al));
        float g = -__expf(P.in[I_A_ALOG][h]) * sp;
#pragma unroll
        for (int o = 1; o < 64; o <<= 1) { const float v = __shfl_up(g, o); if (lane >= o) g += v; }
        const float gl = __shfl(g, 63);
        gcs[lane] = g; bet[lane] = sigmoid_f(bl); egc[lane] = __expf(g); ekd[lane] = __expf(gl - g);
        if (lane == 63) ((float*)(P.ws + WS_EGL))[item] = __expf(g); }
      __syncthreads();
#pragma unroll
      for (int part = 0; part < 3; ++part) {
#pragma unroll
          for (int tt = 0; tt < 2; ++tt) { const int tl = tq + 32 * tt;
              float a[8];
#pragma unroll
              for (int e2 = 0; e2 < 8; ++e2) a[e2] = 0.f;
#pragma unroll
              for (int kk = 0; kk < 4; ++kk) { const v4u zv = za[part][tt][kk]; const f32x4 w0 = wa[part][kk][0], w1 = wa[part][kk][1];
                  a[0] += w0.x * bf2f(zv.x & 0xffff); a[1] += w0.y * bf2f(zv.x >> 16); a[2] += w0.z * bf2f(zv.y & 0xffff); a[3] += w0.w * bf2f(zv.y >> 16);
                  a[4] += w1.x * bf2f(zv.z & 0xffff); a[5] += w1.y * bf2f(zv.z >> 16); a[6] += w1.z * bf2f(zv.w & 0xffff); a[7] += w1.w * bf2f(zv.w >> 16); }
              float q2 = 0.f;
#pragma unroll
              for (int e2 = 0; e2 < 8; ++e2) { a[e2] = a[e2] * __builtin_amdgcn_rcpf(1.f + __builtin_amdgcn_exp2f(-LOG2E_F * a[e2])); q2 += a[e2] * a[e2]; }
              if (part < 2) {
                  q2 += __shfl_xor(q2, 1); q2 += __shfl_xor(q2, 2); q2 += __shfl_xor(q2, 4); q2 += __shfl_xor(q2, 8);
                  const float rs = rsqrtf(q2 + EPS);
#pragma unroll
                  for (int e2 = 0; e2 < 8; ++e2) a[e2] *= rs;
                  v4u wv; wv.x = cvtpk(a[0], a[1]); wv.y = cvtpk(a[2], a[3]); wv.z = cvtpk(a[4], a[5]); wv.w = cvtpk(a[6], a[7]);
                  *(LAS v4u*)(lds + (part == 0 ? DNA_QB : DNA_KB) + tl * 272 + d0 * 2) = wv;
                  if (part == 0) { const float f = SC * egc[tl]; v4u g4; g4.x = cvtpk(a[0] * f, a[1] * f); g4.y = cvtpk(a[2] * f, a[3] * f); g4.z = cvtpk(a[4] * f, a[5] * f); g4.w = cvtpk(a[6] * f, a[7] * f);
                      *(v4u*)(ob + 16384 + (((tl >> 4) * 4 + (d0 >> 5)) * 64 + (tl & 15) + 16 * ((d0 >> 3) & 3)) * 16) = g4; }
                  else { const float f = ekd[tl], fb = bet[tl] * egc[tl];
                      *(LAS f32x4*)(rhs + tl * 256 + d0) = (f32x4){a[0] * fb, a[1] * fb, a[2] * fb, a[3] * fb}; *(LAS f32x4*)(rhs + tl * 256 + d0 + 4) = (f32x4){a[4] * fb, a[5] * fb, a[6] * fb, a[7] * fb};
                      bf16* kd = (bf16*)(ob + 32768) + ((((d0 >> 4) * 2 + (tl >> 5)) * 64 + 16 * ((tl >> 3) & 3)) * 8) + (tl & 7);
#pragma unroll
                      for (int e2 = 0; e2 < 8; ++e2) kd[(((d0 & 15) + e2) * 8)] = (bf16)f2bf(a[e2] * f); } }
              else { const float fb = bet[tl];
                  *(LAS f32x4*)(rhs + tl * 256 + 128 + d0) = (f32x4){a[0] * fb, a[1] * fb, a[2] * fb, a[3] * fb}; *(LAS f32x4*)(rhs + tl * 256 + 128 + d0 + 4) = (f32x4){a[4] * fb, a[5] * fb, a[6] * fb, a[7] * fb}; } } } }
    __syncthreads();
    if (wave < 6) { const int isq = wave >= 3, jb = wave - 3 * isq, it = jb >= 1, jt = jb == 2; const int q = lane & 31, hh = lane >> 5;
        f32x16 d;
#pragma unroll
        for (int r = 0; r < 16; ++r) d[r] = 0.f;
        LAS const unsigned char* ap = lds + (isq ? DNA_QB : DNA_KB) + (it * 32 + q) * 272 + hh * 16; LAS const unsigned char* bp = lds + DNA_KB + (jt * 32 + q) * 272 + hh * 16;
#pragma unroll
        for (int ks = 0; ks < 8; ++ks) d = __builtin_amdgcn_mfma_f32_32x32x16_bf16(*(const LAS bf16x8*)(ap + ks * 32), *(const LAS bf16x8*)(bp + ks * 32), d, 0, 0, 0);
        const int j = jt * 32 + q; const float gj = gcs[j];
#pragma unroll
        for (int r = 0; r < 16; ++r) { const int i = it * 32 + (r & 3) + 8 * (r >> 2) + 4 * hh; const float dec = __expf(fminf(gcs[i] - gj, 0.f));
            if (!isq) Am[(j & 1) * 2304 + i * 36 + (j >> 1)] = i > j ? d[r] * bet[i] * dec : 0.f;
            else ((bf16*)(ob + 65536))[((((i >> 4) * 2 + (j >> 5)) * 64 + (i & 15) + 16 * ((j >> 3) & 3)) * 8) + (j & 7)] = (bf16)f2bf(i >= j ? d[r] * SC * dec : 0.f); } }
    else if (wave == 6) { const v4u z4 = {0u, 0u, 0u, 0u}; *(v4u*)(ob + 65536 + ((0 * 2 + 1) * 64 + lane) * 16) = z4; *(v4u*)(ob + 65536 + ((1 * 2 + 1) * 64 + lane) * 16) = z4; }
    __syncthreads();
    if (tid < 256) { const int cp = tid >> 1, par = tid & 1, c = 2 * cp; LAS const float* Ap = Am + par * 2304; f2v x[32];
#pragma unroll
      for (int jj = 0; jj < 32; ++jj) x[jj] = (f2v){0.f, 0.f};
      f32x4 ab[2][8]; f2v rb[2]; f2v xl[4] = {{0.f, 0.f}, {0.f, 0.f}, {0.f, 0.f}, {0.f, 0.f}};
      rb[0] = *(const LAS f2v*)(rhs + c);
      unsigned* wp = (unsigned*)((bf16*)ob + (((c >> 5) * 64 + 16 * ((c >> 3) & 3)) * 8) + (c & 7));
      const int dv = c - 128; unsigned char* up = ob + 49152 + (((dv >> 4) * 4) * 64 + (dv & 15)) * 8;
#pragma unroll
      for (int i = 0; i < 64; ++i) {
          if (i + 1 < 64) {
#pragma unroll
              for (int j4 = 0; j4 < ((i + 2) / 2 + 3) / 4; ++j4) ab[(i + 1) & 1][j4] = *(const LAS f32x4*)(Ap + (i + 1) * 36 + 4 * j4);
              rb[(i + 1) & 1] = *(const LAS f2v*)(rhs + (i + 1) * 256 + c); }
          __builtin_amdgcn_sched_barrier(0);
          f2v ac4[4] = {{0.f, 0.f}, {0.f, 0.f}, {0.f, 0.f}, {0.f, 0.f}};
#pragma unroll
          for (int jj = 0; jj < (i + 1) / 2; ++jj) { const float a = ab[i & 1][jj >> 2][jj & 3]; ac4[jj & 3] = ac4[jj & 3] + (f2v){a, a} * x[jj]; }
          f2v acc = (ac4[0] + ac4[1]) + (ac4[2] + ac4[3]);
          acc.x += __int_as_float(__builtin_amdgcn_update_dpp(0, __float_as_int(acc.x), 0xB1, 0xF, 0xF, true)); acc.y += __int_as_float(__builtin_amdgcn_update_dpp(0, __float_as_int(acc.y), 0xB1, 0xF, 0xF, true));
          const f2v xi = rb[i & 1] - acc;
          x[i >> 1] = ((i & 1) == par) ? xi : x[i >> 1];
          xl[i & 3] = xi;
          if (tid < 128) { if ((i & 1) == par) wp[(((i >> 4) * 4) * 64 + (i & 15)) * 4] = cvtpk(xi.x, xi.y); }
          else if ((i & 3) == 3 && ((i >> 2) & 1) == par) { v2u w0, w1; w0.x = cvtpk(xl[0].x, xl[1].x); w0.y = cvtpk(xl[2].x, xl[3].x); w1.x = cvtpk(xl[0].y, xl[1].y); w1.y = cvtpk(xl[2].y, xl[3].y);
              unsigned char* u0 = up + (((i >> 2) >> 2) * 64 + 16 * ((i >> 2) & 3)) * 8; *(v2u*)u0 = w0; *(v2u*)(u0 + 8) = w1; }
          __builtin_amdgcn_sched_barrier(0);
      } }
    __syncthreads();
}
__device__ __forceinline__ void phase_dna(const Params& P, LAS unsigned char* lds) { for (int it = blockIdx.x; it < 2048; it += gridDim.x) dna_item(P, lds, it); }

typedef float f32x4v __attribute__((ext_vector_type(4)));
struct DnFrag { bf16x8 m1[4]; bf16x8 at[2]; bf16x8 kd[2]; v2u u; float eg; };
__device__ __forceinline__ void dnb_load(DnFrag& f, const Params& P, int bh, const float* egl, int n, int wave, int lane, int sl) {
    const unsigned char* cb = dn_rec(P, bh * 64 + n); const int ct = wave & 3;
    const unsigned char* m1 = cb + (wave < 4 ? 0 : 16384) + ((ct * 4) * 64 + lane) * 16;
#pragma unroll
    for (int ks = 0; ks < 4; ++ks) f.m1[ks] = *(const bf16x8*)(m1 + ks * 1024);
#pragma unroll
    for (int ks = 0; ks < 2; ++ks) f.kd[ks] = *(const bf16x8*)(cb + 32768 + ((wave * 2 + ks) * 64 + lane) * 16);
    if (wave < 4) f.u = *(const v2u*)(cb + 49152 + ((sl * 4 + ct) * 64 + lane) * 8);
    else {
#pragma unroll
        for (int ks = 0; ks < 2; ++ks) f.at[ks] = *(const bf16x8*)(cb + 65536 + ((ct * 2 + ks) * 64 + lane) * 16); }
    f.eg = egl[n];
}
__device__ __forceinline__ void phase_dnb(const Params& P, LAS unsigned char* lds) {
    int tid_l = threadIdx.x; asm volatile("" : "+v"(tid_l)); const int tid = tid_l, lane = tid & 63, wave = __builtin_amdgcn_readfirstlane(tid >> 6);
    const int x = blockIdx.x; if (x >= 256) return;
    const int xcd = x & 7, idx = x >> 3, bh = xcd * 4 + (idx >> 3), sl = idx & 7, b = bh >> 2, h = bh & 3, ct = wave & 3;
    const float* egl = (const float*)(P.ws + WS_EGL) + bh * 64;
    bf16* yo = (bf16*)(P.ws + WS_Y) + ((size_t)b * SEQ + 16 * ct + 4 * (lane >> 4)) * DM + 512 + h * 128 + sl * 16 + (lane & 15);
    LAS unsigned char* St = lds; LAS unsigned char* vnT = lds + 4352;
    LAS const unsigned char* stb = St + (lane & 15) * 272 + (lane >> 4) * 16; LAS const unsigned char* vnb = vnT + (lane & 15) * 144 + (lane >> 4) * 16;
    if (tid < 272) *(LAS v4u*)(St + tid * 16) = (v4u){0u, 0u, 0u, 0u};
    f32x4v Sacc = {0.f, 0.f, 0.f, 0.f};
    DnFrag fr[4];
#pragma unroll
    for (int u = 0; u < 4; ++u) dnb_load(fr[u], P, bh, egl, u, wave, lane, sl);
    __syncthreads();
#pragma unroll 1
    for (int n0 = 0; n0 < 64; n0 += 4) {
#pragma unroll
        for (int u = 0; u < 4; ++u) { const int n = n0 + u;
            f32x4v acc = {0.f, 0.f, 0.f, 0.f};
#pragma unroll
            for (int ks = 0; ks < 4; ++ks) acc = __builtin_amdgcn_mfma_f32_16x16x32_bf16(fr[u].m1[ks], *(const LAS bf16x8*)(stb + ks * 64), acc, 0, 0, 0);
            if (wave < 4) { const float u0 = bf2f(fr[u].u.x & 0xffff), u1 = bf2f(fr[u].u.x >> 16), u2 = bf2f(fr[u].u.y & 0xffff), u3 = bf2f(fr[u].u.y >> 16);
                v2u w; w.x = cvtpk(u0 - acc[0], u1 - acc[1]); w.y = cvtpk(u2 - acc[2], u3 - acc[3]); *(LAS v2u*)(vnT + (lane & 15) * 144 + (16 * ct + 4 * (lane >> 4)) * 2) = w; }
            __syncthreads();
            const bf16x8 v0 = *(const LAS bf16x8*)(vnb), v1 = *(const LAS bf16x8*)(vnb + 64);
            if (wave >= 4) { acc = __builtin_amdgcn_mfma_f32_16x16x32_bf16(fr[u].at[0], v0, acc, 0, 0, 0); acc = __builtin_amdgcn_mfma_f32_16x16x32_bf16(fr[u].at[1], v1, acc, 0, 0, 0);
                bf16* yp = yo + (size_t)n * 64 * DM;
#pragma unroll
                for (int r = 0; r < 4; ++r) yp[(size_t)r * DM] = (bf16)f2bf(acc[r]); }
            Sacc = Sacc * fr[u].eg;
            Sacc = __builtin_amdgcn_mfma_f32_16x16x32_bf16(fr[u].kd[0], v0, Sacc, 0, 0, 0); Sacc = __builtin_amdgcn_mfma_f32_16x16x32_bf16(fr[u].kd[1], v1, Sacc, 0, 0, 0);
            { v2u w; w.x = cvtpk(Sacc[0], Sacc[1]); w.y = cvtpk(Sacc[2], Sacc[3]); *(LAS v2u*)(St + (lane & 15) * 272 + (16 * wave + 4 * (lane >> 4)) * 2) = w; }
            dnb_load(fr[u], P, bh, egl, n + 4 < 64 ? n + 4 : 63, wave, lane, sl);
            __syncthreads();
        }
    }
}
__device__ __forceinline__ void phase_dnc(const Params& P, LAS unsigned char* lds) {
    int tid_l = threadIdx.x; asm volatile("" : "+v"(tid_l)); const int tid = tid_l, lane = tid & 63, wave = tid >> 6;
    const int gw = blockIdx.x * NWAVES + wave, NGW = gridDim.x * NWAVES;
    const bf16* z = (const bf16*)(P.ws + WS_Z); bf16* y = (bf16*)(P.ws + WS_Y);
    float on[8];
#pragma unroll
    for (int e = 0; e < 8; ++e) on[e] = P.in[I_A_ONORM][(lane & 15) * 8 + e];
    for (int it0 = gw; it0 < T; it0 += 4 * NGW) {
        const int hh = lane >> 4, d0 = (lane & 15) * 8; v4u ov[4], gv[4];
#pragma unroll
        for (int u = 0; u < 4; ++u) { const int it = it0 + u * NGW; if (it < T) { ov[u] = *(const v4u*)(y + (size_t)it * DM + 512 + hh * 128 + d0); gv[u] = *(const v4u*)(z + (size_t)it * 2560 + 2048 + hh * 128 + d0); } }
#pragma unroll
        for (int u = 0; u < 4; ++u) { const int it = it0 + u * NGW; if (it >= T) break;
            float o[8] = {bf2f(ov[u].x & 0xffff), bf2f(ov[u].x >> 16), bf2f(ov[u].y & 0xffff), bf2f(ov[u].y >> 16), bf2f(ov[u].z & 0xffff), bf2f(ov[u].z >> 16), bf2f(ov[u].w & 0xffff), bf2f(ov[u].w >> 16)};
            const float g[8] = {bf2f(gv[u].x & 0xffff), bf2f(gv[u].x >> 16), bf2f(gv[u].y & 0xffff), bf2f(gv[u].y >> 16), bf2f(gv[u].z & 0xffff), bf2f(gv[u].z >> 16), bf2f(gv[u].w & 0xffff), bf2f(gv[u].w >> 16)};
            float s = 0.f;
#pragma unroll
            for (int e = 0; e < 8; ++e) s += o[e] * o[e];
            s += __shfl_xor(s, 1); s += __shfl_xor(s, 2); s += __shfl_xor(s, 4); s += __shfl_xor(s, 8);
            const float rs = rsqrtf(s * (1.f / 128.f) + EPS);
#pragma unroll
            for (int e = 0; e < 8; ++e) o[e] = o[e] * rs * on[e] * (g[e] * __builtin_amdgcn_rcpf(1.f + __builtin_amdgcn_exp2f(-LOG2E_F * g[e])));
            v4u w; w.x = cvtpk(o[0], o[1]); w.y = cvtpk(o[2], o[3]); w.z = cvtpk(o[4], o[5]); w.w = cvtpk(o[6], o[7]);
            *(v4u*)(y + (size_t)it * DM + 512 + hh * 128 + d0) = w; } }
    phase_pool(P, lds);
}

constexpr size_t WS_CTL = 118 * MiB; constexpr int CTL_BYTES = 16384, LDS_CTL_OFF = 147392;
#define XB_TMO      128
#define XB_XCNT(j)  (256  + 64 * (j))
#define XB_XSUB(j)  (1280 + 64 * (j))
#define XB_XGEN(j)  (2304 + 64 * (j))
#define XB_TOP      3328
#define XB_TOPGEN   3392
#define XCD_BAR_WORDS 3456
#define XB_SPIN_CAP (1u << 18)

__device__ __forceinline__ unsigned xb_ld(unsigned* p)              { return __hip_atomic_load(p, __ATOMIC_RELAXED, __HIP_MEMORY_SCOPE_AGENT); }
__device__ __forceinline__ unsigned xb_add(unsigned* p, unsigned v) { return __hip_atomic_fetch_add(p, v, __ATOMIC_RELAXED, __HIP_MEMORY_SCOPE_AGENT); }
__device__ __forceinline__ unsigned xb_xcc_id() { return (unsigned)__builtin_amdgcn_s_getreg((3 << 11) | 20) & 0xFu; }
#define XB_SPIN(cond, bar) do { unsigned _sp = 0; while (cond) { __builtin_amdgcn_s_sleep(1); \
    if ((++_sp & 255u) == 0u) { if (xb_ld(&(bar)[XB_TMO])) break; if (_sp > XB_SPIN_CAP) { atomicAdd(&(bar)[XB_TMO], 1u); break; } } } } while (0)

struct XcdBarrier {
    unsigned* bar; unsigned x;
    volatile LAS unsigned* st;
};

__device__ __forceinline__ XcdBarrier xcd_barrier_post(unsigned* bar, volatile LAS unsigned* st) {
    XcdBarrier b; b.bar = bar; b.x = xb_xcc_id(); b.st = st;
    if (threadIdx.x == 0) (void)xb_add(&bar[XB_XCNT(b.x)], 1u);
    return b;
}
__device__ __forceinline__ void xcd_barrier_complete(unsigned* bar, unsigned x, unsigned& nloc, unsigned& nx) {
    const unsigned G = gridDim.x * gridDim.y * gridDim.z;
    unsigned sum, cnt, mine, sp = 0u;
    for (;;) {
        sum = 0u; cnt = 0u; mine = 0u;
#pragma unroll
        for (unsigned j = 0; j < 16; ++j) { const unsigned c = xb_ld(&bar[XB_XCNT(j)]); sum += c; cnt += (c > 0u) ? 1u : 0u; mine = (j == x) ? c : mine; }
        if (sum == G) break;
        __builtin_amdgcn_s_sleep(1);
        if ((++sp & 255u) == 0u) { if (xb_ld(&bar[XB_TMO])) break; if (sp > XB_SPIN_CAP) { atomicAdd(&bar[XB_TMO], 1u); break; } }
    }
    nloc = mine > 0u ? mine : 1u; nx = cnt > 0u ? cnt : 1u;
}

__device__ __forceinline__ void xcd_barrier(const XcdBarrier& b) {
    asm volatile("s_waitcnt vmcnt(0)" ::: "memory");
    __syncthreads();
    if (threadIdx.x == 0) {
        unsigned* bar = b.bar;
        __builtin_amdgcn_s_waitcnt(0);
        unsigned nloc = b.st[0], nx = b.st[1];
        if (nloc == 0u) { xcd_barrier_complete(bar, b.x, nloc, nx); b.st[0] = nloc; b.st[1] = nx; }
        const unsigned old = xb_add(&bar[XB_XSUB(b.x)], 1u);
        const unsigned gen = old / nloc;
        if (old + 1u == (gen + 1u) * nloc) {
            __builtin_amdgcn_fence(__ATOMIC_RELEASE, "agent");
            asm volatile("s_waitcnt vmcnt(0)" ::: "memory");
            const unsigned og = xb_add(&bar[XB_TOP], 1u);
            const unsigned tg = og / nx;
            if (og + 1u == (tg + 1u) * nx) xb_add(&bar[XB_TOPGEN], 1u);
            else XB_SPIN(xb_ld(&bar[XB_TOPGEN]) == tg, bar);
            __builtin_amdgcn_fence(__ATOMIC_ACQUIRE, "agent");
            xb_add(&bar[XB_XGEN(b.x)], 1u);
            asm volatile("s_waitcnt vmcnt(0)" ::: "memory");
        } else {
            XB_SPIN(xb_ld(&bar[XB_XGEN(b.x)]) == gen, bar);
            __builtin_amdgcn_fence(__ATOMIC_ACQUIRE, "agent");
            asm volatile("s_waitcnt vmcnt(0)" ::: "memory");
        }
    }
    __syncthreads();
}

constexpr int LDS_RS_OFF = 131072;
template <class E> __device__ __forceinline__ void run_gemm(LAS unsigned char* lds, const bf16* A, const bf16* Bt, int M, int N, int K, const E& e, const float* ss = nullptr) {
    pg8::Gemm g{A, Bt, M, N, K}; pg8::StaticOrder So; So.init(M, N, (int)gridDim.x, (int)blockIdx.x);
    if (ss) { pg8::Unit u; LAS float* rs = (LAS float*)(lds + LDS_RS_OFF);
        for (int i = 0; So.next(i, u); ++i) { const int r = threadIdx.x; if (r < 256) rs[256 * i + r] = pg8::row_rstd(ss, u.pm * 256 + r); }
        __syncthreads(); }
    pg8::gemm_phase<E, pg8::StaticOrder, true, true>(lds, g, So, e);
}
constexpr int N_PHASES = 22;
#ifndef MK_PER_PHASE
#define MK_PER_PHASE 0
#endif

template <int ph> __device__ __forceinline__ void do_phase(const Params& P, LAS unsigned char* lds) {
    unsigned char* ws = P.ws;
    bf16* xh = (bf16*)(ws + WS_XH); float* ss = (float*)(ws + WS_SS); bf16* yb = (bf16*)(ws + WS_Y); bf16* zb = (bf16*)(ws + WS_Z);
    if constexpr (ph == 0) phase_prologue(P, lds);
    else if constexpr (ph == 1) {
        pg8::Gemm g{xh, (const bf16*)(ws + WS_AIN), T, 2816, 1024, (const bf16*)(ws + WS_MEMH), (const bf16*)(ws + WS_XKV)};
        pg8::DualOrder So; So.init(T, 2816, 2048, 4096, (int)gridDim.x, (int)blockIdx.x);
        { pg8::Unit u; LAS float* rs = (LAS float*)(lds + LDS_RS_OFF);
          for (int i = 0; So.next(i, u); ++i) { const int r = threadIdx.x; if (r < 256 && u.kind == 0) rs[256 * i + r] = pg8::row_rstd(ss, u.pm * 256 + r); }
          __syncthreads(); }
        pg8::EpiDual<pg8::EpiInA, pg8::EpiBf<0>> e{{zb, (float*)(ws + WS_BA), (LAS float*)(lds + LDS_RS_OFF)}, {(bf16*)(ws + WS_MEMKV), 4096, nullptr, 1.f}};
        pg8::gemm_phase<pg8::EpiDual<pg8::EpiInA, pg8::EpiBf<0>>, pg8::DualOrder, true, true>(lds, g, So, e); }
    else if constexpr (ph == 2) phase_dna(P, lds);
    else if constexpr (ph == 3) phase_dnb(P, lds);
    else if constexpr (ph == 4) phase_dnc(P, lds);
    else if constexpr (ph == 11) { pg8::EpiInC e{zb, zb + (size_t)T * 1024, (float*)(ws + WS_GATES), (LAS float*)(lds + LDS_RS_OFF)}; run_gemm(lds, xh, (const bf16*)(ws + WS_CIN), T, 2560, 1024, e, ss);   }
    else if constexpr (ph == 12) { const int kvs = (int)blockIdx.x >> 5;
        if (kvs < 2) { pg8::EpiF32 e{(float*)(ws + (kvs ? WS_P01V : WS_P01K)), 256};
            pg8::Gemm g{zb + (size_t)T * 1024 + (size_t)kvs * KV_KIND, (const bf16*)(ws + (kvs ? WS_CMPV : WS_CMPK)), 8192, 256, 1024}; pg8::StaticOrder So; So.init(8192, 256, (int)gridDim.x, (int)blockIdx.x & 31);
            pg8::gemm_phase<pg8::EpiF32, pg8::StaticOrder, true, true>(lds, g, So, e);
            pg8::Unit u; So.next(0, u);
            __builtin_amdgcn_fence(__ATOMIC_RELEASE, "agent"); asm volatile("s_waitcnt vmcnt(0)" ::: "memory"); __syncthreads(); __builtin_amdgcn_fence(__ATOMIC_ACQUIRE, "agent"); asm volatile("s_waitcnt vmcnt(0)" ::: "memory");
            cmpfin_bg(P, lds, kvs, u.pm); }
        else { const int gwi = ((int)blockIdx.x - 64) * NWAVES + (int)(threadIdx.x >> 6), ngwi = ((int)gridDim.x - 64) * NWAVES; phase_gates(P, lds, gwi, ngwi); phase_conv_late(P, lds, gwi, ngwi); } }
    else if constexpr (ph == 13) { }
    else if constexpr (ph == 14) phase_nsa(P, lds);
    else if constexpr (ph == 21) phase_final(P);
    else { constexpr int l = ph >= 15 ? 1 : 0, k = ph - (l ? 15 : 5);
        if constexpr (k == 1) {
            { pg8::EpiBf<0> e{(bf16*)(ws + WS_QXA), 1024, (LAS float*)(lds + LDS_RS_OFF), 1.f}; run_gemm(lds, xh, (const bf16*)(ws + WS_XQ) + (size_t)l * 1048576, T, 1024, 1024, e, ss); } }
        else if constexpr (k == 2) phase_xatt(P, lds, l);
        else if constexpr (k == 4) { pg8::EpiBf<1> e{(bf16*)(ws + WS_HMID), 4096, (LAS float*)(lds + LDS_RS_OFF), 1.f}; run_gemm(lds, xh, (const bf16*)(ws + WS_F1) + (size_t)l * 4194304, T, 4096, 1024, e, ss); }
        else { const bf16* A = k == 5 ? (const bf16*)(ws + WS_HMID) : yb; constexpr int K = k == 5 ? 4096 : 1024;
            const bf16* Bt = k == 0 ? (const bf16*)(ws + (l ? WS_COUT : WS_AOUT)) : k == 3 ? (const bf16*)(ws + WS_XO) + (size_t)l * 1048576 : (const bf16*)(ws + WS_F2) + (size_t)l * 4194304;
            { pg8::EpiRes<false> e{xh, ss, nullptr}; run_gemm(lds, A, Bt, T, 1024, K, e); } } }
}
__global__ void __launch_bounds__(NTHR, 2) trunk_fwd(Params P) {
    extern __shared__ __attribute__((aligned(16))) unsigned char lds_raw[];
    LAS unsigned char* lds = (LAS unsigned char*)lds_raw;
    cg::grid_group grid = cg::this_grid();
    const int lo = P.ph_lo, hi = P.ph_hi;
#ifndef PROBE_PH
#define PROBE_PH -1
#endif
    if (threadIdx.x < 2) ((LAS unsigned*)(lds + LDS_CTL_OFF))[threadIdx.x] = 0u;
    __syncthreads();
    const XcdBarrier bar = xcd_barrier_post((unsigned*)(P.ws + WS_CTL), (volatile LAS unsigned*)(lds + LDS_CTL_OFF));
    if (P.ph_lo < 0) grid.sync();
#define SEAM(k) { xcd_barrier(bar); }
#define RUN(k) if (lo <= (k) && (k) < hi) { if ((k) == PROBE_PH) { do_phase<(k)>(P, lds); SEAM(k) } do_phase<(k)>(P, lds); if ((k) + 1 < hi) SEAM(k) }
    RUN(0) RUN(1) RUN(2) RUN(3) RUN(4) RUN(5) RUN(6) RUN(7) RUN(8) RUN(9) RUN(10) RUN(11) RUN(12) RUN(14) RUN(15) RUN(16) RUN(17) RUN(18) RUN(19) RUN(20) RUN(21)
#undef RUN
}

extern "C" void kernel_launch(void* const* d_in, const int* in_sizes, int n_in, void* d_out, int out_size, void* d_ws, size_t ws_size, hipStream_t stream) {
    static int grid = 0;
    if (grid == 0) {
        if (n_in != N_IN || in_sizes[0] != T * DM || out_size != T * DM || ws_size < WS_END) { fprintf(stderr, "kernel_launch: unexpected shapes (n_in %d, in0 %d, out %d, ws %zu)\n", n_in, n_in > 0 ? in_sizes[0] : -1, out_size, ws_size); grid = -1; return; }
        int dev = 0, cus = 0, per_cu = 0;
        if (hipGetDevice(&dev) != hipSuccess || hipDeviceGetAttribute(&cus, hipDeviceAttributeMultiprocessorCount, dev) != hipSuccess) { grid = -1; return; }
        if (hipFuncSetAttribute((const void*)trunk_fwd, hipFuncAttributeMaxDynamicSharedMemorySize, LDS_BYTES) != hipSuccess) { fprintf(stderr, "kernel_launch: hipFuncSetAttribute failed\n"); grid = -1; return; }
        if (hipOccupancyMaxActiveBlocksPerMultiprocessor(&per_cu, (const void*)trunk_fwd, NTHR, LDS_BYTES) != hipSuccess || per_cu < 1) { fprintf(stderr, "kernel_launch: occupancy query says %d blocks/CU\n", per_cu); (void)hipGetLastError(); grid = -1; return; }
        grid = cus;
        fprintf(stderr, "kernel_launch: %d CUs, %d blocks/CU by the occupancy query, grid %d\n", cus, per_cu, grid);
    }
    if (grid < 0) return;
    Params p{};
    for (int i = 0; i < N_IN; ++i) p.in[i] = (const float*)d_in[i];
    p.out = (float*)d_out; p.ws = (unsigned char*)d_ws;
#if MK_PER_PHASE
    for (int ph = 0; ph < N_PHASES; ++ph) { p.ph_lo = ph; p.ph_hi = ph + 1; hipLaunchKernelGGL(trunk_fwd, dim3(grid), dim3(NTHR), LDS_BYTES, stream, p); }
#else
    p.ph_lo = 0; p.ph_hi = N_PHASES;
    if (hipMemsetAsync((char*)d_ws + WS_CTL, 0, CTL_BYTES, stream) != hipSuccess) { fprintf(stderr, "kernel_launch: memset of the barrier words failed\n"); return; }
    void* args[] = {&p};
    hipError_t e = hipLaunchCooperativeKernel((const void*)trunk_fwd, dim3(grid), dim3(NTHR), args, LDS_BYTES, stream);
    if (e != hipSuccess) fprintf(stderr, "kernel_launch: cooperative launch failed: %s (grid %d)\n", hipGetErrorString(e), grid);
#endif
}
```

```cpp
#include <hip/hip_runtime.h>
#include <hip/hip_cooperative_groups.h>
#include <cstdio>
#include <cstdint>
namespace cg = cooperative_groups;
namespace pg8 {
#define PG8_LAS __attribute__((address_space(3)))
typedef unsigned short bf16_t;
typedef short bf16x8 __attribute__((ext_vector_type(8)));
typedef float f32x4 __attribute__((ext_vector_type(4)));
typedef unsigned u32x4 __attribute__((ext_vector_type(4)));
constexpr int BM = 256, BK = 64, HALF = 128, HTB = HALF * BK * 2  , STAGE_BYTES = 8 * HTB, NXCD = 8, WGM = 8;

__host__ __device__ __forceinline__ int lds_byte(int r, int c) { const int st = (r >> 4) * 2 + (c >> 5), rr = r & 15, cc = c & 31, ob = rr * 64 + cc * 2; return st * 1024 + (ob ^ (((ob >> 9) & 1) << 5)); }
__host__ __device__ __forceinline__ void stage_rc(int b, int& R, int& C) { const int st = b / 1024, sb = b % 1024, swz = sb ^ (((sb >> 9) & 1) << 5); R = (st >> 1) * 16 + swz / 64; C = (st & 1) * 32 + (swz % 64) / 2; }
__host__ __device__ __forceinline__ int perm32(int rho) { const int n = rho >> 4, i = rho & 15; return 8 * (i >> 2) + 4 * n + (i & 3); }

struct Unit { int pm, pn, ui, kind; };
struct Gemm { const bf16_t* A; const bf16_t* Bt; int M, N, K; const bf16_t* A2 = nullptr; const bf16_t* Bt2 = nullptr; };

struct StaticOrder {
    int nM, nN, nwg, G, c;
    __host__ __device__ void init(int M, int N, int G_, int c_) { nM = M / BM; nN = N / BM; nwg = nM * nN; G = G_; c = c_; }
    __host__ __device__ bool next(int i, Unit& u) const {
        const long L = (long)i * G + c; if (L >= nwg) return false;
        int wgid = (int)L; { const int q = nwg / NXCD, r = nwg % NXCD, xcd = wgid % NXCD, off = wgid / NXCD; wgid = (xcd < r ? xcd * (q + 1) : r * (q + 1) + (xcd - r) * q) + off; }
        const int nig = WGM * nN, gid = wgid / nig, fm = gid * WGM, gsz = (nM - fm) < WGM ? (nM - fm) : WGM;
        u.pm = fm + ((wgid % nig) % gsz); u.pn = (wgid % nig) / gsz; u.ui = i; u.kind = 0; return true;
    }
    __device__ __forceinline__ void a_ready(const Unit&) const {}
    __device__ __forceinline__ void done(const Unit&) const {}
};
__device__ __forceinline__ unsigned cvt_pk_bf16(float lo, float hi) { unsigned r; asm volatile("v_cvt_pk_bf16_f32 %0, %1, %2" : "=v"(r) : "v"(lo), "v"(hi)); return r; }
typedef float f32x2 __attribute__((ext_vector_type(2)));
typedef float f32x2 __attribute__((ext_vector_type(2)));
template <class Epi, class Sched, bool ALIGN_EPI = false, bool SP2 = false>
__device__ __forceinline__ void gemm_phase(PG8_LAS unsigned char* lds, const Gemm g, const Sched& S, const Epi& E) {
    int tid_l = threadIdx.x; asm volatile("" : "+v"(tid_l));
    const int tid = tid_l, wid = __builtin_amdgcn_readfirstlane(tid >> 6), lane = tid & 63, wr = wid >> 2, wc = wid & 3, fr = lane & 15, fq = lane >> 4;
    const int K = g.K, nt = K / BK;
    unsigned voffA[2], voffB[2];
#pragma unroll
    for (int i = 0; i < 2; ++i) { int R, C; stage_rc(tid * 16 + i * 8192, R, C); const int Rb = Epi::PERM ? ((R & ~31) + perm32(R & 31)) : R;
        voffA[i] = (unsigned)(R * K + C) * 2u; voffB[i] = (unsigned)(Rb * K + C) * 2u; }
    const size_t kstep = (size_t)(BK * 2);
    const size_t hstep = (size_t)HALF * K * 2;
    const size_t tstep = 2 * hstep;
    const unsigned ldsw = (unsigned)wid * 1024u;
    const int aoff = lds_byte(wr * 64 + fr, fq * 8), boff = lds_byte(wc * 32 + fr, fq * 8);
#define PG8_SA(b, h) (((b) * 2 + (h)) * HTB)
#define PG8_SB(b, h) ((4 + (b) * 2 + (h)) * HTB)
#define PG8_STAGE(bufoff, gbase, voff) do { _Pragma("unroll") for (int _i = 0; _i < 2; ++_i) \
        __builtin_amdgcn_global_load_lds((const unsigned*)((const char*)(gbase) + (voff)[_i]), (PG8_LAS unsigned*)(lds + (bufoff) + ldsw + _i * 8192), 16, 0, 0); } while (0)
#define PG8_LDA(dst, b, h) do { _Pragma("unroll") for (int m = 0; m < 4; ++m) _Pragma("unroll") for (int k = 0; k < 2; ++k) dst[m][k] = *(const PG8_LAS bf16x8*)(lds + PG8_SA(b, h) + aoff + m * 2048 + k * 1024); } while (0)
#define PG8_LDB(dst, b, h) do { _Pragma("unroll") for (int n = 0; n < 2; ++n) _Pragma("unroll") for (int k = 0; k < 2; ++k) dst[n][k] = *(const PG8_LAS bf16x8*)(lds + PG8_SB(b, h) + boff + n * 2048 + k * 1024); } while (0)
#define PG8_MMA(ai, bj, At, Bt) do { __builtin_amdgcn_s_setprio(1); _Pragma("unroll") for (int m = 0; m < 4; ++m) _Pragma("unroll") for (int n = 0; n < 2; ++n) _Pragma("unroll") for (int k = 0; k < 2; ++k) \
        acc[ai][bj][m][n] = __builtin_amdgcn_mfma_f32_16x16x32_bf16(Bt[n][k], At[m][k], acc[ai][bj][m][n], 0, 0, 0); __builtin_amdgcn_s_setprio(0); } while (0)
#define PG8_WAIT_V(n) asm volatile("s_waitcnt vmcnt(" #n ")" ::: "memory")
#define PG8_WAIT_L(n) asm volatile("s_waitcnt lgkmcnt(" #n ")" ::: "memory")
#define PG8_BAR __builtin_amdgcn_s_barrier()
#define PG8_SCHED __builtin_amdgcn_sched_barrier(0)
    Unit cur, nxt; int ui = 0;
    if (!S.next(0, cur)) return;
    f32x4 acc[2][2][4][2];
#pragma unroll
    for (int a = 0; a < 2; ++a)
#pragma unroll
        for (int b = 0; b < 2; ++b)
#pragma unroll
            for (int m = 0; m < 4; ++m)
#pragma unroll
                for (int n = 0; n < 2; ++n) acc[a][b][m][n] = (f32x4){0.f, 0.f, 0.f, 0.f};
    bf16x8 At[4][2], B0[2][2], B1[2][2];
    const char* cA = (const char*)(cur.kind ? g.A2 : g.A) + (size_t)cur.pm * tstep; const char* cB = (const char*)(cur.kind ? g.Bt2 : g.Bt) + (size_t)cur.pn * tstep;
    S.a_ready(cur);
    if constexpr (SP2) {
        PG8_STAGE(PG8_SB(0, 0), cB, voffB); PG8_STAGE(PG8_SB(0, 1), cB + hstep, voffB); PG8_STAGE(PG8_SA(0, 0), cA, voffA); PG8_STAGE(PG8_SA(0, 1), cA + hstep, voffA);
        if (wr == 1) PG8_BAR;
        PG8_WAIT_V(2); PG8_BAR;
        PG8_STAGE(PG8_SB(1, 0), cB + kstep, voffB); PG8_STAGE(PG8_SA(1, 0), cA + kstep, voffA); PG8_STAGE(PG8_SB(1, 1), cB + hstep + kstep, voffB);
        PG8_WAIT_V(6); PG8_BAR;
    } else {
        PG8_STAGE(PG8_SB(0, 0), cB, voffB); PG8_STAGE(PG8_SA(0, 0), cA, voffA); PG8_STAGE(PG8_SB(0, 1), cB + hstep, voffB); PG8_STAGE(PG8_SA(0, 1), cA + hstep, voffA);
        if (wr == 1) PG8_BAR;
        PG8_WAIT_V(4); PG8_BAR;
        PG8_STAGE(PG8_SB(1, 0), cB + kstep, voffB); PG8_STAGE(PG8_SA(1, 0), cA + kstep, voffA); PG8_STAGE(PG8_SB(1, 1), cB + hstep + kstep, voffB);
        PG8_WAIT_V(6); PG8_BAR;
    }
    for (;;) {
        const bool has_next = S.next(ui + 1, nxt);
        const char* nA = has_next ? (const char*)(nxt.kind ? g.A2 : g.A) + (size_t)nxt.pm * tstep : cA; const char* nB = has_next ? (const char*)(nxt.kind ? g.Bt2 : g.Bt) + (size_t)nxt.pn * tstep : cB;
        for (int t = 0; t < nt; t += 2) {
            const bool last = (t == nt - 2);
            const char* a1 = cA + (size_t)(t + 1) * kstep;
            const char* a2 = last ? nA : cA + (size_t)(t + 2) * kstep; const char* b2 = last ? nB : cB + (size_t)(t + 2) * kstep;
            const char* a3 = a2 + kstep; const char* b3 = b2 + kstep;
            if (last && has_next) S.a_ready(nxt);
            if constexpr (SP2) {
            PG8_LDB(B0, 0, 0); PG8_LDB(B1, 0, 1); PG8_SCHED; PG8_LDA(At, 0, 0); PG8_STAGE(PG8_SA(1, 1), a1 + hstep, voffA);
            PG8_WAIT_V(8); PG8_WAIT_L(0); PG8_BAR; PG8_MMA(0, 0, At, B0); PG8_MMA(0, 1, At, B1); PG8_BAR; PG8_SCHED;
            PG8_LDA(At, 0, 1); PG8_STAGE(PG8_SB(0, 0), b2, voffB); PG8_STAGE(PG8_SB(0, 1), b2 + hstep, voffB); PG8_STAGE(PG8_SA(0, 0), a2, voffA);
            PG8_WAIT_V(8); PG8_WAIT_L(0); PG8_BAR; PG8_MMA(1, 0, At, B0); PG8_MMA(1, 1, At, B1); PG8_BAR; PG8_SCHED;
            PG8_LDB(B0, 1, 0); PG8_LDB(B1, 1, 1); PG8_SCHED; PG8_LDA(At, 1, 0); PG8_STAGE(PG8_SA(0, 1), a2 + hstep, voffA);
            PG8_WAIT_V(8); PG8_WAIT_L(0); PG8_BAR; PG8_MMA(0, 0, At, B0); PG8_MMA(0, 1, At, B1); PG8_BAR; PG8_SCHED;
            PG8_LDA(At, 1, 1); PG8_STAGE(PG8_SB(1, 0), b3, voffB); PG8_STAGE(PG8_SB(1, 1), b3 + hstep, voffB); PG8_STAGE(PG8_SA(1, 0), a3, voffA);
            PG8_WAIT_V(8); PG8_WAIT_L(0); PG8_BAR; PG8_MMA(1, 0, At, B0); PG8_MMA(1, 1, At, B1); PG8_BAR; PG8_SCHED;
            } else {
            PG8_LDB(B0, 0, 0); PG8_SCHED; PG8_LDA(At, 0, 0); PG8_STAGE(PG8_SA(1, 1), a1 + hstep, voffA);
            PG8_WAIT_L(8); PG8_BAR; PG8_WAIT_L(0); PG8_MMA(0, 0, At, B0); PG8_BAR; PG8_SCHED;
            PG8_LDB(B1, 0, 1); PG8_STAGE(PG8_SB(0, 0), b2, voffB);
            PG8_BAR; PG8_WAIT_L(0); PG8_MMA(0, 1, At, B1); PG8_BAR;
            PG8_LDA(At, 0, 1); PG8_STAGE(PG8_SA(0, 0), a2, voffA);
            PG8_BAR; PG8_WAIT_L(0); PG8_MMA(1, 0, At, B0); PG8_BAR; PG8_SCHED;
            PG8_STAGE(PG8_SB(0, 1), b2 + hstep, voffB);
            PG8_WAIT_V(6); PG8_BAR; PG8_MMA(1, 1, At, B1); PG8_BAR;
            PG8_LDB(B0, 1, 0); PG8_SCHED; PG8_LDA(At, 1, 0); PG8_STAGE(PG8_SA(0, 1), a2 + hstep, voffA);
            PG8_WAIT_L(8); PG8_BAR; PG8_WAIT_L(0); PG8_MMA(0, 0, At, B0); PG8_BAR; PG8_SCHED;
            PG8_LDB(B1, 1, 1); PG8_STAGE(PG8_SB(1, 0), b3, voffB);
            PG8_BAR; PG8_WAIT_L(0); PG8_MMA(0, 1, At, B1); PG8_BAR;
            PG8_LDA(At, 1, 1); PG8_STAGE(PG8_SA(1, 0), a3, voffA);
            PG8_BAR; PG8_WAIT_L(0); PG8_MMA(1, 0, At, B0); PG8_BAR; PG8_SCHED;
            PG8_STAGE(PG8_SB(1, 1), b3 + hstep, voffB);
            PG8_WAIT_V(6); PG8_BAR; PG8_MMA(1, 1, At, B1); PG8_BAR;
            }
        }
        if constexpr (ALIGN_EPI) { if (wr == 0) PG8_BAR; }
        if constexpr (!Epi::AFTER_DRAIN) { E(acc, cur, wr, wc, fr, fq); S.done(cur); }
        if (!has_next) break;
#pragma unroll
        for (int a = 0; a < 2; ++a)
#pragma unroll
            for (int b = 0; b < 2; ++b)
#pragma unroll
                for (int m = 0; m < 4; ++m)
#pragma unroll
                    for (int n = 0; n < 2; ++n) acc[a][b][m][n] = (f32x4){0.f, 0.f, 0.f, 0.f};
        cur = nxt; cA = nA; cB = nB; ++ui;
        if constexpr (ALIGN_EPI) { if (wr == 1) PG8_BAR; }
    }
    PG8_WAIT_V(0);
    if constexpr (!ALIGN_EPI) { if (wr == 0) PG8_BAR; }
    PG8_BAR;
    if constexpr (Epi::AFTER_DRAIN) { E.fused(acc, cur, wr, wc, fr, fq, lds, wid, lane); S.done(cur); }
#undef PG8_SA
#undef PG8_SB
#undef PG8_STAGE
#undef PG8_LDA
#undef PG8_LDB
#undef PG8_MMA
#undef PG8_WAIT_V
#undef PG8_WAIT_L
#undef PG8_BAR
#undef PG8_SCHED
}
}
namespace pg8 {
struct DualOrder {
    StaticOrder s1, s2; int G, c;
    __host__ __device__ void init(int M1, int N1, int M2, int N2, int G_, int c_) { s1.init(M1, N1, 1, 0); s2.init(M2, N2, 1, 0); G = G_; c = c_; }
    __host__ __device__ bool next(int i, Unit& u) const {
        const long L = (long)i * G + c; if (L >= s1.nwg + s2.nwg) return false;
        if (L < s1.nwg) { s1.next((int)L, u); u.kind = 0; } else { s2.next((int)(L - s1.nwg), u); u.kind = 1; }
        u.ui = i; return true;
    }
    __device__ __forceinline__ void a_ready(const Unit&) const {}
    __device__ __forceinline__ void done(const Unit&) const {}
};
__device__ __forceinline__ float row_rstd(const float* ss, int row) {
    const f32x4* p = (const f32x4*)(ss + (size_t)row * 16);
    const f32x4 a = p[0], b = p[1], c = p[2], d = p[3];
    const float s = (((a[0] + a[1]) + (a[2] + a[3])) + ((b[0] + b[1]) + (b[2] + b[3]))) + (((c[0] + c[1]) + (c[2] + c[3])) + ((d[0] + d[1]) + (d[2] + d[3])));
    return rsqrtf(s * (1.0f / 1024.0f) + 1e-6f);
}
__device__ __forceinline__ u32x4 pack8(f32x4 v0, f32x4 v1) { u32x4 w; w.x = cvt_pk_bf16(v0[0], v0[1]); w.y = cvt_pk_bf16(v0[2], v0[3]); w.z = cvt_pk_bf16(v1[0], v1[1]); w.w = cvt_pk_bf16(v1[2], v1[3]); return w; }

template <int ACT  > struct EpiBf {
    static constexpr bool PERM = true, AFTER_DRAIN = false;
    bf16_t* O; int ldc; const PG8_LAS float* rs; float mul;
    __device__ __forceinline__ void operator()(const f32x4 (&acc)[2][2][4][2], const Unit& u, int wr, int wc, int fr, int fq) const {
        const int row0 = u.pm * BM + wr * 64 + fr, col0 = u.pn * BM + wc * 32 + 8 * fq;
#pragma unroll
        for (int ai = 0; ai < 2; ++ai)
#pragma unroll
            for (int m = 0; m < 4; ++m) { const int row = row0 + ai * HALF + m * 16; const float sc = rs ? mul * rs[256 * u.ui + ai * HALF + wr * 64 + m * 16 + fr] : mul; bf16_t* rowp = O + (size_t)row * ldc + col0;
#pragma unroll
                for (int bj = 0; bj < 2; ++bj) { f32x4 v0 = acc[ai][bj][m][0] * sc, v1 = acc[ai][bj][m][1] * sc;
                    if (ACT == 1) {
#pragma unroll
                        for (int j = 0; j < 4; ++j) { const float a = fmaxf(v0[j], 0.f), b = fmaxf(v1[j], 0.f); v0[j] = a * a; v1[j] = b * b; } }
                    *(u32x4*)(rowp + bj * HALF) = pack8(v0, v1); } }
    }
};
struct EpiF32 {
    static constexpr bool PERM = true, AFTER_DRAIN = false;
    float* C; int ldc;
    __device__ __forceinline__ void operator()(const f32x4 (&acc)[2][2][4][2], const Unit& u, int wr, int wc, int fr, int fq) const {
        const int row0 = u.pm * BM + wr * 64 + fr, col0 = u.pn * BM + wc * 32 + 8 * fq;
#pragma unroll
        for (int ai = 0; ai < 2; ++ai)
#pragma unroll
            for (int m = 0; m < 4; ++m) { float* rowp = C + (size_t)(row0 + ai * HALF + m * 16) * ldc + col0;
#pragma unroll
                for (int bj = 0; bj < 2; ++bj) { *(f32x4*)(rowp + bj * HALF) = acc[ai][bj][m][0]; *(f32x4*)(rowp + bj * HALF + 4) = acc[ai][bj][m][1]; } }
    }
};
template <bool F32RES> struct EpiRes {
    static constexpr bool PERM = true, AFTER_DRAIN = false;
    bf16_t* xh; float* ssout; const float* r32;
    __device__ __forceinline__ void operator()(const f32x4 (&acc)[2][2][4][2], const Unit& u, int wr, int wc, int fr, int fq) const {
        const int row0 = u.pm * BM + wr * 64 + fr, col0 = u.pn * BM + wc * 32 + 8 * fq;
#pragma unroll
        for (int ai = 0; ai < 2; ++ai) {
            u32x4 pre[4][2]; f32x4 pf[4][2][2];
#pragma unroll
            for (int m = 0; m < 4; ++m)
#pragma unroll
                for (int bj = 0; bj < 2; ++bj) { const size_t off = (size_t)(row0 + ai * HALF + m * 16) * 1024 + col0 + bj * HALF;
                    if (F32RES) { pf[m][bj][0] = *(const f32x4*)(r32 + off); pf[m][bj][1] = *(const f32x4*)(r32 + off + 4); } else pre[m][bj] = *(const u32x4*)(xh + off); }
            asm volatile("" ::: "memory"); __builtin_amdgcn_sched_barrier(0);
#pragma unroll
            for (int m = 0; m < 4; ++m) { const int row = row0 + ai * HALF + m * 16; float q = 0.f;
#pragma unroll
                for (int bj = 0; bj < 2; ++bj) { const size_t off = (size_t)row * 1024 + col0 + bj * HALF; f32x4 r0, r1;
                    if (F32RES) { r0 = pf[m][bj][0]; r1 = pf[m][bj][1]; }
                    else { const u32x4 p = pre[m][bj];
                        r0 = (f32x4){__uint_as_float(p.x << 16), __uint_as_float(p.x & 0xffff0000u), __uint_as_float(p.y << 16), __uint_as_float(p.y & 0xffff0000u)};
                        r1 = (f32x4){__uint_as_float(p.z << 16), __uint_as_float(p.z & 0xffff0000u), __uint_as_float(p.w << 16), __uint_as_float(p.w & 0xffff0000u)}; }
                    const f32x4 v0 = acc[ai][bj][m][0] + r0, v1 = acc[ai][bj][m][1] + r1;
                    q += ((v0[0] * v0[0] + v0[1] * v0[1]) + (v0[2] * v0[2] + v0[3] * v0[3])) + ((v1[0] * v1[0] + v1[1] * v1[1]) + (v1[2] * v1[2] + v1[3] * v1[3]));
                    *(u32x4*)(xh + off) = pack8(v0, v1); }
                q += __shfl_xor(q, 16); q += __shfl_xor(q, 32);
                if (fq == 0) ssout[(size_t)row * 16 + u.pn * 4 + wc] = q; }
            asm volatile("" ::: "memory"); __builtin_amdgcn_sched_barrier(0); }
    }
};
struct EpiInA {
    static constexpr bool PERM = true, AFTER_DRAIN = false;
    bf16_t* z; float* ba; const PG8_LAS float* rs;
    __device__ __forceinline__ void operator()(const f32x4 (&acc)[2][2][4][2], const Unit& u, int wr, int wc, int fr, int fq) const {
        const int row0 = u.pm * BM + wr * 64 + fr, col0 = u.pn * BM + wc * 32 + 8 * fq;
#pragma unroll
        for (int ai = 0; ai < 2; ++ai)
#pragma unroll
            for (int m = 0; m < 4; ++m) { const int row = row0 + ai * HALF + m * 16; const float sc = rs[256 * u.ui + ai * HALF + wr * 64 + m * 16 + fr];
                if (u.pn < 10) { bf16_t* rowp = z + (size_t)row * 2560 + col0;
#pragma unroll
                    for (int bj = 0; bj < 2; ++bj) *(u32x4*)(rowp + bj * HALF) = pack8(acc[ai][bj][m][0] * sc, acc[ai][bj][m][1] * sc);
                } else if (wc == 0 && fq == 0) { *(f32x4*)(ba + (size_t)row * 8) = acc[ai][0][m][0] * sc; *(f32x4*)(ba + (size_t)row * 8 + 4) = acc[ai][0][m][1] * sc; } }
    }
};
struct EpiInC {
    static constexpr bool PERM = true, AFTER_DRAIN = false;
    bf16_t* q; bf16_t* kv; float* gates; const PG8_LAS float* rs;
    __device__ __forceinline__ void operator()(const f32x4 (&acc)[2][2][4][2], const Unit& u, int wr, int wc, int fr, int fq) const {
        const int row0 = u.pm * BM + wr * 64 + fr, col0 = u.pn * BM + wc * 32 + 8 * fq;
#pragma unroll
        for (int ai = 0; ai < 2; ++ai)
#pragma unroll
            for (int m = 0; m < 4; ++m) { const int row = row0 + ai * HALF + m * 16; const float sc = rs[256 * u.ui + ai * HALF + wr * 64 + m * 16 + fr];
                if (u.pn < 4) { bf16_t* rowp = q + (size_t)row * 1024 + col0; const float sq = sc * 0.18033688011112042f;
#pragma unroll
                    for (int bj = 0; bj < 2; ++bj) *(u32x4*)(rowp + bj * HALF) = pack8(acc[ai][bj][m][0] * sq, acc[ai][bj][m][1] * sq);
                } else if (u.pn < 10) { const int b = row >> 12, s = row & 4095;
#pragma unroll
                    for (int bj = 0; bj < 2; ++bj) { const int cp = col0 + bj * HALF - 1024, kind = cp >> 8, g = (cp >> 6) & 3, d = cp & 63;
                        *(u32x4*)(kv + (size_t)kind * ((size_t)32768 * 256) + ((size_t)((b * 4 + g) * 4096 + s)) * 64 + d) = pack8(acc[ai][bj][m][0] * sc, acc[ai][bj][m][1] * sc); }
                } else { const int cl = wc * 32 + 8 * fq; if (cl < 48) { *(f32x4*)(gates + (size_t)row * 48 + cl) = acc[ai][0][m][0] * sc; *(f32x4*)(gates + (size_t)row * 48 + cl + 4) = acc[ai][0][m][1] * sc; } } }
    }
};
template <class E0, class E1> struct EpiDual {
    static constexpr bool PERM = true, AFTER_DRAIN = false;
    E0 e0; E1 e1;
    __device__ __forceinline__ void operator()(const f32x4 (&acc)[2][2][4][2], const Unit& u, int wr, int wc, int fr, int fq) const { if (u.kind) e1(acc, u, wr, wc, fr, fq); else e0(acc, u, wr, wc, fr, fq); }
};
}
#define LAS __attribute__((address_space(3)))
typedef unsigned short bf16;
typedef float f32x4 __attribute__((ext_vector_type(4)));
typedef unsigned v4u __attribute__((ext_vector_type(4)));
typedef unsigned v2u __attribute__((ext_vector_type(2)));
typedef short bf16x8 __attribute__((ext_vector_type(8)));
typedef float f32x16 __attribute__((ext_vector_type(16)));
typedef short v4i16 __attribute__((ext_vector_type(4)));
typedef float f32x2_t __attribute__((ext_vector_type(2))); typedef __bf16 bf16x2_t __attribute__((ext_vector_type(2)));
__device__ __forceinline__ unsigned cvtpk(float lo, float hi) { f32x2_t v = {lo, hi}; bf16x2_t b = __builtin_convertvector(v, bf16x2_t); return __builtin_bit_cast(unsigned, b); }

constexpr int NWAVES = 8, NTHR = 512;
constexpr int T = 32768, SEQ = 4096, DM = 1024, FF = 4096;
constexpr int LDS_BYTES = 147456;
constexpr float EPS = 1e-6f;

enum { I_X = 0, I_MEM, I_A_LN, I_A_WIN, I_A_POOLW, I_A_POOLS, I_A_CONV, I_A_ALOG, I_A_DTB, I_A_ONORM, I_A_WOUT,
       I_C_LN, I_C_WIN, I_C_PEK, I_C_W1K, I_C_W2K, I_C_PEV, I_C_W1V, I_C_W2V, I_C_WOUT,
       I_XA_LN, I_XA_MLN, I_XA_WQ, I_XA_WK, I_XA_WV, I_XA_WO, I_FF_LN, I_FF_W1, I_FF_W2, I_FLN, N_IN };

constexpr size_t MiB = (size_t)1 << 20;
constexpr size_t WS_AIN = 0, WS_AOUT = 6 * MiB, WS_CIN = 8 * MiB, WS_COUT = 14 * MiB, WS_XQ = 16 * MiB, WS_XKV = 20 * MiB, WS_XO = 28 * MiB;
constexpr size_t WS_F1 = 32 * MiB, WS_F2 = 48 * MiB, WS_CMPK = 64 * MiB, WS_CMPV = 64 * MiB + 512 * 1024, WS_CBIAS = 65 * MiB;
constexpr size_t WS_MEMH = 66 * MiB, WS_MEMKV = 74 * MiB, WS_SS = 90 * MiB, WS_BA = 92 * MiB, WS_GATES = 93 * MiB, WS_CK = 99 * MiB, WS_CV = 100 * MiB;
constexpr size_t WS_P01K = 101 * MiB, WS_P01V = 109 * MiB, WS_POOLW = 117 * MiB;
constexpr size_t WS_Z = 120 * MiB, WS_Y = 280 * MiB, WS_QXA = 344 * MiB, WS_XH = 408 * MiB, WS_HMID = 120 * MiB, WS_END = 489 * MiB;
constexpr size_t KV_KIND = (size_t)T * 256;

struct Params { const float* in[N_IN]; float* out; unsigned char* ws; int ph_lo, ph_hi; };

__device__ __forceinline__ float bf2f(unsigned v) { return __uint_as_float(v << 16); }
__device__ __forceinline__ unsigned f2bf(float f) { unsigned u = __float_as_uint(f); return (u + 0x7fffu + ((u >> 16) & 1u)) >> 16; }
__device__ __forceinline__ unsigned pk2(float lo, float hi) { return f2bf(lo) | (f2bf(hi) << 16); }
__device__ __forceinline__ float wave_sum(float v) {
#pragma unroll
    for (int o = 1; o < 64; o <<= 1) v += __shfl_xor(v, o);
    return v;
}
__device__ __forceinline__ float wave_max(float v) {
#pragma unroll
    for (int o = 1; o < 64; o <<= 1) v = fmaxf(v, __shfl_xor(v, o));
    return v;
}
__device__ __forceinline__ float silu_f(float x) { return x / (1.f + __expf(-x)); }
__device__ __forceinline__ float sigmoid_f(float x) { return 1.f / (1.f + __expf(-x)); }
#define LDS_WAIT() asm volatile("s_waitcnt lgkmcnt(0)" ::: "memory")

__device__ __forceinline__ void transpose_item(const float* W, int K, int N, int ld, const float* gain, bf16* WT, int row_off, LAS float* scr, int item, int lane) {
    const int nblk = N / 32, kb = item / nblk, nb = item % nblk, k0 = 64 * kb, n0 = 32 * nb;
#pragma unroll
    for (int i = 0; i < 8; ++i) { const int kk = 8 * i + (lane >> 3), nn = (lane & 7) * 4; f32x4 v = *(const f32x4*)(W + (size_t)(k0 + kk) * ld + n0 + nn); if (gain) v = v * gain[k0 + kk];
        scr[kk * 33 + nn] = v.x; scr[kk * 33 + nn + 1] = v.y; scr[kk * 33 + nn + 2] = v.z; scr[kk * 33 + nn + 3] = v.w; }
    LDS_WAIT();
    const int c = lane & 7;
#pragma unroll
    for (int j = 0; j < 4; ++j) { const int n = (lane >> 3) + 8 * j; const LAS float* s = scr + (8 * c) * 33 + n;
        v4u o; o.x = pk2(s[0 * 33], s[1 * 33]); o.y = pk2(s[2 * 33], s[3 * 33]); o.z = pk2(s[4 * 33], s[5 * 33]); o.w = pk2(s[6 * 33], s[7 * 33]);
        *(v4u*)(WT + (size_t)(row_off + n0 + n) * K + k0 + 8 * c) = o; }
    LDS_WAIT();
}
#define TJOB(W_, K_, N_, LD_, G_, WT_, RO_) { const int ni_ = ((K_) / 64) * ((N_) / 32); if (r < ni_) { transpose_item((W_), (K_), (N_), (LD_), (G_), (WT_), (RO_), scr, r, lane); continue; } r -= ni_; }

__device__ __forceinline__ void phase_prologue(const Params& P, LAS unsigned char* lds) {
    int tid_l = threadIdx.x; asm volatile("" : "+v"(tid_l)); const int tid = tid_l, lane = tid & 63, wave = tid >> 6;
    constexpr int NSMALL = 32; const bool small_role = (int)blockIdx.x >= (int)gridDim.x - NSMALL;
    const int gw = small_role ? 0x40000000 : (int)blockIdx.x * NWAVES + wave, NGW = ((int)gridDim.x - NSMALL) * NWAVES;
    unsigned char* ws = P.ws;
    LAS float* scr = (LAS float*)(lds + wave * 16384);
    constexpr int NITEMS = 1280 + 512 + 1280 + 512 + 4 * 512 + 512 + 2048 + 2048 + 4 * 64;
    for (int it = gw; it < NITEMS; it += NGW) {
        int r = it;
        TJOB(P.in[I_A_WIN], 1024, 2560, 2568, P.in[I_A_LN], (bf16*)(ws + WS_AIN), 0)
        TJOB(P.in[I_A_WOUT], 1024, 1024, 1024, nullptr, (bf16*)(ws + WS_AOUT), 0)
        TJOB(P.in[I_C_WIN], 1024, 2560, 2608, P.in[I_C_LN], (bf16*)(ws + WS_CIN), 0)
        TJOB(P.in[I_XA_WQ], 1024, 1024, 1024, P.in[I_XA_LN], (bf16*)(ws + WS_XQ), 0)
        TJOB(P.in[I_XA_WK], 1024, 1024, 1024, P.in[I_XA_MLN], (bf16*)(ws + WS_XKV), 0)
        TJOB(P.in[I_XA_WV], 1024, 1024, 1024, P.in[I_XA_MLN], (bf16*)(ws + WS_XKV), 1024)
        TJOB(P.in[I_XA_WK] + 1048576, 1024, 1024, 1024, P.in[I_XA_MLN] + 1024, (bf16*)(ws + WS_XKV) + 2097152, 0)
        TJOB(P.in[I_XA_WV] + 1048576, 1024, 1024, 1024, P.in[I_XA_MLN] + 1024, (bf16*)(ws + WS_XKV) + 2097152, 1024)
        TJOB(P.in[I_XA_WO], 1024, 1024, 1024, nullptr, (bf16*)(ws + WS_XO), 0)
        TJOB(P.in[I_FF_W1], 1024, 4096, 4096, P.in[I_FF_LN], (bf16*)(ws + WS_F1), 0)
        TJOB(P.in[I_FF_W2], 4096, 1024, 1024, nullptr, (bf16*)(ws + WS_F2), 0)
        TJOB(P.in[I_C_W1K], 1024, 128, 128, nullptr, (bf16*)(ws + WS_CMPK), 0)
        TJOB(P.in[I_C_W1K] + 131072, 1024, 128, 128, nullptr, (bf16*)(ws + WS_CMPK), 128)
        TJOB(P.in[I_C_W1V], 1024, 128, 128, nullptr, (bf16*)(ws + WS_CMPV), 0)
        TJOB(P.in[I_C_W1V] + 131072, 1024, 128, 128, nullptr, (bf16*)(ws + WS_CMPV), 128)
    }
    const int gt = small_role ? ((int)blockIdx.x - ((int)gridDim.x - NSMALL)) * NTHR + tid : 0x40000000, NGT = NSMALL * NTHR; const int gws = gt >> 6;
    for (int i = gt; i < 56 * 1024; i += NGT) { const int j = i >> 10, kk = i & 1023;
        if (j < 8) ((bf16*)(ws + WS_AIN))[(size_t)(2560 + j) * 1024 + kk] = (bf16)f2bf(P.in[I_A_LN][kk] * P.in[I_A_WIN][(size_t)kk * 2568 + 2560 + j]);
        else ((bf16*)(ws + WS_CIN))[(size_t)(2560 + j - 8) * 1024 + kk] = (bf16)f2bf(P.in[I_C_LN][kk] * P.in[I_C_WIN][(size_t)kk * 2608 + 2560 + j - 8]); }
    for (int i = gt; i < (248 + 208) * 128; i += NGT) { const int row = i >> 7, pc = i & 127; const v4u z4 = {0u, 0u, 0u, 0u};
        if (row < 248) *(v4u*)((bf16*)(ws + WS_AIN) + (size_t)(2568 + row) * 1024 + pc * 8) = z4; else *(v4u*)((bf16*)(ws + WS_CIN) + (size_t)(2608 + row - 248) * 1024 + pc * 8) = z4; }
    for (int i = gt; i < 4 * 128 * 128; i += NGT) { const int g = i >> 14, d = (i >> 7) & 127, c = i & 127; ((bf16*)(ws + WS_POOLW))[i] = (bf16)f2bf(P.in[I_A_POOLW][(size_t)g * 16384 + c * 128 + d] * P.in[I_A_POOLS][g * 128 + d]); }
    if (gws < 256) { const int n = gws & 127; const float* pe = gws < 128 ? P.in[I_C_PEK] : P.in[I_C_PEV]; const float* w1 = gws < 128 ? P.in[I_C_W1K] : P.in[I_C_W1V];
        float s = 0.f;
#pragma unroll 8
        for (int j = 0; j < 32; ++j) { const int i = lane + 64 * j; s += pe[i] * w1[(size_t)i * 128 + n]; }
        s = wave_sum(s); if (lane == 0) ((float*)(ws + WS_CBIAS))[gws] = s; }
    { bf16* xh = (bf16*)(ws + WS_XH); float* ss = (float*)(ws + WS_SS);
      for (int m0 = gw; m0 < T; m0 += 4 * NGW) { f32x4 v[4][4];
#pragma unroll
          for (int u = 0; u < 4; ++u) { const int m = m0 + u * NGW; if (m < T) { const f32x4* xr = (const f32x4*)(P.in[I_X] + (size_t)m * DM) + lane;
#pragma unroll
                  for (int j = 0; j < 4; ++j) v[u][j] = xr[64 * j]; } }
#pragma unroll
          for (int u = 0; u < 4; ++u) { const int m = m0 + u * NGW; if (m >= T) break; float s = 0.f;
#pragma unroll
              for (int j = 0; j < 4; ++j) s += (v[u][j].x * v[u][j].x + v[u][j].y * v[u][j].y) + (v[u][j].z * v[u][j].z + v[u][j].w * v[u][j].w);
              s = wave_sum(s);
              v2u* o8 = (v2u*)(xh + (size_t)m * DM) + lane;
#pragma unroll
              for (int j = 0; j < 4; ++j) { v2u w; w.x = pk2(v[u][j].x, v[u][j].y); w.y = pk2(v[u][j].z, v[u][j].w); o8[64 * j] = w; }
              if (lane < 16) ss[(size_t)m * 16 + lane] = lane == 0 ? s : 0.f; } } }
    { bf16* mh = (bf16*)(ws + WS_MEMH);
      for (int m = gw; m < 2048; m += NGW) { const f32x4* xr = (const f32x4*)(P.in[I_MEM] + (size_t)m * DM) + lane; f32x4 v[4]; float s = 0.f;
#pragma unroll
          for (int j = 0; j < 4; ++j) { v[j] = xr[64 * j]; s += (v[j].x * v[j].x + v[j].y * v[j].y) + (v[j].z * v[j].z + v[j].w * v[j].w); }
          const float rs = rsqrtf(wave_sum(s) * (1.f / DM) + EPS);
          v2u* o8 = (v2u*)(mh + (size_t)m * DM) + lane;
#pragma unroll
          for (int j = 0; j < 4; ++j) { v2u w; w.x = pk2(v[j].x * rs, v[j].y * rs); w.y = pk2(v[j].z * rs, v[j].w * rs); o8[64 * j] = w; } } }
}

__device__ __forceinline__ void phase_conv_late(const Params& P, LAS unsigned char* lds, int gw, int NGW) {
    const int tid = threadIdx.x, lane = tid & 63, wave = tid >> 6; unsigned char* ws = P.ws;
    LAS float* scr = (LAS float*)(lds + wave * 16384);
    constexpr int NITEMS = 512 + 512 + 512 + 2048 + 2048;
    for (int it = gw; it < NITEMS; it += NGW) {
        int r = it;
        TJOB(P.in[I_C_WOUT], 1024, 1024, 1024, nullptr, (bf16*)(ws + WS_COUT), 0)
        TJOB(P.in[I_XA_WQ] + 1048576, 1024, 1024, 1024, P.in[I_XA_LN] + 1024, (bf16*)(ws + WS_XQ) + 1048576, 0)
        TJOB(P.in[I_XA_WO] + 1048576, 1024, 1024, 1024, nullptr, (bf16*)(ws + WS_XO) + 1048576, 0)
        TJOB(P.in[I_FF_W1] + 4194304, 1024, 4096, 4096, P.in[I_FF_LN] + 1024, (bf16*)(ws + WS_F1) + 4194304, 0)
        TJOB(P.in[I_FF_W2] + 4194304, 4096, 1024, 1024, nullptr, (bf16*)(ws + WS_F2) + 4194304, 0)
    }
}
__device__ __forceinline__ void phase_gates(const Params& P, LAS unsigned char* lds, int gw, int NGW) {
    const int tid = threadIdx.x, lane = tid & 63; unsigned char* ws = P.ws;
    const bf16* wg = (const bf16*)(ws + WS_CIN) + (size_t)2560 * 1024; const bf16* xh = (const bf16*)(ws + WS_XH); const float* ss = (const float*)(ws + WS_SS); float* gates = (float*)(ws + WS_GATES);
    for (int p = tid; p < 48 * 128; p += NTHR) *(LAS v4u*)(lds + p * 16) = *(const v4u*)(wg + (size_t)p * 8);
    __syncthreads();
    for (int rg = gw; rg < T / 16; rg += NGW) { const int t0 = rg * 16;
        f32x4 acc[3] = {{0.f, 0.f, 0.f, 0.f}, {0.f, 0.f, 0.f, 0.f}, {0.f, 0.f, 0.f, 0.f}};
        const bf16* ap = xh + (size_t)(t0 + (lane & 15)) * DM + 8 * (lane >> 4); LAS const unsigned char* bp = lds + (lane & 15) * 2048 + (lane >> 4) * 16;
#pragma unroll 4
        for (int ks = 0; ks < 32; ++ks) { const bf16x8 a = *(const bf16x8*)(ap + 32 * ks);
#pragma unroll
            for (int ct = 0; ct < 3; ++ct) acc[ct] = __builtin_amdgcn_mfma_f32_16x16x32_bf16(a, *(const LAS bf16x8*)(bp + ct * 32768 + ks * 64), acc[ct], 0, 0, 0); }
#pragma unroll
        for (int r = 0; r < 4; ++r) { const int t = t0 + 4 * (lane >> 4) + r; const float rs = pg8::row_rstd(ss, t);
#pragma unroll
            for (int ct = 0; ct < 3; ++ct) gates[(size_t)t * 48 + ct * 16 + (lane & 15)] = acc[ct][r] * rs; } }
    __syncthreads();
}
__device__ __forceinline__ void phase_final(const Params& P) {
    const int tid = threadIdx.x, lane = tid & 63, wave = tid >> 6;
    const int gw = blockIdx.x * NWAVES + wave, NGW = gridDim.x * NWAVES;
    const float* ss = (const float*)(P.ws + WS_SS); const bf16* xh = (const bf16*)(P.ws + WS_XH);
    for (int m = gw; m < T; m += NGW) { f32x4* orow = (f32x4*)(P.out + (size_t)m * DM); const f32x4* gr = (const f32x4*)P.in[I_FLN];
        const float rs = pg8::row_rstd(ss, m);
#pragma unroll
        for (int j = 0; j < 2; ++j) { const v4u p = *(const v4u*)(xh + (size_t)m * DM + (j * 64 + lane) * 8); const f32x4 g0 = gr[(j * 64 + lane) * 2], g1 = gr[(j * 64 + lane) * 2 + 1];
            orow[(j * 64 + lane) * 2] = (f32x4){bf2f(p.x & 0xffff) * rs * g0.x, bf2f(p.x >> 16) * rs * g0.y, bf2f(p.y & 0xffff) * rs * g0.z, bf2f(p.y >> 16) * rs * g0.w};
            orow[(j * 64 + lane) * 2 + 1] = (f32x4){bf2f(p.z & 0xffff) * rs * g1.x, bf2f(p.z >> 16) * rs * g1.y, bf2f(p.w & 0xffff) * rs * g1.z, bf2f(p.w >> 16) * rs * g1.w}; } }
}
__device__ __forceinline__ void phase_pool(const Params& P, LAS unsigned char* lds) {
    int tid_l = threadIdx.x; asm volatile("" : "+v"(tid_l)); const int tid = tid_l, lane = tid & 63, wave = tid >> 6; const int g = blockIdx.x & 3, win = 2 << g;
    const bf16* z = (const bf16*)(P.ws + WS_Z); bf16* y = (bf16*)(P.ws + WS_Y);
    LAS unsigned short* ur = (LAS unsigned short*)lds;
    LAS unsigned char* yp = lds + 20480;
    const int nt = wave & 3, mt = wave >> 2, q = lane & 31, h = lane >> 5;
    bf16x8 bfr[8];
    { const bf16* bt = (const bf16*)(P.ws + WS_POOLW) + (size_t)g * 16384 + (size_t)(nt * 32 + q) * 128 + 8 * h;
#pragma unroll
      for (int ks = 0; ks < 8; ++ks) bfr[ks] = *(const bf16x8*)(bt + 16 * ks); }
    v4u pre[3];
#define POOL_LOAD(it_) { const int t0_ = ((it_) >> 2) * 64, s0_ = t0_ & (SEQ - 1); _Pragma("unroll") for (int j = 0; j < 3; ++j) { const int p = tid + 512 * j, row = p >> 4, pc = p & 15; pre[j] = (v4u){0u, 0u, 0u, 0u}; \
        if (p < 79 * 16 && s0_ + row - 15 >= 0) pre[j] = *(const v4u*)(z + (size_t)(t0_ + row - 15) * 2560 + g * 128 + pc * 8); } }
    int it = blockIdx.x; if (it < 2048) POOL_LOAD(it)
    for (; it < 2048; it += gridDim.x) { const int t0 = (it >> 2) * 64, s0 = t0 & (SEQ - 1);
#pragma unroll
        for (int j = 0; j < 3; ++j) { const int p = tid + 512 * j; if (p < 79 * 16) *(LAS v4u*)(lds + (p >> 4) * 256 + (p & 15) * 16) = pre[j]; }
        __syncthreads();
        if (it + (int)gridDim.x < 2048) POOL_LOAD(it + (int)gridDim.x)
        { const int c = tid & 127, tq = tid >> 7; float sum = 0.f;
          for (int j = 1; j < win; ++j) sum += bf2f(ur[(tq * 16 + 15 - j) * 128 + c]);
#pragma unroll 4
          for (int i = 0; i < 16; ++i) { const int tl = tq * 16 + i, s = s0 + tl; const float u = bf2f(ur[(tl + 15) * 128 + c]); sum += u;
              const float cnt = (float)((s + 1 < win) ? s + 1 : win);
              *(LAS unsigned short*)(yp + tl * 272 + c * 2) = (unsigned short)f2bf(sum / cnt - u);
              sum -= bf2f(ur[(tl + 16 - win) * 128 + c]); } }
        __syncthreads();
        { f32x16 acc;
#pragma unroll
          for (int r = 0; r < 16; ++r) acc[r] = 0.f;
          LAS const unsigned char* ap = yp + (mt * 32 + q) * 272 + h * 16;
#pragma unroll
          for (int ks = 0; ks < 8; ++ks) acc = __builtin_amdgcn_mfma_f32_32x32x16_bf16(bfr[ks], *(const LAS bf16x8*)(ap + ks * 32), acc, 0, 0, 0);
          bf16* yo = y + (size_t)(t0 + mt * 32 + q) * DM + g * 128 + nt * 32 + 4 * h;
#pragma unroll
          for (int a = 0; a < 4; ++a) { v2u w; w.x = cvtpk(acc[4 * a], acc[4 * a + 1]); w.y = cvtpk(acc[4 * a + 2], acc[4 * a + 3]); *(v2u*)(yo + 8 * a) = w; } }
    }
#undef POOL_LOAD
    __syncthreads();
}
__device__ __forceinline__ void dn_naive_item(const Params& P, LAS unsigned char* lds, int item) {
    int tid_l = threadIdx.x; asm volatile("" : "+v"(tid_l)); const int tid = tid_l, lane = tid & 63, wave = tid >> 6; const int b = item >> 2, h = item & 3;
    const bf16* z = (const bf16*)(P.ws + WS_Z); bf16* y = (bf16*)(P.ws + WS_Y); const float* ba = (const float*)(P.ws + WS_BA);
    LAS float* qs = (LAS float*)lds; LAS float* ks = qs + 8192; LAS float* vs = ks + 8192; LAS float* ot = vs + 8192; LAS float* bet = ot + 8192; LAS float* egs = bet + 64;
    const float* cw = P.in[I_A_CONV];
    const float a_exp = __expf(P.in[I_A_ALOG][h]), dtb = P.in[I_A_DTB][h];
    float Sreg[32];
#pragma unroll
    for (int i = 0; i < 32; ++i) Sreg[i] = 0.f;
    const int kq = tid & 3, dv = tid >> 2;
    for (int n = 0; n < 64; ++n) {
        const int sb = n * 64; const size_t rb = (size_t)b * SEQ;
        for (int idx = tid; idx < 64 * 384; idx += NTHR) { const int tl = idx / 384, cc = idx % 384, part = cc >> 7, d = cc & 127; const int ch = part * 512 + h * 128 + d, s = sb + tl; float a = 0.f;
#pragma unroll
            for (int kk = 0; kk < 4; ++kk) { const int sp = s - 3 + kk; if (sp >= 0) a += cw[kk * 1536 + ch] * bf2f(z[(rb + sp) * 2560 + 512 + ch]); }
            qs[part * 8192 + tl * 128 + d] = silu_f(a); }
        if (tid < 64) { const size_t t = rb + sb + tid; const float bl = ba[t * 8 + h], al = ba[t * 8 + 4 + h] + dtb; const float sp = al > 20.f ? al : log1pf(__expf(al));
            bet[tid] = sigmoid_f(bl); egs[tid] = __expf(-a_exp * sp); }
        __syncthreads();
        for (int r = wave * 16; r < wave * 16 + 16; ++r) { LAS float* row = qs + (r >> 6) * 8192 + (r & 63) * 128; const float a = row[lane], c2 = row[lane + 64];
            const float sc = rsqrtf(wave_sum(a * a + c2 * c2) + EPS); row[lane] = a * sc; row[lane + 64] = c2 * sc; }
        __syncthreads();
        for (int tl = 0; tl < 64; ++tl) {
            float kr[32], kS = 0.f;
#pragma unroll
            for (int i = 0; i < 8; ++i) { const f32x4 v = *(const LAS f32x4*)(ks + tl * 128 + kq * 32 + 4 * i); kr[4 * i] = v.x; kr[4 * i + 1] = v.y; kr[4 * i + 2] = v.z; kr[4 * i + 3] = v.w; }
#pragma unroll
            for (int i = 0; i < 32; ++i) kS += kr[i] * Sreg[i];
            kS += __shfl_xor(kS, 1); kS += __shfl_xor(kS, 2);
            const float e = egs[tl], cf = bet[tl] * (vs[tl * 128 + dv] - e * kS);
            float o = 0.f;
#pragma unroll
            for (int i = 0; i < 8; ++i) { const f32x4 qv = *(const LAS f32x4*)(qs + tl * 128 + kq * 32 + 4 * i);
                Sreg[4 * i] = e * Sreg[4 * i] + kr[4 * i] * cf; Sreg[4 * i + 1] = e * Sreg[4 * i + 1] + kr[4 * i + 1] * cf; Sreg[4 * i + 2] = e * Sreg[4 * i + 2] + kr[4 * i + 2] * cf; Sreg[4 * i + 3] = e * Sreg[4 * i + 3] + kr[4 * i + 3] * cf;
                o += (qv.x * Sreg[4 * i] + qv.y * Sreg[4 * i + 1]) + (qv.z * Sreg[4 * i + 2] + qv.w * Sreg[4 * i + 3]); }
            o += __shfl_xor(o, 1); o += __shfl_xor(o, 2);
            if (kq == 0) ot[tl * 128 + dv] = o * 0.08838834764831845f;
        }
        __syncthreads();
        for (int tl = wave * 8; tl < wave * 8 + 8; ++tl) { const float a = ot[tl * 128 + lane], c2 = ot[tl * 128 + lane + 64]; const float rs = rsqrtf(wave_sum(a * a + c2 * c2) * (1.f / 128.f) + EPS);
            const size_t t = rb + sb + tl; const float g0 = bf2f(z[t * 2560 + 2048 + h * 128 + lane]), g1 = bf2f(z[t * 2560 + 2048 + h * 128 + lane + 64]);
            y[t * DM + 512 + h * 128 + lane] = (bf16)f2bf(a * rs * P.in[I_A_ONORM][lane] * silu_f(g0));
            y[t * DM + 512 + h * 128 + lane + 64] = (bf16)f2bf(c2 * rs * P.in[I_A_ONORM][lane + 64] * silu_f(g1)); }
        __syncthreads();
    }
}

__device__ __forceinline__ void phase_xatt_naive(const Params& P, LAS unsigned char* lds, int l) {
    int tid_l = threadIdx.x; asm volatile("" : "+v"(tid_l)); const int tid = tid_l, lane = tid & 63, wave = tid >> 6;
    const int gw = blockIdx.x * NWAVES + wave, NGW = gridDim.x * NWAVES;
    const bf16* qx = (const bf16*)(P.ws + WS_QXA); const bf16* kv = (const bf16*)(P.ws + WS_MEMKV) + (size_t)l * 2048 * 2048; bf16* y = (bf16*)(P.ws + WS_Y);
    LAS float* qf = (LAS float*)(lds + wave * 8192); LAS float* pw = qf + 1024;
    for (int t = gw; t < T; t += NGW) { const int b = t >> 12;
        { const v4u a = *(const v4u*)(qx + (size_t)t * DM + lane * 16), c = *(const v4u*)(qx + (size_t)t * DM + lane * 16 + 8); LAS float* d = qf + lane * 16;
          d[0] = bf2f(a.x & 0xffff); d[1] = bf2f(a.x >> 16); d[2] = bf2f(a.y & 0xffff); d[3] = bf2f(a.y >> 16); d[4] = bf2f(a.z & 0xffff); d[5] = bf2f(a.z >> 16); d[6] = bf2f(a.w & 0xffff); d[7] = bf2f(a.w >> 16);
          d[8] = bf2f(c.x & 0xffff); d[9] = bf2f(c.x >> 16); d[10] = bf2f(c.y & 0xffff); d[11] = bf2f(c.y >> 16); d[12] = bf2f(c.z & 0xffff); d[13] = bf2f(c.z >> 16); d[14] = bf2f(c.w & 0xffff); d[15] = bf2f(c.w >> 16); }
        LDS_WAIT();
        for (int hh = 0; hh < 4; ++hh) { float sc[4];
#pragma unroll
            for (int i = 0; i < 4; ++i) { const bf16* kr = kv + (size_t)(b * 256 + lane + 64 * i) * 2048 + hh * 256; float s = 0.f;
                for (int c8 = 0; c8 < 32; ++c8) { const v4u kk = *(const v4u*)(kr + c8 * 8); const f32x4 q0 = *(const LAS f32x4*)(qf + hh * 256 + c8 * 8), q1 = *(const LAS f32x4*)(qf + hh * 256 + c8 * 8 + 4);
                    s += (q0.x * bf2f(kk.x & 0xffff) + q0.y * bf2f(kk.x >> 16)) + (q0.z * bf2f(kk.y & 0xffff) + q0.w * bf2f(kk.y >> 16)) + (q1.x * bf2f(kk.z & 0xffff) + q1.y * bf2f(kk.z >> 16)) + (q1.z * bf2f(kk.w & 0xffff) + q1.w * bf2f(kk.w >> 16)); }
                sc[i] = s * 0.0625f; }
            const float mx = wave_max(fmaxf(fmaxf(sc[0], sc[1]), fmaxf(sc[2], sc[3])));
            float ps = 0.f;
#pragma unroll
            for (int i = 0; i < 4; ++i) { sc[i] = __expf(sc[i] - mx); ps += sc[i]; }
            const float inv = 1.f / wave_sum(ps);
#pragma unroll
            for (int i = 0; i < 4; ++i) pw[lane + 64 * i] = sc[i] * inv;
            LDS_WAIT();
            float o0 = 0.f, o1 = 0.f, o2 = 0.f, o3 = 0.f; const bf16* vb = kv + (size_t)(b * 256) * 2048 + 1024 + hh * 256 + lane * 4;
            for (int j = 0; j < 256; ++j) { const v2u vv = *(const v2u*)(vb + (size_t)j * 2048); const float p = pw[j];
                o0 += p * bf2f(vv.x & 0xffff); o1 += p * bf2f(vv.x >> 16); o2 += p * bf2f(vv.y & 0xffff); o3 += p * bf2f(vv.y >> 16); }
            v2u w; w.x = pk2(o0, o1); w.y = pk2(o2, o3); *(v2u*)(y + (size_t)t * DM + hh * 256 + lane * 4) = w;
            LDS_WAIT();
        }
    }
}

__device__ __forceinline__ void cmpfin_bg(const Params& P, LAS unsigned char* lds, int kvs, int bg) {
    const int tid = threadIdx.x, lane = tid & 63, wave = tid >> 6, q = lane & 31, h = lane >> 5;
    const float* p01 = (const float*)(P.ws + (kvs ? WS_P01V : WS_P01K)) + (size_t)bg * 256 * 256; const float* bias = (const float*)(P.ws + WS_CBIAS) + kvs * 128; const float* w2 = P.in[kvs ? I_C_W2V : I_C_W2K];
    bf16* outp = (bf16*)(P.ws + (kvs ? WS_CV : WS_CK)) + (size_t)bg * 256 * 64;
    LAS unsigned char* Hb = lds;
    LAS unsigned char* Wt = lds + 69632;
    for (int p = tid; p < 256 * 16; p += NTHR) { const int c = p >> 4, j0 = (p & 15) * 8; v4u w = {0u, 0u, 0u, 0u};
        if (c < 255) { const f32x4 a0 = *(const f32x4*)(p01 + (size_t)c * 256 + j0), a1 = *(const f32x4*)(p01 + (size_t)c * 256 + j0 + 4), b0 = *(const f32x4*)(p01 + (size_t)(c + 1) * 256 + 128 + j0), b1 = *(const f32x4*)(p01 + (size_t)(c + 1) * 256 + 128 + j0 + 4);
            const f32x4 c0 = *(const f32x4*)(bias + j0), c1 = *(const f32x4*)(bias + j0 + 4);
            w.x = cvtpk(silu_f(a0.x + b0.x + c0.x), silu_f(a0.y + b0.y + c0.y)); w.y = cvtpk(silu_f(a0.z + b0.z + c0.z), silu_f(a0.w + b0.w + c0.w));
            w.z = cvtpk(silu_f(a1.x + b1.x + c1.x), silu_f(a1.y + b1.y + c1.y)); w.w = cvtpk(silu_f(a1.z + b1.z + c1.z), silu_f(a1.w + b1.w + c1.w)); }
        *(LAS v4u*)(Hb + c * 272 + j0 * 2) = w; }
    for (int p = tid; p < 128 * 64; p += NTHR) { const int j = p >> 6, d = p & 63; *(LAS unsigned short*)(Wt + d * 272 + j * 2) = (unsigned short)f2bf(w2[p]); }
    __syncthreads();
#pragma unroll
    for (int dt = 0; dt < 2; ++dt) { f32x16 acc;
#pragma unroll
        for (int r = 0; r < 16; ++r) acc[r] = 0.f;
#pragma unroll
        for (int ks = 0; ks < 8; ++ks) acc = __builtin_amdgcn_mfma_f32_32x32x16_bf16(*(const LAS bf16x8*)(Wt + (dt * 32 + q) * 272 + ks * 32 + h * 16), *(const LAS bf16x8*)(Hb + (wave * 32 + q) * 272 + ks * 32 + h * 16), acc, 0, 0, 0);
        const int c = wave * 32 + q;
        if (c < 255) {
#pragma unroll
            for (int a = 0; a < 4; ++a) { v2u w; w.x = cvtpk(acc[4 * a], acc[4 * a + 1]); w.y = cvtpk(acc[4 * a + 2], acc[4 * a + 3]); *(v2u*)(outp + (size_t)c * 64 + dt * 32 + 8 * a + 4 * h) = w; } } }
    __syncthreads();
}
__device__ __forceinline__ void dot4(const bf16* kr, const LAS float* qf, float (&s)[4]) {
    s[0] = s[1] = s[2] = s[3] = 0.f;
#pragma unroll
    for (int c8 = 0; c8 < 8; ++c8) { const v4u kk = *(const v4u*)(kr + c8 * 8);
        const float k0 = bf2f(kk.x & 0xffff), k1 = bf2f(kk.x >> 16), k2 = bf2f(kk.y & 0xffff), k3 = bf2f(kk.y >> 16), k4 = bf2f(kk.z & 0xffff), k5 = bf2f(kk.z >> 16), k6 = bf2f(kk.w & 0xffff), k7 = bf2f(kk.w >> 16);
#pragma unroll
        for (int r = 0; r < 4; ++r) { const f32x4 q0 = *(const LAS f32x4*)(qf + r * 64 + c8 * 8), q1 = *(const LAS f32x4*)(qf + r * 64 + c8 * 8 + 4);
            s[r] += ((q0.x * k0 + q0.y * k1) + (q0.z * k2 + q0.w * k3)) + ((q1.x * k4 + q1.y * k5) + (q1.z * k6 + q1.w * k7)); } }
}
__device__ __forceinline__ void phase_nsa_naive(const Params& P, LAS unsigned char* lds) {
    int tid_l = threadIdx.x; asm volatile("" : "+v"(tid_l)); const int tid = tid_l, lane = tid & 63, wave = tid >> 6;
    const int gw = blockIdx.x * NWAVES + wave, NGW = gridDim.x * NWAVES;
    const bf16* qb = (const bf16*)(P.ws + WS_Z); const bf16* kvb = qb + (size_t)T * 1024;
    const bf16* ck = (const bf16*)(P.ws + WS_CK); const bf16* cv = (const bf16*)(P.ws + WS_CV);
    const float* gates = (const float*)(P.ws + WS_GATES); bf16* y = (bf16*)(P.ws + WS_Y);
    LAS float* qf = (LAS float*)(lds + wave * 8192); LAS float* pc = qf + 256; LAS float* ps = pc + 1024;
    for (int it = gw; it < 4 * T; it += NGW) {
        const int t = it & 4095, g = (it >> 12) & 3, b = it >> 14; const size_t tg = (size_t)b * SEQ + t; const int bg = b * 4 + g;
        float slope[4];
#pragma unroll
        for (int r = 0; r < 4; ++r) slope[r] = exp2f(-0.5f * (float)(g * 4 + r + 1));
#pragma unroll
        for (int r = 0; r < 4; ++r) qf[r * 64 + lane] = bf2f(qb[tg * 1024 + g * 256 + r * 64 + lane]);
        LDS_WAIT();
        const int ncv = t >= 31 ? ((t - 31) >> 4) + 1 : 0;
#pragma unroll 1
        for (int cc = 0; cc < 4; ++cc) { const int c = lane + 64 * cc; float s[4] = {0.f, 0.f, 0.f, 0.f};
            if (cc * 64 < ncv) dot4(ck + ((size_t)bg * 256 + c) * 64, qf, s);
#pragma unroll
            for (int r = 0; r < 4; ++r) pc[r * 256 + c] = c < ncv ? s[r] * 0.125f - slope[r] * (float)(t - (16 * c + 31)) : -INFINITY; }
        LDS_WAIT();
#pragma unroll 1
        for (int r = 0; r < 4; ++r) { float v0 = pc[r * 256 + lane], v1 = pc[r * 256 + lane + 64], v2 = pc[r * 256 + lane + 128], v3 = pc[r * 256 + lane + 192];
            const float mx = wave_max(fmaxf(fmaxf(v0, v1), fmaxf(v2, v3)));
            v0 = lane < ncv ? __expf(v0 - mx) : 0.f; v1 = lane + 64 < ncv ? __expf(v1 - mx) : 0.f; v2 = lane + 128 < ncv ? __expf(v2 - mx) : 0.f; v3 = lane + 192 < ncv ? __expf(v3 - mx) : 0.f;
            const float sm = wave_sum((v0 + v1) + (v2 + v3)); const float inv = ncv > 0 ? 1.f / sm : 0.f;
            pc[r * 256 + lane] = v0 * inv; pc[r * 256 + lane + 64] = v1 * inv; pc[r * 256 + lane + 128] = v2 * inv; pc[r * 256 + lane + 192] = v3 * inv; }
        LDS_WAIT();
        float osum[4];
        { float ocmp[4] = {0.f, 0.f, 0.f, 0.f};
          const bf16* cvp = cv + (size_t)bg * 256 * 64 + lane;
#pragma unroll 2
          for (int c = 0; c < ncv; ++c) { const float v = bf2f(cvp[c * 64]);
#pragma unroll
              for (int r = 0; r < 4; ++r) ocmp[r] += pc[r * 256 + c] * v; }
#pragma unroll
          for (int r = 0; r < 4; ++r) osum[r] = sigmoid_f(gates[tg * 48 + (g * 4 + r) * 3]) * ocmp[r]; }
        unsigned long long mask;
        { const int n = lane, cur = t >> 6; float imp = 0.f;
#pragma unroll
          for (int r = 0; r < 4; ++r) { const f32x4 v = *(const LAS f32x4*)(pc + r * 256 + 4 * n); imp += v.x + v.y + v.z + 0.5f * v.w; if (n > 0) imp += 0.5f * pc[r * 256 + 4 * n - 1]; }
          const bool forced = (n == 0) || (n == cur) || (n == cur - 1);
          const float val = forced ? 1e4f : (n <= cur ? imp : -1.f);
          int rank = 0;
#pragma unroll 4
          for (int m = 0; m < 64; ++m) { const float vm = __shfl(val, m); rank += (vm > val || (vm == val && m < n)) ? 1 : 0; }
          mask = __ballot(rank < 16 && n <= cur); }
#pragma unroll 1
        for (int br = 0; br < 2; ++br) {
            const bf16* kp = kvb + (size_t)(br == 0 ? 2 : 4) * KV_KIND + (size_t)bg * SEQ * 64; const bf16* vp = kvb + (size_t)(br == 0 ? 3 : 5) * KV_KIND + (size_t)bg * SEQ * 64;
            float m_[4] = {-INFINITY, -INFINITY, -INFINITY, -INFINITY}, l_[4] = {0.f, 0.f, 0.f, 0.f}, acc[4] = {0.f, 0.f, 0.f, 0.f};
            const int jlo = br == 0 ? 0 : (t >= 511 ? t - 511 : 0);
            unsigned long long todo = br == 0 ? mask : 0ull; int j0 = jlo & ~63;
#pragma unroll 1
            for (;;) {
                if (br == 0) { if (!todo) break; j0 = (__ffsll((long long)todo) - 1) * 64; todo &= todo - 1; } else { if (j0 > t) break; }
                const int j = j0 + lane; const bool valid = j >= jlo && j <= t;
                float s[4]; dot4(kp + (size_t)j * 64, qf, s);
#pragma unroll
                for (int r = 0; r < 4; ++r) { const float sv = valid ? s[r] * 0.125f - slope[r] * (float)(t - j) : -INFINITY; const float mn = fmaxf(m_[r], wave_max(sv));
                    const float p = valid ? __expf(sv - mn) : 0.f; const float f = __expf(m_[r] - mn); l_[r] = l_[r] * f + wave_sum(p); acc[r] *= f; m_[r] = mn; ps[r * 64 + lane] = p; }
                LDS_WAIT();
                const bf16* vr = vp + (size_t)j0 * 64 + lane;
#pragma unroll 2
                for (int jj = 0; jj < 64; jj += 4) { const float v0 = bf2f(vr[jj * 64]), v1 = bf2f(vr[(jj + 1) * 64]), v2 = bf2f(vr[(jj + 2) * 64]), v3 = bf2f(vr[(jj + 3) * 64]);
#pragma unroll
                    for (int r = 0; r < 4; ++r) { const f32x4 pv = *(const LAS f32x4*)(ps + r * 64 + jj); acc[r] += (pv.x * v0 + pv.y * v1) + (pv.z * v2 + pv.w * v3); } }
                LDS_WAIT();
                if (br == 1) j0 += 64;
            }
#pragma unroll
            for (int r = 0; r < 4; ++r) osum[r] += sigmoid_f(gates[tg * 48 + (g * 4 + r) * 3 + 1 + br]) * (acc[r] / l_[r]);
        }
#pragma unroll
        for (int r = 0; r < 4; ++r) y[tg * DM + g * 256 + r * 64 + lane] = (bf16)f2bf(osum[r]);
        LDS_WAIT();
    }
}
constexpr int NSA_KB = 0, NSA_VB = 18432, NSA_IMPA = 34816, NSA_IMPB = 51200, NSA_MASK = 67584, NSA_UNI = 68096;
constexpr float LOG2E_F = 1.4426950408889634f;

__device__ __forceinline__ float quad_sum(float x) {
    x += __int_as_float(__builtin_amdgcn_update_dpp(0, __float_as_int(x), 0xB1, 0xF, 0xF, true));
    x += __int_as_float(__builtin_amdgcn_update_dpp(0, __float_as_int(x), 0x4E, 0xF, 0xF, true));
    return x;
}
__device__ __forceinline__ void nsa_qk(f32x16& p0, f32x16& p1, LAS const unsigned char* kb, const bf16x8 (&qf)[4], int q, int h, const f32x16& init) {
    p0 = init; p1 = init;
#pragma unroll
    for (int ks = 0; ks < 4; ++ks) { const bf16x8 a0 = *(const LAS bf16x8*)(kb + q * 144 + ks * 32 + h * 16), a1 = *(const LAS bf16x8*)(kb + (q + 32) * 144 + ks * 32 + h * 16);
        p0 = __builtin_amdgcn_mfma_f32_32x32x16_bf16(a0, qf[ks], p0, 0, 0, 0); p1 = __builtin_amdgcn_mfma_f32_32x32x16_bf16(a1, qf[ks], p1, 0, 0, 0); }
}
template <bool CHECK> __device__ __forceinline__ void nsa_bias(f32x16& p0, f32x16& p1, float basef, float slopeK, float cst, float klo, float khi, int h) {
    const float C = 1.f; const float i0 = basef + 4.f * (float)h; const float t0v = fmaf(slopeK, i0, cst);
#pragma unroll
    for (int r = 0; r < 16; ++r) { const float off = (float)((r & 3) + 8 * (r >> 2));
        float v0 = fmaf(p0[r], C, fmaf(slopeK, off, t0v)), v1 = fmaf(p1[r], C, fmaf(slopeK, off + 32.f, t0v));
        if (CHECK) { const float x0 = i0 + off, x1 = i0 + off + 32.f; v0 = (x0 >= klo && x0 <= khi) ? v0 : -INFINITY; v1 = (x1 >= klo && x1 <= khi) ? v1 : -INFINITY; }
        p0[r] = v0; p1[r] = v1; }
}
__device__ __forceinline__ float nsa_rowmax(const f32x16& p0, const f32x16& p1) {
    float a = fmaxf(p0[0], p1[0]);
#pragma unroll
    for (int r = 1; r < 16; ++r) a = fmaxf(a, fmaxf(p0[r], p1[r]));
    return fmaxf(a, __shfl_xor(a, 32));
}
__device__ __forceinline__ void nsa_pv(f32x16 (&o)[2], const f32x16& p0, const f32x16& p1, LAS const unsigned char* vb, int lane, int h) {
    bf16x8 pk[4];
#pragma unroll
    for (int s = 0; s < 4; ++s) { v4u w;
        if (s < 2) { w.x = cvtpk(p0[8 * s + 0], p0[8 * s + 1]); w.y = cvtpk(p0[8 * s + 2], p0[8 * s + 3]); w.z = cvtpk(p0[8 * s + 4], p0[8 * s + 5]); w.w = cvtpk(p0[8 * s + 6], p0[8 * s + 7]); }
        else { w.x = cvtpk(p1[8 * (s - 2) + 0], p1[8 * (s - 2) + 1]); w.y = cvtpk(p1[8 * (s - 2) + 2], p1[8 * (s - 2) + 3]); w.z = cvtpk(p1[8 * (s - 2) + 4], p1[8 * (s - 2) + 5]); w.w = cvtpk(p1[8 * (s - 2) + 6], p1[8 * (s - 2) + 7]); }
        pk[s] = __builtin_bit_cast(bf16x8, w); }
    LAS const unsigned char* vp = vb + (4 * h + ((lane & 15) >> 2)) * 64 + ((lane >> 4) & 1) * 32 + (lane & 3) * 8;
#pragma unroll
    for (int dt = 0; dt < 2; ++dt)
#pragma unroll
        for (int s = 0; s < 4; ++s) { const v4i16 lo = __builtin_amdgcn_ds_read_tr16_b64_v4i16((LAS v4i16*)(vp + dt * 4096 + s * 1024)), hi = __builtin_amdgcn_ds_read_tr16_b64_v4i16((LAS v4i16*)(vp + dt * 4096 + s * 1024 + 512));
            const bf16x8 a = (bf16x8){lo[0], lo[1], lo[2], lo[3], hi[0], hi[1], hi[2], hi[3]};
            o[dt] = __builtin_amdgcn_mfma_f32_32x32x16_bf16(a, pk[s], o[dt], 0, 0, 0); }
}
__device__ __forceinline__ void nsa_online(f32x16& p0, f32x16& p1, float& m, float& l, f32x16 (&o)[2]) {
    const float mx = nsa_rowmax(p0, p1), mn = fmaxf(m, mx), mu = (mn == -INFINITY) ? 0.f : mn; const float f = __builtin_amdgcn_exp2f(m - mu);
    float sum = 0.f;
#pragma unroll
    for (int r = 0; r < 16; ++r) { p0[r] = __builtin_amdgcn_exp2f(p0[r] - mu); p1[r] = __builtin_amdgcn_exp2f(p1[r] - mu); sum += p0[r] + p1[r]; }
    l = l * f + sum; m = mn;
    if (__any(f != 1.f)) {
#pragma unroll
        for (int r = 0; r < 16; ++r) { o[0][r] *= f; o[1][r] *= f; } }
}

typedef float f2v __attribute__((ext_vector_type(2)));
__device__ __forceinline__ void nsa_fast(f32x16& p0, f32x16& p1, float c32, float t0v, float& m, float& l, f32x16 (&o)[2]) {
    float mx0 = p0[0], mx1 = p1[0];
#pragma unroll
    for (int r = 1; r < 16; r += 2) { mx0 = __builtin_fmaxf(__builtin_fmaxf(mx0, p0[r]), p0[r < 15 ? r + 1 : r]); mx1 = __builtin_fmaxf(__builtin_fmaxf(mx1, p1[r]), p1[r < 15 ? r + 1 : r]); }
    float mx = __builtin_fmaxf(mx0, mx1 + c32) + t0v; mx = __builtin_fmaxf(mx, __shfl_xor(mx, 32));
    const float mn = __builtin_fmaxf(m, mx), mu = (mn == -INFINITY) ? 0.f : mn; const float f = __builtin_amdgcn_exp2f(m - mu), d = mu - t0v, d1 = d - c32; const f2v d2 = {d, d}, d12 = {d1, d1};
    f2v s2 = {0.f, 0.f};
#pragma unroll
    for (int k = 0; k < 8; ++k) { f2v a = {p0[2 * k], p0[2 * k + 1]}, b = {p1[2 * k], p1[2 * k + 1]}; a = a - d2; b = b - d12;
        a.x = __builtin_amdgcn_exp2f(a.x); a.y = __builtin_amdgcn_exp2f(a.y); b.x = __builtin_amdgcn_exp2f(b.x); b.y = __builtin_amdgcn_exp2f(b.y);
        s2 = s2 + a; s2 = s2 + b; p0[2 * k] = a.x; p0[2 * k + 1] = a.y; p1[2 * k] = b.x; p1[2 * k + 1] = b.y; }
    l = l * f + (s2.x + s2.y); m = mn;
    if (__any(f != 1.f)) {
#pragma unroll
        for (int r = 0; r < 16; ++r) { o[0][r] *= f; o[1][r] *= f; } }
}
__device__ __forceinline__ void nsa_item(const Params& P, LAS unsigned char* lds, int bg, int tile) {
    int tid_l = threadIdx.x; asm volatile("" : "+v"(tid_l)); const int tid = tid_l, lane = tid & 63, wave = tid >> 6, q = lane & 31, h = lane >> 5;
    const int b = bg >> 2, g = bg & 3, t0 = tile * 64, cur = tile;
    const int tl = 8 * wave + (q >> 2), t = t0 + tl, r = q & 3; const size_t tg = (size_t)b * SEQ + t;
    const bf16* qb = (const bf16*)(P.ws + WS_Z); const bf16* kvb = qb + (size_t)T * 1024;
    const bf16* ckp = (const bf16*)(P.ws + WS_CK) + (size_t)bg * 256 * 64; const bf16* cvp = (const bf16*)(P.ws + WS_CV) + (size_t)bg * 256 * 64;
    const bf16* ksp = kvb + 2 * KV_KIND + (size_t)bg * SEQ * 64; const bf16* vsp = kvb + 3 * KV_KIND + (size_t)bg * SEQ * 64;
    const bf16* kwp = kvb + 4 * KV_KIND + (size_t)bg * SEQ * 64; const bf16* vwp = kvb + 5 * KV_KIND + (size_t)bg * SEQ * 64;
    const float* gp = (const float*)(P.ws + WS_GATES) + tg * 48 + (g * 4 + r) * 3;
    LAS float* impA = (LAS float*)(lds + NSA_IMPA); LAS float* impB = (LAS float*)(lds + NSA_IMPB);
    LAS unsigned long long* masks = (LAS unsigned long long*)(lds + NSA_MASK); LAS unsigned long long* uni = (LAS unsigned long long*)(lds + NSA_UNI);
    const int srow = tid >> 3, spc = tid & 7; const unsigned koff = srow * 144 + spc * 16, voff = (spc >> 2) * 4096 + srow * 64 + (spc & 3) * 16; const size_t goff = (size_t)srow * 64 + spc * 8;
    const float slope2 = exp2f(-0.5f * (float)(g * 4 + r + 1)) * LOG2E_F; const float tf = (float)t;
    bf16x8 qf[4];
#pragma unroll
    for (int ks = 0; ks < 4; ++ks) qf[ks] = *(const bf16x8*)(qb + tg * 1024 + g * 256 + r * 64 + 16 * ks + 8 * h);
    { const v4u z4 = {0u, 0u, 0u, 0u};
#pragma unroll
      for (int i = 0; i < 4; ++i) *(LAS v4u*)(lds + NSA_IMPA + (tid * 4 + i) * 16) = z4; }
    if (tid < 8) uni[tid] = 0ull;
    v4u kreg, vreg;
#define KBUF(i) (lds + NSA_KB + (i) * 9216)
#define VBUF(i) (lds + NSA_VB + (i) * 8192)
    f32x16 osum[2], o[2], p0, p1, bo0, zero16;
#pragma unroll
    for (int rr = 0; rr < 16; ++rr) zero16[rr] = 0.f;
    const int nct = (((t0 + 32) >> 4) >> 6) + 1;
    const float cmaxf = t >= 31 ? (float)((t - 31) >> 4) : -1.f; const float cstc = slope2 * (31.f - tf), slopec = 16.f * slope2;
    float m1 = -INFINITY, l1 = 0.f;
    kreg = *(const v4u*)(ckp + (size_t)(nct - 1) * 4096 + goff); *(LAS v4u*)(KBUF(0) + koff) = kreg; __syncthreads();
#pragma unroll 1
    for (int i = 0; i < nct; ++i) { const int ct = nct - 1 - i;
        if (i + 1 < nct) kreg = *(const v4u*)(ckp + (size_t)(ct - 1) * 4096 + goff);
        else { kreg = *(const v4u*)(ckp + (size_t)(nct - 1) * 4096 + goff); vreg = *(const v4u*)(cvp + (size_t)(nct - 1) * 4096 + goff); }
        nsa_qk(p0, p1, KBUF(i & 1), qf, q, h, zero16); nsa_bias<true>(p0, p1, (float)(ct * 64), slopec, cstc, 0.f, cmaxf, h);
        { const float mx = nsa_rowmax(p0, p1), mn = fmaxf(m1, mx), mu = (mn == -INFINITY) ? 0.f : mn; float sum = 0.f;
#pragma unroll
          for (int rr = 0; rr < 16; ++rr) sum += __builtin_amdgcn_exp2f(p0[rr] - mu) + __builtin_amdgcn_exp2f(p1[rr] - mu);
          l1 = l1 * __builtin_amdgcn_exp2f(m1 - mu) + sum; m1 = mn; }
        if (i + 1 < nct) *(LAS v4u*)(KBUF((i + 1) & 1) + koff) = kreg;
        __syncthreads(); }
    l1 += __shfl_xor(l1, 32);
    const float inv1 = l1 > 0.f ? 1.f / l1 : 0.f, mu1 = (m1 == -INFINITY) ? 0.f : m1;
#pragma unroll
    for (int rr = 0; rr < 16; ++rr) { o[0][rr] = 0.f; o[1][rr] = 0.f; }
    *(LAS v4u*)(KBUF(0) + koff) = kreg; *(LAS v4u*)(VBUF(0) + voff) = vreg; __syncthreads();
#pragma unroll 1
    for (int i = 0; i < nct; ++i) { const int ct = nct - 1 - i;
        if (i + 1 < nct) { kreg = *(const v4u*)(ckp + (size_t)(ct - 1) * 4096 + goff); vreg = *(const v4u*)(cvp + (size_t)(ct - 1) * 4096 + goff); }
        else { kreg = *(const v4u*)(ksp + (size_t)cur * 4096 + goff); vreg = *(const v4u*)(vsp + (size_t)cur * 4096 + goff); }
        nsa_qk(p0, p1, KBUF(i & 1), qf, q, h, zero16); nsa_bias<true>(p0, p1, (float)(ct * 64), slopec, cstc, 0.f, cmaxf, h);
#pragma unroll
        for (int rr = 0; rr < 16; ++rr) { p0[rr] = __builtin_amdgcn_exp2f(p0[rr] - mu1) * inv1; p1[rr] = __builtin_amdgcn_exp2f(p1[rr] - mu1) * inv1; }
#pragma unroll
        for (int a = 0; a < 4; ++a) {
            float A0 = quad_sum(p0[4 * a] + p0[4 * a + 1] + p0[4 * a + 2] + 0.5f * p0[4 * a + 3]), B0 = quad_sum(0.5f * p0[4 * a + 3]);
            float A1 = quad_sum(p1[4 * a] + p1[4 * a + 1] + p1[4 * a + 2] + 0.5f * p1[4 * a + 3]), B1 = quad_sum(0.5f * p1[4 * a + 3]);
            if (r == 0) { const int n0 = 16 * ct + 2 * a + h, n1 = n0 + 8; impA[tl * 64 + n0] = A0; impA[tl * 64 + n1] = A1; impB[tl * 64 + n0 + 1] = B0; if (n1 < 63) impB[tl * 64 + n1 + 1] = B1; } }
        nsa_pv(o, p0, p1, VBUF(i & 1), lane, h);
        if (i + 1 < nct) { *(LAS v4u*)(KBUF((i + 1) & 1) + koff) = kreg; *(LAS v4u*)(VBUF((i + 1) & 1) + voff) = vreg; }
        __syncthreads(); }
    { const float g0 = sigmoid_f(gp[0]);
#pragma unroll
      for (int rr = 0; rr < 16; ++rr) { osum[0][rr] = g0 * o[0][rr]; osum[1][rr] = g0 * o[1][rr]; } }
    { const int tkl = lane >> 3, part = lane & 7, tk = 8 * wave + tkl; unsigned key[8];
      { const f32x4 a0 = *(const LAS f32x4*)(impA + tk * 64 + part * 8), a1 = *(const LAS f32x4*)(impA + tk * 64 + part * 8 + 4), b0 = *(const LAS f32x4*)(impB + tk * 64 + part * 8), b1 = *(const LAS f32x4*)(impB + tk * 64 + part * 8 + 4);
        const float im[8] = {a0.x + b0.x, a0.y + b0.y, a0.z + b0.z, a0.w + b0.w, a1.x + b1.x, a1.y + b1.y, a1.z + b1.z, a1.w + b1.w};
#pragma unroll
        for (int e2 = 0; e2 < 8; ++e2) { const int n = part * 8 + e2; const bool forced = (n == 0) || (n == cur) || (n == cur - 1); key[e2] = n <= cur ? (forced ? 0x7F000000u : __float_as_uint(im[e2]) + 1u) : 0u; } }
      unsigned Tk = 0u;
#pragma unroll 1
      for (int bb = 30; bb >= 0; --bb) { const unsigned cand = Tk | (1u << bb); int c = 0;
#pragma unroll
          for (int e2 = 0; e2 < 8; ++e2) c += key[e2] >= cand ? 1 : 0;
          c += __builtin_amdgcn_update_dpp(0, c, 0xB1, 0xF, 0xF, true); c += __builtin_amdgcn_update_dpp(0, c, 0x4E, 0xF, 0xF, true); c += __builtin_amdgcn_update_dpp(0, c, 0x141, 0xF, 0xF, true);
          Tk = c >= 16 ? cand : Tk; }
      int cg = 0, le = 0;
#pragma unroll
      for (int e2 = 0; e2 < 8; ++e2) { cg += key[e2] > Tk ? 1 : 0; le += key[e2] == Tk ? 1 : 0; }
      cg += __builtin_amdgcn_update_dpp(0, cg, 0xB1, 0xF, 0xF, true); cg += __builtin_amdgcn_update_dpp(0, cg, 0x4E, 0xF, 0xF, true); cg += __builtin_amdgcn_update_dpp(0, cg, 0x141, 0xF, 0xF, true);
      int incl = le;
#pragma unroll
      for (int o2 = 1; o2 < 8; o2 <<= 1) { const int v = __shfl_up(incl, o2, 8); if (part >= o2) incl += v; }
      int before = incl - le; const int need = 16 - cg; unsigned byte = 0u;
#pragma unroll
      for (int e2 = 0; e2 < 8; ++e2) { const bool eq = key[e2] == Tk; const bool selb = (key[e2] > Tk || (eq && before < need)) && (part * 8 + e2 <= cur); before += eq ? 1 : 0; byte |= selb ? (1u << e2) : 0u; }
      ((LAS unsigned char*)masks)[tk * 8 + part] = (unsigned char)byte;
      __hip_atomic_fetch_or(uni, (unsigned long long)byte << (8 * part), __ATOMIC_RELAXED, __HIP_MEMORY_SCOPE_WORKGROUP); }
    __syncthreads();
    unsigned long long todo = uni[0]; const unsigned long long mymask = masks[tl];
#define NSA_LOAD(kp_, vp_, n_) { kreg = *(const v4u*)((kp_) + (size_t)(n_) * 4096 + goff); vreg = *(const v4u*)((vp_) + (size_t)(n_) * 4096 + goff); }
#define NSA_STORE(i_) { *(LAS v4u*)(KBUF((i_) & 1) + koff) = kreg; *(LAS v4u*)(VBUF((i_) & 1) + voff) = vreg; }
#define NSA_FAST(i_, t0v_) { nsa_qk(p0, p1, KBUF((i_) & 1), qf, q, h, bo0); nsa_fast(p0, p1, 32.f * slope2, (t0v_), m, l, o); nsa_pv(o, p0, p1, VBUF((i_) & 1), lane, h); }
#define NSA_STEP(CHECK_, i_, basef_, cst_, klo_, khi_) { nsa_qk(p0, p1, KBUF((i_) & 1), qf, q, h, zero16); nsa_bias<CHECK_>(p0, p1, (basef_), slope2, (cst_), (klo_), (khi_), h); nsa_online(p0, p1, m, l, o); nsa_pv(o, p0, p1, VBUF((i_) & 1), lane, h); }
    {
        float m = -INFINITY, l = 0.f; const float cst = -slope2 * tf;
#pragma unroll
        for (int rr = 0; rr < 16; ++rr) { o[0][rr] = 0.f; o[1][rr] = 0.f; bo0[rr] = slope2 * (float)((rr & 3) + 8 * (rr >> 2)); }
        todo &= ~(1ull << cur);
        NSA_STORE(0) __syncthreads();
        int i = 0, nn = todo ? 63 - __clzll((long long)todo) : -1; if (nn >= 0) todo &= ~(1ull << nn);
        if (nn >= 0) NSA_LOAD(ksp, vsp, nn) else NSA_LOAD(kwp, vwp, tile)
        NSA_STEP(true, 0, (float)(cur * 64), cst, 0.f, tf)
        if (nn >= 0) NSA_STORE(1)
        __syncthreads();
#pragma unroll 1
        while (nn >= 0) { const int n = nn; ++i; nn = todo ? 63 - __clzll((long long)todo) : -1; if (nn >= 0) todo &= ~(1ull << nn);
            if (nn >= 0) NSA_LOAD(ksp, vsp, nn) else NSA_LOAD(kwp, vwp, tile)
            const bool sel = (mymask >> n) & 1ull;
            NSA_FAST(i, sel ? fmaf(slope2, (float)(n * 64 + 4 * h), cst) : -INFINITY)
            if (nn >= 0) NSA_STORE(i + 1)
            __syncthreads(); }
        l += __shfl_xor(l, 32); const float gs = sigmoid_f(gp[1]) / l;
#pragma unroll
        for (int rr = 0; rr < 16; ++rr) { osum[0][rr] += gs * o[0][rr]; osum[1][rr] += gs * o[1][rr]; }
    }
    {
        float m = -INFINITY, l = 0.f; const float cst = -slope2 * tf;
#pragma unroll
        for (int rr = 0; rr < 16; ++rr) { o[0][rr] = 0.f; o[1][rr] = 0.f; }
        const int nw = tile < 8 ? tile + 1 : 9, nmid = nw < 8 ? nw : 8;
        NSA_STORE(0) __syncthreads();
        if (nw > 1) NSA_LOAD(kwp, vwp, tile - 1)
        NSA_STEP(true, 0, (float)(tile * 64), cst, 0.f, tf)
        if (nw > 1) NSA_STORE(1)
        __syncthreads();
#pragma unroll 1
        for (int i = 1; i < nmid; ++i) { const int jt = tile - i;
            if (i + 1 < nw) NSA_LOAD(kwp, vwp, jt - 1)
            NSA_FAST(i, fmaf(slope2, (float)(jt * 64 + 4 * h), cst))
            if (i + 1 < nw) NSA_STORE(i + 1)
            __syncthreads(); }
        if (nw == 9) { NSA_STEP(true, 8, (float)((tile - 8) * 64), cst, tf - 511.f, 1e9f) __syncthreads(); }
        l += __shfl_xor(l, 32); const float gs = sigmoid_f(gp[2]) / l;
#pragma unroll
        for (int rr = 0; rr < 16; ++rr) { osum[0][rr] += gs * o[0][rr]; osum[1][rr] += gs * o[1][rr]; }
    }
#undef NSA_LOAD
#undef NSA_STORE
#undef NSA_STEP
#undef NSA_FAST
    { bf16* yp = (bf16*)(P.ws + WS_Y) + tg * DM + g * 256 + r * 64 + 4 * h;
#pragma unroll
      for (int dt = 0; dt < 2; ++dt)
#pragma unroll
          for (int a = 0; a < 4; ++a) { v2u w; w.x = cvtpk(osum[dt][4 * a], osum[dt][4 * a + 1]); w.y = cvtpk(osum[dt][4 * a + 2], osum[dt][4 * a + 3]); *(v2u*)(yp + dt * 32 + a * 8) = w; } }
#undef KBUF
#undef VBUF
}
__device__ __forceinline__ void phase_nsa(const Params& P, LAS unsigned char* lds) {
    for (int it = blockIdx.x; it < 2048; it += gridDim.x) { const int rnd = it / 256, c = it % 256; const int bg = c & 31, tile = 63 - 8 * rnd - (c >> 5); nsa_item(P, lds, bg, tile); }
}

__device__ __forceinline__ void xatt_item(const Params& P, LAS unsigned char* lds, int l, int bh, int blk) {
    int tid_l = threadIdx.x; asm volatile("" : "+v"(tid_l)); const int tid = tid_l, lane = tid & 63, wave = tid >> 6, q = lane & 31, h = lane >> 5;
    const int b = bh >> 2, hh = bh & 3; const size_t t = (size_t)b * SEQ + blk * 256 + wave * 32 + q;
    const bf16* kvp = (const bf16*)(P.ws + WS_MEMKV) + (size_t)(b * 256) * 4096 + l * 2048 + hh * 256;
    const bf16* qp = (const bf16*)(P.ws + WS_QXA) + t * DM + hh * 256 + 8 * h;
#pragma unroll
    for (int half = 0; half < 2; ++half) { v4u kr[8];
#pragma unroll
        for (int i = 0; i < 8; ++i) { const int p = tid + 512 * (half * 8 + i); kr[i] = *(const v4u*)(kvp + (size_t)(p >> 5) * 4096 + (p & 31) * 8); }
#pragma unroll
        for (int i = 0; i < 8; ++i) { const int p = tid + 512 * (half * 8 + i); *(LAS v4u*)(lds + (p >> 5) * 528 + (p & 31) * 16) = kr[i]; } }
    bf16x8 qf[16];
#pragma unroll
    for (int ks = 0; ks < 16; ++ks) qf[ks] = *(const bf16x8*)(qp + 16 * ks);
    __syncthreads();
    const float C = 0.0625f * LOG2E_F;
    v4u pk[16]; float m = 0.f, lsum = 0.f, f0 = 1.f;
#pragma unroll
    for (int half = 0; half < 2; ++half) {
        f32x16 s[4];
#pragma unroll
        for (int kt = 0; kt < 4; ++kt) {
#pragma unroll
            for (int r = 0; r < 16; ++r) s[kt][r] = 0.f;
            LAS const unsigned char* kb = lds + (half * 128 + kt * 32 + q) * 528 + h * 16;
#pragma unroll
            for (int ks = 0; ks < 16; ++ks) s[kt] = __builtin_amdgcn_mfma_f32_32x32x16_bf16(*(const LAS bf16x8*)(kb + ks * 32), qf[ks], s[kt], 0, 0, 0); }
        float mx = s[0][0];
#pragma unroll
        for (int kt = 0; kt < 4; ++kt)
#pragma unroll
            for (int r = 0; r < 16; ++r) mx = fmaxf(mx, s[kt][r]);
        mx = fmaxf(mx, __shfl_xor(mx, 32)) * C;
        const float mn = half == 0 ? mx : fmaxf(m, mx);
        if (half == 1) { f0 = __builtin_amdgcn_exp2f(m - mn); lsum *= f0; }
        m = mn;
        float sum = 0.f;
#pragma unroll
        for (int kt = 0; kt < 4; ++kt) {
#pragma unroll
            for (int r = 0; r < 16; ++r) { s[kt][r] = __builtin_amdgcn_exp2f(fmaf(s[kt][r], C, -mn)); sum += s[kt][r]; }
#pragma unroll
            for (int e = 0; e < 2; ++e) { v4u w; w.x = cvtpk(s[kt][8 * e + 0], s[kt][8 * e + 1]); w.y = cvtpk(s[kt][8 * e + 2], s[kt][8 * e + 3]); w.z = cvtpk(s[kt][8 * e + 4], s[kt][8 * e + 5]); w.w = cvtpk(s[kt][8 * e + 6], s[kt][8 * e + 7]); pk[half * 8 + kt * 2 + e] = w; } }
        lsum += sum;
    }
    lsum += __shfl_xor(lsum, 32); const float invl = 1.f / lsum;
    __syncthreads();
#pragma unroll
    for (int c = 0; c < 2; ++c) { v4u vr[8];
#pragma unroll
        for (int i = 0; i < 8; ++i) { const int p = tid + 512 * i; vr[i] = *(const v4u*)(kvp + 1024 + (size_t)(p >> 4) * 4096 + c * 128 + (p & 15) * 8); }
#pragma unroll
        for (int i = 0; i < 8; ++i) { const int p = tid + 512 * i; *(LAS v4u*)(lds + c * 65536 + ((p & 15) >> 2) * 16384 + (p >> 4) * 64 + (p & 3) * 16) = vr[i]; } }
    __syncthreads();
    bf16* yp = (bf16*)(P.ws + WS_Y) + t * DM + hh * 256 + 4 * h;
    LAS const unsigned char* vp = lds + (4 * h + ((lane & 15) >> 2)) * 64 + ((lane >> 4) & 1) * 32 + (lane & 3) * 8;
#pragma unroll 1
    for (int dt = 0; dt < 8; ++dt) { f32x16 o;
#pragma unroll
        for (int r = 0; r < 16; ++r) o[r] = 0.f;
        LAS const unsigned char* vd = vp + dt * 16384;
#pragma unroll
        for (int s = 0; s < 8; ++s) { const v4i16 lo = __builtin_amdgcn_ds_read_tr16_b64_v4i16((LAS v4i16*)(vd + s * 1024)), hi = __builtin_amdgcn_ds_read_tr16_b64_v4i16((LAS v4i16*)(vd + s * 1024 + 512));
            o = __builtin_amdgcn_mfma_f32_32x32x16_bf16((bf16x8){lo[0], lo[1], lo[2], lo[3], hi[0], hi[1], hi[2], hi[3]}, __builtin_bit_cast(bf16x8, pk[s]), o, 0, 0, 0); }
#pragma unroll
        for (int r = 0; r < 16; ++r) o[r] *= f0;
#pragma unroll
        for (int s = 8; s < 16; ++s) { const v4i16 lo = __builtin_amdgcn_ds_read_tr16_b64_v4i16((LAS v4i16*)(vd + s * 1024)), hi = __builtin_amdgcn_ds_read_tr16_b64_v4i16((LAS v4i16*)(vd + s * 1024 + 512));
            o = __builtin_amdgcn_mfma_f32_32x32x16_bf16((bf16x8){lo[0], lo[1], lo[2], lo[3], hi[0], hi[1], hi[2], hi[3]}, __builtin_bit_cast(bf16x8, pk[s]), o, 0, 0, 0); }
#pragma unroll
        for (int a = 0; a < 4; ++a) { v2u w; w.x = cvtpk(o[4 * a] * invl, o[4 * a + 1] * invl); w.y = cvtpk(o[4 * a + 2] * invl, o[4 * a + 3] * invl); *(v2u*)(yp + dt * 32 + a * 8) = w; } }
    __syncthreads();
}
__device__ __forceinline__ void phase_xatt(const Params& P, LAS unsigned char* lds, int l) {
    for (int it = blockIdx.x; it < 512; it += gridDim.x) { const int c = it % 256, k = it / 256; xatt_item(P, lds, l, c & 31, (c >> 5) + 8 * k); }
}

constexpr size_t WS_DN = 344 * MiB, DN_CHUNK_BYTES = 73728, WS_EGL = 488 * MiB;
constexpr int DNA_RHS = 0, DNA_QB = 65536, DNA_KB = 82944, DNA_AM = 100352, DNA_SSQ = 118784, DNA_GC = 126976;
__device__ __forceinline__ void dna_item(const Params& P, LAS unsigned char* lds, int item) {
    int tid_l = threadIdx.x; asm volatile("" : "+v"(tid_l)); const int tid = tid_l, lane = tid & 63, wave = tid >> 6;
    const int bh = item >> 6, n = item & 63, b = bh >> 2, h = bh & 3, sb = n * 64; const size_t rb = (size_t)b * SEQ;
    const bf16* z = (const bf16*)(P.ws + WS_Z); const float* ba = (const float*)(P.ws + WS_BA); const float* cw = P.in[I_A_CONV];
    unsigned char* ob = P.ws + WS_DN + (size_t)item * DN_CHUNK_BYTES;
    LAS float* rhs = (LAS float*)(lds + DNA_RHS); LAS float* Am = (LAS float*)(lds + DNA_AM); LAS float* ssq = (LAS float*)(lds + DNA_SSQ);
    LAS float* gcs = (LAS float*)(lds + DNA_GC); LAS float* bet = gcs + 64; LAS float* egc = gcs + 128; LAS float* ekd = gcs + 192;
    const float SC = 0.08838834764831845f;
    { const int gd = tid & 15, tq = tid >> 4, d0 = gd * 8;
      f32x4 wa[3][4][2]; v4u za[3][2][4];
#pragma unroll
      for (int part = 0; part < 3; ++part) { const int ch0 = part * 512 + h * 128 + d0;
#pragma unroll
          for (int kk = 0; kk < 4; ++kk) { wa[part][kk][0] = *(const f32x4*)(cw + kk * 1536 + ch0); wa[part][kk][1] = *(const f32x4*)(cw + kk * 1536 + ch0 + 4); }
#pragma unroll
          for (int tt = 0; tt < 2; ++tt)
#pragma unroll
              for (int kk = 0; kk < 4; ++kk) { const int sp = sb + tq + 32 * tt - 3 + kk; za[part][tt][kk] = (v4u){0u, 0u, 0u, 0u}; if (sp >= 0) za[part][tt][kk] = *(const v4u*)(z + (rb + sp) * 2560 + 512 + ch0); } }
      __builtin_amdgcn_sched_barrier(0);
    if (wave == 0) { const size_t t = rb + sb + lane; const float bl = ba[t * 8 + h], al = ba[t * 8 + 4 + h] + P.in[I_A_DTB][h]; const float sp = al > 20.f ? al : log1pf(__expf(al));
        float g = -__expf(P.in[I_A_ALOG][h]) * sp;
#pragma unroll
        for (int o = 1; o < 64; o <<= 1) { const float v = __shfl_up(g, o); if (lane >= o) g += v; }
        const float gl = __shfl(g, 63);
        gcs[lane] = g; bet[lane] = sigmoid_f(bl); egc[lane] = __expf(g); ekd[lane] = __expf(gl - g);
        if (lane == 63) ((float*)(P.ws + WS_EGL))[item] = __expf(g); }
      __syncthreads();
#pragma unroll
      for (int part = 0; part < 3; ++part) {
#pragma unroll
          for (int tt = 0; tt < 2; ++tt) { const int tl = tq + 32 * tt;
              float a[8];
#pragma unroll
              for (int e2 = 0; e2 < 8; ++e2) a[e2] = 0.f;
#pragma unroll
              for (int kk = 0; kk < 4; ++kk) { const v4u zv = za[part][tt][kk]; const f32x4 w0 = wa[part][kk][0], w1 = wa[part][kk][1];
                  a[0] += w0.x * bf2f(zv.x & 0xffff); a[1] += w0.y * bf2f(zv.x >> 16); a[2] += w0.z * bf2f(zv.y & 0xffff); a[3] += w0.w * bf2f(zv.y >> 16);
                  a[4] += w1.x * bf2f(zv.z & 0xffff); a[5] += w1.y * bf2f(zv.z >> 16); a[6] += w1.z * bf2f(zv.w & 0xffff); a[7] += w1.w * bf2f(zv.w >> 16); }
              float q2 = 0.f;
#pragma unroll
              for (int e2 = 0; e2 < 8; ++e2) { a[e2] = a[e2] * __builtin_amdgcn_rcpf(1.f + __builtin_amdgcn_exp2f(-LOG2E_F * a[e2])); q2 += a[e2] * a[e2]; }
              if (part < 2) {
                  q2 += __shfl_xor(q2, 1); q2 += __shfl_xor(q2, 2); q2 += __shfl_xor(q2, 4); q2 += __shfl_xor(q2, 8);
                  const float rs = rsqrtf(q2 + EPS);
#pragma unroll
                  for (int e2 = 0; e2 < 8; ++e2) a[e2] *= rs;
                  v4u wv; wv.x = cvtpk(a[0], a[1]); wv.y = cvtpk(a[2], a[3]); wv.z = cvtpk(a[4], a[5]); wv.w = cvtpk(a[6], a[7]);
                  *(LAS v4u*)(lds + (part == 0 ? DNA_QB : DNA_KB) + tl * 272 + d0 * 2) = wv;
                  if (part == 0) { const float f = SC * egc[tl]; v4u g4; g4.x = cvtpk(a[0] * f, a[1] * f); g4.y = cvtpk(a[2] * f, a[3] * f); g4.z = cvtpk(a[4] * f, a[5] * f); g4.w = cvtpk(a[6] * f, a[7] * f);
                      *(v4u*)(ob + 16384 + (((tl >> 4) * 4 + (d0 >> 5)) * 64 + (tl & 15) + 16 * ((d0 >> 3) & 3)) * 16) = g4; }
                  else { const float f = ekd[tl], fb = bet[tl] * egc[tl];
                      *(LAS f32x4*)(rhs + tl * 256 + d0) = (f32x4){a[0] * fb, a[1] * fb, a[2] * fb, a[3] * fb}; *(LAS f32x4*)(rhs + tl * 256 + d0 + 4) = (f32x4){a[4] * fb, a[5] * fb, a[6] * fb, a[7] * fb};
                      bf16* kd = (bf16*)(ob + 32768) + ((((d0 >> 4) * 2 + (tl >> 5)) * 64 + 16 * ((tl >> 3) & 3)) * 8) + (tl & 7);
#pragma unroll
                      for (int e2 = 0; e2 < 8; ++e2) kd[(((d0 & 15) + e2) * 8)] = (bf16)f2bf(a[e2] * f); } }
              else { const float fb = bet[tl];
                  *(LAS f32x4*)(rhs + tl * 256 + 128 + d0) = (f32x4){a[0] * fb, a[1] * fb, a[2] * fb, a[3] * fb}; *(LAS f32x4*)(rhs + tl * 256 + 128 + d0 + 4) = (f32x4){a[4] * fb, a[5] * fb, a[6] * fb, a[7] * fb}; } } } }
    __syncthreads();
    if (wave < 6) { const int isq = wave >= 3, jb = wave - 3 * isq, it = jb >= 1, jt = jb == 2; const int q = lane & 31, hh = lane >> 5;
        f32x16 d;
#pragma unroll
        for (int r = 0; r < 16; ++r) d[r] = 0.f;
        LAS const unsigned char* ap = lds + (isq ? DNA_QB : DNA_KB) + (it * 32 + q) * 272 + hh * 16; LAS const unsigned char* bp = lds + DNA_KB + (jt * 32 + q) * 272 + hh * 16;
#pragma unroll
        for (int ks = 0; ks < 8; ++ks) d = __builtin_amdgcn_mfma_f32_32x32x16_bf16(*(const LAS bf16x8*)(ap + ks * 32), *(const LAS bf16x8*)(bp + ks * 32), d, 0, 0, 0);
        const int j = jt * 32 + q; const float gj = gcs[j];
#pragma unroll
        for (int r = 0; r < 16; ++r) { const int i = it * 32 + (r & 3) + 8 * (r >> 2) + 4 * hh; const float dec = __expf(fminf(gcs[i] - gj, 0.f));
            if (!isq) Am[(j & 1) * 2304 + i * 36 + (j >> 1)] = i > j ? d[r] * bet[i] * dec : 0.f;
            else ((bf16*)(ob + 65536))[((((i >> 4) * 2 + (j >> 5)) * 64 + (i & 15) + 16 * ((j >> 3) & 3)) * 8) + (j & 7)] = (bf16)f2bf(i >= j ? d[r] * SC * dec : 0.f); } }
    else if (wave == 6) { const v4u z4 = {0u, 0u, 0u, 0u}; *(v4u*)(ob + 65536 + ((0 * 2 + 1) * 64 + lane) * 16) = z4; *(v4u*)(ob + 65536 + ((1 * 2 + 1) * 64 + lane) * 16) = z4; }
    __syncthreads();
    if (tid < 256) { const int cp = tid >> 1, par = tid & 1, c = 2 * cp; LAS const float* Ap = Am + par * 2304; f2v x[32];
#pragma unroll
      for (int jj = 0; jj < 32; ++jj) x[jj] = (f2v){0.f, 0.f};
      f32x4 ab[2][8]; f2v rb[2]; f2v xl[4] = {{0.f, 0.f}, {0.f, 0.f}, {0.f, 0.f}, {0.f, 0.f}};
      rb[0] = *(const LAS f2v*)(rhs + c);
      unsigned* wp = (unsigned*)((bf16*)ob + (((c >> 5) * 64 + 16 * ((c >> 3) & 3)) * 8) + (c & 7));
      const int dv = c - 128; unsigned char* up = ob + 49152 + (((dv >> 4) * 4) * 64 + (dv & 15)) * 8;
#pragma unroll
      for (int i = 0; i < 64; ++i) {
          if (i + 1 < 64) {
#pragma unroll
              for (int j4 = 0; j4 < ((i + 2) / 2 + 3) / 4; ++j4) ab[(i + 1) & 1][j4] = *(const LAS f32x4*)(Ap + (i + 1) * 36 + 4 * j4);
              rb[(i + 1) & 1] = *(const LAS f2v*)(rhs + (i + 1) * 256 + c); }
          __builtin_amdgcn_sched_barrier(0);
          f2v ac4[4] = {{0.f, 0.f}, {0.f, 0.f}, {0.f, 0.f}, {0.f, 0.f}};
#pragma unroll
          for (int jj = 0; jj < (i + 1) / 2; ++jj) { const float a = ab[i & 1][jj >> 2][jj & 3]; ac4[jj & 3] = ac4[jj & 3] + (f2v){a, a} * x[jj]; }
          f2v acc = (ac4[0] + ac4[1]) + (ac4[2] + ac4[3]);
          acc.x += __int_as_float(__builtin_amdgcn_update_dpp(0, __float_as_int(acc.x), 0xB1, 0xF, 0xF, true)); acc.y += __int_as_float(__builtin_amdgcn_update_dpp(0, __float_as_int(acc.y), 0xB1, 0xF, 0xF, true));
          const f2v xi = rb[i & 1] - acc;
          x[i >> 1] = ((i & 1) == par) ? xi : x[i >> 1];
          xl[i & 3] = xi;
          if (tid < 128) { if ((i & 1) == par) wp[(((i >> 4) * 4) * 64 + (i & 15)) * 4] = cvtpk(xi.x, xi.y); }
          else if ((i & 3) == 3 && ((i >> 2) & 1) == par) { v2u w0, w1; w0.x = cvtpk(xl[0].x, xl[1].x); w0.y = cvtpk(xl[2].x, xl[3].x); w1.x = cvtpk(xl[0].y, xl[1].y); w1.y = cvtpk(xl[2].y, xl[3].y);
              unsigned char* u0 = up + (((i >> 2) >> 2) * 64 + 16 * ((i >> 2) & 3)) * 8; *(v2u*)u0 = w0; *(v2u*)(u0 + 8) = w1; }
          __builtin_amdgcn_sched_barrier(0);
      } }
    __syncthreads();
}
__device__ __forceinline__ void phase_dna(const Params& P, LAS unsigned char* lds) { for (int it = blockIdx.x; it < 2048; it += gridDim.x) dna_item(P, lds, it); }

typedef float f32x4v __attribute__((ext_vector_type(4)));
template <bool HI> struct DnFrag { bf16x8 m1[4]; bf16x8 x2[2]; bf16x8 kd[2]; float eg; };
template <bool HI> __device__ __forceinline__ void dnb_load(DnFrag<HI>& f, const unsigned char* base, const float* egl, int n, int wave, int lane, int sl) {
    const unsigned char* cb = base + (size_t)n * DN_CHUNK_BYTES; const int ct = wave & 3;
    const unsigned char* m1 = cb + (HI ? 16384 : 0) + ((ct * 4) * 64 + lane) * 16;
#pragma unroll
    for (int ks = 0; ks < 4; ++ks) f.m1[ks] = *(const bf16x8*)(m1 + ks * 1024);
#pragma unroll
    for (int ks = 0; ks < 2; ++ks) f.kd[ks] = *(const bf16x8*)(cb + 32768 + ((wave * 2 + ks) * 64 + lane) * 16);
    if (HI) {
#pragma unroll
        for (int ks = 0; ks < 2; ++ks) f.x2[ks] = *(const bf16x8*)(cb + 65536 + ((ct * 2 + ks) * 64 + lane) * 16); }
    else { const v2u uu = *(const v2u*)(cb + 49152 + ((sl * 4 + ct) * 64 + lane) * 8); f.x2[0] = __builtin_bit_cast(bf16x8, (v4u){uu.x, uu.y, 0u, 0u}); }
    f.eg = egl[n];
}
template <bool HI> __device__ __forceinline__ void dnb_loop(const unsigned char* base, const float* egl, bf16* yo, LAS unsigned char* lds, int wave, int lane, int sl) {
    const int ct = wave & 3; LAS unsigned char* St = lds; LAS unsigned char* vnT = lds + 4352;
    LAS const unsigned char* stb = St + (lane & 15) * 272 + (lane >> 4) * 16; LAS const unsigned char* vnb = vnT + (lane & 15) * 144 + (lane >> 4) * 16;
    f32x4v Sacc = {0.f, 0.f, 0.f, 0.f};
    DnFrag<HI> fr[4];
#pragma unroll
    for (int u = 0; u < 4; ++u) dnb_load<HI>(fr[u], base, egl, u, wave, lane, sl);
    __syncthreads();
#pragma unroll 1
    for (int n0 = 0; n0 < 64; n0 += 4) {
#pragma unroll
        for (int u = 0; u < 4; ++u) { const int n = n0 + u;
            f32x4v acc = {0.f, 0.f, 0.f, 0.f};
#pragma unroll
            for (int ks = 0; ks < 4; ++ks) acc = __builtin_amdgcn_mfma_f32_16x16x32_bf16(fr[u].m1[ks], *(const LAS bf16x8*)(stb + ks * 64), acc, 0, 0, 0);
            if (!HI) { const v4u uu = __builtin_bit_cast(v4u, fr[u].x2[0]); const float u0 = bf2f(uu.x & 0xffff), u1 = bf2f(uu.x >> 16), u2 = bf2f(uu.y & 0xffff), u3 = bf2f(uu.y >> 16);
                v2u w; w.x = cvtpk(u0 - acc[0], u1 - acc[1]); w.y = cvtpk(u2 - acc[2], u3 - acc[3]); *(LAS v2u*)(vnT + (lane & 15) * 144 + (16 * ct + 4 * (lane >> 4)) * 2) = w; }
            __syncthreads();
            const bf16x8 v0 = *(const LAS bf16x8*)(vnb), v1 = *(const LAS bf16x8*)(vnb + 64);
            if (HI) { acc = __builtin_amdgcn_mfma_f32_16x16x32_bf16(fr[u].x2[0], v0, acc, 0, 0, 0); acc = __builtin_amdgcn_mfma_f32_16x16x32_bf16(fr[u].x2[1], v1, acc, 0, 0, 0);
                bf16* yp = yo + (size_t)n * 64 * DM;
#pragma unroll
                for (int r = 0; r < 4; ++r) yp[(size_t)r * DM] = (bf16)f2bf(acc[r]); }
            Sacc = Sacc * fr[u].eg;
            Sacc = __builtin_amdgcn_mfma_f32_16x16x32_bf16(fr[u].kd[0], v0, Sacc, 0, 0, 0); Sacc = __builtin_amdgcn_mfma_f32_16x16x32_bf16(fr[u].kd[1], v1, Sacc, 0, 0, 0);
            { v2u w; w.x = cvtpk(Sacc[0], Sacc[1]); w.y = cvtpk(Sacc[2], Sacc[3]); *(LAS v2u*)(St + (lane & 15) * 272 + (16 * wave + 4 * (lane >> 4)) * 2) = w; }
            dnb_load<HI>(fr[u], base, egl, n + 4 < 64 ? n + 4 : 63, wave, lane, sl);
            __syncthreads();
        }
    }
}
__device__ __forceinline__ void phase_dnb(const Params& P, LAS unsigned char* lds) {
    int tid_l = threadIdx.x; asm volatile("" : "+v"(tid_l)); const int tid = tid_l, lane = tid & 63, wave = __builtin_amdgcn_readfirstlane(tid >> 6);
    const int x = blockIdx.x; if (x >= 256) return;
    const int xcd = x & 7, idx = x >> 3, bh = xcd * 4 + (idx >> 3), sl = idx & 7, b = bh >> 2, h = bh & 3, ct = wave & 3;
    const unsigned char* base = P.ws + WS_DN + (size_t)bh * 64 * DN_CHUNK_BYTES; const float* egl = (const float*)(P.ws + WS_EGL) + bh * 64;
    bf16* yo = (bf16*)(P.ws + WS_Y) + ((size_t)b * SEQ + 16 * ct + 4 * (lane >> 4)) * DM + 512 + h * 128 + sl * 16 + (lane & 15);
    if (tid < 272) *(LAS v4u*)(lds + tid * 16) = (v4u){0u, 0u, 0u, 0u};
    if (wave < 4) dnb_loop<false>(base, egl, yo, lds, wave, lane, sl); else dnb_loop<true>(base, egl, yo, lds, wave, lane, sl);
}
__device__ __forceinline__ void phase_dnc(const Params& P, LAS unsigned char* lds) {
    int tid_l = threadIdx.x; asm volatile("" : "+v"(tid_l)); const int tid = tid_l, lane = tid & 63, wave = tid >> 6;
    const int gw = blockIdx.x * NWAVES + wave, NGW = gridDim.x * NWAVES;
    const bf16* z = (const bf16*)(P.ws + WS_Z); bf16* y = (bf16*)(P.ws + WS_Y);
    float on[8];
#pragma unroll
    for (int e = 0; e < 8; ++e) on[e] = P.in[I_A_ONORM][(lane & 15) * 8 + e];
    for (int it0 = gw; it0 < T; it0 += 4 * NGW) {
        const int hh = lane >> 4, d0 = (lane & 15) * 8; v4u ov[4], gv[4];
#pragma unroll
        for (int u = 0; u < 4; ++u) { const int it = it0 + u * NGW; if (it < T) { ov[u] = *(const v4u*)(y + (size_t)it * DM + 512 + hh * 128 + d0); gv[u] = *(const v4u*)(z + (size_t)it * 2560 + 2048 + hh * 128 + d0); } }
#pragma unroll
        for (int u = 0; u < 4; ++u) { const int it = it0 + u * NGW; if (it >= T) break;
            float o[8] = {bf2f(ov[u].x & 0xffff), bf2f(ov[u].x >> 16), bf2f(ov[u].y & 0xffff), bf2f(ov[u].y >> 16), bf2f(ov[u].z & 0xffff), bf2f(ov[u].z >> 16), bf2f(ov[u].w & 0xffff), bf2f(ov[u].w >> 16)};
            const float g[8] = {bf2f(gv[u].x & 0xffff), bf2f(gv[u].x >> 16), bf2f(gv[u].y & 0xffff), bf2f(gv[u].y >> 16), bf2f(gv[u].z & 0xffff), bf2f(gv[u].z >> 16), bf2f(gv[u].w & 0xffff), bf2f(gv[u].w >> 16)};
            float s = 0.f;
#pragma unroll
            for (int e = 0; e < 8; ++e) s += o[e] * o[e];
            s += __shfl_xor(s, 1); s += __shfl_xor(s, 2); s += __shfl_xor(s, 4); s += __shfl_xor(s, 8);
            const float rs = rsqrtf(s * (1.f / 128.f) + EPS);
#pragma unroll
            for (int e = 0; e < 8; ++e) o[e] = o[e] * rs * on[e] * (g[e] * __builtin_amdgcn_rcpf(1.f + __builtin_amdgcn_exp2f(-LOG2E_F * g[e])));
            v4u w; w.x = cvtpk(o[0], o[1]); w.y = cvtpk(o[2], o[3]); w.z = cvtpk(o[4], o[5]); w.w = cvtpk(o[6], o[7]);
            *(v4u*)(y + (size_t)it * DM + 512 + hh * 128 + d0) = w; } }
    phase_pool(P, lds);
}

constexpr size_t WS_CTL = 118 * MiB; constexpr int CTL_BYTES = 16384, LDS_CTL_OFF = 147392;
#define XB_TMO      128
#define XB_XCNT(j)  (256  + 64 * (j))
#define XB_XSUB(j)  (1280 + 64 * (j))
#define XB_XGEN(j)  (2304 + 64 * (j))
#define XB_TOP      3328
#define XB_TOPGEN   3392
#define XCD_BAR_WORDS 3456
#define XB_SPIN_CAP (1u << 18)

__device__ __forceinline__ unsigned xb_ld(unsigned* p)              { return __hip_atomic_load(p, __ATOMIC_RELAXED, __HIP_MEMORY_SCOPE_AGENT); }
__device__ __forceinline__ unsigned xb_add(unsigned* p, unsigned v) { return __hip_atomic_fetch_add(p, v, __ATOMIC_RELAXED, __HIP_MEMORY_SCOPE_AGENT); }
__device__ __forceinline__ unsigned xb_xcc_id() { return (unsigned)__builtin_amdgcn_s_getreg((3 << 11) | 20) & 0xFu; }
#define XB_SPIN(cond, bar) do { unsigned _sp = 0; while (cond) { __builtin_amdgcn_s_sleep(1); \
    if ((++_sp & 255u) == 0u) { if (xb_ld(&(bar)[XB_TMO])) break; if (_sp > XB_SPIN_CAP) { atomicAdd(&(bar)[XB_TMO], 1u); break; } } } } while (0)

struct XcdBarrier {
    unsigned* bar; unsigned x;
    volatile LAS unsigned* st;
};

__device__ __forceinline__ XcdBarrier xcd_barrier_post(unsigned* bar, volatile LAS unsigned* st) {
    XcdBarrier b; b.bar = bar; b.x = xb_xcc_id(); b.st = st;
    if (threadIdx.x == 0) (void)xb_add(&bar[XB_XCNT(b.x)], 1u);
    return b;
}
__device__ __forceinline__ void xcd_barrier_complete(unsigned* bar, unsigned x, unsigned& nloc, unsigned& nx) {
    const unsigned G = gridDim.x * gridDim.y * gridDim.z;
    unsigned sum, cnt, mine, sp = 0u;
    for (;;) {
        sum = 0u; cnt = 0u; mine = 0u;
#pragma unroll
        for (unsigned j = 0; j < 16; ++j) { const unsigned c = xb_ld(&bar[XB_XCNT(j)]); sum += c; cnt += (c > 0u) ? 1u : 0u; mine = (j == x) ? c : mine; }
        if (sum == G) break;
        __builtin_amdgcn_s_sleep(1);
        if ((++sp & 255u) == 0u) { if (xb_ld(&bar[XB_TMO])) break; if (sp > XB_SPIN_CAP) { atomicAdd(&bar[XB_TMO], 1u); break; } }
    }
    nloc = mine > 0u ? mine : 1u; nx = cnt > 0u ? cnt : 1u;
}

__device__ __forceinline__ void xcd_barrier(const XcdBarrier& b) {
    asm volatile("s_waitcnt vmcnt(0)" ::: "memory");
    __syncthreads();
    if (threadIdx.x == 0) {
        unsigned* bar = b.bar;
        __builtin_amdgcn_s_waitcnt(0);
        unsigned nloc = b.st[0], nx = b.st[1];
        if (nloc == 0u) { xcd_barrier_complete(bar, b.x, nloc, nx); b.st[0] = nloc; b.st[1] = nx; }
        const unsigned old = xb_add(&bar[XB_XSUB(b.x)], 1u);
        const unsigned gen = old / nloc;
        if (old + 1u == (gen + 1u) * nloc) {
            __builtin_amdgcn_fence(__ATOMIC_RELEASE, "agent");
            asm volatile("s_waitcnt vmcnt(0)" ::: "memory");
            const unsigned og = xb_add(&bar[XB_TOP], 1u);
            const unsigned tg = og / nx;
            if (og + 1u == (tg + 1u) * nx) xb_add(&bar[XB_TOPGEN], 1u);
            else XB_SPIN(xb_ld(&bar[XB_TOPGEN]) == tg, bar);
            __builtin_amdgcn_fence(__ATOMIC_ACQUIRE, "agent");
            xb_add(&bar[XB_XGEN(b.x)], 1u);
            asm volatile("s_waitcnt vmcnt(0)" ::: "memory");
        } else {
            XB_SPIN(xb_ld(&bar[XB_XGEN(b.x)]) == gen, bar);
            __builtin_amdgcn_fence(__ATOMIC_ACQUIRE, "agent");
            asm volatile("s_waitcnt vmcnt(0)" ::: "memory");
        }
    }
    __syncthreads();
}

constexpr int LDS_RS_OFF = 131072;
template <class E> __device__ __forceinline__ void run_gemm(LAS unsigned char* lds, const bf16* A, const bf16* Bt, int M, int N, int K, const E& e, const float* ss = nullptr) {
    pg8::Gemm g{A, Bt, M, N, K}; pg8::StaticOrder So; So.init(M, N, (int)gridDim.x, (int)blockIdx.x);
    if (ss) { pg8::Unit u; LAS float* rs = (LAS float*)(lds + LDS_RS_OFF);
        for (int i = 0; So.next(i, u); ++i) { const int r = threadIdx.x; if (r < 256) rs[256 * i + r] = pg8::row_rstd(ss, u.pm * 256 + r); }
        __syncthreads(); }
    pg8::gemm_phase<E, pg8::StaticOrder, true, true>(lds, g, So, e);
}
constexpr int N_PHASES = 22;
#ifndef MK_PER_PHASE
#define MK_PER_PHASE 0
#endif

template <int ph> __device__ __forceinline__ void do_phase(const Params& P, LAS unsigned char* lds) {
    unsigned char* ws = P.ws;
    bf16* xh = (bf16*)(ws + WS_XH); float* ss = (float*)(ws + WS_SS); bf16* yb = (bf16*)(ws + WS_Y); bf16* zb = (bf16*)(ws + WS_Z);
    if constexpr (ph == 0) phase_prologue(P, lds);
    else if constexpr (ph == 1) {
        pg8::Gemm g{xh, (const bf16*)(ws + WS_AIN), T, 2816, 1024, (const bf16*)(ws + WS_MEMH), (const bf16*)(ws + WS_XKV)};
        pg8::DualOrder So; So.init(T, 2816, 2048, 4096, (int)gridDim.x, (int)blockIdx.x);
        { pg8::Unit u; LAS float* rs = (LAS float*)(lds + LDS_RS_OFF);
          for (int i = 0; So.next(i, u); ++i) { const int r = threadIdx.x; if (r < 256 && u.kind == 0) rs[256 * i + r] = pg8::row_rstd(ss, u.pm * 256 + r); }
          __syncthreads(); }
        pg8::EpiDual<pg8::EpiInA, pg8::EpiBf<0>> e{{zb, (float*)(ws + WS_BA), (LAS float*)(lds + LDS_RS_OFF)}, {(bf16*)(ws + WS_MEMKV), 4096, nullptr, 1.f}};
        pg8::gemm_phase<pg8::EpiDual<pg8::EpiInA, pg8::EpiBf<0>>, pg8::DualOrder, true, true>(lds, g, So, e); }
    else if constexpr (ph == 2) phase_dna(P, lds);
    else if constexpr (ph == 3) phase_dnb(P, lds);
    else if constexpr (ph == 4) phase_dnc(P, lds);
    else if constexpr (ph == 11) { pg8::EpiInC e{zb, zb + (size_t)T * 1024, (float*)(ws + WS_GATES), (LAS float*)(lds + LDS_RS_OFF)}; run_gemm(lds, xh, (const bf16*)(ws + WS_CIN), T, 2560, 1024, e, ss);   }
    else if constexpr (ph == 12) { const int kvs = (int)blockIdx.x >> 5;
        if (kvs < 2) { pg8::EpiF32 e{(float*)(ws + (kvs ? WS_P01V : WS_P01K)), 256};
            pg8::Gemm g{zb + (size_t)T * 1024 + (size_t)kvs * KV_KIND, (const bf16*)(ws + (kvs ? WS_CMPV : WS_CMPK)), 8192, 256, 1024}; pg8::StaticOrder So; So.init(8192, 256, (int)gridDim.x, (int)blockIdx.x & 31);
            pg8::gemm_phase<pg8::EpiF32, pg8::StaticOrder, true, true>(lds, g, So, e);
            pg8::Unit u; So.next(0, u);
            __builtin_amdgcn_fence(__ATOMIC_RELEASE, "agent"); asm volatile("s_waitcnt vmcnt(0)" ::: "memory"); __syncthreads(); __builtin_amdgcn_fence(__ATOMIC_ACQUIRE, "agent"); asm volatile("s_waitcnt vmcnt(0)" ::: "memory");
            cmpfin_bg(P, lds, kvs, u.pm); }
        else { const int gwi = ((int)blockIdx.x - 64) * NWAVES + (int)(threadIdx.x >> 6), ngwi = ((int)gridDim.x - 64) * NWAVES; phase_gates(P, lds, gwi, ngwi); phase_conv_late(P, lds, gwi, ngwi); } }
    else if constexpr (ph == 13) { }
    else if constexpr (ph == 14) phase_nsa(P, lds);
    else if constexpr (ph == 21) phase_final(P);
    else { constexpr int l = ph >= 15 ? 1 : 0, k = ph - (l ? 15 : 5);
        if constexpr (k == 1) {
            { pg8::EpiBf<0> e{(bf16*)(ws + WS_QXA), 1024, (LAS float*)(lds + LDS_RS_OFF), 1.f}; run_gemm(lds, xh, (const bf16*)(ws + WS_XQ) + (size_t)l * 1048576, T, 1024, 1024, e, ss); } }
        else if constexpr (k == 2) phase_xatt(P, lds, l);
        else if constexpr (k == 4) { pg8::EpiBf<1> e{(bf16*)(ws + WS_HMID), 4096, (LAS float*)(lds + LDS_RS_OFF), 1.f}; run_gemm(lds, xh, (const bf16*)(ws + WS_F1) + (size_t)l * 4194304, T, 4096, 1024, e, ss); }
        else { const bf16* A = k == 5 ? (const bf16*)(ws + WS_HMID) : yb; constexpr int K = k == 5 ? 4096 : 1024;
            const bf16* Bt = k == 0 ? (const bf16*)(ws + (l ? WS_COUT : WS_AOUT)) : k == 3 ? (const bf16*)(ws + WS_XO) + (size_t)l * 1048576 : (const bf16*)(ws + WS_F2) + (size_t)l * 4194304;
            if constexpr (ph == 5) { pg8::EpiRes<true> e{xh, ss, P.in[I_X]}; run_gemm(lds, A, Bt, T, 1024, K, e); }
            else { pg8::EpiRes<false> e{xh, ss, nullptr}; run_gemm(lds, A, Bt, T, 1024, K, e); } } }
}
__global__ void __launch_bounds__(NTHR, 2) trunk_fwd(Params P) {
    extern __shared__ __attribute__((aligned(16))) unsigned char lds_raw[];
    LAS unsigned char* lds = (LAS unsigned char*)lds_raw;
    cg::grid_group grid = cg::this_grid();
    const int lo = P.ph_lo, hi = P.ph_hi;
#ifndef PROBE_PH
#define PROBE_PH -1
#endif
    if (threadIdx.x < 2) ((LAS unsigned*)(lds + LDS_CTL_OFF))[threadIdx.x] = 0u;
    __syncthreads();
    const XcdBarrier bar = xcd_barrier_post((unsigned*)(P.ws + WS_CTL), (volatile LAS unsigned*)(lds + LDS_CTL_OFF));
    if (P.ph_lo < 0) grid.sync();
#define SEAM(k) { xcd_barrier(bar); }
#define RUN(k) if (lo <= (k) && (k) < hi) { if ((k) == PROBE_PH) { do_phase<(k)>(P, lds); SEAM(k) } do_phase<(k)>(P, lds); if ((k) + 1 < hi) SEAM(k) }
    RUN(0) RUN(1) RUN(2) RUN(3) RUN(4) RUN(5) RUN(6) RUN(7) RUN(8) RUN(9) RUN(10) RUN(11) RUN(12) RUN(14) RUN(15) RUN(16) RUN(17) RUN(18) RUN(19) RUN(20) RUN(21)
#undef RUN
}

extern "C" void kernel_launch(void* const* d_in, const int* in_sizes, int n_in, void* d_out, int out_size, void* d_ws, size_t ws_size, hipStream_t stream) {
    static int grid = 0;
    if (grid == 0) {
        if (n_in != N_IN || in_sizes[0] != T * DM || out_size != T * DM || ws_size < WS_END) { fprintf(stderr, "kernel_launch: unexpected shapes (n_in %d, in0 %d, out %d, ws %zu)\n", n_in, n_in > 0 ? in_sizes[0] : -1, out_size, ws_size); grid = -1; return; }
        int dev = 0, cus = 0, per_cu = 0;
        if (hipGetDevice(&dev) != hipSuccess || hipDeviceGetAttribute(&cus, hipDeviceAttributeMultiprocessorCount, dev) != hipSuccess) { grid = -1; return; }
        if (hipFuncSetAttribute((const void*)trunk_fwd, hipFuncAttributeMaxDynamicSharedMemorySize, LDS_BYTES) != hipSuccess) { fprintf(stderr, "kernel_launch: hipFuncSetAttribute failed\n"); grid = -1; return; }
        if (hipOccupancyMaxActiveBlocksPerMultiprocessor(&per_cu, (const void*)trunk_fwd, NTHR, LDS_BYTES) != hipSuccess || per_cu < 1) { fprintf(stderr, "kernel_launch: occupancy query says %d blocks/CU\n", per_cu); (void)hipGetLastError(); grid = -1; return; }
        grid = cus;
        fprintf(stderr, "kernel_launch: %d CUs, %d blocks/CU by the occupancy query, grid %d\n", cus, per_cu, grid);
    }
    if (grid < 0) return;
    Params p{};
    for (int i = 0; i < N_IN; ++i) p.in[i] = (const float*)d_in[i];
    p.out = (float*)d_out; p.ws = (unsigned char*)d_ws;
#if MK_PER_PHASE
    for (int ph = 0; ph < N_PHASES; ++ph) { p.ph_lo = ph; p.ph_hi = ph + 1; hipLaunchKernelGGL(trunk_fwd, dim3(grid), dim3(NTHR), LDS_BYTES, stream, p); }
#else
    p.ph_lo = 0; p.ph_hi = N_PHASES;
    if (hipMemsetAsync((char*)d_ws + WS_CTL, 0, CTL_BYTES, stream) != hipSuccess) { fprintf(stderr, "kernel_launch: memset of the barrier words failed\n"); return; }
    void* args[] = {&p};
    hipError_t e = hipLaunchCooperativeKernel((const void*)trunk_fwd, dim3(grid), dim3(NTHR), args, LDS_BYTES, stream);
    if (e != hipSuccess) fprintf(stderr, "kernel_launch: cooperative launch failed: %s (grid %d)\n", hipGetErrorString(e), grid);
#endif
}
```

```cpp
#include <hip/hip_runtime.h>
#include <hip/hip_cooperative_groups.h>
#include <cstdio>
#include <cstdint>
namespace cg = cooperative_groups;
namespace pg8 {
#define PG8_LAS __attribute__((address_space(3)))
typedef unsigned short bf16_t;
typedef short bf16x8 __attribute__((ext_vector_type(8)));
typedef float f32x4 __attribute__((ext_vector_type(4)));
typedef unsigned u32x4 __attribute__((ext_vector_type(4)));
constexpr int BM = 256, BK = 64, HALF = 128, HTB = HALF * BK * 2  , STAGE_BYTES = 8 * HTB, NXCD = 8, WGM = 8;

__host__ __device__ __forceinline__ int lds_byte(int r, int c) { const int st = (r >> 4) * 2 + (c >> 5), rr = r & 15, cc = c & 31, ob = rr * 64 + cc * 2; return st * 1024 + (ob ^ (((ob >> 9) & 1) << 5)); }
__host__ __device__ __forceinline__ void stage_rc(int b, int& R, int& C) { const int st = b / 1024, sb = b % 1024, swz = sb ^ (((sb >> 9) & 1) << 5); R = (st >> 1) * 16 + swz / 64; C = (st & 1) * 32 + (swz % 64) / 2; }
__host__ __device__ __forceinline__ int perm32(int rho) { const int n = rho >> 4, i = rho & 15; return 8 * (i >> 2) + 4 * n + (i & 3); }

struct Unit { int pm, pn, ui, kind; };
struct Gemm { const bf16_t* A; const bf16_t* Bt; int M, N, K; const bf16_t* A2 = nullptr; const bf16_t* Bt2 = nullptr; };

struct StaticOrder {
    int nM, nN, nwg, G, c;
    __host__ __device__ void init(int M, int N, int G_, int c_) { nM = M / BM; nN = N / BM; nwg = nM * nN; G = G_; c = c_; }
    __host__ __device__ bool next(int i, Unit& u) const {
        const long L = (long)i * G + c; if (L >= nwg) return false;
        int wgid = (int)L; { const int q = nwg / NXCD, r = nwg % NXCD, xcd = wgid % NXCD, off = wgid / NXCD; wgid = (xcd < r ? xcd * (q + 1) : r * (q + 1) + (xcd - r) * q) + off; }
        const int nig = WGM * nN, gid = wgid / nig, fm = gid * WGM, gsz = (nM - fm) < WGM ? (nM - fm) : WGM;
        u.pm = fm + ((wgid % nig) % gsz); u.pn = (wgid % nig) / gsz; u.ui = i; u.kind = 0; return true;
    }
    __device__ __forceinline__ void a_ready(const Unit&) const {}
    __device__ __forceinline__ void done(const Unit&) const {}
};
__device__ __forceinline__ unsigned cvt_pk_bf16(float lo, float hi) { unsigned r; asm volatile("v_cvt_pk_bf16_f32 %0, %1, %2" : "=v"(r) : "v"(lo), "v"(hi)); return r; }
typedef float f32x2 __attribute__((ext_vector_type(2)));
typedef float f32x2 __attribute__((ext_vector_type(2)));
template <class Epi, class Sched, bool ALIGN_EPI = false, bool SP2 = false>
__device__ __forceinline__ void gemm_phase(PG8_LAS unsigned char* lds, const Gemm g, const Sched& S, const Epi& E) {
    int tid_l = threadIdx.x; asm volatile("" : "+v"(tid_l));
    const int tid = tid_l, wid = __builtin_amdgcn_readfirstlane(tid >> 6), lane = tid & 63, wr = wid >> 2, wc = wid & 3, fr = lane & 15, fq = lane >> 4;
    const int K = g.K, nt = K / BK;
    unsigned voffA[2], voffB[2];
#pragma unroll
    for (int i = 0; i < 2; ++i) { int R, C; stage_rc(tid * 16 + i * 8192, R, C); const int Rb = Epi::PERM ? ((R & ~31) + perm32(R & 31)) : R;
        voffA[i] = (unsigned)(R * K + C) * 2u; voffB[i] = (unsigned)(Rb * K + C) * 2u; }
    const size_t kstep = (size_t)(BK * 2);
    const size_t hstep = (size_t)HALF * K * 2;
    const size_t tstep = 2 * hstep;
    const unsigned ldsw = (unsigned)wid * 1024u;
    const int aoff = lds_byte(wr * 64 + fr, fq * 8), boff = lds_byte(wc * 32 + fr, fq * 8);
#define PG8_SA(b, h) (((b) * 2 + (h)) * HTB)
#define PG8_SB(b, h) ((4 + (b) * 2 + (h)) * HTB)
#define PG8_STAGE(bufoff, gbase, voff) do { _Pragma("unroll") for (int _i = 0; _i < 2; ++_i) \
        __builtin_amdgcn_global_load_lds((const unsigned*)((const char*)(gbase) + (voff)[_i]), (PG8_LAS unsigned*)(lds + (bufoff) + ldsw + _i * 8192), 16, 0, 0); } while (0)
#define PG8_LDA(dst, b, h) do { _Pragma("unroll") for (int m = 0; m < 4; ++m) _Pragma("unroll") for (int k = 0; k < 2; ++k) dst[m][k] = *(const PG8_LAS bf16x8*)(lds + PG8_SA(b, h) + aoff + m * 2048 + k * 1024); } while (0)
#define PG8_LDB(dst, b, h) do { _Pragma("unroll") for (int n = 0; n < 2; ++n) _Pragma("unroll") for (int k = 0; k < 2; ++k) dst[n][k] = *(const PG8_LAS bf16x8*)(lds + PG8_SB(b, h) + boff + n * 2048 + k * 1024); } while (0)
#define PG8_MMA(ai, bj, At, Bt) do { __builtin_amdgcn_s_setprio(1); _Pragma("unroll") for (int m = 0; m < 4; ++m) _Pragma("unroll") for (int n = 0; n < 2; ++n) _Pragma("unroll") for (int k = 0; k < 2; ++k) \
        acc[ai][bj][m][n] = __builtin_amdgcn_mfma_f32_16x16x32_bf16(Bt[n][k], At[m][k], acc[ai][bj][m][n], 0, 0, 0); __builtin_amdgcn_s_setprio(0); } while (0)
#define PG8_WAIT_V(n) asm volatile("s_waitcnt vmcnt(" #n ")" ::: "memory")
#define PG8_WAIT_L(n) asm volatile("s_waitcnt lgkmcnt(" #n ")" ::: "memory")
#define PG8_BAR __builtin_amdgcn_s_barrier()
#define PG8_SCHED __builtin_amdgcn_sched_barrier(0)
    Unit cur, nxt; int ui = 0;
    if (!S.next(0, cur)) return;
    f32x4 acc[2][2][4][2];
#pragma unroll
    for (int a = 0; a < 2; ++a)
#pragma unroll
        for (int b = 0; b < 2; ++b)
#pragma unroll
            for (int m = 0; m < 4; ++m)
#pragma unroll
                for (int n = 0; n < 2; ++n) acc[a][b][m][n] = (f32x4){0.f, 0.f, 0.f, 0.f};
    bf16x8 At[4][2], B0[2][2], B1[2][2];
    const char* cA = (const char*)(cur.kind ? g.A2 : g.A) + (size_t)cur.pm * tstep; const char* cB = (const char*)(cur.kind ? g.Bt2 : g.Bt) + (size_t)cur.pn * tstep;
    S.a_ready(cur);
    if constexpr (SP2) {
        PG8_STAGE(PG8_SB(0, 0), cB, voffB); PG8_STAGE(PG8_SB(0, 1), cB + hstep, voffB); PG8_STAGE(PG8_SA(0, 0), cA, voffA); PG8_STAGE(PG8_SA(0, 1), cA + hstep, voffA);
        if (wr == 1) PG8_BAR;
        PG8_WAIT_V(2); PG8_BAR;
        PG8_STAGE(PG8_SB(1, 0), cB + kstep, voffB); PG8_STAGE(PG8_SA(1, 0), cA + kstep, voffA); PG8_STAGE(PG8_SB(1, 1), cB + hstep + kstep, voffB);
        PG8_WAIT_V(6); PG8_BAR;
    } else {
        PG8_STAGE(PG8_SB(0, 0), cB, voffB); PG8_STAGE(PG8_SA(0, 0), cA, voffA); PG8_STAGE(PG8_SB(0, 1), cB + hstep, voffB); PG8_STAGE(PG8_SA(0, 1), cA + hstep, voffA);
        if (wr == 1) PG8_BAR;
        PG8_WAIT_V(4); PG8_BAR;
        PG8_STAGE(PG8_SB(1, 0), cB + kstep, voffB); PG8_STAGE(PG8_SA(1, 0), cA + kstep, voffA); PG8_STAGE(PG8_SB(1, 1), cB + hstep + kstep, voffB);
        PG8_WAIT_V(6); PG8_BAR;
    }
    for (;;) {
        const bool has_next = S.next(ui + 1, nxt);
        const char* nA = has_next ? (const char*)(nxt.kind ? g.A2 : g.A) + (size_t)nxt.pm * tstep : cA; const char* nB = has_next ? (const char*)(nxt.kind ? g.Bt2 : g.Bt) + (size_t)nxt.pn * tstep : cB;
        for (int t = 0; t < nt; t += 2) {
            const bool last = (t == nt - 2);
            const char* a1 = cA + (size_t)(t + 1) * kstep;
            const char* a2 = last ? nA : cA + (size_t)(t + 2) * kstep; const char* b2 = last ? nB : cB + (size_t)(t + 2) * kstep;
            const char* a3 = a2 + kstep; const char* b3 = b2 + kstep;
            if (last && has_next) S.a_ready(nxt);
            if constexpr (SP2) {
            PG8_LDB(B0, 0, 0); PG8_LDB(B1, 0, 1); PG8_SCHED; PG8_LDA(At, 0, 0); PG8_STAGE(PG8_SA(1, 1), a1 + hstep, voffA);
            PG8_WAIT_V(8); PG8_WAIT_L(0); PG8_BAR; PG8_MMA(0, 0, At, B0); PG8_MMA(0, 1, At, B1); PG8_BAR; PG8_SCHED;
            PG8_LDA(At, 0, 1); PG8_STAGE(PG8_SB(0, 0), b2, voffB); PG8_STAGE(PG8_SB(0, 1), b2 + hstep, voffB); PG8_STAGE(PG8_SA(0, 0), a2, voffA);
            PG8_WAIT_V(8); PG8_WAIT_L(0); PG8_BAR; PG8_MMA(1, 0, At, B0); PG8_MMA(1, 1, At, B1); PG8_BAR; PG8_SCHED;
            PG8_LDB(B0, 1, 0); PG8_LDB(B1, 1, 1); PG8_SCHED; PG8_LDA(At, 1, 0); PG8_STAGE(PG8_SA(0, 1), a2 + hstep, voffA);
            PG8_WAIT_V(8); PG8_WAIT_L(0); PG8_BAR; PG8_MMA(0, 0, At, B0); PG8_MMA(0, 1, At, B1); PG8_BAR; PG8_SCHED;
            PG8_LDA(At, 1, 1); PG8_STAGE(PG8_SB(1, 0), b3, voffB); PG8_STAGE(PG8_SB(1, 1), b3 + hstep, voffB); PG8_STAGE(PG8_SA(1, 0), a3, voffA);
            PG8_WAIT_V(8); PG8_WAIT_L(0); PG8_BAR; PG8_MMA(1, 0, At, B0); PG8_MMA(1, 1, At, B1); PG8_BAR; PG8_SCHED;
            } else {
            PG8_LDB(B0, 0, 0); PG8_SCHED; PG8_LDA(At, 0, 0); PG8_STAGE(PG8_SA(1, 1), a1 + hstep, voffA);
            PG8_WAIT_L(8); PG8_BAR; PG8_WAIT_L(0); PG8_MMA(0, 0, At, B0); PG8_BAR; PG8_SCHED;
            PG8_LDB(B1, 0, 1); PG8_STAGE(PG8_SB(0, 0), b2, voffB);
            PG8_BAR; PG8_WAIT_L(0); PG8_MMA(0, 1, At, B1); PG8_BAR;
            PG8_LDA(At, 0, 1); PG8_STAGE(PG8_SA(0, 0), a2, voffA);
            PG8_BAR; PG8_WAIT_L(0); PG8_MMA(1, 0, At, B0); PG8_BAR; PG8_SCHED;
            PG8_STAGE(PG8_SB(0, 1), b2 + hstep, voffB);
            PG8_WAIT_V(6); PG8_BAR; PG8_MMA(1, 1, At, B1); PG8_BAR;
            PG8_LDB(B0, 1, 0); PG8_SCHED; PG8_LDA(At, 1, 0); PG8_STAGE(PG8_SA(0, 1), a2 + hstep, voffA);
            PG8_WAIT_L(8); PG8_BAR; PG8_WAIT_L(0); PG8_MMA(0, 0, At, B0); PG8_BAR; PG8_SCHED;
            PG8_LDB(B1, 1, 1); PG8_STAGE(PG8_SB(1, 0), b3, voffB);
            PG8_BAR; PG8_WAIT_L(0); PG8_MMA(0, 1, At, B1); PG8_BAR;
            PG8_LDA(At, 1, 1); PG8_STAGE(PG8_SA(1, 0), a3, voffA);
            PG8_BAR; PG8_WAIT_L(0); PG8_MMA(1, 0, At, B0); PG8_BAR; PG8_SCHED;
            PG8_STAGE(PG8_SB(1, 1), b3 + hstep, voffB);
            PG8_WAIT_V(6); PG8_BAR; PG8_MMA(1, 1, At, B1); PG8_BAR;
            }
        }
        if constexpr (ALIGN_EPI) { if (wr == 0) PG8_BAR; }
        if constexpr (!Epi::AFTER_DRAIN) { E(acc, cur, wr, wc, fr, fq); S.done(cur); }
        if (!has_next) break;
#pragma unroll
        for (int a = 0; a < 2; ++a)
#pragma unroll
            for (int b = 0; b < 2; ++b)
#pragma unroll
                for (int m = 0; m < 4; ++m)
#pragma unroll
                    for (int n = 0; n < 2; ++n) acc[a][b][m][n] = (f32x4){0.f, 0.f, 0.f, 0.f};
        cur = nxt; cA = nA; cB = nB; ++ui;
        if constexpr (ALIGN_EPI) { if (wr == 1) PG8_BAR; }
    }
    PG8_WAIT_V(0);
    if constexpr (!ALIGN_EPI) { if (wr == 0) PG8_BAR; }
    PG8_BAR;
    if constexpr (Epi::AFTER_DRAIN) { E.fused(acc, cur, wr, wc, fr, fq, lds, wid, lane); S.done(cur); }
#undef PG8_SA
#undef PG8_SB
#undef PG8_STAGE
#undef PG8_LDA
#undef PG8_LDB
#undef PG8_MMA
#undef PG8_WAIT_V
#undef PG8_WAIT_L
#undef PG8_BAR
#undef PG8_SCHED
}
}
namespace pg8 {
struct DualOrder {
    StaticOrder s1, s2; int G, c;
    __host__ __device__ void init(int M1, int N1, int M2, int N2, int G_, int c_) { s1.init(M1, N1, 1, 0); s2.init(M2, N2, 1, 0); G = G_; c = c_; }
    __host__ __device__ bool next(int i, Unit& u) const {
        const long L = (long)i * G + c; if (L >= s1.nwg + s2.nwg) return false;
        if (L < s1.nwg) { s1.next((int)L, u); u.kind = 0; } else { s2.next((int)(L - s1.nwg), u); u.kind = 1; }
        u.ui = i; return true;
    }
    __device__ __forceinline__ void a_ready(const Unit&) const {}
    __device__ __forceinline__ void done(const Unit&) const {}
};
__device__ __forceinline__ float row_rstd(const float* ss, int row) {
    const f32x4* p = (const f32x4*)(ss + (size_t)row * 16);
    const f32x4 a = p[0], b = p[1], c = p[2], d = p[3];
    const float s = (((a[0] + a[1]) + (a[2] + a[3])) + ((b[0] + b[1]) + (b[2] + b[3]))) + (((c[0] + c[1]) + (c[2] + c[3])) + ((d[0] + d[1]) + (d[2] + d[3])));
    return rsqrtf(s * (1.0f / 1024.0f) + 1e-6f);
}
__device__ __forceinline__ u32x4 pack8(f32x4 v0, f32x4 v1) { u32x4 w; w.x = cvt_pk_bf16(v0[0], v0[1]); w.y = cvt_pk_bf16(v0[2], v0[3]); w.z = cvt_pk_bf16(v1[0], v1[1]); w.w = cvt_pk_bf16(v1[2], v1[3]); return w; }

template <int ACT  > struct EpiBf {
    static constexpr bool PERM = true, AFTER_DRAIN = false;
    bf16_t* O; int ldc; const PG8_LAS float* rs; float mul;
    __device__ __forceinline__ void operator()(const f32x4 (&acc)[2][2][4][2], const Unit& u, int wr, int wc, int fr, int fq) const {
        const int row0 = u.pm * BM + wr * 64 + fr, col0 = u.pn * BM + wc * 32 + 8 * fq;
#pragma unroll
        for (int ai = 0; ai < 2; ++ai)
#pragma unroll
            for (int m = 0; m < 4; ++m) { const int row = row0 + ai * HALF + m * 16; const float sc = rs ? mul * rs[256 * u.ui + ai * HALF + wr * 64 + m * 16 + fr] : mul; bf16_t* rowp = O + (size_t)row * ldc + col0;
#pragma unroll
                for (int bj = 0; bj < 2; ++bj) { f32x4 v0 = acc[ai][bj][m][0] * sc, v1 = acc[ai][bj][m][1] * sc;
                    if (ACT == 1) {
#pragma unroll
                        for (int j = 0; j < 4; ++j) { const float a = fmaxf(v0[j], 0.f), b = fmaxf(v1[j], 0.f); v0[j] = a * a; v1[j] = b * b; } }
                    *(u32x4*)(rowp + bj * HALF) = pack8(v0, v1); } }
    }
};
struct EpiF32 {
    static constexpr bool PERM = true, AFTER_DRAIN = false;
    float* C; int ldc;
    __device__ __forceinline__ void operator()(const f32x4 (&acc)[2][2][4][2], const Unit& u, int wr, int wc, int fr, int fq) const {
        const int row0 = u.pm * BM + wr * 64 + fr, col0 = u.pn * BM + wc * 32 + 8 * fq;
#pragma unroll
        for (int ai = 0; ai < 2; ++ai)
#pragma unroll
            for (int m = 0; m < 4; ++m) { float* rowp = C + (size_t)(row0 + ai * HALF + m * 16) * ldc + col0;
#pragma unroll
                for (int bj = 0; bj < 2; ++bj) { *(f32x4*)(rowp + bj * HALF) = acc[ai][bj][m][0]; *(f32x4*)(rowp + bj * HALF + 4) = acc[ai][bj][m][1]; } }
    }
};
template <bool F32RES> struct EpiRes {
    static constexpr bool PERM = true, AFTER_DRAIN = false;
    bf16_t* xh; float* ssout; const float* r32;
    __device__ __forceinline__ void operator()(const f32x4 (&acc)[2][2][4][2], const Unit& u, int wr, int wc, int fr, int fq) const {
        const int row0 = u.pm * BM + wr * 64 + fr, col0 = u.pn * BM + wc * 32 + 8 * fq;
#pragma unroll
        for (int ai = 0; ai < 2; ++ai) {
            u32x4 pre[4][2]; f32x4 pf[4][2][2];
#pragma unroll
            for (int m = 0; m < 4; ++m)
#pragma unroll
                for (int bj = 0; bj < 2; ++bj) { const size_t off = (size_t)(row0 + ai * HALF + m * 16) * 1024 + col0 + bj * HALF;
                    if (F32RES) { pf[m][bj][0] = *(const f32x4*)(r32 + off); pf[m][bj][1] = *(const f32x4*)(r32 + off + 4); } else pre[m][bj] = *(const u32x4*)(xh + off); }
            asm volatile("" ::: "memory"); __builtin_amdgcn_sched_barrier(0);
#pragma unroll
            for (int m = 0; m < 4; ++m) { const int row = row0 + ai * HALF + m * 16; float q = 0.f;
#pragma unroll
                for (int bj = 0; bj < 2; ++bj) { const size_t off = (size_t)row * 1024 + col0 + bj * HALF; f32x4 r0, r1;
                    if (F32RES) { r0 = pf[m][bj][0]; r1 = pf[m][bj][1]; }
                    else { const u32x4 p = pre[m][bj];
                        r0 = (f32x4){__uint_as_float(p.x << 16), __uint_as_float(p.x & 0xffff0000u), __uint_as_float(p.y << 16), __uint_as_float(p.y & 0xffff0000u)};
                        r1 = (f32x4){__uint_as_float(p.z << 16), __uint_as_float(p.z & 0xffff0000u), __uint_as_float(p.w << 16), __uint_as_float(p.w & 0xffff0000u)}; }
                    const f32x4 v0 = acc[ai][bj][m][0] + r0, v1 = acc[ai][bj][m][1] + r1;
                    q += ((v0[0] * v0[0] + v0[1] * v0[1]) + (v0[2] * v0[2] + v0[3] * v0[3])) + ((v1[0] * v1[0] + v1[1] * v1[1]) + (v1[2] * v1[2] + v1[3] * v1[3]));
                    *(u32x4*)(xh + off) = pack8(v0, v1); }
                q += __shfl_xor(q, 16); q += __shfl_xor(q, 32);
                if (fq == 0) ssout[(size_t)row * 16 + u.pn * 4 + wc] = q; }
            asm volatile("" ::: "memory"); __builtin_amdgcn_sched_barrier(0); }
    }
};
struct EpiInA {
    static constexpr bool PERM = true, AFTER_DRAIN = false;
    bf16_t* z; float* ba; const PG8_LAS float* rs;
    __device__ __forceinline__ void operator()(const f32x4 (&acc)[2][2][4][2], const Unit& u, int wr, int wc, int fr, int fq) const {
        const int row0 = u.pm * BM + wr * 64 + fr, col0 = u.pn * BM + wc * 32 + 8 * fq;
#pragma unroll
        for (int ai = 0; ai < 2; ++ai)
#pragma unroll
            for (int m = 0; m < 4; ++m) { const int row = row0 + ai * HALF + m * 16; const float sc = rs[256 * u.ui + ai * HALF + wr * 64 + m * 16 + fr];
                if (u.pn < 10) { bf16_t* rowp = z + (size_t)row * 2560 + col0;
#pragma unroll
                    for (int bj = 0; bj < 2; ++bj) *(u32x4*)(rowp + bj * HALF) = pack8(acc[ai][bj][m][0] * sc, acc[ai][bj][m][1] * sc);
                } else if (wc == 0 && fq == 0) { *(f32x4*)(ba + (size_t)row * 8) = acc[ai][0][m][0] * sc; *(f32x4*)(ba + (size_t)row * 8 + 4) = acc[ai][0][m][1] * sc; } }
    }
};
struct EpiInC {
    static constexpr bool PERM = true, AFTER_DRAIN = false;
    bf16_t* q; bf16_t* kv; float* gates; const PG8_LAS float* rs;
    __device__ __forceinline__ void operator()(const f32x4 (&acc)[2][2][4][2], const Unit& u, int wr, int wc, int fr, int fq) const {
        const int row0 = u.pm * BM + wr * 64 + fr, col0 = u.pn * BM + wc * 32 + 8 * fq;
#pragma unroll
        for (int ai = 0; ai < 2; ++ai)
#pragma unroll
            for (int m = 0; m < 4; ++m) { const int row = row0 + ai * HALF + m * 16; const float sc = rs[256 * u.ui + ai * HALF + wr * 64 + m * 16 + fr];
                if (u.pn < 4) { bf16_t* rowp = q + (size_t)row * 1024 + col0; const float sq = sc * 0.18033688011112042f;
#pragma unroll
                    for (int bj = 0; bj < 2; ++bj) *(u32x4*)(rowp + bj * HALF) = pack8(acc[ai][bj][m][0] * sq, acc[ai][bj][m][1] * sq);
                } else if (u.pn < 10) { const int b = row >> 12, s = row & 4095;
#pragma unroll
                    for (int bj = 0; bj < 2; ++bj) { const int cp = col0 + bj * HALF - 1024, kind = cp >> 8, g = (cp >> 6) & 3, d = cp & 63;
                        *(u32x4*)(kv + (size_t)kind * ((size_t)32768 * 256) + ((size_t)((b * 4 + g) * 4096 + s)) * 64 + d) = pack8(acc[ai][bj][m][0] * sc, acc[ai][bj][m][1] * sc); }
                } else { const int cl = wc * 32 + 8 * fq; if (cl < 48) { *(f32x4*)(gates + (size_t)row * 48 + cl) = acc[ai][0][m][0] * sc; *(f32x4*)(gates + (size_t)row * 48 + cl + 4) = acc[ai][0][m][1] * sc; } } }
    }
};
template <class E0, class E1> struct EpiDual {
    static constexpr bool PERM = true, AFTER_DRAIN = false;
    E0 e0; E1 e1;
    __device__ __forceinline__ void operator()(const f32x4 (&acc)[2][2][4][2], const Unit& u, int wr, int wc, int fr, int fq) const { if (u.kind) e1(acc, u, wr, wc, fr, fq); else e0(acc, u, wr, wc, fr, fq); }
};
}
#define LAS __attribute__((address_space(3)))
typedef unsigned short bf16;
typedef float f32x4 __attribute__((ext_vector_type(4)));
typedef unsigned v4u __attribute__((ext_vector_type(4)));
typedef unsigned v2u __attribute__((ext_vector_type(2)));
typedef short bf16x8 __attribute__((ext_vector_type(8)));
typedef float f32x16 __attribute__((ext_vector_type(16)));
typedef short v4i16 __attribute__((ext_vector_type(4)));
typedef float f32x2_t __attribute__((ext_vector_type(2))); typedef __bf16 bf16x2_t __attribute__((ext_vector_type(2)));
__device__ __forceinline__ unsigned cvtpk(float lo, float hi) { f32x2_t v = {lo, hi}; bf16x2_t b = __builtin_convertvector(v, bf16x2_t); return __builtin_bit_cast(unsigned, b); }

#ifndef TEAM_A
#define TEAM_A 1
#endif
#ifndef TEAM_B
#define TEAM_B 0
#endif
constexpr int NWAVES = 8, NTHR = 512;
constexpr int T = 32768, SEQ = 4096, DM = 1024, FF = 4096;
constexpr int LDS_BYTES = 147456;
constexpr float EPS = 1e-6f;

enum { I_X = 0, I_MEM, I_A_LN, I_A_WIN, I_A_POOLW, I_A_POOLS, I_A_CONV, I_A_ALOG, I_A_DTB, I_A_ONORM, I_A_WOUT,
       I_C_LN, I_C_WIN, I_C_PEK, I_C_W1K, I_C_W2K, I_C_PEV, I_C_W1V, I_C_W2V, I_C_WOUT,
       I_XA_LN, I_XA_MLN, I_XA_WQ, I_XA_WK, I_XA_WV, I_XA_WO, I_FF_LN, I_FF_W1, I_FF_W2, I_FLN, N_IN };

constexpr size_t MiB = (size_t)1 << 20;
constexpr size_t WS_AIN = 0, WS_AOUT = 6 * MiB, WS_CIN = 8 * MiB, WS_COUT = 14 * MiB, WS_XQ = 16 * MiB, WS_XKV = 20 * MiB, WS_XO = 28 * MiB;
constexpr size_t WS_F1 = 32 * MiB, WS_F2 = 48 * MiB, WS_CMPK = 64 * MiB, WS_CMPV = 64 * MiB + 512 * 1024, WS_CBIAS = 65 * MiB;
constexpr size_t WS_MEMH = 66 * MiB, WS_MEMKV = 74 * MiB, WS_SS = 90 * MiB, WS_BA = 92 * MiB, WS_GATES = 93 * MiB, WS_CK = 99 * MiB, WS_CV = 100 * MiB;
constexpr size_t WS_P01K = 101 * MiB, WS_P01V = 109 * MiB, WS_POOLW = 117 * MiB;
#define Y_BASE(P)   ((unsigned char*)(P).out)
#define QXA_BASE(P) ((unsigned char*)(P).out + 64 * MiB)
constexpr size_t WS_Z = 120 * MiB, WS_Y = 280 * MiB, WS_QXA = 344 * MiB, WS_XH = 408 * MiB, WS_HMID = 120 * MiB, WS_END = 491 * MiB;
constexpr size_t KV_KIND = (size_t)T * 256;

struct Params { const float* in[N_IN]; float* out; unsigned char* ws; int ph_lo, ph_hi; };

__device__ __forceinline__ float bf2f(unsigned v) { return __uint_as_float(v << 16); }
__device__ __forceinline__ unsigned f2bf(float f) { unsigned u = __float_as_uint(f); return (u + 0x7fffu + ((u >> 16) & 1u)) >> 16; }
__device__ __forceinline__ unsigned pk2(float lo, float hi) { return f2bf(lo) | (f2bf(hi) << 16); }
__device__ __forceinline__ float wave_sum(float v) {
#pragma unroll
    for (int o = 1; o < 64; o <<= 1) v += __shfl_xor(v, o);
    return v;
}
__device__ __forceinline__ float wave_max(float v) {
#pragma unroll
    for (int o = 1; o < 64; o <<= 1) v = fmaxf(v, __shfl_xor(v, o));
    return v;
}
__device__ __forceinline__ float silu_f(float x) { return x / (1.f + __expf(-x)); }
__device__ __forceinline__ float sigmoid_f(float x) { return 1.f / (1.f + __expf(-x)); }
#define LDS_WAIT() asm volatile("s_waitcnt lgkmcnt(0)" ::: "memory")

__device__ __forceinline__ void transpose_item(const float* W, int K, int N, int ld, const float* gain, bf16* WT, int row_off, LAS float* scr, int item, int lane) {
    const int nblk = N / 32, kb = item / nblk, nb = item % nblk, k0 = 64 * kb, n0 = 32 * nb;
#pragma unroll
    for (int i = 0; i < 8; ++i) { const int kk = 8 * i + (lane >> 3), nn = (lane & 7) * 4; f32x4 v = __builtin_nontemporal_load((const f32x4*)(W + (size_t)(k0 + kk) * ld + n0 + nn)); if (gain) v = v * gain[k0 + kk];
        scr[kk * 33 + nn] = v.x; scr[kk * 33 + nn + 1] = v.y; scr[kk * 33 + nn + 2] = v.z; scr[kk * 33 + nn + 3] = v.w; }
    LDS_WAIT();
    const int c = lane & 7;
#pragma unroll
    for (int j = 0; j < 4; ++j) { const int n = (lane >> 3) + 8 * j; const LAS float* s = scr + (8 * c) * 33 + n;
        v4u o; o.x = pk2(s[0 * 33], s[1 * 33]); o.y = pk2(s[2 * 33], s[3 * 33]); o.z = pk2(s[4 * 33], s[5 * 33]); o.w = pk2(s[6 * 33], s[7 * 33]);
        *(v4u*)(WT + (size_t)(row_off + n0 + n) * K + k0 + 8 * c) = o; }
    LDS_WAIT();
}
#define TJOB(W_, K_, N_, LD_, G_, WT_, RO_) { const int ni_ = ((K_) / 64) * ((N_) / 32); if (r < ni_) { transpose_item((W_), (K_), (N_), (LD_), (G_), (WT_), (RO_), scr, r, lane); continue; } r -= ni_; }

__device__ __forceinline__ void phase_prologue(const Params& P, LAS unsigned char* lds) {
    int tid_l = threadIdx.x; asm volatile("" : "+v"(tid_l)); const int tid = tid_l, lane = tid & 63, wave = tid >> 6;
    constexpr int NSMALL = 32; const bool small_role = (int)blockIdx.x >= (int)gridDim.x - NSMALL;
    const int gw = small_role ? 0x40000000 : (int)blockIdx.x * NWAVES + wave, NGW = ((int)gridDim.x - NSMALL) * NWAVES;
    unsigned char* ws = P.ws;
    LAS float* scr = (LAS float*)(lds + wave * 16384);
    constexpr int NITEMS = 1280 + 512 + 1280 + 512 + 4 * 512 + 512 + 2048 + 2048 + 4 * 64;
    for (int it = gw; it < NITEMS; it += NGW) {
        int r = it;
        TJOB(P.in[I_A_WIN], 1024, 2560, 2568, P.in[I_A_LN], (bf16*)(ws + WS_AIN), 0)
        TJOB(P.in[I_A_WOUT], 1024, 1024, 1024, nullptr, (bf16*)(ws + WS_AOUT), 0)
        TJOB(P.in[I_C_WIN], 1024, 2560, 2608, P.in[I_C_LN], (bf16*)(ws + WS_CIN), 0)
        TJOB(P.in[I_XA_WQ], 1024, 1024, 1024, P.in[I_XA_LN], (bf16*)(ws + WS_XQ), 0)
        TJOB(P.in[I_XA_WK], 1024, 1024, 1024, P.in[I_XA_MLN], (bf16*)(ws + WS_XKV), 0)
        TJOB(P.in[I_XA_WV], 1024, 1024, 1024, P.in[I_XA_MLN], (bf16*)(ws + WS_XKV), 1024)
        TJOB(P.in[I_XA_WK] + 1048576, 1024, 1024, 1024, P.in[I_XA_MLN] + 1024, (bf16*)(ws + WS_XKV) + 2097152, 0)
        TJOB(P.in[I_XA_WV] + 1048576, 1024, 1024, 1024, P.in[I_XA_MLN] + 1024, (bf16*)(ws + WS_XKV) + 2097152, 1024)
        TJOB(P.in[I_XA_WO], 1024, 1024, 1024, nullptr, (bf16*)(ws + WS_XO), 0)
        TJOB(P.in[I_FF_W1], 1024, 4096, 4096, P.in[I_FF_LN], (bf16*)(ws + WS_F1), 0)
        TJOB(P.in[I_FF_W2], 4096, 1024, 1024, nullptr, (bf16*)(ws + WS_F2), 0)
        TJOB(P.in[I_C_W1K], 1024, 128, 128, nullptr, (bf16*)(ws + WS_CMPK), 0)
        TJOB(P.in[I_C_W1K] + 131072, 1024, 128, 128, nullptr, (bf16*)(ws + WS_CMPK), 128)
        TJOB(P.in[I_C_W1V], 1024, 128, 128, nullptr, (bf16*)(ws + WS_CMPV), 0)
        TJOB(P.in[I_C_W1V] + 131072, 1024, 128, 128, nullptr, (bf16*)(ws + WS_CMPV), 128)
    }
    const int gt = small_role ? ((int)blockIdx.x - ((int)gridDim.x - NSMALL)) * NTHR + tid : 0x40000000, NGT = NSMALL * NTHR; const int gws = gt >> 6;
    for (int i = gt; i < 56 * 1024; i += NGT) { const int j = i >> 10, kk = i & 1023;
        if (j < 8) ((bf16*)(ws + WS_AIN))[(size_t)(2560 + j) * 1024 + kk] = (bf16)f2bf(P.in[I_A_LN][kk] * P.in[I_A_WIN][(size_t)kk * 2568 + 2560 + j]);
        else ((bf16*)(ws + WS_CIN))[(size_t)(2560 + j - 8) * 1024 + kk] = (bf16)f2bf(P.in[I_C_LN][kk] * P.in[I_C_WIN][(size_t)kk * 2608 + 2560 + j - 8]); }
    for (int i = gt; i < (248 + 208) * 128; i += NGT) { const int row = i >> 7, pc = i & 127; const v4u z4 = {0u, 0u, 0u, 0u};
        if (row < 248) *(v4u*)((bf16*)(ws + WS_AIN) + (size_t)(2568 + row) * 1024 + pc * 8) = z4; else *(v4u*)((bf16*)(ws + WS_CIN) + (size_t)(2608 + row - 248) * 1024 + pc * 8) = z4; }
    for (int i = gt; i < 4 * 128 * 128; i += NGT) { const int g = i >> 14, d = (i >> 7) & 127, c = i & 127; ((bf16*)(ws + WS_POOLW))[i] = (bf16)f2bf(P.in[I_A_POOLW][(size_t)g * 16384 + c * 128 + d] * P.in[I_A_POOLS][g * 128 + d]); }
    if (gws < 256) { const int n = gws & 127; const float* pe = gws < 128 ? P.in[I_C_PEK] : P.in[I_C_PEV]; const float* w1 = gws < 128 ? P.in[I_C_W1K] : P.in[I_C_W1V];
        float s = 0.f;
#pragma unroll 8
        for (int j = 0; j < 32; ++j) { const int i = lane + 64 * j; s += pe[i] * w1[(size_t)i * 128 + n]; }
        s = wave_sum(s); if (lane == 0) ((float*)(ws + WS_CBIAS))[gws] = s; }
    { bf16* xh = (bf16*)(ws + WS_XH); float* ss = (float*)(ws + WS_SS);
      for (int m0 = gw; m0 < T; m0 += 4 * NGW) { f32x4 v[4][4];
#pragma unroll
          for (int u = 0; u < 4; ++u) { const int m = m0 + u * NGW; if (m < T) { const f32x4* xr = (const f32x4*)(P.in[I_X] + (size_t)m * DM) + lane;
#pragma unroll
                  for (int j = 0; j < 4; ++j) v[u][j] = __builtin_nontemporal_load(xr + 64 * j); } }
#pragma unroll
          for (int u = 0; u < 4; ++u) { const int m = m0 + u * NGW; if (m >= T) break; float s = 0.f;
#pragma unroll
              for (int j = 0; j < 4; ++j) s += (v[u][j].x * v[u][j].x + v[u][j].y * v[u][j].y) + (v[u][j].z * v[u][j].z + v[u][j].w * v[u][j].w);
              s = wave_sum(s);
              v2u* o8 = (v2u*)(xh + (size_t)m * DM) + lane;
#pragma unroll
              for (int j = 0; j < 4; ++j) { v2u w; w.x = pk2(v[u][j].x, v[u][j].y); w.y = pk2(v[u][j].z, v[u][j].w); o8[64 * j] = w; }
              if (lane < 16) ss[(size_t)m * 16 + lane] = lane == 0 ? s : 0.f; } } }
    { bf16* mh = (bf16*)(ws + WS_MEMH);
      for (int m = gw; m < 2048; m += NGW) { const f32x4* xr = (const f32x4*)(P.in[I_MEM] + (size_t)m * DM) + lane; f32x4 v[4]; float s = 0.f;
#pragma unroll
          for (int j = 0; j < 4; ++j) { v[j] = __builtin_nontemporal_load(xr + 64 * j); s += (v[j].x * v[j].x + v[j].y * v[j].y) + (v[j].z * v[j].z + v[j].w * v[j].w); }
          const float rs = rsqrtf(wave_sum(s) * (1.f / DM) + EPS);
          v2u* o8 = (v2u*)(mh + (size_t)m * DM) + lane;
#pragma unroll
          for (int j = 0; j < 4; ++j) { v2u w; w.x = pk2(v[j].x * rs, v[j].y * rs); w.y = pk2(v[j].z * rs, v[j].w * rs); o8[64 * j] = w; } } }
}

__device__ __forceinline__ void phase_conv_late(const Params& P, LAS unsigned char* lds, int gw, int NGW) {
    const int tid = threadIdx.x, lane = tid & 63, wave = tid >> 6; unsigned char* ws = P.ws;
    LAS float* scr = (LAS float*)(lds + wave * 16384);
    constexpr int NITEMS = 512 + 512 + 512 + 2048 + 2048;
    for (int it = gw; it < NITEMS; it += NGW) {
        int r = it;
        TJOB(P.in[I_C_WOUT], 1024, 1024, 1024, nullptr, (bf16*)(ws + WS_COUT), 0)
        TJOB(P.in[I_XA_WQ] + 1048576, 1024, 1024, 1024, P.in[I_XA_LN] + 1024, (bf16*)(ws + WS_XQ) + 1048576, 0)
        TJOB(P.in[I_XA_WO] + 1048576, 1024, 1024, 1024, nullptr, (bf16*)(ws + WS_XO) + 1048576, 0)
        TJOB(P.in[I_FF_W1] + 4194304, 1024, 4096, 4096, P.in[I_FF_LN] + 1024, (bf16*)(ws + WS_F1) + 4194304, 0)
        TJOB(P.in[I_FF_W2] + 4194304, 4096, 1024, 1024, nullptr, (bf16*)(ws + WS_F2) + 4194304, 0)
    }
}
__device__ __forceinline__ void phase_gates(const Params& P, LAS unsigned char* lds, int gw, int NGW, int rg0, int nrg) {
    const int tid = threadIdx.x, lane = tid & 63; unsigned char* ws = P.ws;
    const bf16* wg = (const bf16*)(ws + WS_CIN) + (size_t)2560 * 1024; const bf16* xh = (const bf16*)(ws + WS_XH); const float* ss = (const float*)(ws + WS_SS); float* gates = (float*)(ws + WS_GATES);
    for (int p = tid; p < 48 * 128; p += NTHR) *(LAS v4u*)(lds + p * 16) = *(const v4u*)(wg + (size_t)p * 8);
    __syncthreads();
    for (int rgl = gw; rgl < nrg; rgl += NGW) { const int t0 = (rg0 + rgl) * 16;
        f32x4 acc[3] = {{0.f, 0.f, 0.f, 0.f}, {0.f, 0.f, 0.f, 0.f}, {0.f, 0.f, 0.f, 0.f}};
        const bf16* ap = xh + (size_t)(t0 + (lane & 15)) * DM + 8 * (lane >> 4); LAS const unsigned char* bp = lds + (lane & 15) * 2048 + (lane >> 4) * 16;
#pragma unroll 4
        for (int ks = 0; ks < 32; ++ks) { const bf16x8 a = *(const bf16x8*)(ap + 32 * ks);
#pragma unroll
            for (int ct = 0; ct < 3; ++ct) acc[ct] = __builtin_amdgcn_mfma_f32_16x16x32_bf16(a, *(const LAS bf16x8*)(bp + ct * 32768 + ks * 64), acc[ct], 0, 0, 0); }
#pragma unroll
        for (int r = 0; r < 4; ++r) { const int t = t0 + 4 * (lane >> 4) + r; const float rs = pg8::row_rstd(ss, t);
#pragma unroll
            for (int ct = 0; ct < 3; ++ct) gates[(size_t)t * 48 + ct * 16 + (lane & 15)] = acc[ct][r] * rs; } }
    __syncthreads();
}
__device__ __forceinline__ void phase_final(const Params& P) {
    const int tid = threadIdx.x, lane = tid & 63, wave = tid >> 6;
    const int gw = blockIdx.x * NWAVES + wave, NGW = gridDim.x * NWAVES;
    const float* ss = (const float*)(P.ws + WS_SS); const bf16* xh = (const bf16*)(P.ws + WS_XH);
    for (int m = gw; m < T; m += NGW) { f32x4* orow = (f32x4*)(P.out + (size_t)m * DM); const f32x4* gr = (const f32x4*)P.in[I_FLN];
        const float rs = pg8::row_rstd(ss, m);
#pragma unroll
        for (int j = 0; j < 2; ++j) { const v4u p = __builtin_nontemporal_load((const v4u*)(xh + (size_t)m * DM + (j * 64 + lane) * 8)); const f32x4 g0 = gr[(j * 64 + lane) * 2], g1 = gr[(j * 64 + lane) * 2 + 1];
            __builtin_nontemporal_store((f32x4){bf2f(p.x & 0xffff) * rs * g0.x, bf2f(p.x >> 16) * rs * g0.y, bf2f(p.y & 0xffff) * rs * g0.z, bf2f(p.y >> 16) * rs * g0.w}, orow + (j * 64 + lane) * 2);
            __builtin_nontemporal_store((f32x4){bf2f(p.z & 0xffff) * rs * g1.x, bf2f(p.z >> 16) * rs * g1.y, bf2f(p.w & 0xffff) * rs * g1.z, bf2f(p.w >> 16) * rs * g1.w}, orow + (j * 64 + lane) * 2 + 1); } }
}
template <bool DYN> __device__ __forceinline__ void phase_pool(const Params& P, LAS unsigned char* lds) {
    int tid_l = threadIdx.x; asm volatile("" : "+v"(tid_l)); const int tid = tid_l, lane = tid & 63, wave = tid >> 6;
    const bool al = TEAM_A && gridDim.x == 256u; const int c_ = blockIdx.x;
    const int g = al ? (c_ >> 3) & 3 : c_ & 3, win = 2 << g, it0 = al ? (c_ & 7) * 256 + (c_ >> 3) : c_, its = al ? 32 : (int)gridDim.x, itn = al ? (c_ & 7) * 256 + 256 : 2048;
    const bf16* z = (const bf16*)(P.ws + WS_Z); bf16* y = (bf16*)(Y_BASE(P));
    LAS unsigned short* ur = (LAS unsigned short*)lds;
    LAS unsigned char* yp = lds + 20480;
    const int nt = wave & 3, mt = wave >> 2, q = lane & 31, h = lane >> 5;
    bf16x8 bfr[8];
    { const bf16* bt = (const bf16*)(P.ws + WS_POOLW) + (size_t)g * 16384 + (size_t)(nt * 32 + q) * 128 + 8 * h;
#pragma unroll
      for (int ks = 0; ks < 8; ++ks) bfr[ks] = *(const bf16x8*)(bt + 16 * ks); }
    v4u pre[3];
#define POOL_LOAD(it_) { const int t0_ = ((it_) >> 2) * 64, s0_ = t0_ & (SEQ - 1); _Pragma("unroll") for (int j = 0; j < 3; ++j) { const int p = tid + 512 * j, row = p >> 4, pc = p & 15; pre[j] = (v4u){0u, 0u, 0u, 0u}; \
        if (p < 79 * 16 && s0_ + row - 15 >= 0) pre[j] = __builtin_nontemporal_load((const v4u*)(z + (size_t)(t0_ + row - 15) * 2560 + g * 128 + pc * 8)); } }
    unsigned* qc = (unsigned*)(P.ws + 118 * MiB  ) + 14336 + 64 * ((c_ & 7) * 4 + g); volatile LAS unsigned* nx = (volatile LAS unsigned*)(lds + 147392   + 16); const int qb = (c_ & 7) * 256 + g;
    int it = it0, itnext = it0 + its;
    if (DYN) { if (tid == 0) nx[0] = __hip_atomic_fetch_add(qc, 2u, __ATOMIC_RELAXED, __HIP_MEMORY_SCOPE_AGENT); __syncthreads(); const int j0 = (int)nx[0]; __syncthreads();
        it = j0 < 64 ? qb + 4 * j0 : itn; itnext = j0 + 1 < 64 ? qb + 4 * (j0 + 1) : itn; }
    if (it < itn) POOL_LOAD(it)
    while (it < itn) { const int t0 = (it >> 2) * 64, s0 = t0 & (SEQ - 1); unsigned popped = 0u;
        if (DYN && tid == 0) popped = __hip_atomic_fetch_add(qc, 1u, __ATOMIC_RELAXED, __HIP_MEMORY_SCOPE_AGENT);
#pragma unroll
        for (int j = 0; j < 3; ++j) { const int p = tid + 512 * j; if (p < 79 * 16) *(LAS v4u*)(lds + (p >> 4) * 256 + (p & 15) * 16) = pre[j]; }
        __syncthreads();
        if (itnext < itn) POOL_LOAD(itnext)
        { const int c = tid & 127, tq = tid >> 7; float sum = 0.f;
          for (int j = 1; j < win; ++j) sum += bf2f(ur[(tq * 16 + 15 - j) * 128 + c]);
#pragma unroll 4
          for (int i = 0; i < 16; ++i) { const int tl = tq * 16 + i, s = s0 + tl; const float u = bf2f(ur[(tl + 15) * 128 + c]); sum += u;
              const float cnt = (float)((s + 1 < win) ? s + 1 : win);
              *(LAS unsigned short*)(yp + tl * 272 + c * 2) = (unsigned short)f2bf(sum / cnt - u);
              sum -= bf2f(ur[(tl + 16 - win) * 128 + c]); } }
        if (DYN && tid == 0) nx[0] = popped;
        __syncthreads();
        { f32x16 acc;
#pragma unroll
          for (int r = 0; r < 16; ++r) acc[r] = 0.f;
          LAS const unsigned char* ap = yp + (mt * 32 + q) * 272 + h * 16;
#pragma unroll
          for (int ks = 0; ks < 8; ++ks) acc = __builtin_amdgcn_mfma_f32_32x32x16_bf16(bfr[ks], *(const LAS bf16x8*)(ap + ks * 32), acc, 0, 0, 0);
          bf16* yo = y + (size_t)(t0 + mt * 32 + q) * DM + g * 128 + nt * 32 + 4 * h;
#pragma unroll
          for (int a = 0; a < 4; ++a) { v2u w; w.x = cvtpk(acc[4 * a], acc[4 * a + 1]); w.y = cvtpk(acc[4 * a + 2], acc[4 * a + 3]); *(v2u*)(yo + 8 * a) = w; } }
        { int itnn = itnext + its; if (DYN) { const int jn = (int)nx[0]; itnn = jn < 64 ? qb + 4 * jn : itn; } it = itnext; itnext = itnn; }
    }
#undef POOL_LOAD
    __syncthreads();
}
__device__ __forceinline__ void dn_naive_item(const Params& P, LAS unsigned char* lds, int item) {
    int tid_l = threadIdx.x; asm volatile("" : "+v"(tid_l)); const int tid = tid_l, lane = tid & 63, wave = tid >> 6; const int b = item >> 2, h = item & 3;
    const bf16* z = (const bf16*)(P.ws + WS_Z); bf16* y = (bf16*)(Y_BASE(P)); const float* ba = (const float*)(P.ws + WS_BA);
    LAS float* qs = (LAS float*)lds; LAS float* ks = qs + 8192; LAS float* vs = ks + 8192; LAS float* ot = vs + 8192; LAS float* bet = ot + 8192; LAS float* egs = bet + 64;
    const float* cw = P.in[I_A_CONV];
    const float a_exp = __expf(P.in[I_A_ALOG][h]), dtb = P.in[I_A_DTB][h];
    float Sreg[32];
#pragma unroll
    for (int i = 0; i < 32; ++i) Sreg[i] = 0.f;
    const int kq = tid & 3, dv = tid >> 2;
    for (int n = 0; n < 64; ++n) {
        const int sb = n * 64; const size_t rb = (size_t)b * SEQ;
        for (int idx = tid; idx < 64 * 384; idx += NTHR) { const int tl = idx / 384, cc = idx % 384, part = cc >> 7, d = cc & 127; const int ch = part * 512 + h * 128 + d, s = sb + tl; float a = 0.f;
#pragma unroll
            for (int kk = 0; kk < 4; ++kk) { const int sp = s - 3 + kk; if (sp >= 0) a += cw[kk * 1536 + ch] * bf2f(z[(rb + sp) * 2560 + 512 + ch]); }
            qs[part * 8192 + tl * 128 + d] = silu_f(a); }
        if (tid < 64) { const size_t t = rb + sb + tid; const float bl = ba[t * 8 + h], al = ba[t * 8 + 4 + h] + dtb; const float sp = al > 20.f ? al : log1pf(__expf(al));
            bet[tid] = sigmoid_f(bl); egs[tid] = __expf(-a_exp * sp); }
        __syncthreads();
        for (int r = wave * 16; r < wave * 16 + 16; ++r) { LAS float* row = qs + (r >> 6) * 8192 + (r & 63) * 128; const float a = row[lane], c2 = row[lane + 64];
            const float sc = rsqrtf(wave_sum(a * a + c2 * c2) + EPS); row[lane] = a * sc; row[lane + 64] = c2 * sc; }
        __syncthreads();
        for (int tl = 0; tl < 64; ++tl) {
            float kr[32], kS = 0.f;
#pragma unroll
            for (int i = 0; i < 8; ++i) { const f32x4 v = *(const LAS f32x4*)(ks + tl * 128 + kq * 32 + 4 * i); kr[4 * i] = v.x; kr[4 * i + 1] = v.y; kr[4 * i + 2] = v.z; kr[4 * i + 3] = v.w; }
#pragma unroll
            for (int i = 0; i < 32; ++i) kS += kr[i] * Sreg[i];
            kS += __shfl_xor(kS, 1); kS += __shfl_xor(kS, 2);
            const float e = egs[tl], cf = bet[tl] * (vs[tl * 128 + dv] - e * kS);
            float o = 0.f;
#pragma unroll
            for (int i = 0; i < 8; ++i) { const f32x4 qv = *(const LAS f32x4*)(qs + tl * 128 + kq * 32 + 4 * i);
                Sreg[4 * i] = e * Sreg[4 * i] + kr[4 * i] * cf; Sreg[4 * i + 1] = e * Sreg[4 * i + 1] + kr[4 * i + 1] * cf; Sreg[4 * i + 2] = e * Sreg[4 * i + 2] + kr[4 * i + 2] * cf; Sreg[4 * i + 3] = e * Sreg[4 * i + 3] + kr[4 * i + 3] * cf;
                o += (qv.x * Sreg[4 * i] + qv.y * Sreg[4 * i + 1]) + (qv.z * Sreg[4 * i + 2] + qv.w * Sreg[4 * i + 3]); }
            o += __shfl_xor(o, 1); o += __shfl_xor(o, 2);
            if (kq == 0) ot[tl * 128 + dv] = o * 0.08838834764831845f;
        }
        __syncthreads();
        for (int tl = wave * 8; tl < wave * 8 + 8; ++tl) { const float a = ot[tl * 128 + lane], c2 = ot[tl * 128 + lane + 64]; const float rs = rsqrtf(wave_sum(a * a + c2 * c2) * (1.f / 128.f) + EPS);
            const size_t t = rb + sb + tl; const float g0 = bf2f(z[t * 2560 + 2048 + h * 128 + lane]), g1 = bf2f(z[t * 2560 + 2048 + h * 128 + lane + 64]);
            y[t * DM + 512 + h * 128 + lane] = (bf16)f2bf(a * rs * P.in[I_A_ONORM][lane] * silu_f(g0));
            y[t * DM + 512 + h * 128 + lane + 64] = (bf16)f2bf(c2 * rs * P.in[I_A_ONORM][lane + 64] * silu_f(g1)); }
        __syncthreads();
    }
}

__device__ __forceinline__ void phase_xatt_naive(const Params& P, LAS unsigned char* lds, int l) {
    int tid_l = threadIdx.x; asm volatile("" : "+v"(tid_l)); const int tid = tid_l, lane = tid & 63, wave = tid >> 6;
    const int gw = blockIdx.x * NWAVES + wave, NGW = gridDim.x * NWAVES;
    const bf16* qx = (const bf16*)(QXA_BASE(P)); const bf16* kv = (const bf16*)(P.ws + WS_MEMKV) + (size_t)l * 2048 * 2048; bf16* y = (bf16*)(Y_BASE(P));
    LAS float* qf = (LAS float*)(lds + wave * 8192); LAS float* pw = qf + 1024;
    for (int t = gw; t < T; t += NGW) { const int b = t >> 12;
        { const v4u a = *(const v4u*)(qx + (size_t)t * DM + lane * 16), c = *(const v4u*)(qx + (size_t)t * DM + lane * 16 + 8); LAS float* d = qf + lane * 16;
          d[0] = bf2f(a.x & 0xffff); d[1] = bf2f(a.x >> 16); d[2] = bf2f(a.y & 0xffff); d[3] = bf2f(a.y >> 16); d[4] = bf2f(a.z & 0xffff); d[5] = bf2f(a.z >> 16); d[6] = bf2f(a.w & 0xffff); d[7] = bf2f(a.w >> 16);
          d[8] = bf2f(c.x & 0xffff); d[9] = bf2f(c.x >> 16); d[10] = bf2f(c.y & 0xffff); d[11] = bf2f(c.y >> 16); d[12] = bf2f(c.z & 0xffff); d[13] = bf2f(c.z >> 16); d[14] = bf2f(c.w & 0xffff); d[15] = bf2f(c.w >> 16); }
        LDS_WAIT();
        for (int hh = 0; hh < 4; ++hh) { float sc[4];
#pragma unroll
            for (int i = 0; i < 4; ++i) { const bf16* kr = kv + (size_t)(b * 256 + lane + 64 * i) * 2048 + hh * 256; float s = 0.f;
                for (int c8 = 0; c8 < 32; ++c8) { const v4u kk = *(const v4u*)(kr + c8 * 8); const f32x4 q0 = *(const LAS f32x4*)(qf + hh * 256 + c8 * 8), q1 = *(const LAS f32x4*)(qf + hh * 256 + c8 * 8 + 4);
                    s += (q0.x * bf2f(kk.x & 0xffff) + q0.y * bf2f(kk.x >> 16)) + (q0.z * bf2f(kk.y & 0xffff) + q0.w * bf2f(kk.y >> 16)) + (q1.x * bf2f(kk.z & 0xffff) + q1.y * bf2f(kk.z >> 16)) + (q1.z * bf2f(kk.w & 0xffff) + q1.w * bf2f(kk.w >> 16)); }
                sc[i] = s * 0.0625f; }
            const float mx = wave_max(fmaxf(fmaxf(sc[0], sc[1]), fmaxf(sc[2], sc[3])));
            float ps = 0.f;
#pragma unroll
            for (int i = 0; i < 4; ++i) { sc[i] = __expf(sc[i] - mx); ps += sc[i]; }
            const float inv = 1.f / wave_sum(ps);
#pragma unroll
            for (int i = 0; i < 4; ++i) pw[lane + 64 * i] = sc[i] * inv;
            LDS_WAIT();
            float o0 = 0.f, o1 = 0.f, o2 = 0.f, o3 = 0.f; const bf16* vb = kv + (size_t)(b * 256) * 2048 + 1024 + hh * 256 + lane * 4;
            for (int j = 0; j < 256; ++j) { const v2u vv = *(const v2u*)(vb + (size_t)j * 2048); const float p = pw[j];
                o0 += p * bf2f(vv.x & 0xffff); o1 += p * bf2f(vv.x >> 16); o2 += p * bf2f(vv.y & 0xffff); o3 += p * bf2f(vv.y >> 16); }
            v2u w; w.x = pk2(o0, o1); w.y = pk2(o2, o3); *(v2u*)(y + (size_t)t * DM + hh * 256 + lane * 4) = w;
            LDS_WAIT();
        }
    }
}

__device__ __forceinline__ void cmpfin_bg(const Params& P, LAS unsigned char* lds, int kvs, int bg) {
    const int tid = threadIdx.x, lane = tid & 63, wave = tid >> 6, q = lane & 31, h = lane >> 5;
    const float* p01 = (const float*)(P.ws + (kvs ? WS_P01V : WS_P01K)) + (size_t)bg * 256 * 256; const float* bias = (const float*)(P.ws + WS_CBIAS) + kvs * 128; const float* w2 = P.in[kvs ? I_C_W2V : I_C_W2K];
    bf16* outp = (bf16*)(P.ws + (kvs ? WS_CV : WS_CK)) + (size_t)bg * 256 * 64;
    LAS unsigned char* Hb = lds;
    LAS unsigned char* Wt = lds + 69632;
    for (int p = tid; p < 256 * 16; p += NTHR) { const int c = p >> 4, j0 = (p & 15) * 8; v4u w = {0u, 0u, 0u, 0u};
        if (c < 255) { const f32x4 a0 = *(const f32x4*)(p01 + (size_t)c * 256 + j0), a1 = *(const f32x4*)(p01 + (size_t)c * 256 + j0 + 4), b0 = *(const f32x4*)(p01 + (size_t)(c + 1) * 256 + 128 + j0), b1 = *(const f32x4*)(p01 + (size_t)(c + 1) * 256 + 128 + j0 + 4);
            const f32x4 c0 = *(const f32x4*)(bias + j0), c1 = *(const f32x4*)(bias + j0 + 4);
            w.x = cvtpk(silu_f(a0.x + b0.x + c0.x), silu_f(a0.y + b0.y + c0.y)); w.y = cvtpk(silu_f(a0.z + b0.z + c0.z), silu_f(a0.w + b0.w + c0.w));
            w.z = cvtpk(silu_f(a1.x + b1.x + c1.x), silu_f(a1.y + b1.y + c1.y)); w.w = cvtpk(silu_f(a1.z + b1.z + c1.z), silu_f(a1.w + b1.w + c1.w)); }
        *(LAS v4u*)(Hb + c * 272 + j0 * 2) = w; }
    for (int p = tid; p < 128 * 64; p += NTHR) { const int j = p >> 6, d = p & 63; *(LAS unsigned short*)(Wt + d * 272 + j * 2) = (unsigned short)f2bf(w2[p]); }
    __syncthreads();
#pragma unroll
    for (int dt = 0; dt < 2; ++dt) { f32x16 acc;
#pragma unroll
        for (int r = 0; r < 16; ++r) acc[r] = 0.f;
#pragma unroll
        for (int ks = 0; ks < 8; ++ks) acc = __builtin_amdgcn_mfma_f32_32x32x16_bf16(*(const LAS bf16x8*)(Wt + (dt * 32 + q) * 272 + ks * 32 + h * 16), *(const LAS bf16x8*)(Hb + (wave * 32 + q) * 272 + ks * 32 + h * 16), acc, 0, 0, 0);
        const int c = wave * 32 + q;
        if (c < 255) {
#pragma unroll
            for (int a = 0; a < 4; ++a) { v2u w; w.x = cvtpk(acc[4 * a], acc[4 * a + 1]); w.y = cvtpk(acc[4 * a + 2], acc[4 * a + 3]); *(v2u*)(outp + (size_t)c * 64 + dt * 32 + 8 * a + 4 * h) = w; } } }
    __syncthreads();
}
__device__ __forceinline__ void dot4(const bf16* kr, const LAS float* qf, float (&s)[4]) {
    s[0] = s[1] = s[2] = s[3] = 0.f;
#pragma unroll
    for (int c8 = 0; c8 < 8; ++c8) { const v4u kk = *(const v4u*)(kr + c8 * 8);
        const float k0 = bf2f(kk.x & 0xffff), k1 = bf2f(kk.x >> 16), k2 = bf2f(kk.y & 0xffff), k3 = bf2f(kk.y >> 16), k4 = bf2f(kk.z & 0xffff), k5 = bf2f(kk.z >> 16), k6 = bf2f(kk.w & 0xffff), k7 = bf2f(kk.w >> 16);
#pragma unroll
        for (int r = 0; r < 4; ++r) { const f32x4 q0 = *(const LAS f32x4*)(qf + r * 64 + c8 * 8), q1 = *(const LAS f32x4*)(qf + r * 64 + c8 * 8 + 4);
            s[r] += ((q0.x * k0 + q0.y * k1) + (q0.z * k2 + q0.w * k3)) + ((q1.x * k4 + q1.y * k5) + (q1.z * k6 + q1.w * k7)); } }
}
__device__ __forceinline__ void phase_nsa_naive(const Params& P, LAS unsigned char* lds) {
    int tid_l = threadIdx.x; asm volatile("" : "+v"(tid_l)); const int tid = tid_l, lane = tid & 63, wave = tid >> 6;
    const int gw = blockIdx.x * NWAVES + wave, NGW = gridDim.x * NWAVES;
    const bf16* qb = (const bf16*)(P.ws + WS_Z); const bf16* kvb = qb + (size_t)T * 1024;
    const bf16* ck = (const bf16*)(P.ws + WS_CK); const bf16* cv = (const bf16*)(P.ws + WS_CV);
    const float* gates = (const float*)(P.ws + WS_GATES); bf16* y = (bf16*)(Y_BASE(P));
    LAS float* qf = (LAS float*)(lds + wave * 8192); LAS float* pc = qf + 256; LAS float* ps = pc + 1024;
    for (int it = gw; it < 4 * T; it += NGW) {
        const int t = it & 4095, g = (it >> 12) & 3, b = it >> 14; const size_t tg = (size_t)b * SEQ + t; const int bg = b * 4 + g;
        float slope[4];
#pragma unroll
        for (int r = 0; r < 4; ++r) slope[r] = exp2f(-0.5f * (float)(g * 4 + r + 1));
#pragma unroll
        for (int r = 0; r < 4; ++r) qf[r * 64 + lane] = bf2f(qb[tg * 1024 + g * 256 + r * 64 + lane]);
        LDS_WAIT();
        const int ncv = t >= 31 ? ((t - 31) >> 4) + 1 : 0;
#pragma unroll 1
        for (int cc = 0; cc < 4; ++cc) { const int c = lane + 64 * cc; float s[4] = {0.f, 0.f, 0.f, 0.f};
            if (cc * 64 < ncv) dot4(ck + ((size_t)bg * 256 + c) * 64, qf, s);
#pragma unroll
            for (int r = 0; r < 4; ++r) pc[r * 256 + c] = c < ncv ? s[r] * 0.125f - slope[r] * (float)(t - (16 * c + 31)) : -INFINITY; }
        LDS_WAIT();
#pragma unroll 1
        for (int r = 0; r < 4; ++r) { float v0 = pc[r * 256 + lane], v1 = pc[r * 256 + lane + 64], v2 = pc[r * 256 + lane + 128], v3 = pc[r * 256 + lane + 192];
            const float mx = wave_max(fmaxf(fmaxf(v0, v1), fmaxf(v2, v3)));
            v0 = lane < ncv ? __expf(v0 - mx) : 0.f; v1 = lane + 64 < ncv ? __expf(v1 - mx) : 0.f; v2 = lane + 128 < ncv ? __expf(v2 - mx) : 0.f; v3 = lane + 192 < ncv ? __expf(v3 - mx) : 0.f;
            const float sm = wave_sum((v0 + v1) + (v2 + v3)); const float inv = ncv > 0 ? 1.f / sm : 0.f;
            pc[r * 256 + lane] = v0 * inv; pc[r * 256 + lane + 64] = v1 * inv; pc[r * 256 + lane + 128] = v2 * inv; pc[r * 256 + lane + 192] = v3 * inv; }
        LDS_WAIT();
        float osum[4];
        { float ocmp[4] = {0.f, 0.f, 0.f, 0.f};
          const bf16* cvp = cv + (size_t)bg * 256 * 64 + lane;
#pragma unroll 2
          for (int c = 0; c < ncv; ++c) { const float v = bf2f(cvp[c * 64]);
#pragma unroll
              for (int r = 0; r < 4; ++r) ocmp[r] += pc[r * 256 + c] * v; }
#pragma unroll
          for (int r = 0; r < 4; ++r) osum[r] = sigmoid_f(gates[tg * 48 + (g * 4 + r) * 3]) * ocmp[r]; }
        unsigned long long mask;
        { const int n = lane, cur = t >> 6; float imp = 0.f;
#pragma unroll
          for (int r = 0; r < 4; ++r) { const f32x4 v = *(const LAS f32x4*)(pc + r * 256 + 4 * n); imp += v.x + v.y + v.z + 0.5f * v.w; if (n > 0) imp += 0.5f * pc[r * 256 + 4 * n - 1]; }
          const bool forced = (n == 0) || (n == cur) || (n == cur - 1);
          const float val = forced ? 1e4f : (n <= cur ? imp : -1.f);
          int rank = 0;
#pragma unroll 4
          for (int m = 0; m < 64; ++m) { const float vm = __shfl(val, m); rank += (vm > val || (vm == val && m < n)) ? 1 : 0; }
          mask = __ballot(rank < 16 && n <= cur); }
#pragma unroll 1
        for (int br = 0; br < 2; ++br) {
            const bf16* kp = kvb + (size_t)(br == 0 ? 2 : 4) * KV_KIND + (size_t)bg * SEQ * 64; const bf16* vp = kvb + (size_t)(br == 0 ? 3 : 5) * KV_KIND + (size_t)bg * SEQ * 64;
            float m_[4] = {-INFINITY, -INFINITY, -INFINITY, -INFINITY}, l_[4] = {0.f, 0.f, 0.f, 0.f}, acc[4] = {0.f, 0.f, 0.f, 0.f};
            const int jlo = br == 0 ? 0 : (t >= 511 ? t - 511 : 0);
            unsigned long long todo = br == 0 ? mask : 0ull; int j0 = jlo & ~63;
#pragma unroll 1
            for (;;) {
                if (br == 0) { if (!todo) break; j0 = (__ffsll((long long)todo) - 1) * 64; todo &= todo - 1; } else { if (j0 > t) break; }
                const int j = j0 + lane; const bool valid = j >= jlo && j <= t;
                float s[4]; dot4(kp + (size_t)j * 64, qf, s);
#pragma unroll
                for (int r = 0; r < 4; ++r) { const float sv = valid ? s[r] * 0.125f - slope[r] * (float)(t - j) : -INFINITY; const float mn = fmaxf(m_[r], wave_max(sv));
                    const float p = valid ? __expf(sv - mn) : 0.f; const float f = __expf(m_[r] - mn); l_[r] = l_[r] * f + wave_sum(p); acc[r] *= f; m_[r] = mn; ps[r * 64 + lane] = p; }
                LDS_WAIT();
                const bf16* vr = vp + (size_t)j0 * 64 + lane;
#pragma unroll 2
                for (int jj = 0; jj < 64; jj += 4) { const float v0 = bf2f(vr[jj * 64]), v1 = bf2f(vr[(jj + 1) * 64]), v2 = bf2f(vr[(jj + 2) * 64]), v3 = bf2f(vr[(jj + 3) * 64]);
#pragma unroll
                    for (int r = 0; r < 4; ++r) { const f32x4 pv = *(const LAS f32x4*)(ps + r * 64 + jj); acc[r] += (pv.x * v0 + pv.y * v1) + (pv.z * v2 + pv.w * v3); } }
                LDS_WAIT();
                if (br == 1) j0 += 64;
            }
#pragma unroll
            for (int r = 0; r < 4; ++r) osum[r] += sigmoid_f(gates[tg * 48 + (g * 4 + r) * 3 + 1 + br]) * (acc[r] / l_[r]);
        }
#pragma unroll
        for (int r = 0; r < 4; ++r) y[tg * DM + g * 256 + r * 64 + lane] = (bf16)f2bf(osum[r]);
        LDS_WAIT();
    }
}
constexpr int NSA_KB = 0, NSA_VB = 18432, NSA_IMPA = 34816, NSA_IMPB = 51200, NSA_MASK = 67584, NSA_UNI = 68096;
constexpr float LOG2E_F = 1.4426950408889634f;

__device__ __forceinline__ float quad_sum(float x) {
    x += __int_as_float(__builtin_amdgcn_update_dpp(0, __float_as_int(x), 0xB1, 0xF, 0xF, true));
    x += __int_as_float(__builtin_amdgcn_update_dpp(0, __float_as_int(x), 0x4E, 0xF, 0xF, true));
    return x;
}
__device__ __forceinline__ void nsa_qk(f32x16& p0, f32x16& p1, LAS const unsigned char* kb, const bf16x8 (&qf)[4], int q, int h, const f32x16& init) {
    p0 = init; p1 = init;
#pragma unroll
    for (int ks = 0; ks < 4; ++ks) { const bf16x8 a0 = *(const LAS bf16x8*)(kb + q * 144 + ks * 32 + h * 16), a1 = *(const LAS bf16x8*)(kb + (q + 32) * 144 + ks * 32 + h * 16);
        p0 = __builtin_amdgcn_mfma_f32_32x32x16_bf16(a0, qf[ks], p0, 0, 0, 0); p1 = __builtin_amdgcn_mfma_f32_32x32x16_bf16(a1, qf[ks], p1, 0, 0, 0); }
}
template <bool CHECK> __device__ __forceinline__ void nsa_bias(f32x16& p0, f32x16& p1, float basef, float slopeK, float cst, float klo, float khi, int h) {
    const float C = 1.f; const float i0 = basef + 4.f * (float)h; const float t0v = fmaf(slopeK, i0, cst);
#pragma unroll
    for (int r = 0; r < 16; ++r) { const float off = (float)((r & 3) + 8 * (r >> 2));
        float v0 = fmaf(p0[r], C, fmaf(slopeK, off, t0v)), v1 = fmaf(p1[r], C, fmaf(slopeK, off + 32.f, t0v));
        if (CHECK) { const float x0 = i0 + off, x1 = i0 + off + 32.f; v0 = (x0 >= klo && x0 <= khi) ? v0 : -INFINITY; v1 = (x1 >= klo && x1 <= khi) ? v1 : -INFINITY; }
        p0[r] = v0; p1[r] = v1; }
}
__device__ __forceinline__ float nsa_rowmax(const f32x16& p0, const f32x16& p1) {
    float a = fmaxf(p0[0], p1[0]);
#pragma unroll
    for (int r = 1; r < 16; ++r) a = fmaxf(a, fmaxf(p0[r], p1[r]));
    return fmaxf(a, __shfl_xor(a, 32));
}
__device__ __forceinline__ void nsa_pv(f32x16 (&o)[2], const f32x16& p0, const f32x16& p1, LAS const unsigned char* vb, int lane, int h) {
    bf16x8 pk[4];
#pragma unroll
    for (int s = 0; s < 4; ++s) { v4u w;
        if (s < 2) { w.x = cvtpk(p0[8 * s + 0], p0[8 * s + 1]); w.y = cvtpk(p0[8 * s + 2], p0[8 * s + 3]); w.z = cvtpk(p0[8 * s + 4], p0[8 * s + 5]); w.w = cvtpk(p0[8 * s + 6], p0[8 * s + 7]); }
        else { w.x = cvtpk(p1[8 * (s - 2) + 0], p1[8 * (s - 2) + 1]); w.y = cvtpk(p1[8 * (s - 2) + 2], p1[8 * (s - 2) + 3]); w.z = cvtpk(p1[8 * (s - 2) + 4], p1[8 * (s - 2) + 5]); w.w = cvtpk(p1[8 * (s - 2) + 6], p1[8 * (s - 2) + 7]); }
        pk[s] = __builtin_bit_cast(bf16x8, w); }
    LAS const unsigned char* vp = vb + (4 * h + ((lane & 15) >> 2)) * 64 + ((lane >> 4) & 1) * 32 + (lane & 3) * 8;
#pragma unroll
    for (int dt = 0; dt < 2; ++dt)
#pragma unroll
        for (int s = 0; s < 4; ++s) { const v4i16 lo = __builtin_amdgcn_ds_read_tr16_b64_v4i16((LAS v4i16*)(vp + dt * 4096 + s * 1024)), hi = __builtin_amdgcn_ds_read_tr16_b64_v4i16((LAS v4i16*)(vp + dt * 4096 + s * 1024 + 512));
            const bf16x8 a = (bf16x8){lo[0], lo[1], lo[2], lo[3], hi[0], hi[1], hi[2], hi[3]};
            o[dt] = __builtin_amdgcn_mfma_f32_32x32x16_bf16(a, pk[s], o[dt], 0, 0, 0); }
}
__device__ __forceinline__ void nsa_online(f32x16& p0, f32x16& p1, float& m, float& l, f32x16 (&o)[2]) {
    const float mx = nsa_rowmax(p0, p1), mn = fmaxf(m, mx), mu = (mn == -INFINITY) ? 0.f : mn; const float f = __builtin_amdgcn_exp2f(m - mu);
    float sum = 0.f;
#pragma unroll
    for (int r = 0; r < 16; ++r) { p0[r] = __builtin_amdgcn_exp2f(p0[r] - mu); p1[r] = __builtin_amdgcn_exp2f(p1[r] - mu); sum += p0[r] + p1[r]; }
    l = l * f + sum; m = mn;
    if (__any(f != 1.f)) {
#pragma unroll
        for (int r = 0; r < 16; ++r) { o[0][r] *= f; o[1][r] *= f; } }
}

typedef float f2v __attribute__((ext_vector_type(2)));
__device__ __forceinline__ void nsa_fast(f32x16& p0, f32x16& p1, float c32, float t0v, float& m, float& l, f32x16 (&o)[2]) {
    float mx0 = p0[0], mx1 = p1[0];
#pragma unroll
    for (int r = 1; r < 16; r += 2) { mx0 = __builtin_fmaxf(__builtin_fmaxf(mx0, p0[r]), p0[r < 15 ? r + 1 : r]); mx1 = __builtin_fmaxf(__builtin_fmaxf(mx1, p1[r]), p1[r < 15 ? r + 1 : r]); }
    float mx = __builtin_fmaxf(mx0, mx1 + c32) + t0v; mx = __builtin_fmaxf(mx, __shfl_xor(mx, 32));
    const float mn = __builtin_fmaxf(m, mx), mu = (mn == -INFINITY) ? 0.f : mn; const float f = __builtin_amdgcn_exp2f(m - mu), d = mu - t0v, d1 = d - c32; const f2v d2 = {d, d}, d12 = {d1, d1};
    f2v s2 = {0.f, 0.f};
#pragma unroll
    for (int k = 0; k < 8; ++k) { f2v a = {p0[2 * k], p0[2 * k + 1]}, b = {p1[2 * k], p1[2 * k + 1]}; a = a - d2; b = b - d12;
        a.x = __builtin_amdgcn_exp2f(a.x); a.y = __builtin_amdgcn_exp2f(a.y); b.x = __builtin_amdgcn_exp2f(b.x); b.y = __builtin_amdgcn_exp2f(b.y);
        s2 = s2 + a; s2 = s2 + b; p0[2 * k] = a.x; p0[2 * k + 1] = a.y; p1[2 * k] = b.x; p1[2 * k + 1] = b.y; }
    l = l * f + (s2.x + s2.y); m = mn;
    if (__any(f != 1.f)) {
#pragma unroll
        for (int r = 0; r < 16; ++r) { o[0][r] *= f; o[1][r] *= f; } }
}
__device__ __forceinline__ void nsa_item(const Params& P, LAS unsigned char* lds, int bg, int tile) {
    int tid_l = threadIdx.x; asm volatile("" : "+v"(tid_l)); const int tid = tid_l, lane = tid & 63, wave = tid >> 6, q = lane & 31, h = lane >> 5;
    const int b = bg >> 2, g = bg & 3, t0 = tile * 64, cur = tile;
    const int tl = 8 * wave + (q >> 2), t = t0 + tl, r = q & 3; const size_t tg = (size_t)b * SEQ + t;
    const bf16* qb = (const bf16*)(P.ws + WS_Z); const bf16* kvb = qb + (size_t)T * 1024;
    const bf16* ckp = (const bf16*)(P.ws + WS_CK) + (size_t)bg * 256 * 64; const bf16* cvp = (const bf16*)(P.ws + WS_CV) + (size_t)bg * 256 * 64;
    const bf16* ksp = kvb + 2 * KV_KIND + (size_t)bg * SEQ * 64; const bf16* vsp = kvb + 3 * KV_KIND + (size_t)bg * SEQ * 64;
    const bf16* kwp = kvb + 4 * KV_KIND + (size_t)bg * SEQ * 64; const bf16* vwp = kvb + 5 * KV_KIND + (size_t)bg * SEQ * 64;
    const float* gp = (const float*)(P.ws + WS_GATES) + tg * 48 + (g * 4 + r) * 3;
    LAS float* impA = (LAS float*)(lds + NSA_IMPA); LAS float* impB = (LAS float*)(lds + NSA_IMPB);
    LAS unsigned long long* masks = (LAS unsigned long long*)(lds + NSA_MASK); LAS unsigned long long* uni = (LAS unsigned long long*)(lds + NSA_UNI);
    const int srow = tid >> 3, spc = tid & 7; const unsigned koff = srow * 144 + spc * 16, voff = (spc >> 2) * 4096 + srow * 64 + (spc & 3) * 16; const size_t goff = (size_t)srow * 64 + spc * 8;
    const float slope2 = exp2f(-0.5f * (float)(g * 4 + r + 1)) * LOG2E_F; const float tf = (float)t;
    bf16x8 qf[4];
#pragma unroll
    for (int ks = 0; ks < 4; ++ks) qf[ks] = *(const bf16x8*)(qb + tg * 1024 + g * 256 + r * 64 + 16 * ks + 8 * h);
    { const v4u z4 = {0u, 0u, 0u, 0u};
#pragma unroll
      for (int i = 0; i < 4; ++i) *(LAS v4u*)(lds + NSA_IMPA + (tid * 4 + i) * 16) = z4; }
    if (tid < 8) uni[tid] = 0ull;
    v4u kreg, vreg;
#define KBUF(i) (lds + NSA_KB + (i) * 9216)
#define VBUF(i) (lds + NSA_VB + (i) * 8192)
    f32x16 osum[2], o[2], p0, p1, bo0, zero16;
#pragma unroll
    for (int rr = 0; rr < 16; ++rr) zero16[rr] = 0.f;
    const int nct = (((t0 + 32) >> 4) >> 6) + 1;
    const float cmaxf = t >= 31 ? (float)((t - 31) >> 4) : -1.f; const float cstc = slope2 * (31.f - tf), slopec = 16.f * slope2;
    float m1 = -INFINITY, l1 = 0.f;
    kreg = *(const v4u*)(ckp + (size_t)(nct - 1) * 4096 + goff); *(LAS v4u*)(KBUF(0) + koff) = kreg; __syncthreads();
#pragma unroll 1
    for (int i = 0; i < nct; ++i) { const int ct = nct - 1 - i;
        if (i + 1 < nct) kreg = *(const v4u*)(ckp + (size_t)(ct - 1) * 4096 + goff);
        else { kreg = *(const v4u*)(ckp + (size_t)(nct - 1) * 4096 + goff); vreg = *(const v4u*)(cvp + (size_t)(nct - 1) * 4096 + goff); }
        nsa_qk(p0, p1, KBUF(i & 1), qf, q, h, zero16); nsa_bias<true>(p0, p1, (float)(ct * 64), slopec, cstc, 0.f, cmaxf, h);
        { const float mx = nsa_rowmax(p0, p1), mn = fmaxf(m1, mx), mu = (mn == -INFINITY) ? 0.f : mn; float sum = 0.f;
#pragma unroll
          for (int rr = 0; rr < 16; ++rr) sum += __builtin_amdgcn_exp2f(p0[rr] - mu) + __builtin_amdgcn_exp2f(p1[rr] - mu);
          l1 = l1 * __builtin_amdgcn_exp2f(m1 - mu) + sum; m1 = mn; }
        if (i + 1 < nct) *(LAS v4u*)(KBUF((i + 1) & 1) + koff) = kreg;
        __syncthreads(); }
    l1 += __shfl_xor(l1, 32);
    const float inv1 = l1 > 0.f ? 1.f / l1 : 0.f, mu1 = (m1 == -INFINITY) ? 0.f : m1;
#pragma unroll
    for (int rr = 0; rr < 16; ++rr) { o[0][rr] = 0.f; o[1][rr] = 0.f; }
    *(LAS v4u*)(KBUF(0) + koff) = kreg; *(LAS v4u*)(VBUF(0) + voff) = vreg; __syncthreads();
#pragma unroll 1
    for (int i = 0; i < nct; ++i) { const int ct = nct - 1 - i;
        if (i + 1 < nct) { kreg = *(const v4u*)(ckp + (size_t)(ct - 1) * 4096 + goff); vreg = *(const v4u*)(cvp + (size_t)(ct - 1) * 4096 + goff); }
        else { kreg = *(const v4u*)(ksp + (size_t)cur * 4096 + goff); vreg = *(const v4u*)(vsp + (size_t)cur * 4096 + goff); }
        nsa_qk(p0, p1, KBUF(i & 1), qf, q, h, zero16); nsa_bias<true>(p0, p1, (float)(ct * 64), slopec, cstc, 0.f, cmaxf, h);
#pragma unroll
        for (int rr = 0; rr < 16; ++rr) { p0[rr] = __builtin_amdgcn_exp2f(p0[rr] - mu1) * inv1; p1[rr] = __builtin_amdgcn_exp2f(p1[rr] - mu1) * inv1; }
#pragma unroll
        for (int a = 0; a < 4; ++a) {
            float A0 = quad_sum(p0[4 * a] + p0[4 * a + 1] + p0[4 * a + 2] + 0.5f * p0[4 * a + 3]), B0 = quad_sum(0.5f * p0[4 * a + 3]);
            float A1 = quad_sum(p1[4 * a] + p1[4 * a + 1] + p1[4 * a + 2] + 0.5f * p1[4 * a + 3]), B1 = quad_sum(0.5f * p1[4 * a + 3]);
            if (r == 0) { const int n0 = 16 * ct + 2 * a + h, n1 = n0 + 8; impA[tl * 64 + n0] = A0; impA[tl * 64 + n1] = A1; impB[tl * 64 + n0 + 1] = B0; if (n1 < 63) impB[tl * 64 + n1 + 1] = B1; } }
        nsa_pv(o, p0, p1, VBUF(i & 1), lane, h);
        if (i + 1 < nct) { *(LAS v4u*)(KBUF((i + 1) & 1) + koff) = kreg; *(LAS v4u*)(VBUF((i + 1) & 1) + voff) = vreg; }
        __syncthreads(); }
    { const float g0 = sigmoid_f(gp[0]);
#pragma unroll
      for (int rr = 0; rr < 16; ++rr) { osum[0][rr] = g0 * o[0][rr]; osum[1][rr] = g0 * o[1][rr]; } }
    if (cur < 16) {
        const int tkl = lane >> 3, part = lane & 7, tk = 8 * wave + tkl; const unsigned long long all = (2ull << cur) - 1ull; const unsigned byte = (unsigned)(all >> (8 * part)) & 0xffu;
        ((LAS unsigned char*)masks)[tk * 8 + part] = (unsigned char)byte; if (tid == 0) uni[0] = all; }
    else
    { const int tkl = lane >> 3, part = lane & 7, tk = 8 * wave + tkl; unsigned key[8];
      { const f32x4 a0 = *(const LAS f32x4*)(impA + tk * 64 + part * 8), a1 = *(const LAS f32x4*)(impA + tk * 64 + part * 8 + 4), b0 = *(const LAS f32x4*)(impB + tk * 64 + part * 8), b1 = *(const LAS f32x4*)(impB + tk * 64 + part * 8 + 4);
        const float im[8] = {a0.x + b0.x, a0.y + b0.y, a0.z + b0.z, a0.w + b0.w, a1.x + b1.x, a1.y + b1.y, a1.z + b1.z, a1.w + b1.w};
#pragma unroll
        for (int e2 = 0; e2 < 8; ++e2) { const int n = part * 8 + e2; const bool forced = (n == 0) || (n == cur) || (n == cur - 1); key[e2] = n <= cur ? (forced ? 0x7F000000u : __float_as_uint(im[e2]) + 1u) : 0u; } }
      unsigned Tk = 0u;
#pragma unroll 1
      for (int bb = 30; bb >= 0; --bb) { const unsigned cand = Tk | (1u << bb); int c = 0;
#pragma unroll
          for (int e2 = 0; e2 < 8; ++e2) c += key[e2] >= cand ? 1 : 0;
          c += __builtin_amdgcn_update_dpp(0, c, 0xB1, 0xF, 0xF, true); c += __builtin_amdgcn_update_dpp(0, c, 0x4E, 0xF, 0xF, true); c += __builtin_amdgcn_update_dpp(0, c, 0x141, 0xF, 0xF, true);
          Tk = c >= 16 ? cand : Tk; }
      int cg = 0, le = 0;
#pragma unroll
      for (int e2 = 0; e2 < 8; ++e2) { cg += key[e2] > Tk ? 1 : 0; le += key[e2] == Tk ? 1 : 0; }
      cg += __builtin_amdgcn_update_dpp(0, cg, 0xB1, 0xF, 0xF, true); cg += __builtin_amdgcn_update_dpp(0, cg, 0x4E, 0xF, 0xF, true); cg += __builtin_amdgcn_update_dpp(0, cg, 0x141, 0xF, 0xF, true);
      int incl = le;
#pragma unroll
      for (int o2 = 1; o2 < 8; o2 <<= 1) { const int v = __shfl_up(incl, o2, 8); if (part >= o2) incl += v; }
      int before = incl - le; const int need = 16 - cg; unsigned byte = 0u;
#pragma unroll
      for (int e2 = 0; e2 < 8; ++e2) { const bool eq = key[e2] == Tk; const bool selb = (key[e2] > Tk || (eq && before < need)) && (part * 8 + e2 <= cur); before += eq ? 1 : 0; byte |= selb ? (1u << e2) : 0u; }
      ((LAS unsigned char*)masks)[tk * 8 + part] = (unsigned char)byte;
      __hip_atomic_fetch_or(uni, (unsigned long long)byte << (8 * part), __ATOMIC_RELAXED, __HIP_MEMORY_SCOPE_WORKGROUP); }
    __syncthreads();
    unsigned long long todo = uni[0]; const unsigned long long mymask = masks[tl];
#define NSA_LOAD(kp_, vp_, n_) { kreg = *(const v4u*)((kp_) + (size_t)(n_) * 4096 + goff); vreg = *(const v4u*)((vp_) + (size_t)(n_) * 4096 + goff); }
#define NSA_STORE(i_) { *(LAS v4u*)(KBUF((i_) & 1) + koff) = kreg; *(LAS v4u*)(VBUF((i_) & 1) + voff) = vreg; }
#define NSA_FAST(i_, t0v_) { nsa_qk(p0, p1, KBUF((i_) & 1), qf, q, h, bo0); nsa_fast(p0, p1, 32.f * slope2, (t0v_), m, l, o); nsa_pv(o, p0, p1, VBUF((i_) & 1), lane, h); }
#define NSA_STEP(CHECK_, i_, basef_, cst_, klo_, khi_) { nsa_qk(p0, p1, KBUF((i_) & 1), qf, q, h, zero16); nsa_bias<CHECK_>(p0, p1, (basef_), slope2, (cst_), (klo_), (khi_), h); nsa_online(p0, p1, m, l, o); nsa_pv(o, p0, p1, VBUF((i_) & 1), lane, h); }
    {
        float m = -INFINITY, l = 0.f; const float cst = -slope2 * tf;
#pragma unroll
        for (int rr = 0; rr < 16; ++rr) { o[0][rr] = 0.f; o[1][rr] = 0.f; bo0[rr] = slope2 * (float)((rr & 3) + 8 * (rr >> 2)); }
        todo &= ~(1ull << cur);
        NSA_STORE(0) __syncthreads();
        int i = 0, nn = todo ? 63 - __clzll((long long)todo) : -1; if (nn >= 0) todo &= ~(1ull << nn);
        if (nn >= 0) NSA_LOAD(ksp, vsp, nn) else NSA_LOAD(kwp, vwp, tile)
        NSA_STEP(true, 0, (float)(cur * 64), cst, 0.f, tf)
        if (nn >= 0) NSA_STORE(1)
        __syncthreads();
#pragma unroll 1
        while (nn >= 0) { const int n = nn; ++i; nn = todo ? 63 - __clzll((long long)todo) : -1; if (nn >= 0) todo &= ~(1ull << nn);
            if (nn >= 0) NSA_LOAD(ksp, vsp, nn) else NSA_LOAD(kwp, vwp, tile)
            const bool sel = (mymask >> n) & 1ull;
            if (__builtin_amdgcn_ballot_w64(sel) != 0ull) { NSA_FAST(i, sel ? fmaf(slope2, (float)(n * 64 + 4 * h), cst) : -INFINITY) }
            if (nn >= 0) NSA_STORE(i + 1)
            __syncthreads(); }
        l += __shfl_xor(l, 32); const float gs = sigmoid_f(gp[1]) / l;
#pragma unroll
        for (int rr = 0; rr < 16; ++rr) { osum[0][rr] += gs * o[0][rr]; osum[1][rr] += gs * o[1][rr]; }
    }
    {
        float m = -INFINITY, l = 0.f; const float cst = -slope2 * tf;
#pragma unroll
        for (int rr = 0; rr < 16; ++rr) { o[0][rr] = 0.f; o[1][rr] = 0.f; }
        const int nw = tile < 8 ? tile + 1 : 9, nmid = nw < 8 ? nw : 8;
        NSA_STORE(0) __syncthreads();
        if (nw > 1) NSA_LOAD(kwp, vwp, tile - 1)
        NSA_STEP(true, 0, (float)(tile * 64), cst, 0.f, tf)
        if (nw > 1) NSA_STORE(1)
        __syncthreads();
#pragma unroll 1
        for (int i = 1; i < nmid; ++i) { const int jt = tile - i;
            if (i + 1 < nw) NSA_LOAD(kwp, vwp, jt - 1)
            NSA_FAST(i, fmaf(slope2, (float)(jt * 64 + 4 * h), cst))
            if (i + 1 < nw) NSA_STORE(i + 1)
            __syncthreads(); }
        if (nw == 9) { NSA_STEP(true, 8, (float)((tile - 8) * 64), cst, tf - 511.f, 1e9f) __syncthreads(); }
        l += __shfl_xor(l, 32); const float gs = sigmoid_f(gp[2]) / l;
#pragma unroll
        for (int rr = 0; rr < 16; ++rr) { osum[0][rr] += gs * o[0][rr]; osum[1][rr] += gs * o[1][rr]; }
    }
#undef NSA_LOAD
#undef NSA_STORE
#undef NSA_STEP
#undef NSA_FAST
    { bf16* yp = (bf16*)(Y_BASE(P)) + tg * DM + g * 256 + r * 64 + 4 * h;
#pragma unroll
      for (int dt = 0; dt < 2; ++dt)
#pragma unroll
          for (int a = 0; a < 4; ++a) { v2u w; w.x = cvtpk(osum[dt][4 * a], osum[dt][4 * a + 1]); w.y = cvtpk(osum[dt][4 * a + 2], osum[dt][4 * a + 3]); *(v2u*)(yp + dt * 32 + a * 8) = w; } }
#undef KBUF
#undef VBUF
}
__device__ __forceinline__ void phase_nsa(const Params& P, LAS unsigned char* lds) {
    for (int it = blockIdx.x; it < 2048; it += gridDim.x) { const int rnd = it / 256, c = it % 256; const int bg = TEAM_B && gridDim.x == 256u ? (c & 7) * 4 + ((c >> 3) & 3) : c & 31, j = gridDim.x == 256u ? c >> 5 : c >> 5, tile = 63 - 8 * rnd - ((rnd & 1) ? 7 - j : j); nsa_item(P, lds, bg, tile); }
}

__device__ __forceinline__ void xatt_item(const Params& P, LAS unsigned char* lds, int l, int bh, int blk) {
    int tid_l = threadIdx.x; asm volatile("" : "+v"(tid_l)); const int tid = tid_l, lane = tid & 63, wave = tid >> 6, q = lane & 31, h = lane >> 5;
    const int b = bh >> 2, hh = bh & 3; const size_t t = (size_t)b * SEQ + blk * 256 + wave * 32 + q;
    const bf16* kvp = (const bf16*)(P.ws + WS_MEMKV) + (size_t)(b * 256) * 4096 + l * 2048 + hh * 256;
    const bf16* qp = (const bf16*)(QXA_BASE(P)) + t * DM + hh * 256 + 8 * h;
#pragma unroll
    for (int half = 0; half < 2; ++half) { v4u kr[8];
#pragma unroll
        for (int i = 0; i < 8; ++i) { const int p = tid + 512 * (half * 8 + i); kr[i] = *(const v4u*)(kvp + (size_t)(p >> 5) * 4096 + (p & 31) * 8); }
#pragma unroll
        for (int i = 0; i < 8; ++i) { const int p = tid + 512 * (half * 8 + i); *(LAS v4u*)(lds + (p >> 5) * 528 + (p & 31) * 16) = kr[i]; } }
    bf16x8 qf[16];
#pragma unroll
    for (int ks = 0; ks < 16; ++ks) qf[ks] = *(const bf16x8*)(qp + 16 * ks);
    __syncthreads();
    const float C = 0.0625f * LOG2E_F;
    v4u pk[16]; float m = 0.f, lsum = 0.f, f0 = 1.f;
#pragma unroll
    for (int half = 0; half < 2; ++half) {
        f32x16 s[4];
#pragma unroll
        for (int kt = 0; kt < 4; ++kt) {
#pragma unroll
            for (int r = 0; r < 16; ++r) s[kt][r] = 0.f;
            LAS const unsigned char* kb = lds + (half * 128 + kt * 32 + q) * 528 + h * 16;
#pragma unroll
            for (int ks = 0; ks < 16; ++ks) s[kt] = __builtin_amdgcn_mfma_f32_32x32x16_bf16(*(const LAS bf16x8*)(kb + ks * 32), qf[ks], s[kt], 0, 0, 0); }
        float mx = s[0][0];
#pragma unroll
        for (int kt = 0; kt < 4; ++kt)
#pragma unroll
            for (int r = 0; r < 16; ++r) mx = fmaxf(mx, s[kt][r]);
        mx = fmaxf(mx, __shfl_xor(mx, 32)) * C;
        const float mn = half == 0 ? mx : fmaxf(m, mx);
        if (half == 1) { f0 = __builtin_amdgcn_exp2f(m - mn); lsum *= f0; }
        m = mn;
        float sum = 0.f;
#pragma unroll
        for (int kt = 0; kt < 4; ++kt) {
#pragma unroll
            for (int r = 0; r < 16; ++r) { s[kt][r] = __builtin_amdgcn_exp2f(fmaf(s[kt][r], C, -mn)); sum += s[kt][r]; }
#pragma unroll
            for (int e = 0; e < 2; ++e) { v4u w; w.x = cvtpk(s[kt][8 * e + 0], s[kt][8 * e + 1]); w.y = cvtpk(s[kt][8 * e + 2], s[kt][8 * e + 3]); w.z = cvtpk(s[kt][8 * e + 4], s[kt][8 * e + 5]); w.w = cvtpk(s[kt][8 * e + 6], s[kt][8 * e + 7]); pk[half * 8 + kt * 2 + e] = w; } }
        lsum += sum;
    }
    lsum += __shfl_xor(lsum, 32); const float invl = 1.f / lsum;
    __syncthreads();
#pragma unroll
    for (int c = 0; c < 2; ++c) { v4u vr[8];
#pragma unroll
        for (int i = 0; i < 8; ++i) { const int p = tid + 512 * i; vr[i] = *(const v4u*)(kvp + 1024 + (size_t)(p >> 4) * 4096 + c * 128 + (p & 15) * 8); }
#pragma unroll
        for (int i = 0; i < 8; ++i) { const int p = tid + 512 * i; *(LAS v4u*)(lds + c * 65536 + ((p & 15) >> 2) * 16384 + (p >> 4) * 64 + (p & 3) * 16) = vr[i]; } }
    __syncthreads();
    bf16* yp = (bf16*)(Y_BASE(P)) + t * DM + hh * 256 + 4 * h;
    LAS const unsigned char* vp = lds + (4 * h + ((lane & 15) >> 2)) * 64 + ((lane >> 4) & 1) * 32 + (lane & 3) * 8;
#pragma unroll 1
    for (int dt = 0; dt < 8; ++dt) { f32x16 o;
#pragma unroll
        for (int r = 0; r < 16; ++r) o[r] = 0.f;
        LAS const unsigned char* vd = vp + dt * 16384;
#pragma unroll
        for (int s = 0; s < 8; ++s) { const v4i16 lo = __builtin_amdgcn_ds_read_tr16_b64_v4i16((LAS v4i16*)(vd + s * 1024)), hi = __builtin_amdgcn_ds_read_tr16_b64_v4i16((LAS v4i16*)(vd + s * 1024 + 512));
            o = __builtin_amdgcn_mfma_f32_32x32x16_bf16((bf16x8){lo[0], lo[1], lo[2], lo[3], hi[0], hi[1], hi[2], hi[3]}, __builtin_bit_cast(bf16x8, pk[s]), o, 0, 0, 0); }
#pragma unroll
        for (int r = 0; r < 16; ++r) o[r] *= f0;
#pragma unroll
        for (int s = 8; s < 16; ++s) { const v4i16 lo = __builtin_amdgcn_ds_read_tr16_b64_v4i16((LAS v4i16*)(vd + s * 1024)), hi = __builtin_amdgcn_ds_read_tr16_b64_v4i16((LAS v4i16*)(vd + s * 1024 + 512));
            o = __builtin_amdgcn_mfma_f32_32x32x16_bf16((bf16x8){lo[0], lo[1], lo[2], lo[3], hi[0], hi[1], hi[2], hi[3]}, __builtin_bit_cast(bf16x8, pk[s]), o, 0, 0, 0); }
#pragma unroll
        for (int a = 0; a < 4; ++a) { v2u w; w.x = cvtpk(o[4 * a] * invl, o[4 * a + 1] * invl); w.y = cvtpk(o[4 * a + 2] * invl, o[4 * a + 3] * invl); *(v2u*)(yp + dt * 32 + a * 8) = w; } }
    __syncthreads();
}
__device__ __forceinline__ void phase_xatt(const Params& P, LAS unsigned char* lds, int l) {
    for (int it = blockIdx.x; it < 512; it += gridDim.x) { const int c = it % 256, k = it / 256; xatt_item(P, lds, l, c & 31, (c >> 5) + 8 * k); }
}

constexpr size_t WS_DN = 280 * MiB, WS_DN7 = 472 * MiB, DN_CHUNK_BYTES = 73728, WS_EGL = 490 * MiB;
__device__ __forceinline__ size_t dn_off(int bh) { return bh < 28 ? WS_DN + (size_t)bh * 64 * 73728 : WS_DN7 + (size_t)(bh - 28) * 64 * 73728; }
constexpr int DNA_RHS = 0, DNA_QB = 65536, DNA_KB = 82944, DNA_AM = 100352, DNA_SSQ = 118784, DNA_GC = 126976;
__device__ __forceinline__ void dna_item(const Params& P, LAS unsigned char* lds, int item) {
    int tid_l = threadIdx.x; asm volatile("" : "+v"(tid_l)); const int tid = tid_l, lane = tid & 63, wave = tid >> 6;
    const int bh = item >> 6, n = item & 63, b = bh >> 2, h = bh & 3, sb = n * 64; const size_t rb = (size_t)b * SEQ;
    const bf16* z = (const bf16*)(P.ws + WS_Z); const float* ba = (const float*)(P.ws + WS_BA); const float* cw = P.in[I_A_CONV];
    unsigned char* ob = P.ws + dn_off(bh) + (size_t)n * DN_CHUNK_BYTES;
    LAS float* rhs = (LAS float*)(lds + DNA_RHS); LAS float* Am = (LAS float*)(lds + DNA_AM); LAS float* ssq = (LAS float*)(lds + DNA_SSQ);
    LAS float* gcs = (LAS float*)(lds + DNA_GC); LAS float* bet = gcs + 64; LAS float* egc = gcs + 128; LAS float* ekd = gcs + 192;
    const float SC = 0.08838834764831845f;
    { const int gd = tid & 15, tq = tid >> 4, d0 = gd * 8;
      f32x4 wa[3][4][2]; v4u za[3][2][4];
#pragma unroll
      for (int part = 0; part < 3; ++part) { const int ch0 = part * 512 + h * 128 + d0;
#pragma unroll
          for (int kk = 0; kk < 4; ++kk) { wa[part][kk][0] = *(const f32x4*)(cw + kk * 1536 + ch0); wa[part][kk][1] = *(const f32x4*)(cw + kk * 1536 + ch0 + 4); }
#pragma unroll
          for (int tt = 0; tt < 2; ++tt)
#pragma unroll
              for (int kk = 0; kk < 4; ++kk) { const int sp = sb + tq + 32 * tt - 3 + kk; za[part][tt][kk] = (v4u){0u, 0u, 0u, 0u}; if (sp >= 0) za[part][tt][kk] = *(const v4u*)(z + (rb + sp) * 2560 + 512 + ch0); } }
      __builtin_amdgcn_sched_barrier(0);
    if (wave == 0) { const size_t t = rb + sb + lane; const float bl = ba[t * 8 + h], al = ba[t * 8 + 4 + h] + P.in[I_A_DTB][h]; const float sp = al > 20.f ? al : log1pf(__expf(al));
        float g = -__expf(P.in[I_A_ALOG][h]) * sp;
#pragma unroll
        for (int o = 1; o < 64; o <<= 1) { const float v = __shfl_up(g, o); if (lane >= o) g += v; }
        const float gl = __shfl(g, 63);
        gcs[lane] = g; bet[lane] = sigmoid_f(bl); egc[lane] = __expf(g); ekd[lane] = __expf(gl - g);
        if (lane == 63) ((float*)(P.ws + WS_EGL))[item] = __expf(g); }
      __syncthreads();
#pragma unroll
      for (int part = 0; part < 3; ++part) {
#pragma unroll
          for (int tt = 0; tt < 2; ++tt) { const int tl = tq + 32 * tt;
              float a[8];
#pragma unroll
              for (int e2 = 0; e2 < 8; ++e2) a[e2] = 0.f;
#pragma unroll
              for (int kk = 0; kk < 4; ++kk) { const v4u zv = za[part][tt][kk]; const f32x4 w0 = wa[part][kk][0], w1 = wa[part][kk][1];
                  a[0] += w0.x * bf2f(zv.x & 0xffff); a[1] += w0.y * bf2f(zv.x >> 16); a[2] += w0.z * bf2f(zv.y & 0xffff); a[3] += w0.w * bf2f(zv.y >> 16);
                  a[4] += w1.x * bf2f(zv.z & 0xffff); a[5] += w1.y * bf2f(zv.z >> 16); a[6] += w1.z * bf2f(zv.w & 0xffff); a[7] += w1.w * bf2f(zv.w >> 16); }
              float q2 = 0.f;
#pragma unroll
              for (int e2 = 0; e2 < 8; ++e2) { a[e2] = a[e2] * __builtin_amdgcn_rcpf(1.f + __builtin_amdgcn_exp2f(-LOG2E_F * a[e2])); q2 += a[e2] * a[e2]; }
              if (part < 2) {
                  q2 += __shfl_xor(q2, 1); q2 += __shfl_xor(q2, 2); q2 += __shfl_xor(q2, 4); q2 += __shfl_xor(q2, 8);
                  const float rs = rsqrtf(q2 + EPS);
#pragma unroll
                  for (int e2 = 0; e2 < 8; ++e2) a[e2] *= rs;
                  v4u wv; wv.x = cvtpk(a[0], a[1]); wv.y = cvtpk(a[2], a[3]); wv.z = cvtpk(a[4], a[5]); wv.w = cvtpk(a[6], a[7]);
                  *(LAS v4u*)(lds + (part == 0 ? DNA_QB : DNA_KB) + tl * 272 + d0 * 2) = wv;
                  if (part == 0) { const float f = SC * egc[tl]; v4u g4; g4.x = cvtpk(a[0] * f, a[1] * f); g4.y = cvtpk(a[2] * f, a[3] * f); g4.z = cvtpk(a[4] * f, a[5] * f); g4.w = cvtpk(a[6] * f, a[7] * f);
                      *(v4u*)(ob + 16384 + (((tl >> 4) * 4 + (d0 >> 5)) * 64 + (tl & 15) + 16 * ((d0 >> 3) & 3)) * 16) = g4; }
                  else { const float f = ekd[tl], fb = bet[tl] * egc[tl];
                      *(LAS f32x4*)(rhs + tl * 256 + d0) = (f32x4){a[0] * fb, a[1] * fb, a[2] * fb, a[3] * fb}; *(LAS f32x4*)(rhs + tl * 256 + d0 + 4) = (f32x4){a[4] * fb, a[5] * fb, a[6] * fb, a[7] * fb};
                      bf16* kd = (bf16*)(ob + 32768) + ((((d0 >> 4) * 2 + (tl >> 5)) * 64 + 16 * ((tl >> 3) & 3)) * 8) + (tl & 7);
#pragma unroll
                      for (int e2 = 0; e2 < 8; ++e2) kd[(((d0 & 15) + e2) * 8)] = (bf16)f2bf(a[e2] * f); } }
              else { const float fb = bet[tl];
                  *(LAS f32x4*)(rhs + tl * 256 + 128 + d0) = (f32x4){a[0] * fb, a[1] * fb, a[2] * fb, a[3] * fb}; *(LAS f32x4*)(rhs + tl * 256 + 128 + d0 + 4) = (f32x4){a[4] * fb, a[5] * fb, a[6] * fb, a[7] * fb}; } } } }
    __syncthreads();
    if (wave < 6) { const int isq = wave >= 3, jb = wave - 3 * isq, it = jb >= 1, jt = jb == 2; const int q = lane & 31, hh = lane >> 5;
        f32x16 d;
#pragma unroll
        for (int r = 0; r < 16; ++r) d[r] = 0.f;
        LAS const unsigned char* ap = lds + (isq ? DNA_QB : DNA_KB) + (it * 32 + q) * 272 + hh * 16; LAS const unsigned char* bp = lds + DNA_KB + (jt * 32 + q) * 272 + hh * 16;
#pragma unroll
        for (int ks = 0; ks < 8; ++ks) d = __builtin_amdgcn_mfma_f32_32x32x16_bf16(*(const LAS bf16x8*)(ap + ks * 32), *(const LAS bf16x8*)(bp + ks * 32), d, 0, 0, 0);
        const int j = jt * 32 + q; const float gj = gcs[j];
#pragma unroll
        for (int r = 0; r < 16; ++r) { const int i = it * 32 + (r & 3) + 8 * (r >> 2) + 4 * hh; const float dec = __expf(fminf(gcs[i] - gj, 0.f));
            if (!isq) Am[(j & 1) * 2304 + i * 36 + (j >> 1)] = i > j ? d[r] * bet[i] * dec : 0.f;
            else ((bf16*)(ob + 65536))[((((i >> 4) * 2 + (j >> 5)) * 64 + (i & 15) + 16 * ((j >> 3) & 3)) * 8) + (j & 7)] = (bf16)f2bf(i >= j ? d[r] * SC * dec : 0.f); } }
    else if (wave == 6) { const v4u z4 = {0u, 0u, 0u, 0u}; *(v4u*)(ob + 65536 + ((0 * 2 + 1) * 64 + lane) * 16) = z4; *(v4u*)(ob + 65536 + ((1 * 2 + 1) * 64 + lane) * 16) = z4; }
    __syncthreads();
    if (tid < 256) { const int cp = tid >> 1, par = tid & 1, c = 2 * cp; LAS const float* Ap = Am + par * 2304; f2v x[32];
#pragma unroll
      for (int jj = 0; jj < 32; ++jj) x[jj] = (f2v){0.f, 0.f};
      f32x4 ab[2][8]; f2v rb[2]; f2v xl[4] = {{0.f, 0.f}, {0.f, 0.f}, {0.f, 0.f}, {0.f, 0.f}};
      rb[0] = *(const LAS f2v*)(rhs + c);
      unsigned* wp = (unsigned*)((bf16*)ob + (((c >> 5) * 64 + 16 * ((c >> 3) & 3)) * 8) + (c & 7));
      const int dv = c - 128; unsigned char* up = ob + 49152 + (((dv >> 4) * 4) * 64 + (dv & 15)) * 8;
#pragma unroll
      for (int i = 0; i < 64; ++i) {
          if (i + 1 < 64) {
#pragma unroll
              for (int j4 = 0; j4 < ((i + 2) / 2 + 3) / 4; ++j4) ab[(i + 1) & 1][j4] = *(const LAS f32x4*)(Ap + (i + 1) * 36 + 4 * j4);
              rb[(i + 1) & 1] = *(const LAS f2v*)(rhs + (i + 1) * 256 + c); }
          __builtin_amdgcn_sched_barrier(0);
          f2v ac4[4] = {{0.f, 0.f}, {0.f, 0.f}, {0.f, 0.f}, {0.f, 0.f}};
#pragma unroll
          for (int jj = 0; jj < (i + 1) / 2; ++jj) { const float a = ab[i & 1][jj >> 2][jj & 3]; ac4[jj & 3] = ac4[jj & 3] + (f2v){a, a} * x[jj]; }
          f2v acc = (ac4[0] + ac4[1]) + (ac4[2] + ac4[3]);
          acc.x += __int_as_float(__builtin_amdgcn_update_dpp(0, __float_as_int(acc.x), 0xB1, 0xF, 0xF, true)); acc.y += __int_as_float(__builtin_amdgcn_update_dpp(0, __float_as_int(acc.y), 0xB1, 0xF, 0xF, true));
          const f2v xi = rb[i & 1] - acc;
          x[i >> 1] = ((i & 1) == par) ? xi : x[i >> 1];
          xl[i & 3] = xi;
          if (tid < 128) { if ((i & 1) == par) wp[(((i >> 4) * 4) * 64 + (i & 15)) * 4] = cvtpk(xi.x, xi.y); }
          else if ((i & 3) == 3 && ((i >> 2) & 1) == par) { v2u w0, w1; w0.x = cvtpk(xl[0].x, xl[1].x); w0.y = cvtpk(xl[2].x, xl[3].x); w1.x = cvtpk(xl[0].y, xl[1].y); w1.y = cvtpk(xl[2].y, xl[3].y);
              unsigned char* u0 = up + (((i >> 2) >> 2) * 64 + 16 * ((i >> 2) & 3)) * 8; *(v2u*)u0 = w0; *(v2u*)(u0 + 8) = w1; }
          __builtin_amdgcn_sched_barrier(0);
      } }
    __syncthreads();
}
__device__ __forceinline__ void phase_dna(const Params& P, LAS unsigned char* lds) {
    if (TEAM_A && gridDim.x == 256u) { const int c = blockIdx.x; for (int r = 0; r < 8; ++r) dna_item(P, lds, (c & 7) * 256 + (c >> 3) + 32 * r); }
    else for (int it = blockIdx.x; it < 2048; it += gridDim.x) dna_item(P, lds, it); }

typedef float f32x4v __attribute__((ext_vector_type(4)));
template <bool HI> struct DnFrag { bf16x8 m1[4]; bf16x8 x2[2]; bf16x8 kd[2]; float eg; };
template <bool HI> __device__ __forceinline__ void dnb_load(DnFrag<HI>& f, const unsigned char* base, const float* egl, int n, int wave, int lane, int sl) {
    const unsigned char* cb = base + (size_t)n * DN_CHUNK_BYTES; const int ct = wave & 3;
    const unsigned char* m1 = cb + (HI ? 16384 : 0) + ((ct * 4) * 64 + lane) * 16;
#pragma unroll
    for (int ks = 0; ks < 4; ++ks) f.m1[ks] = *(const bf16x8*)(m1 + ks * 1024);
#pragma unroll
    for (int ks = 0; ks < 2; ++ks) f.kd[ks] = *(const bf16x8*)(cb + 32768 + ((wave * 2 + ks) * 64 + lane) * 16);
    if (HI) {
#pragma unroll
        for (int ks = 0; ks < 2; ++ks) f.x2[ks] = *(const bf16x8*)(cb + 65536 + ((ct * 2 + ks) * 64 + lane) * 16); }
    else { const v2u uu = *(const v2u*)(cb + 49152 + ((sl * 4 + ct) * 64 + lane) * 8); f.x2[0] = __builtin_bit_cast(bf16x8, (v4u){uu.x, uu.y, 0u, 0u}); }
    f.eg = egl[n];
}
template <bool HI> __device__ __forceinline__ void dnb_loop(const unsigned char* base, const float* egl, bf16* yo, LAS unsigned char* lds, int wave, int lane, int sl) {
    const int ct = wave & 3; LAS unsigned char* St = lds; LAS unsigned char* vnT = lds + 4352;
    LAS const unsigned char* stb = St + (lane & 15) * 272 + (lane >> 4) * 16; LAS const unsigned char* vnb = vnT + (lane & 15) * 144 + (lane >> 4) * 16;
    f32x4v Sacc = {0.f, 0.f, 0.f, 0.f};
    DnFrag<HI> fr[4];
#pragma unroll
    for (int u = 0; u < 4; ++u) dnb_load<HI>(fr[u], base, egl, u, wave, lane, sl);
    __syncthreads();
#pragma unroll 1
    for (int n0 = 0; n0 < 64; n0 += 4) {
#pragma unroll
        for (int u = 0; u < 4; ++u) { const int n = n0 + u;
            f32x4v acc = {0.f, 0.f, 0.f, 0.f};
#pragma unroll
            for (int ks = 0; ks < 4; ++ks) acc = __builtin_amdgcn_mfma_f32_16x16x32_bf16(fr[u].m1[ks], *(const LAS bf16x8*)(stb + ks * 64), acc, 0, 0, 0);
            if (!HI) { const v4u uu = __builtin_bit_cast(v4u, fr[u].x2[0]); const float u0 = bf2f(uu.x & 0xffff), u1 = bf2f(uu.x >> 16), u2 = bf2f(uu.y & 0xffff), u3 = bf2f(uu.y >> 16);
                v2u w; w.x = cvtpk(u0 - acc[0], u1 - acc[1]); w.y = cvtpk(u2 - acc[2], u3 - acc[3]); *(LAS v2u*)(vnT + (lane & 15) * 144 + (16 * ct + 4 * (lane >> 4)) * 2) = w; }
            __syncthreads();
            const bf16x8 v0 = *(const LAS bf16x8*)(vnb), v1 = *(const LAS bf16x8*)(vnb + 64);
            if (HI) { acc = __builtin_amdgcn_mfma_f32_16x16x32_bf16(fr[u].x2[0], v0, acc, 0, 0, 0); acc = __builtin_amdgcn_mfma_f32_16x16x32_bf16(fr[u].x2[1], v1, acc, 0, 0, 0);
                bf16* yp = yo + (size_t)n * 64 * DM;
#pragma unroll
                for (int r = 0; r < 4; ++r) yp[(size_t)r * DM] = (bf16)f2bf(acc[r]); }
            Sacc = Sacc * fr[u].eg;
            Sacc = __builtin_amdgcn_mfma_f32_16x16x32_bf16(fr[u].kd[0], v0, Sacc, 0, 0, 0); Sacc = __builtin_amdgcn_mfma_f32_16x16x32_bf16(fr[u].kd[1], v1, Sacc, 0, 0, 0);
            { v2u w; w.x = cvtpk(Sacc[0], Sacc[1]); w.y = cvtpk(Sacc[2], Sacc[3]); *(LAS v2u*)(St + (lane & 15) * 272 + (16 * wave + 4 * (lane >> 4)) * 2) = w; }
            dnb_load<HI>(fr[u], base, egl, n + 4 < 64 ? n + 4 : 63, wave, lane, sl);
            __syncthreads();
        }
    }
}
__device__ __forceinline__ void phase_dnb(const Params& P, LAS unsigned char* lds) {
    int tid_l = threadIdx.x; asm volatile("" : "+v"(tid_l)); const int tid = tid_l, lane = tid & 63, wave = __builtin_amdgcn_readfirstlane(tid >> 6);
    const int x = blockIdx.x; if (x >= 256) return;
    const int xcd = x & 7, idx = x >> 3, bh = xcd * 4 + (idx >> 3), sl = idx & 7, b = bh >> 2, h = bh & 3, ct = wave & 3;
    const unsigned char* base = P.ws + dn_off(bh); const float* egl = (const float*)(P.ws + WS_EGL) + bh * 64;
    bf16* yo = (bf16*)(Y_BASE(P)) + ((size_t)b * SEQ + 16 * ct + 4 * (lane >> 4)) * DM + 512 + h * 128 + sl * 16 + (lane & 15);
    if (tid < 272) *(LAS v4u*)(lds + tid * 16) = (v4u){0u, 0u, 0u, 0u};
    if (wave < 4) dnb_loop<false>(base, egl, yo, lds, wave, lane, sl); else dnb_loop<true>(base, egl, yo, lds, wave, lane, sl);
}
__device__ __forceinline__ void phase_dnc(const Params& P, LAS unsigned char* lds) {
    int tid_l = threadIdx.x; asm volatile("" : "+v"(tid_l)); const int tid = tid_l, lane = tid & 63, wave = tid >> 6;
    const bool al = TEAM_A && gridDim.x == 256u;
    const int gw = al ? (int)(blockIdx.x >> 3) * NWAVES + wave : (int)blockIdx.x * NWAVES + wave, NGW = al ? 32 * NWAVES : (int)gridDim.x * NWAVES, TB = al ? (int)(blockIdx.x & 7) * SEQ : 0, TL = al ? SEQ : T;
    const bf16* z = (const bf16*)(P.ws + WS_Z) + (size_t)TB * 2560; bf16* y = (bf16*)(Y_BASE(P)) + (size_t)TB * DM;
    float on[8];
#pragma unroll
    for (int e = 0; e < 8; ++e) on[e] = P.in[I_A_ONORM][(lane & 15) * 8 + e];
    for (int it0 = gw; it0 < TL; it0 += 4 * NGW) {
        const int hh = lane >> 4, d0 = (lane & 15) * 8; v4u ov[4], gv[4];
#pragma unroll
        for (int u = 0; u < 4; ++u) { const int it = it0 + u * NGW; if (it < TL) { ov[u] = __builtin_nontemporal_load((const v4u*)(y + (size_t)it * DM + 512 + hh * 128 + d0)); gv[u] = __builtin_nontemporal_load((const v4u*)(z + (size_t)it * 2560 + 2048 + hh * 128 + d0)); } }
#pragma unroll
        for (int u = 0; u < 4; ++u) { const int it = it0 + u * NGW; if (it >= TL) break;
            float o[8] = {bf2f(ov[u].x & 0xffff), bf2f(ov[u].x >> 16), bf2f(ov[u].y & 0xffff), bf2f(ov[u].y >> 16), bf2f(ov[u].z & 0xffff), bf2f(ov[u].z >> 16), bf2f(ov[u].w & 0xffff), bf2f(ov[u].w >> 16)};
            const float g[8] = {bf2f(gv[u].x & 0xffff), bf2f(gv[u].x >> 16), bf2f(gv[u].y & 0xffff), bf2f(gv[u].y >> 16), bf2f(gv[u].z & 0xffff), bf2f(gv[u].z >> 16), bf2f(gv[u].w & 0xffff), bf2f(gv[u].w >> 16)};
            float s = 0.f;
#pragma unroll
            for (int e = 0; e < 8; ++e) s += o[e] * o[e];
            s += __shfl_xor(s, 1); s += __shfl_xor(s, 2); s += __shfl_xor(s, 4); s += __shfl_xor(s, 8);
            const float rs = rsqrtf(s * (1.f / 128.f) + EPS);
#pragma unroll
            for (int e = 0; e < 8; ++e) o[e] = o[e] * rs * on[e] * (g[e] * __builtin_amdgcn_rcpf(1.f + __builtin_amdgcn_exp2f(-LOG2E_F * g[e])));
            v4u w; w.x = cvtpk(o[0], o[1]); w.y = cvtpk(o[2], o[3]); w.z = cvtpk(o[4], o[5]); w.w = cvtpk(o[6], o[7]);
            *(v4u*)(y + (size_t)it * DM + 512 + hh * 128 + d0) = w; } }
    if (!(TEAM_A && gridDim.x == 256u)) phase_pool<false>(P, lds);
}

constexpr size_t WS_CTL = 118 * MiB; constexpr int CTL_BYTES = 65536, LDS_CTL_OFF = 147392;
#define XB_TMO      128
#define XB_XCNT(j)  (256  + 64 * (j))
#define XB_XSUB(j)  (1280 + 64 * (j))
#define XB_XGEN(j)  (2304 + 64 * (j))
#define XB_TOP      3328
#define XB_TOPGEN   3392
#define XCD_BAR_WORDS 3456
#define XB_SPIN_CAP (1u << 18)

__device__ __forceinline__ unsigned xb_ld(unsigned* p)              { return __hip_atomic_load(p, __ATOMIC_RELAXED, __HIP_MEMORY_SCOPE_AGENT); }
__device__ __forceinline__ unsigned xb_add(unsigned* p, unsigned v) { return __hip_atomic_fetch_add(p, v, __ATOMIC_RELAXED, __HIP_MEMORY_SCOPE_AGENT); }
__device__ __forceinline__ unsigned xb_xcc_id() { return (unsigned)__builtin_amdgcn_s_getreg((3 << 11) | 20) & 0xFu; }
#define XB_SPIN(cond, bar) do { unsigned _sp = 0; while (cond) { __builtin_amdgcn_s_sleep(1); \
    if ((++_sp & 255u) == 0u) { if (xb_ld(&(bar)[XB_TMO])) break; if (_sp > XB_SPIN_CAP) { atomicAdd(&(bar)[XB_TMO], 1u); break; } } } } while (0)

struct XcdBarrier {
    unsigned* bar; unsigned x;
    volatile LAS unsigned* st;
};

__device__ __forceinline__ XcdBarrier xcd_barrier_post(unsigned* bar, volatile LAS unsigned* st) {
    XcdBarrier b; b.bar = bar; b.x = xb_xcc_id(); b.st = st;
    if (threadIdx.x == 0) (void)xb_add(&bar[XB_XCNT(b.x)], 1u);
    return b;
}
__device__ __forceinline__ void xcd_barrier_complete(unsigned* bar, unsigned x, unsigned& nloc, unsigned& nx) {
    const unsigned G = gridDim.x * gridDim.y * gridDim.z;
    unsigned sum, cnt, mine, sp = 0u;
    for (;;) {
        sum = 0u; cnt = 0u; mine = 0u;
#pragma unroll
        for (unsigned j = 0; j < 16; ++j) { const unsigned c = xb_ld(&bar[XB_XCNT(j)]); sum += c; cnt += (c > 0u) ? 1u : 0u; mine = (j == x) ? c : mine; }
        if (sum == G) break;
        __builtin_amdgcn_s_sleep(1);
        if ((++sp & 255u) == 0u) { if (xb_ld(&bar[XB_TMO])) break; if (sp > XB_SPIN_CAP) { atomicAdd(&bar[XB_TMO], 1u); break; } }
    }
    nloc = mine > 0u ? mine : 1u; nx = cnt > 0u ? cnt : 1u;
}

__device__ __forceinline__ void xcd_barrier(const XcdBarrier& b) {
    asm volatile("s_waitcnt vmcnt(0)" ::: "memory");
    __syncthreads();
    if (threadIdx.x == 0) {
        unsigned* bar = b.bar;
        __builtin_amdgcn_s_waitcnt(0);
        unsigned nloc = b.st[0], nx = b.st[1];
        if (nloc == 0u) { xcd_barrier_complete(bar, b.x, nloc, nx); b.st[0] = nloc; b.st[1] = nx; }
        const unsigned old = xb_add(&bar[XB_XSUB(b.x)], 1u);
        const unsigned gen = old / nloc;
        if (old + 1u == (gen + 1u) * nloc) {
            __builtin_amdgcn_fence(__ATOMIC_RELEASE, "agent");
            asm volatile("s_waitcnt vmcnt(0)" ::: "memory");
            const unsigned og = xb_add(&bar[XB_TOP], 1u);
            const unsigned tg = og / nx;
            if (og + 1u == (tg + 1u) * nx) xb_add(&bar[XB_TOPGEN], 1u);
            else XB_SPIN(xb_ld(&bar[XB_TOPGEN]) == tg, bar);
            __builtin_amdgcn_fence(__ATOMIC_ACQUIRE, "agent");
            xb_add(&bar[XB_XGEN(b.x)], 1u);
            asm volatile("s_waitcnt vmcnt(0)" ::: "memory");
        } else {
            XB_SPIN(xb_ld(&bar[XB_XGEN(b.x)]) == gen, bar);
            __builtin_amdgcn_fence(__ATOMIC_ACQUIRE, "agent");
            asm volatile("s_waitcnt vmcnt(0)" ::: "memory");
        }
    }
    __syncthreads();
}

template <bool TEAM> __device__ __forceinline__ void grp_barrier(unsigned* bar, unsigned target, volatile LAS unsigned* same) {
    asm volatile("s_waitcnt vmcnt(0)" ::: "memory");
    __syncthreads();
    if (threadIdx.x == 0) {
        const unsigned c = blockIdx.x, g = TEAM ? 64u + (c & 7u) : (c & 7u) * 8u + ((c >> 3) & 7u); unsigned* gc = bar + 4096 + 64 * g;
        __builtin_amdgcn_s_waitcnt(0);
        unsigned sm = *same;
        if (sm == 0u) { const unsigned m = xb_ld(bar + 8960 + 64 * g); sm = (m & (m - 1u)) == 0u && m != 0u ? 1u : 2u; *same = sm; }
        if (sm != 1u) { __builtin_amdgcn_fence(__ATOMIC_RELEASE, "agent"); asm volatile("s_waitcnt vmcnt(0)" ::: "memory"); }
        (void)xb_add(gc, 1u);
        XB_SPIN(xb_ld(gc) < target, bar);
        __builtin_amdgcn_fence(__ATOMIC_ACQUIRE, "agent");
        asm volatile("s_waitcnt vmcnt(0)" ::: "memory");
    }
    __syncthreads();
}
constexpr int team_ordinal(int k) { return k == 1 ? 1 : k == 2 ? 2 : k == 3 ? 3 : k == 11 ? 4 : 0; }
constexpr int grp_ordinal(int k) { return k == 5 ? 1 : k == 6 ? 2 : k == 8 ? 3 : k == 9 ? 4 : k == 15 ? 5 : k == 16 ? 6 : k == 18 ? 7 : k == 19 ? 8 : 0; }

constexpr int LDS_RS_OFF = 131072;
template <class E> __device__ __forceinline__ void run_gemm(LAS unsigned char* lds, const bf16* A, const bf16* Bt, int M, int N, int K, const E& e, const float* ss = nullptr) {
    pg8::Gemm g{A, Bt, M, N, K}; pg8::StaticOrder So; So.init(M, N, (int)gridDim.x, (int)blockIdx.x);
    if (ss) { pg8::Unit u; LAS float* rs = (LAS float*)(lds + LDS_RS_OFF);
        for (int i = 0; So.next(i, u); ++i) { const int r = threadIdx.x; if (r < 256) rs[256 * i + r] = pg8::row_rstd(ss, u.pm * 256 + r); }
        __syncthreads(); }
    pg8::gemm_phase<E, pg8::StaticOrder, true, true>(lds, g, So, e);
}
constexpr int N_PHASES = 22;
#ifndef MK_PER_PHASE
#define MK_PER_PHASE 0
#endif

template <int ph> __device__ __forceinline__ void do_phase(const Params& P, LAS unsigned char* lds) {
    unsigned char* ws = P.ws;
    bf16* xh = (bf16*)(ws + WS_XH); float* ss = (float*)(ws + WS_SS); bf16* yb = (bf16*)(Y_BASE(P)); bf16* zb = (bf16*)(ws + WS_Z);
    if constexpr (ph == 0) phase_prologue(P, lds);
    else if constexpr (ph == 1) {
        pg8::Gemm g{xh, (const bf16*)(ws + WS_AIN), T, 2816, 1024, (const bf16*)(ws + WS_MEMH), (const bf16*)(ws + WS_XKV)};
        pg8::DualOrder So; So.init(T, 2816, 2048, 4096, (int)gridDim.x, (int)blockIdx.x);
        { pg8::Unit u; LAS float* rs = (LAS float*)(lds + LDS_RS_OFF);
          for (int i = 0; So.next(i, u); ++i) { const int r = threadIdx.x; if (r < 256 && u.kind == 0) rs[256 * i + r] = pg8::row_rstd(ss, u.pm * 256 + r); }
          __syncthreads(); }
        pg8::EpiDual<pg8::EpiInA, pg8::EpiBf<0>> e{{zb, (float*)(ws + WS_BA), (LAS float*)(lds + LDS_RS_OFF)}, {(bf16*)(ws + WS_MEMKV), 4096, nullptr, 1.f}};
        pg8::gemm_phase<pg8::EpiDual<pg8::EpiInA, pg8::EpiBf<0>>, pg8::DualOrder, true, true>(lds, g, So, e); }
    else if constexpr (ph == 2) phase_dna(P, lds);
    else if constexpr (ph == 3) { phase_dnb(P, lds); if (TEAM_A && gridDim.x == 256u) { __syncthreads(); phase_pool<true>(P, lds); } }
    else if constexpr (ph == 4) phase_dnc(P, lds);
    else if constexpr (ph == 11) { pg8::EpiInC e{zb, zb + (size_t)T * 1024, (float*)(ws + WS_GATES), (LAS float*)(lds + LDS_RS_OFF)}; run_gemm(lds, xh, (const bf16*)(ws + WS_CIN), T, 2560, 1024, e, ss);   }
    else if constexpr (ph == 12) { const int kvs = (int)blockIdx.x >> 5;
        if (kvs < 2) { pg8::EpiF32 e{(float*)(ws + (kvs ? WS_P01V : WS_P01K)), 256};
            pg8::Gemm g{zb + (size_t)T * 1024 + (size_t)kvs * KV_KIND, (const bf16*)(ws + (kvs ? WS_CMPV : WS_CMPK)), 8192, 256, 1024}; pg8::StaticOrder So; So.init(8192, 256, (int)gridDim.x, (int)blockIdx.x & 31);
            pg8::gemm_phase<pg8::EpiF32, pg8::StaticOrder, true, true>(lds, g, So, e);
            pg8::Unit u; So.next(0, u);
            asm volatile("s_waitcnt vmcnt(0)" ::: "memory"); __syncthreads(); if (threadIdx.x < 64) { __builtin_amdgcn_fence(__ATOMIC_ACQUIRE, "agent"); asm volatile("s_waitcnt vmcnt(0)" ::: "memory"); } __syncthreads();
            cmpfin_bg(P, lds, kvs, u.pm); }
        else { const int gwi = ((int)blockIdx.x - 64) * NWAVES + (int)(threadIdx.x >> 6), ngwi = ((int)gridDim.x - 64) * NWAVES;
            if (TEAM_B && gridDim.x == 256u) phase_gates(P, lds, (((int)blockIdx.x >> 3) - 8) * NWAVES + (int)(threadIdx.x >> 6), 24 * NWAVES, ((int)blockIdx.x & 7) * 256, 256);
            else phase_gates(P, lds, gwi, ngwi, 0, T / 16);
            phase_conv_late(P, lds, gwi, ngwi); } }
    else if constexpr (ph == 13) { }
    else if constexpr (ph == 14) phase_nsa(P, lds);
    else if constexpr (ph == 21) phase_final(P);
    else { constexpr int l = ph >= 15 ? 1 : 0, k = ph - (l ? 15 : 5);
        if constexpr (k == 1) {
            { pg8::EpiBf<0> e{(bf16*)(QXA_BASE(P)), 1024, (LAS float*)(lds + LDS_RS_OFF), 1.f}; run_gemm(lds, xh, (const bf16*)(ws + WS_XQ) + (size_t)l * 1048576, T, 1024, 1024, e, ss); }
            asm volatile("s_waitcnt vmcnt(0)" ::: "memory"); __syncthreads();
            if (threadIdx.x < 64) { __builtin_amdgcn_fence(__ATOMIC_ACQUIRE, "agent"); asm volatile("s_waitcnt vmcnt(0)" ::: "memory"); }
            __syncthreads();
            { pg8::StaticOrder So; So.init(T, 1024, (int)gridDim.x, (int)blockIdx.x); pg8::Unit u;
              for (int i = 0; So.next(i, u); ++i) xatt_item(P, lds, l, (u.pm >> 4) * 4 + u.pn, u.pm & 15); } }
        else if constexpr (k == 2) { }
        else if constexpr (k == 4) { pg8::EpiBf<1> e{(bf16*)(ws + WS_HMID), 4096, (LAS float*)(lds + LDS_RS_OFF), 1.f}; run_gemm(lds, xh, (const bf16*)(ws + WS_F1) + (size_t)l * 4194304, T, 4096, 1024, e, ss); }
        else { const bf16* A = k == 5 ? (const bf16*)(ws + WS_HMID) : yb; constexpr int K = k == 5 ? 4096 : 1024;
            const bf16* Bt = k == 0 ? (const bf16*)(ws + (l ? WS_COUT : WS_AOUT)) : k == 3 ? (const bf16*)(ws + WS_XO) + (size_t)l * 1048576 : (const bf16*)(ws + WS_F2) + (size_t)l * 4194304;
            { pg8::EpiRes<false> e{xh, ss, nullptr}; run_gemm(lds, A, Bt, T, 1024, K, e); } } }
}
__global__ void __launch_bounds__(NTHR, 2) trunk_fwd(Params P) {
    extern __shared__ __attribute__((aligned(16))) unsigned char lds_raw[];
    LAS unsigned char* lds = (LAS unsigned char*)lds_raw;
    cg::grid_group grid = cg::this_grid();
    const int lo = P.ph_lo, hi = P.ph_hi;
#ifndef PROBE_PH
#define PROBE_PH -1
#endif
    if (threadIdx.x < 4) ((LAS unsigned*)(lds + LDS_CTL_OFF))[threadIdx.x] = 0u;
    if (threadIdx.x == 0) { const unsigned c = blockIdx.x; (void)__hip_atomic_fetch_or((unsigned*)(P.ws + WS_CTL) + 8960 + 64 * ((c & 7u) * 8u + ((c >> 3) & 7u)), 1u << xb_xcc_id(), __ATOMIC_RELAXED, __HIP_MEMORY_SCOPE_AGENT);
        (void)__hip_atomic_fetch_or((unsigned*)(P.ws + WS_CTL) + 8960 + 64 * (64u + (c & 7u)), 1u << xb_xcc_id(), __ATOMIC_RELAXED, __HIP_MEMORY_SCOPE_AGENT); }
    __syncthreads();
    const XcdBarrier bar = xcd_barrier_post((unsigned*)(P.ws + WS_CTL), (volatile LAS unsigned*)(lds + LDS_CTL_OFF));
    if (P.ph_lo < 0) grid.sync();
    const bool grp_ok = gridDim.x == 256u;
#define SEAM(k) { if (grp_ordinal(k) && grp_ok) grp_barrier<false>(bar.bar, 4u * grp_ordinal(k), (volatile LAS unsigned*)(lds + LDS_CTL_OFF + 8)); \
                  else if (team_ordinal(k) && grp_ok) grp_barrier<true>(bar.bar, 32u * team_ordinal(k), (volatile LAS unsigned*)(lds + LDS_CTL_OFF + 12)); else xcd_barrier(bar); }
#define RUN(k) if (lo <= (k) && (k) < hi) { if ((k) == PROBE_PH) { do_phase<(k)>(P, lds); SEAM(k) } do_phase<(k)>(P, lds); if ((k) + 1 < hi) SEAM(k) }
    RUN(0) RUN(1) RUN(2) RUN(3) RUN(4) RUN(5) RUN(6) RUN(8) RUN(9) RUN(10) RUN(11) RUN(12) RUN(14) RUN(15) RUN(16) RUN(18) RUN(19) RUN(20) RUN(21)
#undef RUN
}

extern "C" void kernel_launch(void* const* d_in, const int* in_sizes, int n_in, void* d_out, int out_size, void* d_ws, size_t ws_size, hipStream_t stream) {
    static int grid = 0;
    if (grid == 0) {
        if (n_in != N_IN || in_sizes[0] != T * DM || out_size != T * DM || ws_size < WS_END) { fprintf(stderr, "kernel_launch: unexpected shapes (n_in %d, in0 %d, out %d, ws %zu)\n", n_in, n_in > 0 ? in_sizes[0] : -1, out_size, ws_size); grid = -1; return; }
        int dev = 0, cus = 0, per_cu = 0;
        if (hipGetDevice(&dev) != hipSuccess || hipDeviceGetAttribute(&cus, hipDeviceAttributeMultiprocessorCount, dev) != hipSuccess) { grid = -1; return; }
        if (hipFuncSetAttribute((const void*)trunk_fwd, hipFuncAttributeMaxDynamicSharedMemorySize, LDS_BYTES) != hipSuccess) { fprintf(stderr, "kernel_launch: hipFuncSetAttribute failed\n"); grid = -1; return; }
        if (hipOccupancyMaxActiveBlocksPerMultiprocessor(&per_cu, (const void*)trunk_fwd, NTHR, LDS_BYTES) != hipSuccess || per_cu < 1) { fprintf(stderr, "kernel_launch: occupancy query says %d blocks/CU\n", per_cu); (void)hipGetLastError(); grid = -1; return; }
        grid = cus;
        fprintf(stderr, "kernel_launch: %d CUs, %d blocks/CU by the occupancy query, grid %d\n", cus, per_cu, grid);
    }
    if (grid < 0) return;
    Params p{};
    for (int i = 0; i < N_IN; ++i) p.in[i] = (const float*)d_in[i];
    p.out = (float*)d_out; p.ws = (unsigned char*)d_ws;
#if MK_PER_PHASE
    for (int ph = 0; ph < N_PHASES; ++ph) { p.ph_lo = ph; p.ph_hi = ph + 1; hipLaunchKernelGGL(trunk_fwd, dim3(grid), dim3(NTHR), LDS_BYTES, stream, p); }
#else
    p.ph_lo = 0; p.ph_hi = N_PHASES;
    if (hipMemsetAsync((char*)d_ws + WS_CTL, 0, CTL_BYTES, stream) != hipSuccess) { fprintf(stderr, "kernel_launch: memset of the barrier words failed\n"); return; }
    void* args[] = {&p};
    hipError_t e = hipLaunchCooperativeKernel((const void*)trunk_fwd, dim3(grid), dim3(NTHR), args, LDS_BYTES, stream);
    if (e != hipSuccess) fprintf(stderr, "kernel_launch: cooperative launch failed: %s (grid %d)\n", hipGetErrorString(e), grid);
#endif
}
```
